# Optimizing an MI355X kernel written in HIP

```python
import jax, jax.numpy as jnp
from jax import lax
import numpy as np

D_MODEL = 2048
BATCH = 2
SEQ = 4096
DEPTH = 1
DEC_BATCH = 16
DEC_SEQ = 32
PAST_LEN = 4096

CHUNK = 64
Q_BLOCK = 128
EPS = 1e-6
POOL_WINDOWS = (2, 4, 8, 16)
N_POOL_GROUPS = 4
POOL_W = D_MODEL // 2
POOL_GW = POOL_W // N_POOL_GROUPS
POOL_OUT_GW = D_MODEL // N_POOL_GROUPS
POOL_STATE = max(POOL_WINDOWS) - 1
MLA_HEADS = 16
Q_LORA = 512
KV_LORA = 512
QK_NOPE = 128
QK_ROPE = 64
QK_HEAD = QK_NOPE + QK_ROPE
V_HEAD = 128
ROPE_THETA = 10000.0
MLA_SCALE = QK_HEAD ** -0.5
N_MEM = 256
MEM_HEADS = 4
MEM_HEAD_DIM = 256
MEM_W = MEM_HEADS * MEM_HEAD_DIM
MEM_SCALE = MEM_HEAD_DIM ** -0.5
N_BRANCH = 3
D_FF = 4 * D_MODEL
D_IN = POOL_W + Q_LORA + KV_LORA + QK_ROPE + MEM_W + N_BRANCH * D_MODEL

kernel_name = "hybrid_pool_mla_memory_stream_step"


def rmsnorm(x, g):
    xf = x.astype(jnp.float32)
    y = xf * lax.rsqrt(jnp.mean(xf * xf, axis=-1, keepdims=True) + EPS)
    return (y * g.astype(jnp.float32)).astype(x.dtype)


def rope(x, pos):
    half = QK_ROPE // 2
    inv = 1.0 / (ROPE_THETA ** (jnp.arange(half, dtype=jnp.float32) * (2.0 / QK_ROPE)))
    ang = pos.astype(jnp.float32)[:, None] * inv[None, :]
    cos = jnp.cos(ang)[:, None, :]
    sin = jnp.sin(ang)[:, None, :]
    xf = x.astype(jnp.float32)
    x1, x2 = xf[..., :half], xf[..., half:]
    out = jnp.concatenate([x1 * cos - x2 * sin, x2 * cos + x1 * sin], axis=-1)
    return out.astype(x.dtype)


def attend(q, k, v, scale, mask=None):
    s = jnp.einsum('bqhd,bkhd->bhqk', q, k).astype(jnp.float32) * scale
    if mask is not None:
        s = jnp.where(mask, s, -1e30)
    p = jax.nn.softmax(s, axis=-1).astype(v.dtype)
    return jnp.einsum('bhqk,bkhd->bqhd', p, v)


def chunk_attend(q, q_pos, k, v, k_pos):
    mask = (q_pos // CHUNK)[:, None] >= (k_pos // CHUNK)[None, :]
    return attend(q, k, v, MLA_SCALE, mask)


def split_in(z):
    sizes = (POOL_W, Q_LORA, KV_LORA, QK_ROPE, MEM_W, N_BRANCH * D_MODEL)
    parts, off = [], 0
    for s in sizes:
        parts.append(z[..., off:off + s])
        off += s
    return parts


def pool_branch(u, left, pos, w_pool, pool_scale):
    B, L, _ = u.shape
    xp = jnp.concatenate([left.astype(jnp.float32), u.astype(jnp.float32)], axis=1)
    cs = jnp.concatenate([jnp.zeros((B, 1, POOL_W), jnp.float32), jnp.cumsum(xp, axis=1)], axis=1)
    top = cs[:, POOL_STATE + 1:]
    means = []
    for g, win in enumerate(POOL_WINDOWS):
        sl = slice(g * POOL_GW, (g + 1) * POOL_GW)
        lo = POOL_STATE + 1 - win
        wsum = top[..., sl] - cs[:, lo:lo + L, sl]
        cnt = jnp.minimum(pos + 1, win).astype(jnp.float32)[None, :, None]
        means.append(wsum / cnt)
    d = jnp.concatenate(means, axis=-1) - u.astype(jnp.float32)
    d = d.astype(u.dtype).reshape(B, L, N_POOL_GROUPS, POOL_GW)
    y = jnp.einsum('blgc,gco->blgo', d, w_pool).reshape(B, L, D_MODEL)
    new_state = xp[:, -POOL_STATE:].astype(u.dtype)
    return y * pool_scale, new_state


def mla_queries(q_lat, pos, w):
    B, L, _ = q_lat.shape
    q = (rmsnorm(q_lat, w['g_q_lat']) @ w['w_qb']).reshape(B, L, MLA_HEADS, QK_HEAD)
    q = rmsnorm(q, w['g_q_head'])
    return jnp.concatenate([q[..., :QK_NOPE], rope(q[..., QK_NOPE:], pos)], axis=-1)


def mla_keys_values(c_kv, k_pe, pos, w):
    B, L, _ = c_kv.shape
    k_nope = (c_kv @ w['w_kb']).reshape(B, L, MLA_HEADS, QK_NOPE)
    kpe = jnp.broadcast_to(k_pe[:, :, None, :], (B, L, MLA_HEADS, QK_ROPE))
    k = rmsnorm(jnp.concatenate([k_nope, kpe], axis=-1), w['g_k_head'])
    k = jnp.concatenate([k[..., :QK_NOPE], rope(k[..., QK_NOPE:], pos)], axis=-1)
    v = (c_kv @ w['w_vb']).reshape(B, L, MLA_HEADS, V_HEAD)
    return k, v


def memory_kv(mem, w):
    B = mem.shape[0]
    m = rmsnorm(mem, w['g_mem']) @ w['w_mem_kv']
    k = rmsnorm(m[..., :MEM_W].reshape(B, N_MEM, MEM_HEADS, MEM_HEAD_DIM), w['g_mem_k'])
    v = m[..., MEM_W:].reshape(B, N_MEM, MEM_HEADS, MEM_HEAD_DIM)
    return k, v


def trunk_layer(x, pos, pool_left, mla_past, mem_k, mem_v, w):
    B, L, _ = x.shape
    h = rmsnorm(x, w['g_mix'])
    u, q_lat, kv_lat, k_pe, mq, gate_logits = split_in(h @ w['w_in'])
    y_pool, new_pool = pool_branch(u, pool_left, pos, w['w_pool'], w['pool_scale'])
    c_kv = rmsnorm(kv_lat, w['g_kv_lat'])
    q = mla_queries(q_lat, pos, w)
    if mla_past is None:
        k, v = mla_keys_values(c_kv, k_pe, pos, w)
        nb = L // Q_BLOCK
        qb = q.reshape(B, nb, Q_BLOCK, MLA_HEADS, QK_HEAD).transpose(1, 0, 2, 3, 4)
        pb = pos.reshape(nb, Q_BLOCK)
        o = lax.map(lambda a: chunk_attend(a[0], a[1], k, v, pos), (qb, pb))
        o = o.transpose(1, 0, 2, 3, 4).reshape(B, L, MLA_HEADS, V_HEAD)
    else:
        past_lat, past_kpe = mla_past
        n_past = past_lat.shape[1]
        all_lat = jnp.concatenate([past_lat, c_kv], axis=1)
        all_kpe = jnp.concatenate([past_kpe, k_pe], axis=1)
        k_pos = jnp.arange(n_past + L, dtype=jnp.int32)
        k, v = mla_keys_values(all_lat, all_kpe, k_pos, w)
        o = chunk_attend(q, pos, k, v, k_pos)
    y_mla = o.reshape(B, L, MLA_HEADS * V_HEAD) @ w['w_mla_o']
    qm = rmsnorm(mq.reshape(B, L, MEM_HEADS, MEM_HEAD_DIM), w['g_mem_q'])
    y_mem = attend(qm, mem_k, mem_v, MEM_SCALE).reshape(B, L, MEM_W) @ w['w_mem_o']
    gates = jax.nn.sigmoid((gate_logits + w['b_gate']).astype(jnp.float32)).astype(x.dtype)
    gates = gates.reshape(B, L, N_BRANCH, D_MODEL)
    merged = gates[:, :, 0] * y_pool + gates[:, :, 1] * y_mla + gates[:, :, 2] * y_mem
    x = x + merged @ w['w_out']
    f = rmsnorm(x, w['g_ff']) @ w['w_up']
    x = x + jnp.square(jax.nn.relu(f)) @ w['w_down']
    return x, c_kv, k_pe, new_pool


def setup_inputs(seed: int = 0) -> dict:
    key = jax.random.key(seed)
    ks = iter(jax.random.split(key, 40))
    f32 = jnp.float32

    def nrm(shape, scale=1.0):
        return jax.random.normal(next(ks), shape, f32) * scale

    def gain(n):
        return 1.0 + nrm((n,), 0.02)

    return {
        'x_prompt': nrm((BATCH, SEQ, D_MODEL)),
        'mem_prompt': nrm((BATCH, N_MEM, D_MODEL)),
        'x_sample': nrm((DEC_BATCH, DEC_SEQ, D_MODEL)),
        'cache_mla_latent': nrm((DEC_BATCH, PAST_LEN, KV_LORA)),
        'cache_mla_kpe': nrm((DEC_BATCH, PAST_LEN, QK_ROPE)),
        'state_pool': nrm((DEC_BATCH, POOL_STATE, POOL_W)),
        'cache_mem_k': nrm((DEC_BATCH, N_MEM, MEM_HEADS, MEM_HEAD_DIM)),
        'cache_mem_v': nrm((DEC_BATCH, N_MEM, MEM_HEADS, MEM_HEAD_DIM)),
        'g_mix': gain(D_MODEL),
        'w_in': nrm((D_MODEL, D_IN), D_MODEL ** -0.5),
        'b_gate': nrm((N_BRANCH * D_MODEL,), 0.01),
        'w_pool': nrm((N_POOL_GROUPS, POOL_GW, POOL_OUT_GW), POOL_GW ** -0.5),
        'pool_scale': gain(D_MODEL),
        'g_q_lat': gain(Q_LORA),
        'w_qb': nrm((Q_LORA, MLA_HEADS * QK_HEAD), Q_LORA ** -0.5),
        'g_q_head': gain(QK_HEAD),
        'g_kv_lat': gain(KV_LORA),
        'w_kb': nrm((KV_LORA, MLA_HEADS * QK_NOPE), KV_LORA ** -0.5),
        'w_vb': nrm((KV_LORA, MLA_HEADS * V_HEAD), KV_LORA ** -0.5),
        'g_k_head': gain(QK_HEAD),
        'w_mla_o': nrm((MLA_HEADS * V_HEAD, D_MODEL), (MLA_HEADS * V_HEAD) ** -0.5),
        'g_mem': gain(D_MODEL),
        'w_mem_kv': nrm((D_MODEL, 2 * MEM_W), D_MODEL ** -0.5),
        'g_mem_q': gain(MEM_HEAD_DIM),
        'g_mem_k': gain(MEM_HEAD_DIM),
        'w_mem_o': nrm((MEM_W, D_MODEL), MEM_W ** -0.5),
        'w_out': nrm((D_MODEL, D_MODEL), D_MODEL ** -0.5),
        'g_ff': gain(D_MODEL),
        'w_up': nrm((D_MODEL, D_FF), D_MODEL ** -0.5),
        'w_down': nrm((D_FF, D_MODEL), D_FF ** -0.5),
    }


def reference(x_prompt, mem_prompt, x_sample, cache_mla_latent, cache_mla_kpe, state_pool,
              cache_mem_k, cache_mem_v, g_mix, w_in, b_gate, w_pool, pool_scale, g_q_lat, w_qb,
              g_q_head, g_kv_lat, w_kb, w_vb, g_k_head, w_mla_o, g_mem, w_mem_kv, g_mem_q,
              g_mem_k, w_mem_o, w_out, g_ff, w_up, w_down):
    w = dict(g_mix=g_mix, w_in=w_in, b_gate=b_gate, w_pool=w_pool, pool_scale=pool_scale,
             g_q_lat=g_q_lat, w_qb=w_qb, g_q_head=g_q_head, g_kv_lat=g_kv_lat, w_kb=w_kb,
             w_vb=w_vb, g_k_head=g_k_head, w_mla_o=w_mla_o, g_mem=g_mem, w_mem_kv=w_mem_kv,
             g_mem_q=g_mem_q, g_mem_k=g_mem_k, w_mem_o=w_mem_o, w_out=w_out, g_ff=g_ff,
             w_up=w_up, w_down=w_down)
    L_p = x_prompt.shape[1]
    pos_p = jnp.arange(L_p, dtype=jnp.int32)
    mem_k_p, mem_v_p = memory_kv(mem_prompt, w)
    y_p = x_prompt
    pool_left_p = jnp.zeros((x_prompt.shape[0], POOL_STATE, POOL_W), x_prompt.dtype)
    for _ in range(DEPTH):
        y_p, lat_p, kpe_p, pool_p = trunk_layer(y_p, pos_p, pool_left_p, None, mem_k_p, mem_v_p, w)
    n_past = cache_mla_latent.shape[1]
    pos_s = n_past + jnp.arange(x_sample.shape[1], dtype=jnp.int32)
    y_s = x_sample
    for _ in range(DEPTH):
        y_s, lat_s, kpe_s, pool_s = trunk_layer(y_s, pos_s, state_pool,
                                                (cache_mla_latent, cache_mla_kpe),
                                                cache_mem_k, cache_mem_v, w)
    return (y_p, y_s, lat_p, kpe_p, pool_p, mem_k_p, mem_v_p, lat_s, kpe_s, pool_s)
```

```cpp
#include <hip/hip_runtime.h>
#include <cstdio>
#include <cstdint>

#define LAS __attribute__((address_space(3)))
#define GAS __attribute__((address_space(1)))
typedef unsigned short bf16_t;
typedef short bf16x8 __attribute__((ext_vector_type(8)));
typedef short s16x4 __attribute__((ext_vector_type(4)));
typedef float f32x2 __attribute__((ext_vector_type(2)));
typedef float f32x4 __attribute__((ext_vector_type(4)));
typedef float f32x16 __attribute__((ext_vector_type(16)));
typedef unsigned u32x2 __attribute__((ext_vector_type(2)));
typedef unsigned u32x4 __attribute__((ext_vector_type(4)));
typedef __bf16 bf16x2_t __attribute__((ext_vector_type(2)));

constexpr int DM = 2048, TP = 8192, TS = 512, TT = TP + TS, SEQ = 4096, LS = 32, NBS = 16;
constexpr int KPAD = 4160;
constexpr int ZS_LD = 3136, G_LD = 6144, QLD = 3072, NHEAD = 16;
constexpr float EPS = 1e-6f;
constexpr float MLA_C = 0.07216878364870322f * 1.4426950408889634f;
constexpr float MEM_C = 0.0625f * 1.4426950408889634f;
constexpr size_t O_YP = 0, O_YS = 16777216, O_LATP = 17825792, O_KPEP = 22020096, O_POOLP = 22544384, O_MEMK = 22575104, O_MEMV = 23099392,
                 O_LATS = 23623680, O_KPES = 23885824, O_POOLS = 23918592;
constexpr size_t MiB = 1u << 20;
constexpr size_t WS_CTL = 0, CTL_ZERO_BYTES = 1 * MiB;
constexpr size_t WS_WIN = 1 * MiB, WS_WMEMKV = 38 * MiB, WS_WQB = 46 * MiB, WS_WKB = 49 * MiB, WS_WVB = 51 * MiB, WS_WKBN = 53 * MiB, WS_WPOOL = 55 * MiB,
                 WS_WMLAO = 56 * MiB, WS_WMEMO = 64 * MiB, WS_WOUT = 68 * MiB, WS_WUP = 76 * MiB, WS_WDOWN = 108 * MiB;
constexpr size_t WS_G = 140 * MiB, WS_ZS = 242 * MiB, WS_Q = 242 * MiB, WS_A = 140 * MiB;
constexpr size_t WS_LATS = 295 * MiB, WS_KRS = 360 * MiB, WS_KPESS = 368 * MiB + 512 * 1024, WS_MG = 295 * MiB, WS_X1B = 329 * MiB;
constexpr size_t WS_H = 369 * MiB, WS_DP = 369 * MiB, WS_QN = 386 * MiB, WS_OMEM = 386 * MiB, WS_OMLA = 1 * MiB;
constexpr size_t WS_HM = 403 * MiB, WS_M = 405 * MiB, WS_QM = 409 * MiB, WS_V = 426 * MiB, WS_KSS = 458 * MiB, WS_MK = 475 * MiB, WS_MVT = 484 * MiB,
                 WS_KRP = 493 * MiB, WS_KPESSP = 494 * MiB, WS_SSX = 494 * MiB + 256 * 1024, WS_END = 496 * MiB;
constexpr size_t DO_K = 0, DO_CKVP = 56 * MiB;

constexpr int LDS_BYTES = 160 * 1024, MISC_OFF = LDS_BYTES - 256;
constexpr int NWAVES = 8;

#define LDS_WAIT() asm volatile("s_waitcnt lgkmcnt(0)" ::: "memory")
#define VM_WAIT() asm volatile("s_waitcnt vmcnt(0)" ::: "memory")
#define SBAR() __builtin_amdgcn_sched_barrier(0)
__device__ __forceinline__ unsigned cvtpk(float lo, float hi) { f32x2 v = {lo, hi}; bf16x2_t b = __builtin_convertvector(v, bf16x2_t); return __builtin_bit_cast(unsigned, b); }
__device__ __forceinline__ float bflo(unsigned u) { return __uint_as_float(u << 16); }
__device__ __forceinline__ float bfhi(unsigned u) { return __uint_as_float(u & 0xffff0000u); }
__device__ __forceinline__ float bf2f(bf16_t b) { return __uint_as_float((unsigned)b << 16); }
__device__ __forceinline__ bf16_t f2bf(float f) { return (bf16_t)(cvtpk(f, 0.f) & 0xffffu); }
__device__ __forceinline__ float wave_sum(float v) {
#pragma unroll
    for (int o = 1; o < 64; o <<= 1) v += __shfl_xor(v, o);
    return v;
}
__device__ __forceinline__ int crow(int r, int hi) { return (r & 3) + 8 * (r >> 2) + 4 * hi; }
__device__ __forceinline__ float rope_inv(int j) { return __builtin_amdgcn_exp2f(-(float)j * (13.287712379549449f / 32.0f)); }

#define XB_TMO      128
#define XB_XCNT(j)  (256  + 64 * (j))
#define XB_XSUB(j)  (1280 + 64 * (j))
#define XB_XGEN(j)  (2304 + 64 * (j))
#define XB_TOP      3328
#define XB_TOPGEN   3392
#define XCD_BAR_WORDS 3456
#define XB_SPIN_CAP (1u << 20)
__device__ __forceinline__ unsigned xb_ld(unsigned* p)              { return __hip_atomic_load(p, __ATOMIC_RELAXED, __HIP_MEMORY_SCOPE_AGENT); }
__device__ __forceinline__ unsigned xb_add(unsigned* p, unsigned v) { return __hip_atomic_fetch_add(p, v, __ATOMIC_RELAXED, __HIP_MEMORY_SCOPE_AGENT); }
__device__ __forceinline__ unsigned xb_xcc_id() { return (unsigned)__builtin_amdgcn_s_getreg((3 << 11) | 20) & 0xFu; }
#define XB_SPIN(cond, bar) do { unsigned _sp = 0; while (cond) { __builtin_amdgcn_s_sleep(1); \
    if ((++_sp & 255u) == 0u) { if (xb_ld(&(bar)[XB_TMO])) break; if (_sp > XB_SPIN_CAP) { atomicAdd(&(bar)[XB_TMO], 1u); break; } } } } while (0)
struct XcdBarrier { unsigned* bar; unsigned x; volatile LAS unsigned* st; };
__device__ __forceinline__ XcdBarrier xcd_barrier_post(unsigned* bar, volatile LAS unsigned* st) {
    XcdBarrier b; b.bar = bar; b.x = xb_xcc_id(); b.st = st;
    if (threadIdx.x == 0) (void)xb_add(&bar[XB_XCNT(b.x)], 1u);
    return b;
}
__device__ __forceinline__ void xcd_barrier_complete(unsigned* bar, unsigned x, unsigned& nloc, unsigned& nx) {
    const unsigned G = gridDim.x * gridDim.y * gridDim.z;
    unsigned sum, cnt, mine, sp = 0u;
    for (;;) {
        sum = 0u; cnt = 0u; mine = 0u;
#pragma unroll
        for (unsigned j = 0; j < 16; ++j) { const unsigned c = xb_ld(&bar[XB_XCNT(j)]); sum += c; cnt += (c > 0u) ? 1u : 0u; mine = (j == x) ? c : mine; }
        if (sum == G) break;
        __builtin_amdgcn_s_sleep(1);
        if ((++sp & 255u) == 0u) { if (xb_ld(&bar[XB_TMO])) break; if (sp > XB_SPIN_CAP) { atomicAdd(&bar[XB_TMO], 1u); break; } }
    }
    nloc = mine > 0u ? mine : 1u; nx = cnt > 0u ? cnt : 1u;
}
__device__ __forceinline__ void xcd_barrier(const XcdBarrier& b) {
    asm volatile("s_waitcnt vmcnt(0)" ::: "memory");
    __syncthreads();
    if (threadIdx.x == 0) {
        unsigned* bar = b.bar;
        __builtin_amdgcn_s_waitcnt(0);
        unsigned nloc = b.st[0], nx = b.st[1];
        if (nloc == 0u) { xcd_barrier_complete(bar, b.x, nloc, nx); b.st[0] = nloc; b.st[1] = nx; }
        const unsigned old = xb_add(&bar[XB_XSUB(b.x)], 1u);
        const unsigned gen = old / nloc;
        if (old + 1u == (gen + 1u) * nloc) {
            __builtin_amdgcn_fence(__ATOMIC_RELEASE, "agent");
            asm volatile("s_waitcnt vmcnt(0)" ::: "memory");
            const unsigned og = xb_add(&bar[XB_TOP], 1u);
            const unsigned tg = og / nx;
            if (og + 1u == (tg + 1u) * nx) xb_add(&bar[XB_TOPGEN], 1u);
            else XB_SPIN(xb_ld(&bar[XB_TOPGEN]) == tg, bar);
            __builtin_amdgcn_fence(__ATOMIC_ACQUIRE, "agent");
            xb_add(&bar[XB_XGEN(b.x)], 1u);
            asm volatile("s_waitcnt vmcnt(0)" ::: "memory");
        } else {
            XB_SPIN(xb_ld(&bar[XB_XGEN(b.x)]) == gen, bar);
            __builtin_amdgcn_fence(__ATOMIC_ACQUIRE, "agent");
            asm volatile("s_waitcnt vmcnt(0)" ::: "memory");
        }
    }
    __syncthreads();
}

namespace pg8 {
constexpr int BM = 256, BK = 64, HALF = 128, HTB = HALF * BK * 2, STAGE_BYTES = 8 * HTB, NXCD = 8, WGM = 8;
__device__ __forceinline__ int lds_byte(int r, int c) { const int st = (r >> 4) * 2 + (c >> 5), rr = r & 15, cc = c & 31, ob = rr * 64 + cc * 2; return st * 1024 + (ob ^ (((ob >> 9) & 1) << 5)); }
__device__ __forceinline__ void stage_rc(int b, int& R, int& C) { const int st = b / 1024, sb = b % 1024, swz = sb ^ (((sb >> 9) & 1) << 5); R = (st >> 1) * 16 + swz / 64; C = (st & 1) * 32 + (swz % 64) / 2; }
__device__ __forceinline__ int perm32(int rho) { const int n = rho >> 4, i = rho & 15; return 8 * (i >> 2) + 4 * n + (i & 3); }

struct Unit { const char* A; const char* B; unsigned lda2, ldb2; int nt, pm, pn, kind; };

__device__ __forceinline__ void tile_of(int wgid, int nM, int nN, int& pm, int& pn) {
    const int nwg = nM * nN;
    { const int q = nwg / NXCD, r = nwg % NXCD, xcd = wgid % NXCD, off = wgid / NXCD; wgid = (xcd < r ? xcd * (q + 1) : r * (q + 1) + (xcd - r) * q) + off; }
    const int nig = WGM * nN, gid = wgid / nig, fm = gid * WGM, gsz = (nM - fm) < WGM ? (nM - fm) : WGM;
    pm = fm + ((wgid % nig) % gsz); pn = (wgid % nig) / gsz;
}

struct Job { const bf16_t* A; const bf16_t* B; int lda, K, nM, nN, kind; };
struct JobSched1 {
    Job j0; int G, c;
    __device__ __forceinline__ void finish(int G_, int c_) { G = G_; c = c_; }
    __device__ __forceinline__ bool next(int i, Unit& u) const {
        const long L = (long)i * G + c; if (L >= j0.nM * j0.nN) return false;
        int pm, pn; tile_of((int)L, j0.nM, j0.nN, pm, pn);
        u.A = (const char*)(j0.A + (size_t)pm * BM * j0.lda); u.B = (const char*)(j0.B + (size_t)pn * BM * j0.K);
        u.lda2 = (unsigned)j0.lda * 2u; u.ldb2 = (unsigned)j0.K * 2u; u.nt = j0.K / BK; u.pm = pm; u.pn = pn; u.kind = j0.kind; return true;
    }
};

#define PG8_SA(b, h) (((b) * 2 + (h)) * HTB)
#define PG8_SB(b, h) ((4 + (b) * 2 + (h)) * HTB)
#define PG8_STAGE(bufoff, gbase, Rv, ld2) do { const unsigned _vo = (unsigned)(Rv) * (ld2) + c2; \
        __builtin_amdgcn_global_load_lds((const unsigned*)((gbase) + _vo), (LAS unsigned*)(lds + (bufoff) + ldsw), 16, 0, 0); \
        __builtin_amdgcn_global_load_lds((const unsigned*)((gbase) + 64u * (ld2) + _vo), (LAS unsigned*)(lds + (bufoff) + ldsw + 8192), 16, 0, 0); } while (0)
#define PG8_LDA(dst, b, h) do { _Pragma("unroll") for (int m = 0; m < 4; ++m) _Pragma("unroll") for (int k = 0; k < 2; ++k) dst[m][k] = *(const LAS bf16x8*)(lds + PG8_SA(b, h) + aoff + m * 2048 + k * 1024); } while (0)
#define PG8_LDB(dst, b, h) do { _Pragma("unroll") for (int n = 0; n < 2; ++n) _Pragma("unroll") for (int k = 0; k < 2; ++k) dst[n][k] = *(const LAS bf16x8*)(lds + PG8_SB(b, h) + boff + n * 2048 + k * 1024); } while (0)
#define PG8_MMA(ai, bj, At, Bt) do { __builtin_amdgcn_s_setprio(1); _Pragma("unroll") for (int m = 0; m < 4; ++m) _Pragma("unroll") for (int n = 0; n < 2; ++n) _Pragma("unroll") for (int k = 0; k < 2; ++k) \
        acc[ai][bj][m][n] = __builtin_amdgcn_mfma_f32_16x16x32_bf16(Bt[n][k], At[m][k], acc[ai][bj][m][n], 0, 0, 0); __builtin_amdgcn_s_setprio(0); } while (0)
#define PG8_WAIT_V(n) asm volatile("s_waitcnt vmcnt(" #n ")" ::: "memory")
#define PG8_WAIT_L(n) asm volatile("s_waitcnt lgkmcnt(" #n ")" ::: "memory")
#define PG8_BAR __builtin_amdgcn_s_barrier()
#define PG8_SCHED __builtin_amdgcn_sched_barrier(0)

template <class Epi, class Sched>
__device__ __forceinline__ void gemm_stream(LAS unsigned char* lds, const Sched& S, const Epi& E) {
    int tid = threadIdx.x; asm volatile("" : "+v"(tid));
    const int wid = __builtin_amdgcn_readfirstlane(tid >> 6), lane = tid & 63, wr = wid >> 2, wc = wid & 3, fr = lane & 15, fq = lane >> 4;
    int R0, C0; stage_rc(tid * 16, R0, C0);
    const int Rb0 = Epi::PERM ? ((R0 & ~31) + perm32(R0 & 31)) : R0;
    const unsigned c2 = (unsigned)C0 * 2u;
    const unsigned ldsw = (unsigned)wid * 1024u;
    const int aoff = lds_byte(wr * 64 + fr, fq * 8), boff = lds_byte(wc * 32 + fr, fq * 8);
    Unit cur, nxt; int ui = 0;
    if (!S.next(0, cur)) return;
    f32x4 acc[2][2][4][2];
#pragma unroll
    for (int a = 0; a < 2; ++a)
#pragma unroll
        for (int b = 0; b < 2; ++b)
#pragma unroll
            for (int m = 0; m < 4; ++m)
#pragma unroll
                for (int n = 0; n < 2; ++n) acc[a][b][m][n] = (f32x4){0.f, 0.f, 0.f, 0.f};
    bf16x8 At[4][2], B0[2][2], B1[2][2];
    const char* cA = cur.A; const char* cB = cur.B; unsigned la = cur.lda2, lb = cur.ldb2;
    const size_t kstep = (size_t)(BK * 2);
    PG8_STAGE(PG8_SB(0, 0), cB, Rb0, lb); PG8_STAGE(PG8_SB(0, 1), cB + (size_t)HALF * lb, Rb0, lb); PG8_STAGE(PG8_SA(0, 0), cA, R0, la); PG8_STAGE(PG8_SA(0, 1), cA + (size_t)HALF * la, R0, la);
    if (wr == 1) PG8_BAR;
    PG8_WAIT_V(2); PG8_BAR;
    PG8_STAGE(PG8_SB(1, 0), cB + kstep, Rb0, lb); PG8_STAGE(PG8_SA(1, 0), cA + kstep, R0, la); PG8_STAGE(PG8_SB(1, 1), cB + (size_t)HALF * lb + kstep, Rb0, lb);
    PG8_WAIT_V(6); PG8_BAR;
    for (;;) {
        const bool has_next = S.next(ui + 1, nxt);
        const char* nA = has_next ? nxt.A : cA; const char* nB = has_next ? nxt.B : cB;
        const unsigned nla = has_next ? nxt.lda2 : la, nlb = has_next ? nxt.ldb2 : lb;
        const int nt = cur.nt;
        for (int t = 0; t < nt; t += 2) {
            const bool last = (t == nt - 2);
            const char* a1 = cA + (size_t)(t + 1) * kstep;
            const char* a2 = last ? nA : cA + (size_t)(t + 2) * kstep; const char* b2 = last ? nB : cB + (size_t)(t + 2) * kstep;
            const unsigned la2 = last ? nla : la, lb2 = last ? nlb : lb;
            const char* a3 = a2 + kstep; const char* b3 = b2 + kstep;
            PG8_LDB(B0, 0, 0); PG8_LDB(B1, 0, 1); PG8_SCHED; PG8_LDA(At, 0, 0); PG8_STAGE(PG8_SA(1, 1), a1 + (size_t)HALF * la, R0, la);
            PG8_WAIT_V(8); PG8_WAIT_L(0); PG8_BAR; PG8_MMA(0, 0, At, B0); PG8_MMA(0, 1, At, B1); PG8_BAR; PG8_SCHED;
            PG8_LDA(At, 0, 1); PG8_STAGE(PG8_SB(0, 0), b2, Rb0, lb2); PG8_STAGE(PG8_SB(0, 1), b2 + (size_t)HALF * lb2, Rb0, lb2); PG8_STAGE(PG8_SA(0, 0), a2, R0, la2);
            PG8_WAIT_V(8); PG8_WAIT_L(0); PG8_BAR; PG8_MMA(1, 0, At, B0); PG8_MMA(1, 1, At, B1); PG8_BAR; PG8_SCHED;
            PG8_LDB(B0, 1, 0); PG8_LDB(B1, 1, 1); PG8_SCHED; PG8_LDA(At, 1, 0); PG8_STAGE(PG8_SA(0, 1), a2 + (size_t)HALF * la2, R0, la2);
            PG8_WAIT_V(8); PG8_WAIT_L(0); PG8_BAR; PG8_MMA(0, 0, At, B0); PG8_MMA(0, 1, At, B1); PG8_BAR; PG8_SCHED;
            PG8_LDA(At, 1, 1); PG8_STAGE(PG8_SB(1, 0), b3, Rb0, lb2); PG8_STAGE(PG8_SB(1, 1), b3 + (size_t)HALF * lb2, Rb0, lb2); PG8_STAGE(PG8_SA(1, 0), a3, R0, la2);
            PG8_WAIT_V(8); PG8_WAIT_L(0); PG8_BAR; PG8_MMA(1, 0, At, B0); PG8_MMA(1, 1, At, B1); PG8_BAR; PG8_SCHED;
        }
        if (wr == 0) PG8_BAR;
        const bool keep = E(acc, cur, wr, wc, fr, fq);
        if (!has_next) break;
        if (!keep) {
#pragma unroll
            for (int a = 0; a < 2; ++a)
#pragma unroll
                for (int b = 0; b < 2; ++b)
#pragma unroll
                    for (int m = 0; m < 4; ++m)
#pragma unroll
                        for (int n = 0; n < 2; ++n) acc[a][b][m][n] = (f32x4){0.f, 0.f, 0.f, 0.f};
        }
        cur = nxt; cA = nA; cB = nB; la = nla; lb = nlb; ++ui;
        if (wr == 1) PG8_BAR;
    }
    PG8_WAIT_V(0);
    PG8_BAR;
}
}

struct Args { const float* in[30]; float* out; unsigned char* ws; };
enum { I_XP = 0, I_MEMP, I_XS, I_CLAT, I_CKPE, I_SPOOL, I_CMK, I_CMV, I_GMIX, I_WIN, I_BGATE, I_WPOOL, I_PSCALE, I_GQLAT, I_WQB, I_GQHEAD, I_GKVLAT, I_WKB, I_WVB,
       I_GKHEAD, I_WMLAO, I_GMEM, I_WMEMKV, I_GMEMQ, I_GMEMK, I_WMEMO, I_WOUT, I_GFF, I_WUP, I_WDOWN };

__device__ __forceinline__ void transpose_item(const float* __restrict__ W, int ldw, int K, bf16_t* __restrict__ WT, LAS float* scr, int kb, int n0src, int nrow_dst, int lane, const float* __restrict__ kscale) {
    const int k0 = 64 * kb;
#pragma unroll 8
    for (int i = 0; i < 32; ++i) { const int kk = 2 * i + (lane >> 5); float v = W[(size_t)(k0 + kk) * ldw + n0src + (lane & 31)]; if (kscale) v *= kscale[k0 + kk]; scr[kk * 33 + (lane & 31)] = v; }
    LDS_WAIT(); asm volatile("" ::: "memory");
    const int c = lane & 7;
#pragma unroll
    for (int j = 0; j < 4; ++j) { const int n = (lane >> 3) + 8 * j; const LAS float* s = scr + (8 * c) * 33 + n;
        u32x4 o; o.x = cvtpk(s[0 * 33], s[1 * 33]); o.y = cvtpk(s[2 * 33], s[3 * 33]); o.z = cvtpk(s[4 * 33], s[5 * 33]); o.w = cvtpk(s[6 * 33], s[7 * 33]);
        *(u32x4*)(WT + (size_t)(nrow_dst + n) * K + k0 + 8 * c) = o; }
    LDS_WAIT(); asm volatile("" ::: "memory");
}
__device__ __forceinline__ void rms_row_2048(const float* __restrict__ xrow, const float* __restrict__ g, bf16_t* __restrict__ orow, int lane) {
    const f32x4* xr = (const f32x4*)xrow + lane; const f32x4* gr = (const f32x4*)g + lane;
    f32x4 v[8]; float s = 0.f;
#pragma unroll
    for (int j = 0; j < 8; ++j) { v[j] = xr[64 * j]; s += (v[j].x * v[j].x + v[j].y * v[j].y) + (v[j].z * v[j].z + v[j].w * v[j].w); }
    const float r = rsqrtf(wave_sum(s) * (1.f / 2048.f) + EPS);
    u32x2* o8 = (u32x2*)orow + lane;
#pragma unroll
    for (int j = 0; j < 8; ++j) { const f32x4 gg = gr[64 * j]; u32x2 w; w.x = cvtpk(v[j].x * r * gg.x, v[j].y * r * gg.y); w.y = cvtpk(v[j].z * r * gg.z, v[j].w * r * gg.w); o8[64 * j] = w; }
}
__device__ __forceinline__ float rope_lane(float w, int lane, float pos) {
    const float partner = __shfl_xor(w, 32);
    float sn, cs; sincosf(pos * rope_inv(lane & 31), &sn, &cs);
    return lane < 32 ? w * cs - partner * sn : w * cs + partner * sn;
}

__device__ __forceinline__ void phase_prep(const Args& P, LAS unsigned char* lds, int gw, int NGW, int wave, int lane) {
    unsigned char* ws = P.ws;
    LAS float* scr = (LAS float*)(lds + wave * 16384);
    {
        constexpr int I_IN = 32 * 290, I_MKV = 32 * 64, I_QB = 8 * 96, I_KB = 8 * 64, I_VB = 8 * 64, I_PL = 4 * 4 * 16, I_MLAO = 32 * 64, I_MEMO = 16 * 64, I_OUT = 32 * 64, I_UP = 32 * 256, I_DN = 128 * 64,
                      I_MV = 16 * 4 * 32;
        constexpr int NITEMS = I_IN + I_MKV + I_QB + I_KB + I_VB + I_PL + I_MLAO + I_MEMO + I_OUT + I_UP + I_DN + I_MV;
        for (int it = gw; it < NITEMS; it += NGW) {
            int r = it;
            if (r < I_IN) { const int kb = r / 290, nb = r % 290, n0 = nb * 32; const int nd = n0 < 2048 ? n0 : (n0 < 2112 ? 9216 + (n0 - 2048) : n0 - 64);
                transpose_item(P.in[I_WIN], 9280, 2048, (bf16_t*)(ws + WS_WIN), scr, kb, n0, nd, lane, nullptr); continue; } r -= I_IN;
            if (r < I_MKV) { transpose_item(P.in[I_WMEMKV], 2048, 2048, (bf16_t*)(ws + WS_WMEMKV), scr, r / 64, (r % 64) * 32, (r % 64) * 32, lane, nullptr); continue; } r -= I_MKV;
            if (r < I_QB) { transpose_item(P.in[I_WQB], 3072, 512, (bf16_t*)(ws + WS_WQB), scr, r / 96, (r % 96) * 32, (r % 96) * 32, lane, nullptr); continue; } r -= I_QB;
            if (r < I_KB) { transpose_item(P.in[I_WKB], 2048, 512, (bf16_t*)(ws + WS_WKB), scr, r / 64, (r % 64) * 32, (r % 64) * 32, lane, nullptr); continue; } r -= I_KB;
            if (r < I_VB) { transpose_item(P.in[I_WVB], 2048, 512, (bf16_t*)(ws + WS_WVB), scr, r / 64, (r % 64) * 32, (r % 64) * 32, lane, nullptr); continue; } r -= I_VB;
            if (r < I_PL) { const int g = r / 64, q = r % 64; transpose_item(P.in[I_WPOOL] + (size_t)g * 256 * 512, 512, 256, (bf16_t*)(ws + WS_WPOOL), scr, q / 16, (q % 16) * 32, g * 512 + (q % 16) * 32, lane, nullptr); continue; } r -= I_PL;
            if (r < I_MLAO) { transpose_item(P.in[I_WMLAO], 2048, 2048, (bf16_t*)(ws + WS_WMLAO), scr, r / 64, (r % 64) * 32, (r % 64) * 32, lane, nullptr); continue; } r -= I_MLAO;
            if (r < I_MEMO) { transpose_item(P.in[I_WMEMO], 2048, 1024, (bf16_t*)(ws + WS_WMEMO), scr, r / 64, (r % 64) * 32, (r % 64) * 32, lane, nullptr); continue; } r -= I_MEMO;
            if (r < I_OUT) { transpose_item(P.in[I_WOUT], 2048, 2048, (bf16_t*)(ws + WS_WOUT), scr, r / 64, (r % 64) * 32, (r % 64) * 32, lane, nullptr); continue; } r -= I_OUT;
            if (r < I_UP) { transpose_item(P.in[I_WUP], 8192, 2048, (bf16_t*)(ws + WS_WUP), scr, r / 256, (r % 256) * 32, (r % 256) * 32, lane, P.in[I_GFF]); continue; } r -= I_UP;
            if (r < I_DN) { transpose_item(P.in[I_WDOWN], 2048, 8192, (bf16_t*)(ws + WS_WDOWN), scr, r / 64, (r % 64) * 32, (r % 64) * 32, lane, nullptr); continue; } r -= I_DN;
            { const int b = r / 128, q = r % 128;
              transpose_item(P.in[I_CMV] + (size_t)b * 262144, 1024, 256, (bf16_t*)(ws + WS_MVT) + (size_t)(2 + b) * 262144, scr, q / 32, (q % 32) * 32, (q % 32) * 32, lane, nullptr); }
        }
    }
    for (int m = gw; m < TT + 512; m += NGW) {
        if (m < TP) rms_row_2048(P.in[I_XP] + (size_t)m * DM, P.in[I_GMIX], (bf16_t*)(ws + WS_H) + (size_t)m * DM, lane);
        else if (m < TT) rms_row_2048(P.in[I_XS] + (size_t)(m - TP) * DM, P.in[I_GMIX], (bf16_t*)(ws + WS_H) + (size_t)m * DM, lane);
        else rms_row_2048(P.in[I_MEMP] + (size_t)(m - TT) * DM, P.in[I_GMEM], (bf16_t*)(ws + WS_HM) + (size_t)(m - TT) * DM, lane);
    }
    {
        bf16_t* KRs = (bf16_t*)(ws + WS_KRS); float* KPESS = (float*)(ws + WS_KPESS); bf16_t* LATs = (bf16_t*)(ws + WS_LATS);
        const float gk = P.in[I_GKHEAD][128 + lane];
        for (int rr = gw; rr < NBS * 4096; rr += NGW) { const int b = rr >> 12, pos = rr & 4095;
            const float v = P.in[I_CKPE][(size_t)rr * 64 + lane]; const float ss = wave_sum(v * v);
            const float o = rope_lane(v * gk, lane, (float)pos);
            const size_t kidx = (size_t)b * KPAD + pos; KRs[kidx * 64 + lane] = f2bf(o); if (lane == 0) KPESS[kidx] = ss; }
        for (int rr = gw; rr < NBS * 32; rr += NGW) { const size_t kidx = (size_t)(rr >> 5) * KPAD + 4128 + (rr & 31);
            KRs[kidx * 64 + lane] = 0; if (lane == 0) KPESS[kidx] = 0.f;
            *(u32x4*)(LATs + kidx * 512 + lane * 8) = (u32x4){0u, 0u, 0u, 0u}; }
    }
    {
        const long tid_g = (long)gw * 64 + lane, NT_G = (long)NGW * 64;
        bf16_t* LATs = (bf16_t*)(ws + WS_LATS);
        for (long i = tid_g; i < (long)NBS * 4096 * 64; i += NT_G) { const long b = i >> 18, rem = i & 262143;
            const f32x4 a = *(const f32x4*)(P.in[I_CLAT] + i * 8), c = *(const f32x4*)(P.in[I_CLAT] + i * 8 + 4);
            *(u32x4*)(LATs + (size_t)b * KPAD * 512 + rem * 8) = (u32x4){cvtpk(a.x, a.y), cvtpk(a.z, a.w), cvtpk(c.x, c.y), cvtpk(c.z, c.w)}; }
        bf16_t* MKs = (bf16_t*)(ws + WS_MK) + (size_t)2 * 262144;
        for (long i = tid_g; i < (long)NBS * 262144 / 8; i += NT_G) {
            const f32x4 a = *(const f32x4*)(P.in[I_CMK] + i * 8), c = *(const f32x4*)(P.in[I_CMK] + i * 8 + 4);
            *(u32x4*)(MKs + i * 8) = (u32x4){cvtpk(a.x, a.y), cvtpk(a.z, a.w), cvtpk(c.x, c.y), cvtpk(c.z, c.w)}; }
        bf16_t* WKN = (bf16_t*)(ws + WS_WKBN);
        for (long i = tid_g; i < 512L * 2048 / 8; i += NT_G) {
            const f32x4 a = *(const f32x4*)(P.in[I_WKB] + i * 8), c = *(const f32x4*)(P.in[I_WKB] + i * 8 + 4);
            *(u32x4*)(WKN + i * 8) = (u32x4){cvtpk(a.x, a.y), cvtpk(a.z, a.w), cvtpk(c.x, c.y), cvtpk(c.z, c.w)}; }
    }
}

struct EpiIn {
    static constexpr bool PERM = true;
    bf16_t* ZS; bf16_t* G; float* M; const float* bgate;
    __device__ __forceinline__ bool operator()(f32x4 (&acc)[2][2][4][2], const pg8::Unit& u, int wr, int wc, int fr, int fq) const {
        const int row0 = u.pm * 256 + wr * 64 + fr, ct = wc * 32 + 8 * fq;
        if (u.kind == 1) {
#pragma unroll
            for (int ai = 0; ai < 2; ++ai)
#pragma unroll
                for (int m = 0; m < 4; ++m) { float* rp = M + (size_t)(row0 + ai * 128 + m * 16) * 2048 + u.pn * 256 + ct;
#pragma unroll
                    for (int bj = 0; bj < 2; ++bj) { *(f32x4*)(rp + bj * 128) = acc[ai][bj][m][0]; *(f32x4*)(rp + bj * 128 + 4) = acc[ai][bj][m][1]; } }
            return false;
        }
        const int pn = u.pn;
        if (pn >= 12 && pn < 36) {
            const int gc = (pn - 12) * 256 + ct;
            f32x4 bv[2][2];
#pragma unroll
            for (int bj = 0; bj < 2; ++bj) { bv[bj][0] = *(const f32x4*)(bgate + gc + bj * 128); bv[bj][1] = *(const f32x4*)(bgate + gc + bj * 128 + 4); }
#pragma unroll
            for (int ai = 0; ai < 2; ++ai)
#pragma unroll
                for (int m = 0; m < 4; ++m) { bf16_t* rp = G + (size_t)(row0 + ai * 128 + m * 16) * G_LD + gc;
#pragma unroll
                    for (int bj = 0; bj < 2; ++bj) { f32x4 v0 = acc[ai][bj][m][0] + bv[bj][0], v1 = acc[ai][bj][m][1] + bv[bj][1];
#pragma unroll
                        for (int e = 0; e < 4; ++e) { v0[e] = __builtin_amdgcn_rcpf(1.f + __builtin_amdgcn_exp2f(-1.4426950408889634f * v0[e])); v1[e] = __builtin_amdgcn_rcpf(1.f + __builtin_amdgcn_exp2f(-1.4426950408889634f * v1[e])); }
                        *(u32x4*)(rp + bj * 128) = (u32x4){cvtpk(v0[0], v0[1]), cvtpk(v0[2], v0[3]), cvtpk(v1[0], v1[1]), cvtpk(v1[2], v1[3])}; } }
            return false;
        }
        const int zc = (pn < 12 ? pn * 256 : 3072) + ct;
#pragma unroll
        for (int ai = 0; ai < 2; ++ai)
#pragma unroll
            for (int m = 0; m < 4; ++m) { bf16_t* rp = ZS + (size_t)(row0 + ai * 128 + m * 16) * ZS_LD + zc;
#pragma unroll
                for (int bj = 0; bj < 2; ++bj) { if (pn == 36 && (bj == 1 || wc >= 2)) continue;
                    const f32x4 v0 = acc[ai][bj][m][0], v1 = acc[ai][bj][m][1];
                    *(u32x4*)(rp + bj * 128) = (u32x4){cvtpk(v0[0], v0[1]), cvtpk(v0[2], v0[3]), cvtpk(v1[0], v1[1]), cvtpk(v1[2], v1[3])}; } }
        return false;
    }
};

__device__ __forceinline__ void unpack8(const u32x4 w, float (&f)[8]) { f[0] = bflo(w.x); f[1] = bfhi(w.x); f[2] = bflo(w.y); f[3] = bfhi(w.y); f[4] = bflo(w.z); f[5] = bfhi(w.z); f[6] = bflo(w.w); f[7] = bfhi(w.w); }
__device__ __forceinline__ u32x4 pack8(const float (&f)[8]) { return (u32x4){cvtpk(f[0], f[1]), cvtpk(f[2], f[3]), cvtpk(f[4], f[5]), cvtpk(f[6], f[7])}; }

__device__ __forceinline__ void phase_rows(const Args& P, LAS unsigned char* lds, int gw, int NGW, int wave, int lane) {
    unsigned char* ws = P.ws; float* out = P.out;
    const bf16_t* ZS = (const bf16_t*)(ws + WS_ZS);
    for (int t = gw; t < TT; t += NGW) {
        const bool prm = t < TP; const int b = prm ? (t >> 12) : ((t - TP) >> 5), li = prm ? (t & 4095) : ((t - TP) & 31), pos = prm ? li : 4096 + li;
        const bf16_t* z = ZS + (size_t)t * ZS_LD;
        { float v[8]; unpack8(*(const u32x4*)(z + 1536 + lane * 8), v); float s = 0.f;
#pragma unroll
          for (int j = 0; j < 8; ++j) s += v[j] * v[j];
          const float r = rsqrtf(wave_sum(s) * (1.f / 512.f) + EPS);
          const f32x4 g0 = *(const f32x4*)(P.in[I_GKVLAT] + lane * 8), g1 = *(const f32x4*)(P.in[I_GKVLAT] + lane * 8 + 4);
          v[0] *= r * g0.x; v[1] *= r * g0.y; v[2] *= r * g0.z; v[3] *= r * g0.w; v[4] *= r * g1.x; v[5] *= r * g1.y; v[6] *= r * g1.z; v[7] *= r * g1.w;
          float* lo = prm ? out + O_LATP + (size_t)t * 512 : out + O_LATS + (size_t)(t - TP) * 512;
          *(f32x4*)(lo + lane * 8) = (f32x4){v[0], v[1], v[2], v[3]}; *(f32x4*)(lo + lane * 8 + 4) = (f32x4){v[4], v[5], v[6], v[7]};
          bf16_t* dst = prm ? (bf16_t*)((unsigned char*)out + DO_CKVP) + (size_t)t * 512 : (bf16_t*)(ws + WS_LATS) + ((size_t)b * KPAD + 4096 + li) * 512;
          *(u32x4*)(dst + lane * 8) = pack8(v); }
        { const float v = bf2f(z[3072 + lane]);
          (prm ? out + O_KPEP + (size_t)t * 64 : out + O_KPES + (size_t)(t - TP) * 64)[lane] = v;
          const float ss = wave_sum(v * v); const float o = rope_lane(v * P.in[I_GKHEAD][128 + lane], lane, (float)pos);
          if (prm) { ((bf16_t*)(ws + WS_KRP))[(size_t)t * 64 + lane] = f2bf(o); if (lane == 0) ((float*)(ws + WS_KPESSP))[t] = ss; }
          else { const size_t kidx = (size_t)b * KPAD + 4096 + li; ((bf16_t*)(ws + WS_KRS))[kidx * 64 + lane] = f2bf(o); if (lane == 0) ((float*)(ws + WS_KPESS))[kidx] = ss; } }
        { float v[8]; unpack8(*(const u32x4*)(z + 1024 + lane * 8), v); float s = 0.f;
#pragma unroll
          for (int j = 0; j < 8; ++j) s += v[j] * v[j];
          const float r = rsqrtf(wave_sum(s) * (1.f / 512.f) + EPS);
          const f32x4 g0 = *(const f32x4*)(P.in[I_GQLAT] + lane * 8), g1 = *(const f32x4*)(P.in[I_GQLAT] + lane * 8 + 4);
          v[0] *= r * g0.x; v[1] *= r * g0.y; v[2] *= r * g0.z; v[3] *= r * g0.w; v[4] *= r * g1.x; v[5] *= r * g1.y; v[6] *= r * g1.z; v[7] *= r * g1.w;
          *(u32x4*)((bf16_t*)(ws + WS_QN) + (size_t)t * 512 + lane * 8) = pack8(v); }
        { const f32x4 g = *(const f32x4*)(P.in[I_GMEMQ] + lane * 4);
#pragma unroll
          for (int h = 0; h < 4; ++h) { const u32x2 w = *(const u32x2*)(z + 2048 + h * 256 + lane * 4);
              const float a0 = bflo(w.x), a1 = bfhi(w.x), a2 = bflo(w.y), a3 = bfhi(w.y);
              const float r = rsqrtf(wave_sum((a0 * a0 + a1 * a1) + (a2 * a2 + a3 * a3)) * (1.f / 256.f) + EPS) * MEM_C;
              *(u32x2*)((bf16_t*)(ws + WS_QM) + (size_t)t * 1024 + h * 256 + lane * 4) = (u32x2){cvtpk(a0 * r * g.x, a1 * r * g.y), cvtpk(a2 * r * g.z, a3 * r * g.w)}; } }
        { const int ca = lane * 8, cb = 512 + lane * 8, wa = lane < 32 ? 2 : 4, wb = lane < 32 ? 8 : 16;
          float sa[8], sb[8], ua[8], ub[8];
          unpack8(*(const u32x4*)(z + ca), ua); unpack8(*(const u32x4*)(z + cb), ub);
#pragma unroll
          for (int j = 0; j < 8; ++j) { sa[j] = ua[j]; sb[j] = ub[j]; }
          for (int k = 1; k < 16; ++k) {
              if (k > li && prm) break;
              if (k <= li) { const bf16_t* zk = z - (size_t)k * ZS_LD; float tmp[8];
                  if (k < wa) { unpack8(*(const u32x4*)(zk + ca), tmp);
#pragma unroll
                      for (int j = 0; j < 8; ++j) sa[j] += tmp[j]; }
                  if (k < wb) { unpack8(*(const u32x4*)(zk + cb), tmp);
#pragma unroll
                      for (int j = 0; j < 8; ++j) sb[j] += tmp[j]; } }
              else { const float* sp = P.in[I_SPOOL] + ((size_t)b * 15 + (15 + li - k)) * 1024;
                  if (k < wa) { const f32x4 p0 = *(const f32x4*)(sp + ca), p1 = *(const f32x4*)(sp + ca + 4); sa[0] += p0.x; sa[1] += p0.y; sa[2] += p0.z; sa[3] += p0.w; sa[4] += p1.x; sa[5] += p1.y; sa[6] += p1.z; sa[7] += p1.w; }
                  if (k < wb) { const f32x4 p0 = *(const f32x4*)(sp + cb), p1 = *(const f32x4*)(sp + cb + 4); sb[0] += p0.x; sb[1] += p0.y; sb[2] += p0.z; sb[3] += p0.w; sb[4] += p1.x; sb[5] += p1.y; sb[6] += p1.z; sb[7] += p1.w; } }
          }
          const float ia = 1.f / (float)(pos + 1 < wa ? pos + 1 : wa), ib = 1.f / (float)(pos + 1 < wb ? pos + 1 : wb);
#pragma unroll
          for (int j = 0; j < 8; ++j) { sa[j] = sa[j] * ia - ua[j]; sb[j] = sb[j] * ib - ub[j]; }
          bf16_t* dp = (bf16_t*)(ws + WS_DP) + (size_t)t * 1024;
          *(u32x4*)(dp + ca) = pack8(sa); *(u32x4*)(dp + cb) = pack8(sb);
          const int last0 = prm ? 4081 : 17;
          if (li >= last0) { float* po = (prm ? out + O_POOLP : out + O_POOLS) + ((size_t)b * 15 + (li - last0)) * 1024;
              *(f32x4*)(po + ca) = (f32x4){ua[0], ua[1], ua[2], ua[3]}; *(f32x4*)(po + ca + 4) = (f32x4){ua[4], ua[5], ua[6], ua[7]};
              *(f32x4*)(po + cb) = (f32x4){ub[0], ub[1], ub[2], ub[3]}; *(f32x4*)(po + cb + 4) = (f32x4){ub[4], ub[5], ub[6], ub[7]}; } }
    }
    for (int m = gw; m < 512; m += NGW) {
        const float* mr = (const float*)(ws + WS_M) + (size_t)m * 2048; const f32x4 g = *(const f32x4*)(P.in[I_GMEMK] + lane * 4);
#pragma unroll
        for (int h = 0; h < 4; ++h) { f32x4 v = *(const f32x4*)(mr + h * 256 + lane * 4);
            const float r = rsqrtf(wave_sum((v.x * v.x + v.y * v.y) + (v.z * v.z + v.w * v.w)) * (1.f / 256.f) + EPS);
            v.x *= r * g.x; v.y *= r * g.y; v.z *= r * g.z; v.w *= r * g.w;
            *(f32x4*)(out + O_MEMK + (size_t)m * 1024 + h * 256 + lane * 4) = v;
            *(u32x2*)((bf16_t*)(ws + WS_MK) + (size_t)m * 1024 + h * 256 + lane * 4) = (u32x2){cvtpk(v.x, v.y), cvtpk(v.z, v.w)};
            *(f32x4*)(out + O_MEMV + (size_t)m * 1024 + h * 256 + lane * 4) = *(const f32x4*)(mr + 1024 + h * 256 + lane * 4); }
    }
    { LAS float* scr = (LAS float*)(lds + wave * 16384);
      for (int it = gw; it < 2 * 128; it += NGW) { const int b = it / 128, q = it % 128;
          transpose_item((const float*)(ws + WS_M) + (size_t)b * 256 * 2048 + 1024, 2048, 256, (bf16_t*)(ws + WS_MVT) + (size_t)b * 262144, scr, q / 32, (q % 32) * 32, (q % 32) * 32, lane, nullptr); } }
}


struct EpiQKV {
    static constexpr bool PERM = true;
    bf16_t* Q; bf16_t* K; bf16_t* V; float* KSS;
    __device__ __forceinline__ bool operator()(f32x4 (&acc)[2][2][4][2], const pg8::Unit& u, int wr, int wc, int fr, int fq) const {
        const int row0 = u.pm * 256 + wr * 64 + fr, ct = wc * 32 + 8 * fq;
        if (u.kind == 3) {
#pragma unroll
            for (int ai = 0; ai < 2; ++ai)
#pragma unroll
                for (int m = 0; m < 4; ++m)
#pragma unroll
                    for (int bj = 0; bj < 2; ++bj) { const f32x4 a = acc[ai][bj][m][0], b = acc[ai][bj][m][1];
                        float s = ((a.x * a.x + a.y * a.y) + (a.z * a.z + a.w * a.w)) + ((b.x * b.x + b.y * b.y) + (b.z * b.z + b.w * b.w));
                        s += __shfl_xor(s, 16); s += __shfl_xor(s, 32);
                        if (fq == 0) KSS[((size_t)(row0 + ai * 128 + m * 16) * 16 + (u.pn * 2 + bj)) * 4 + wc] = s; }
            return false;
        }
        bf16_t* base; int ld, c0, c1;
        if (u.kind == 0) { base = Q; ld = QLD; c0 = u.pn * 256 + ct; c1 = c0 + 128; }
        else if (u.kind == 1) { base = K; ld = QLD; c0 = (u.pn * 2) * 192 + ct; c1 = c0 + 192; }
        else { base = V; ld = 2048; c0 = u.pn * 256 + ct; c1 = c0 + 128; }
#pragma unroll
        for (int ai = 0; ai < 2; ++ai)
#pragma unroll
            for (int m = 0; m < 4; ++m) { bf16_t* rp = base + (size_t)(row0 + ai * 128 + m * 16) * ld;
#pragma unroll
                for (int bj = 0; bj < 2; ++bj) { const f32x4 v0 = acc[ai][bj][m][0], v1 = acc[ai][bj][m][1];
                    *(u32x4*)(rp + (bj ? c1 : c0)) = (u32x4){cvtpk(v0[0], v0[1]), cvtpk(v0[2], v0[3]), cvtpk(v1[0], v1[1]), cvtpk(v1[2], v1[3])}; } }
        return false;
    }
};

__device__ __forceinline__ void phase_heads(const Args& P, int gw, int NGW, int lane) {
    unsigned char* ws = P.ws;
    bf16_t* Q = (bf16_t*)(ws + WS_Q); bf16_t* K = (bf16_t*)((unsigned char*)P.out + DO_K);
    const float gq0 = P.in[I_GQHEAD][lane], gq1 = P.in[I_GQHEAD][64 + lane], gq2 = P.in[I_GQHEAD][128 + lane];
    const float gk0 = P.in[I_GKHEAD][lane], gk1 = P.in[I_GKHEAD][64 + lane];
    const float inv = rope_inv(lane & 31);
    for (int t = gw; t < TT; t += NGW) {
        const bool prm = t < TP; const int pos = prm ? (t & 4095) : 4096 + ((t - TP) & 31);
        float sn, cs; sincosf((float)pos * inv, &sn, &cs);
        bf16_t* q = Q + (size_t)t * QLD;
#pragma unroll 4
        for (int h = 0; h < 16; ++h) { bf16_t* qh = q + h * 192;
            const float v0 = bf2f(qh[lane]), v1 = bf2f(qh[64 + lane]), v2 = bf2f(qh[128 + lane]);
            const float r = rsqrtf(wave_sum(v0 * v0 + v1 * v1 + v2 * v2) * (1.f / 192.f) + EPS);
            const float y2 = v2 * r * gq2, pr = __shfl_xor(y2, 32);
            qh[lane] = f2bf(v0 * r * gq0); qh[64 + lane] = f2bf(v1 * r * gq1);
            qh[128 + lane] = f2bf(lane < 32 ? y2 * cs - pr * sn : y2 * cs + pr * sn); }
        if (prm) { bf16_t* k = K + (size_t)t * QLD; const float kss = ((const float*)(ws + WS_KPESSP))[t]; const float kr = bf2f(((const bf16_t*)(ws + WS_KRP))[(size_t)t * 64 + lane]);
#pragma unroll 4
            for (int h = 0; h < 16; ++h) { bf16_t* kh = k + h * 192;
                const float v0 = bf2f(kh[lane]), v1 = bf2f(kh[64 + lane]);
                const float r = rsqrtf((wave_sum(v0 * v0 + v1 * v1) + kss) * (1.f / 192.f) + EPS);
                kh[lane] = f2bf(v0 * r * gk0); kh[64 + lane] = f2bf(v1 * r * gk1); kh[128 + lane] = f2bf(kr * r); } }
    }
}


typedef short v4i16_t __attribute__((ext_vector_type(4)));
__device__ __forceinline__ s16x4 vtr(const LAS char* p) { return __builtin_bit_cast(s16x4, __builtin_amdgcn_ds_read_tr16_b64_v4i16((LAS v4i16_t*)p)); }
#define SWZF(row) ((((((row) & 2) << 1) | (((row) >> 2) & 3))) << 4)
__device__ __forceinline__ void partialSM(f32x16& p0, f32x16& p1, float& m_reg, float& mn, float& alpha, const float C) {
    float pmax = p0[0];
#pragma unroll
    for (int r = 1; r < 16; ++r) pmax = fmaxf(pmax, p0[r]);
#pragma unroll
    for (int r = 0; r < 16; ++r) pmax = fmaxf(pmax, p1[r]);
    { auto rr = __builtin_amdgcn_permlane32_swap(__float_as_uint(pmax), __float_as_uint(pmax), false, false);
      pmax = fmaxf(__uint_as_float(rr[0]), __uint_as_float(rr[1])); }
    if (__builtin_expect(__all((pmax - m_reg) * C <= 11.5f), 1)) { mn = m_reg; alpha = 1.f; }
    else { mn = fmaxf(m_reg, pmax); alpha = __builtin_amdgcn_exp2f((m_reg - mn) * C); m_reg = mn; }
    const float mnC = -mn * C;
#pragma unroll
    for (int r = 0; r < 16; ++r) p0[r] = fmaf(p0[r], C, mnC);
#pragma unroll
    for (int r = 0; r < 16; ++r) p1[r] = fmaf(p1[r], C, mnC);
#pragma unroll
    for (int r = 0; r < 16; ++r) p0[r] = __builtin_amdgcn_exp2f(p0[r]);
}
__device__ __forceinline__ void finishSM(f32x16& p0, f32x16& p1, float alpha, float& l_reg, bf16x8& pa0, bf16x8& pa1, bf16x8& pa2, bf16x8& pa3) {
#pragma unroll
    for (int r = 0; r < 16; ++r) p1[r] = __builtin_amdgcn_exp2f(p1[r]);
    float ps = 0;
#pragma unroll
    for (int r = 0; r < 16; ++r) ps += p0[r];
#pragma unroll
    for (int r = 0; r < 16; ++r) ps += p1[r];
    { auto rr = __builtin_amdgcn_permlane32_swap(__float_as_uint(ps), __float_as_uint(ps), false, false);
      ps = __uint_as_float(rr[0]) + __uint_as_float(rr[1]); }
    l_reg = l_reg * alpha + ps;
#define PK4(P, BASE, OUT) do { unsigned a0 = cvtpk(P[BASE + 0], P[BASE + 1]), a1 = cvtpk(P[BASE + 2], P[BASE + 3]);   \
    unsigned b0 = cvtpk(P[BASE + 4], P[BASE + 5]), b1 = cvtpk(P[BASE + 6], P[BASE + 7]);                              \
    auto r0 = __builtin_amdgcn_permlane32_swap(a0, b0, false, false); auto r1 = __builtin_amdgcn_permlane32_swap(a1, b1, false, false); \
    u32x4 w = {r0[0], r1[0], r0[1], r1[1]}; OUT = __builtin_bit_cast(bf16x8, w); } while (0)
    PK4(p0, 0, pa0); PK4(p0, 8, pa1); PK4(p1, 0, pa2); PK4(p1, 8, pa3);
#undef PK4
}
#define PKV(L, H) (bf16x8){L[0], L[1], L[2], L[3], H[0], H[1], H[2], H[3]}

namespace pat {
constexpr int LDQ = 3072, LDK = 3072, LDV = 2048, LDO = 2048;
constexpr int SHM_V = 16384, SHM_K = 24576, OFF_K = 2 * SHM_V, OFF_WS = OFF_K + 2 * SHM_K;
#define KSW(row, colB) ((row) * 384 + ((colB) ^ SWZF(row)))
__device__ __forceinline__ void qkt(f32x16& p0, f32x16& p1, const LAS char* Ks, const bf16x8* qr, int r32, int hi) {
    p0 = f32x16{}; p1 = f32x16{};
#pragma unroll
    for (int d0 = 0; d0 < 12; ++d0) { const int cb = (d0 * 16 + hi * 8) * 2;
        const bf16x8 b0 = *(const LAS bf16x8*)(Ks + KSW(r32, cb));
        const bf16x8 b1 = *(const LAS bf16x8*)(Ks + KSW(32 + r32, cb));
        p0 = __builtin_amdgcn_mfma_f32_32x32x16_bf16(b0, qr[d0], p0, 0, 0, 0);
        p1 = __builtin_amdgcn_mfma_f32_32x32x16_bf16(b1, qr[d0], p1, 0, 0, 0);
        if ((d0 % 3) == 2) asm volatile("" ::: "memory"); }
}
__device__ __forceinline__ int v_st(int k, int c) { const int kk = (k & ~0xC) | ((k & 4) << 1) | ((k & 8) >> 1); return ((kk >> 3) * 4 + (c >> 5)) * 512 + ((kk & 7) * 32 + (c & 31)) * 2; }
__device__ __forceinline__ int v_rd_base(int lane) { return ((lane & 3) << 3) | (((lane >> 2) & 3) << 6) | (((lane >> 4) & 1) << 5) | (((lane >> 5) & 1) << 8); }
constexpr int v_rd_off(int d0, int ks, int half) { return d0 * 512 + ks * 4096 + half * 2048; }
template <int OFF> __device__ __forceinline__ s16x4 tr_read(int vb) {
    s16x4 r; asm volatile("ds_read_b64_tr_b16 %0, %1 offset:%2" : "=&v"(r) : "v"(vb), "i"(OFF) : "memory"); return r;
}
template <int D0> __device__ __forceinline__ void pv_one(f32x16& od, int vb, bf16x8 pa0, bf16x8 pa1, bf16x8 pa2, bf16x8 pa3) {
    const s16x4 l0 = tr_read<v_rd_off(D0, 0, 0)>(vb), h0 = tr_read<v_rd_off(D0, 0, 1)>(vb), l1 = tr_read<v_rd_off(D0, 1, 0)>(vb), h1 = tr_read<v_rd_off(D0, 1, 1)>(vb);
    const s16x4 l2 = tr_read<v_rd_off(D0, 2, 0)>(vb), h2 = tr_read<v_rd_off(D0, 2, 1)>(vb), l3 = tr_read<v_rd_off(D0, 3, 0)>(vb), h3 = tr_read<v_rd_off(D0, 3, 1)>(vb);
    asm volatile("s_waitcnt lgkmcnt(0)" ::: "memory"); SBAR();
    od = __builtin_amdgcn_mfma_f32_32x32x16_bf16(pa0, PKV(l0, h0), od, 0, 0, 0);
    od = __builtin_amdgcn_mfma_f32_32x32x16_bf16(pa1, PKV(l1, h1), od, 0, 0, 0);
    od = __builtin_amdgcn_mfma_f32_32x32x16_bf16(pa2, PKV(l2, h2), od, 0, 0, 0);
    od = __builtin_amdgcn_mfma_f32_32x32x16_bf16(pa3, PKV(l3, h3), od, 0, 0, 0);
}
__device__ __forceinline__ void pv_d0(f32x16* o, int vb, bf16x8 pa0, bf16x8 pa1, bf16x8 pa2, bf16x8 pa3) {
    pv_one<0>(o[0], vb, pa0, pa1, pa2, pa3); pv_one<1>(o[1], vb, pa0, pa1, pa2, pa3); pv_one<2>(o[2], vb, pa0, pa1, pa2, pa3); pv_one<3>(o[3], vb, pa0, pa1, pa2, pa3);
}
__device__ __forceinline__ void unit(const bf16_t* __restrict__ Qb, const bf16_t* __restrict__ Kh, const bf16_t* __restrict__ Vh, bf16_t* __restrict__ Ob, int qb, LAS char* lds) {
    constexpr float C = MLA_C;
    int tid = threadIdx.x; asm volatile("" : "+v"(tid));
    const int wid = __builtin_amdgcn_readfirstlane(tid >> 6), lane = tid & 63, r32 = lane & 31, hi = lane >> 5;
    LAS char* V_lds = lds; LAS char* K_lds = lds + OFF_K;
    LAS float* wsf = (LAS float*)(lds + OFF_WS) + wid * 64; LAS float* li_l = wsf; LAS float* al_l = wsf + 32;
    float m_reg = -1e30f, l_reg = 0; f32x16 o[4] = {}; bf16x8 qr[12];
    const bf16_t* Qw = Qb + (size_t)(wid * 32 + r32) * LDQ + hi * 8;
#pragma unroll
    for (int d0 = 0; d0 < 12; ++d0) qr[d0] = *(const bf16x8*)(Qw + d0 * 16);
    const int srow = tid >> 3, c8 = tid & 7;
    const int vst = v_st(srow, c8 * 8), kst = KSW(srow, c8 * 16);
    const bf16_t* Vsrc = Vh + (size_t)srow * LDV + c8 * 8; const bf16_t* Ksrc = Kh + (size_t)srow * LDK + c8 * 8;
    const int vb0 = (int)(uintptr_t)V_lds + v_rd_base(lane);
    bf16x8 vs0, vs1, ks0, ks1, ks2;
#define SLOAD(k0) do { const bf16_t* vp_ = Vsrc + (size_t)(k0) * LDV; const bf16_t* kp_ = Ksrc + (size_t)(k0) * LDK; \
    vs0 = *(const bf16x8*)(vp_); vs1 = *(const bf16x8*)(vp_ + 64); ks0 = *(const bf16x8*)(kp_); ks1 = *(const bf16x8*)(kp_ + 64); ks2 = *(const bf16x8*)(kp_ + 128); } while (0)
#define SWRITE(b) do { *(LAS bf16x8*)(V_lds + (b) * SHM_V + vst) = vs0; *(LAS bf16x8*)(V_lds + (b) * SHM_V + vst + 1024) = vs1; \
    *(LAS bf16x8*)(K_lds + (b) * SHM_K + kst) = ks0; *(LAS bf16x8*)(K_lds + (b) * SHM_K + kst + 128) = ks1; *(LAS bf16x8*)(K_lds + (b) * SHM_K + kst + 256) = ks2; } while (0)
#define RESC(a) do { if (__any((a) < 1.f)) { if (hi == 0) al_l[r32] = (a); LDS_WAIT(); \
    _Pragma("unroll") for (int d = 0; d < 4; ++d) _Pragma("unroll") for (int r = 0; r < 16; ++r) o[d][r] *= al_l[crow(r, hi)]; } } while (0)
#define MASKT(P0, P1, tix) do { if ((tix) > mylast) { _Pragma("unroll") for (int r = 0; r < 16; ++r) { P0[r] = -1e30f; P1[r] = -1e30f; } } } while (0)
    const int NT = 4 * qb + 4, mylast = 4 * qb + (wid >> 1);
    SLOAD(0); SWRITE(0); __syncthreads();
    SLOAD(64);
    for (int j = 0; j < NT; ++j) {
        const int b = j & 1;
        f32x16 p0, p1; float mn, alpha; bf16x8 pa0, pa1, pa2, pa3;
        qkt(p0, p1, K_lds + b * SHM_K, qr, r32, hi); MASKT(p0, p1, j);
        partialSM(p0, p1, m_reg, mn, alpha, C);
        RESC(alpha);
        finishSM(p0, p1, alpha, l_reg, pa0, pa1, pa2, pa3); SBAR();
        pv_d0(o, vb0 + b * SHM_V, pa0, pa1, pa2, pa3);
        if (j + 1 < NT) { SWRITE(b ^ 1); if (j + 2 < NT) SLOAD((j + 2) * 64); }
        __syncthreads();
    }
    if (hi == 0) li_l[r32] = l_reg; LDS_WAIT();
    float rli[16];
#pragma unroll
    for (int r = 0; r < 16; ++r) rli[r] = __builtin_amdgcn_rcpf(li_l[crow(r, hi)]);
    bf16_t* Ow = Ob + (size_t)(wid * 32) * LDO;
#pragma unroll
    for (int r = 0; r < 16; ++r) { const int orow = crow(r, hi);
#pragma unroll
        for (int d0 = 0; d0 < 4; ++d0) Ow[(size_t)orow * LDO + d0 * 32 + r32] = f2bf(o[d0][r] * rli[r]); }
    __syncthreads();
#undef SLOAD
#undef SWRITE
#undef RESC
#undef MASKT
}
}

template <int NB> __device__ __forceinline__ void resc_shfl(f32x16 (&o)[NB], float alpha, int hi) {
    if (__any(alpha < 1.f)) {
#pragma unroll
        for (int r = 0; r < 16; ++r) { const float a = __shfl(alpha, crow(r, hi));
#pragma unroll
            for (int d = 0; d < NB; ++d) o[d][r] *= a; }
    }
}

__device__ __forceinline__ void mem_attn_item(const Args& P, int item, int lane_) {
    int lane = lane_; asm volatile("" : "+v"(lane));
    unsigned char* ws = P.ws; const int r32 = lane & 31, hi = lane >> 5;
    const int rb = item >> 2, h = item & 3, t0 = rb * 32;
    const int bsel = t0 < TP ? (t0 >> 12) : 2 + ((t0 - TP) >> 5);
    const bf16_t* Kb = (const bf16_t*)(ws + WS_MK) + (size_t)bsel * 262144 + h * 256;
    const bf16_t* VTb = (const bf16_t*)(ws + WS_MVT) + (size_t)bsel * 262144 + (size_t)h * 65536;
    const bf16_t* Qw = (const bf16_t*)(ws + WS_QM) + (size_t)(t0 + r32) * 1024 + h * 256 + hi * 8;
    bf16x8 qf[16];
#pragma unroll
    for (int ks = 0; ks < 16; ++ks) qf[ks] = *(const bf16x8*)(Qw + ks * 16);
    for (int dh = 0; dh < 2; ++dh) {
        float m_reg = -1e30f, l_reg = 0.f; f32x16 o[4];
#pragma unroll
        for (int d = 0; d < 4; ++d) o[d] = f32x16{};
        for (int tile = 0; tile < 4; ++tile) {
            f32x16 p0 = f32x16{}, p1 = f32x16{};
            const bf16_t* Kt = Kb + (size_t)(tile * 64 + r32) * 1024 + hi * 8;
#pragma unroll
            for (int ks = 0; ks < 16; ++ks) {
                const bf16x8 a0 = *(const bf16x8*)(Kt + ks * 16), a1 = *(const bf16x8*)(Kt + 32 * 1024 + ks * 16);
                p0 = __builtin_amdgcn_mfma_f32_32x32x16_bf16(a0, qf[ks], p0, 0, 0, 0);
                p1 = __builtin_amdgcn_mfma_f32_32x32x16_bf16(a1, qf[ks], p1, 0, 0, 0);
                if ((ks & 1) == 1) asm volatile("" ::: "memory"); }
            float mn, alpha; bf16x8 pa0, pa1, pa2, pa3;
            partialSM(p0, p1, m_reg, mn, alpha, 1.0f);
            resc_shfl<4>(o, alpha, hi);
            finishSM(p0, p1, alpha, l_reg, pa0, pa1, pa2, pa3);
            const bf16_t* Vt = VTb + (size_t)(dh * 128 + r32) * 256 + tile * 64 + hi * 8;
#pragma unroll
            for (int db = 0; db < 4; ++db) { const bf16_t* vp = Vt + (size_t)db * 32 * 256;
                const bf16x8 b0 = *(const bf16x8*)(vp), b1 = *(const bf16x8*)(vp + 16), b2 = *(const bf16x8*)(vp + 32), b3 = *(const bf16x8*)(vp + 48);
                o[db] = __builtin_amdgcn_mfma_f32_32x32x16_bf16(pa0, b0, o[db], 0, 0, 0);
                o[db] = __builtin_amdgcn_mfma_f32_32x32x16_bf16(pa1, b1, o[db], 0, 0, 0);
                o[db] = __builtin_amdgcn_mfma_f32_32x32x16_bf16(pa2, b2, o[db], 0, 0, 0);
                o[db] = __builtin_amdgcn_mfma_f32_32x32x16_bf16(pa3, b3, o[db], 0, 0, 0);
                asm volatile("" ::: "memory"); }
        }
        const float rl = __builtin_amdgcn_rcpf(l_reg);
        bf16_t* Ow = (bf16_t*)(ws + WS_OMEM) + (size_t)t0 * 1024 + h * 256 + dh * 128 + r32;
#pragma unroll
        for (int r = 0; r < 16; ++r) { const float a = __shfl(rl, crow(r, hi)); const int orow = crow(r, hi);
#pragma unroll
            for (int db = 0; db < 4; ++db) Ow[(size_t)orow * 1024 + db * 32] = f2bf(o[db][r] * a); }
    }
}

namespace sat {
constexpr int ROWB = 1152, TKEYS = 32, CT_BYTES = TKEYS * ROWB, OFF_X = 2 * CT_BYTES, OFF_RK = OFF_X + 32768, NT = 4128 / TKEYS, OLB = 1040;
__device__ __forceinline__ int coff(int row, int colB) { return row * ROWB + (colB ^ SWZF(row)); }
__device__ __forceinline__ void partialSM1(f32x16& p0, float& m_reg, float& alpha) {
    float pmax = p0[0];
#pragma unroll
    for (int r = 1; r < 16; ++r) pmax = fmaxf(pmax, p0[r]);
    { auto rr = __builtin_amdgcn_permlane32_swap(__float_as_uint(pmax), __float_as_uint(pmax), false, false);
      pmax = fmaxf(__uint_as_float(rr[0]), __uint_as_float(rr[1])); }
    float mn;
    if (__builtin_expect(__all(pmax - m_reg <= 11.5f), 1)) { mn = m_reg; alpha = 1.f; }
    else { mn = fmaxf(m_reg, pmax); alpha = __builtin_amdgcn_exp2f(m_reg - mn); m_reg = mn; }
#pragma unroll
    for (int r = 0; r < 16; ++r) p0[r] = __builtin_amdgcn_exp2f(p0[r] - mn);
}
__device__ __forceinline__ void finishSM1(f32x16& p0, float alpha, float& l_reg, bf16x8& pa0, bf16x8& pa1) {
    float ps = 0;
#pragma unroll
    for (int r = 0; r < 16; ++r) ps += p0[r];
    { auto rr = __builtin_amdgcn_permlane32_swap(__float_as_uint(ps), __float_as_uint(ps), false, false);
      ps = __uint_as_float(rr[0]) + __uint_as_float(rr[1]); }
    l_reg = l_reg * alpha + ps;
#define PK4(P, BASE, OUT) do { unsigned a0 = cvtpk(P[BASE + 0], P[BASE + 1]), a1 = cvtpk(P[BASE + 2], P[BASE + 3]);   \
    unsigned b0 = cvtpk(P[BASE + 4], P[BASE + 5]), b1 = cvtpk(P[BASE + 6], P[BASE + 7]);                              \
    auto r0 = __builtin_amdgcn_permlane32_swap(a0, b0, false, false); auto r1 = __builtin_amdgcn_permlane32_swap(a1, b1, false, false); \
    u32x4 w = {r0[0], r1[0], r0[1], r1[1]}; OUT = __builtin_bit_cast(bf16x8, w); } while (0)
    PK4(p0, 0, pa0); PK4(p0, 8, pa1);
#undef PK4
}
__device__ __forceinline__ void unit(const Args& P, int b, int hp, LAS char* lds) {
    unsigned char* ws = P.ws;
    int tid = threadIdx.x; asm volatile("" : "+v"(tid));
    const int wid = __builtin_amdgcn_readfirstlane(tid >> 6), lane = tid & 63, r32 = lane & 31, hi = lane >> 5;
    const int hl = wid >> 2, wq = wid & 3, h = 2 * hp + hl;
    const bf16_t* LATb = (const bf16_t*)(ws + WS_LATS) + (size_t)b * KPAD * 512;
    const bf16_t* KRb = (const bf16_t*)(ws + WS_KRS) + (size_t)b * KPAD * 64;
    const float* KPESSb = (const float*)(ws + WS_KPESS) + (size_t)b * KPAD;
    const float* KSSb = (const float*)(ws + WS_KSS) + (size_t)b * KPAD * 64;
    LAS char* CT = lds; LAS char* XCH = lds + OFF_X; LAS float* RK = (LAS float*)(lds + OFF_RK);
    bf16x8 qa[9];
    { const bf16_t* Qh = (const bf16_t*)(ws + WS_Q) + (size_t)(TP + b * 32 + r32) * QLD + h * 192;
      const float* gk = P.in[I_GKHEAD];
      bf16x8 qg[8];
#pragma unroll
      for (int ks = 0; ks < 8; ++ks) { float f[8]; unpack8(*(const u32x4*)(Qh + ks * 16 + hi * 8), f);
          const f32x4 g0 = *(const f32x4*)(gk + ks * 16 + hi * 8), g1 = *(const f32x4*)(gk + ks * 16 + hi * 8 + 4);
          f[0] *= g0.x; f[1] *= g0.y; f[2] *= g0.z; f[3] *= g0.w; f[4] *= g1.x; f[5] *= g1.y; f[6] *= g1.z; f[7] *= g1.w;
          qg[ks] = __builtin_bit_cast(bf16x8, pack8(f)); }
      const int prow = (r32 & ~12) | ((r32 & 4) << 1) | ((r32 & 8) >> 1);
      const bf16_t* Wn = (const bf16_t*)(ws + WS_WKBN) + (size_t)(128 * wq + prow) * 2048 + h * 128 + hi * 8;
#pragma unroll
      for (int cb = 0; cb < 4; ++cb) { f32x16 acc = f32x16{};
#pragma unroll
          for (int ks = 0; ks < 8; ++ks) { const bf16x8 a = *(const bf16x8*)(Wn + (size_t)cb * 32 * 2048 + ks * 16); acc = __builtin_amdgcn_mfma_f32_32x32x16_bf16(a, qg[ks], acc, 0, 0, 0); }
          qa[2 * cb] = __builtin_bit_cast(bf16x8, (u32x4){cvtpk(acc[0], acc[1]), cvtpk(acc[2], acc[3]), cvtpk(acc[4], acc[5]), cvtpk(acc[6], acc[7])});
          qa[2 * cb + 1] = __builtin_bit_cast(bf16x8, (u32x4){cvtpk(acc[8], acc[9]), cvtpk(acc[10], acc[11]), cvtpk(acc[12], acc[13]), cvtpk(acc[14], acc[15])});
          asm volatile("" ::: "memory"); }
      qa[8] = *(const bf16x8*)(Qh + 128 + 16 * wq + 8 * hi); }
    int soff[5]; bool iskr[5];
#pragma unroll
    for (int k = 0; k < 5; ++k) { const int d = (wid + 8 * k) * 1024 + lane * 16, row = d / ROWB, cs = (d - row * ROWB) >> 4, ch = cs ^ (SWZF(row) >> 4);
        iskr[k] = ch >= 64; soff[k] = ch >= 64 ? row * 64 + (ch - 64) * 8 : row * 512 + ch * 8; }
#define TDMA(j, buf) do { _Pragma("unroll") for (int k = 0; k < 5; ++k) { if (k < 4 || wid < 4) { \
        const bf16_t* sp_ = iskr[k] ? KRb + (size_t)(j) * TKEYS * 64 + soff[k] : LATb + (size_t)(j) * TKEYS * 512 + soff[k]; \
        __builtin_amdgcn_global_load_lds((const unsigned*)sp_, (LAS unsigned*)(CT + (buf) * CT_BYTES + (wid + 8 * k) * 1024), 16, 0, 0); } } } while (0)
#define RKVAL(j) (rsqrtf(((rk4.x + rk4.y) + (rk4.z + rk4.w) + rkp) * (1.f / 192.f) + EPS) * MLA_C)
#define RKLOAD(j) do { if (tid < 64) { const int key = (j) * TKEYS + (tid & 31); rk4 = *(const f32x4*)(KSSb + ((size_t)key * 16 + 2 * hp + (tid >> 5)) * 4); rkp = KPESSb[key]; } } while (0)
    f32x4 rk4 = {0.f, 0.f, 0.f, 0.f}; float rkp = 0.f;
    int trb[2][2];
#pragma unroll
    for (int t = 0; t < 2; ++t)
#pragma unroll
        for (int c1 = 0; c1 < 2; ++c1) trb[t][c1] = coff(8 * hi + 4 * t + ((r32 & 15) >> 2), 256 * wq + 64 * c1 + 32 * (r32 >> 4) + 8 * (r32 & 3));
    int aoff[5];
#pragma unroll
    for (int k = 0; k < 4; ++k) aoff[k] = coff(r32, 256 * wq + 32 * k + 16 * hi);
    aoff[4] = coff(r32, 1024 + 32 * wq + 16 * hi);
    float m_reg = -1e30f, l_reg = 0.f; f32x16 o[4];
#pragma unroll
    for (int d = 0; d < 4; ++d) o[d] = f32x16{};
    TDMA(0, 0); RKLOAD(0);
    if (tid < 64) RK[tid] = RKVAL(0);
    asm volatile("s_waitcnt vmcnt(0) lgkmcnt(0)" ::: "memory"); __builtin_amdgcn_s_barrier(); asm volatile("" ::: "memory");
    for (int j = 0; j < NT; ++j) {
        const int bf = j & 1; const LAS char* CTb = CT + bf * CT_BYTES;
        if (j + 1 < NT) { TDMA(j + 1, bf ^ 1); RKLOAD(j + 1); }
        f32x16 p0 = f32x16{};
#pragma unroll
        for (int ks = 0; ks < 9; ++ks) { const bf16x8 a0 = *(const LAS bf16x8*)(CTb + (ks < 8 ? aoff[ks & 3] + 128 * (ks >> 2) : aoff[4]));
            p0 = __builtin_amdgcn_mfma_f32_32x32x16_bf16(a0, qa[ks], p0, 0, 0, 0); }
        { LAS char* xw = XCH + wid * 4096 + lane * 16;
#pragma unroll
          for (int a = 0; a < 4; ++a) *(LAS f32x4*)(xw + a * 1024) = (f32x4){p0[4 * a], p0[4 * a + 1], p0[4 * a + 2], p0[4 * a + 3]}; }
        asm volatile("s_waitcnt lgkmcnt(0)" ::: "memory"); __builtin_amdgcn_s_barrier(); asm volatile("" ::: "memory");
        { const LAS char* xr = XCH + hl * 16384 + lane * 16;
#pragma unroll
          for (int a = 0; a < 4; ++a) {
              f32x4 s0 = *(const LAS f32x4*)(xr + a * 1024);
#pragma unroll
              for (int w = 1; w < 4; ++w) s0 += *(const LAS f32x4*)(xr + w * 4096 + a * 1024);
              s0 *= *(const LAS f32x4*)(RK + bf * 64 + hl * 32 + 8 * a + 4 * hi);
              p0[4 * a] = s0.x; p0[4 * a + 1] = s0.y; p0[4 * a + 2] = s0.z; p0[4 * a + 3] = s0.w; } }
        float alpha; bf16x8 pa0, pa1;
        partialSM1(p0, m_reg, alpha);
        resc_shfl<4>(o, alpha, hi);
        finishSM1(p0, alpha, l_reg, pa0, pa1);
#pragma unroll
        for (int cb = 0; cb < 4; ++cb) {
            const LAS char* b0 = CTb + trb[0][cb & 1] + (cb >> 1) * 128; const LAS char* b1 = CTb + trb[1][cb & 1] + (cb >> 1) * 128;
            const s16x4 l0 = vtr(b0), h0 = vtr(b1), l1 = vtr(b0 + 16 * ROWB), h1 = vtr(b1 + 16 * ROWB);
            o[cb] = __builtin_amdgcn_mfma_f32_32x32x16_bf16(pa0, PKV(l0, h0), o[cb], 0, 0, 0);
            o[cb] = __builtin_amdgcn_mfma_f32_32x32x16_bf16(pa1, PKV(l1, h1), o[cb], 0, 0, 0); }
        if (j + 1 < NT && tid < 64) RK[(bf ^ 1) * 64 + tid] = RKVAL(j + 1);
        asm volatile("s_waitcnt vmcnt(0) lgkmcnt(0)" ::: "memory"); __builtin_amdgcn_s_barrier(); asm volatile("" ::: "memory");
    }
    { const float rl = __builtin_amdgcn_rcpf(l_reg);
      LAS bf16_t* OL = (LAS bf16_t*)(CT + hl * 32 * OLB);
#pragma unroll
      for (int r = 0; r < 16; ++r) { const float a = __shfl(rl, crow(r, hi)); const int orow = crow(r, hi);
#pragma unroll
          for (int cb = 0; cb < 4; ++cb) OL[orow * (OLB / 2) + 128 * wq + 32 * cb + r32] = f2bf(o[cb][r] * a); }
      __syncthreads();
      f32x16 acc = f32x16{};
      const bf16_t* Wv = (const bf16_t*)(ws + WS_WVB) + (size_t)(h * 128 + 32 * wq + r32) * 512 + hi * 8;
      const LAS char* ar = CT + hl * 32 * OLB + r32 * OLB + hi * 16;
#pragma unroll 8
      for (int ks = 0; ks < 32; ++ks) { const bf16x8 a = *(const LAS bf16x8*)(ar + ks * 32); const bf16x8 bw = *(const bf16x8*)(Wv + ks * 16);
          acc = __builtin_amdgcn_mfma_f32_32x32x16_bf16(a, bw, acc, 0, 0, 0); }
      bf16_t* Ow = (bf16_t*)(ws + WS_OMLA) + (size_t)(TP + b * 32) * 2048 + h * 128 + 32 * wq + r32;
#pragma unroll
      for (int r = 0; r < 16; ++r) Ow[(size_t)crow(r, hi) * 2048] = f2bf(acc[r]);
      __syncthreads(); }
#undef TDMA
#undef RKLOAD
#undef RKVAL
}
}


struct MergeSched {
    const bf16_t *D, *WP, *OML, *WML, *OME, *WME; int G, c;
    __device__ __forceinline__ bool next(int i, pg8::Unit& u) const {
        const int ti = i / 3, seg = i - 3 * ti; const long L = (long)ti * G + c; if (L >= 34 * 8) return false;
        int pm, pn; pg8::tile_of((int)L, 34, 8, pm, pn); u.pm = pm; u.pn = pn; u.kind = seg;
        if (seg == 0) { u.A = (const char*)(D + (size_t)pm * 256 * 1024 + (pn >> 1) * 256); u.lda2 = 2048u; u.B = (const char*)(WP + (size_t)pn * 256 * 256); u.ldb2 = 512u; u.nt = 4; }
        else if (seg == 1) { u.A = (const char*)(OML + (size_t)pm * 256 * 2048); u.lda2 = 4096u; u.B = (const char*)(WML + (size_t)pn * 256 * 2048); u.ldb2 = 4096u; u.nt = 32; }
        else { u.A = (const char*)(OME + (size_t)pm * 256 * 1024); u.lda2 = 2048u; u.B = (const char*)(WME + (size_t)pn * 256 * 1024); u.ldb2 = 2048u; u.nt = 16; }
        return true;
    }
};
struct EpiMerge {
    static constexpr bool PERM = true;
    const bf16_t* G; const float* ps; bf16_t* MG;
    __device__ __forceinline__ bool operator()(f32x4 (&acc)[2][2][4][2], const pg8::Unit& u, int wr, int wc, int fr, int fq) const {
        const int row0 = u.pm * 256 + wr * 64 + fr, c0 = u.pn * 256 + wc * 32 + 8 * fq;
        const int seg = u.kind;
        f32x4 pv[2][2];
        if (seg == 0) {
#pragma unroll
            for (int bj = 0; bj < 2; ++bj) { pv[bj][0] = *(const f32x4*)(ps + c0 + bj * 128); pv[bj][1] = *(const f32x4*)(ps + c0 + bj * 128 + 4); }
        }
#pragma unroll
        for (int ai = 0; ai < 2; ++ai)
#pragma unroll
            for (int m = 0; m < 4; ++m) { const size_t row = (size_t)(row0 + ai * 128 + m * 16); const bf16_t* gr = G + row * G_LD + c0;
#pragma unroll
                for (int bj = 0; bj < 2; ++bj) {
                    float f[8];
                    if (seg == 0) { float a[8], b[8]; unpack8(*(const u32x4*)(gr + bj * 128), a); unpack8(*(const u32x4*)(gr + 2048 + bj * 128), b);
#pragma unroll
                        for (int e = 0; e < 8; ++e) f[e] = a[e] * __builtin_amdgcn_rcpf(b[e]) * pv[bj][e >> 2][e & 3]; }
                    else if (seg == 1) { float a[8], b[8]; unpack8(*(const u32x4*)(gr + 2048 + bj * 128), a); unpack8(*(const u32x4*)(gr + 4096 + bj * 128), b);
#pragma unroll
                        for (int e = 0; e < 8; ++e) f[e] = a[e] * __builtin_amdgcn_rcpf(b[e]); }
                    else unpack8(*(const u32x4*)(gr + 4096 + bj * 128), f);
                    f32x4& v0 = acc[ai][bj][m][0]; f32x4& v1 = acc[ai][bj][m][1];
                    v0[0] *= f[0]; v0[1] *= f[1]; v0[2] *= f[2]; v0[3] *= f[3]; v1[0] *= f[4]; v1[1] *= f[5]; v1[2] *= f[6]; v1[3] *= f[7];
                    if (seg == 2) *(u32x4*)(MG + row * 2048 + c0 + bj * 128) = (u32x4){cvtpk(v0[0], v0[1]), cvtpk(v0[2], v0[3]), cvtpk(v1[0], v1[1]), cvtpk(v1[2], v1[3])};
                } }
        return seg != 2;
    }
};
struct EpiOut {
    static constexpr bool PERM = false;
    const float* xp; const float* xs; float* X1; bf16_t* X1b; float* SSX;
    __device__ __forceinline__ bool operator()(f32x4 (&acc)[2][2][4][2], const pg8::Unit& u, int wr, int wc, int fr, int fq) const {
        const int row0 = u.pm * 256 + wr * 64 + fr, c0 = u.pn * 256 + wc * 32 + 4 * fq;
#pragma unroll
        for (int ai = 0; ai < 2; ++ai)
#pragma unroll
            for (int m = 0; m < 4; ++m) { const int row = row0 + ai * 128 + m * 16;
                const float* xr = (row < TP ? xp + (size_t)row * DM : xs + (size_t)(row - TP) * DM) + c0;
                float s = 0.f;
#pragma unroll
                for (int bj = 0; bj < 2; ++bj)
#pragma unroll
                    for (int n = 0; n < 2; ++n) { const f32x4 v = acc[ai][bj][m][n] + *(const f32x4*)(xr + bj * 128 + n * 16);
                        s += (v.x * v.x + v.y * v.y) + (v.z * v.z + v.w * v.w);
                        *(f32x4*)(X1 + (size_t)row * DM + c0 + bj * 128 + n * 16) = v;
                        *(u32x2*)(X1b + (size_t)row * DM + c0 + bj * 128 + n * 16) = (u32x2){cvtpk(v.x, v.y), cvtpk(v.z, v.w)}; }
                s += __shfl_xor(s, 16); s += __shfl_xor(s, 32);
                if (fq == 0) SSX[(size_t)row * 32 + u.pn * 4 + wc] = s; }
        return false;
    }
};
struct EpiUp {
    static constexpr bool PERM = true;
    const float* SSX; bf16_t* A;
    __device__ __forceinline__ bool operator()(f32x4 (&acc)[2][2][4][2], const pg8::Unit& u, int wr, int wc, int fr, int fq) const {
        const int row0 = u.pm * 256 + wr * 64 + fr, c0 = u.pn * 256 + wc * 32 + 8 * fq;
#pragma unroll
        for (int ai = 0; ai < 2; ++ai)
#pragma unroll
            for (int m = 0; m < 4; ++m) { const size_t row = (size_t)(row0 + ai * 128 + m * 16);
                const f32x4 s0 = *(const f32x4*)(SSX + row * 32 + fq * 8), s1 = *(const f32x4*)(SSX + row * 32 + fq * 8 + 4);
                float s = ((s0.x + s0.y) + (s0.z + s0.w)) + ((s1.x + s1.y) + (s1.z + s1.w));
                s += __shfl_xor(s, 16); s += __shfl_xor(s, 32);
                const float r = rsqrtf(s * (1.f / 2048.f) + EPS);
#pragma unroll
                for (int bj = 0; bj < 2; ++bj) { f32x4 v0 = acc[ai][bj][m][0] * r, v1 = acc[ai][bj][m][1] * r;
#pragma unroll
                    for (int e = 0; e < 4; ++e) { const float a = fmaxf(v0[e], 0.f), b = fmaxf(v1[e], 0.f); v0[e] = a * a; v1[e] = b * b; }
                    *(u32x4*)(A + row * 8192 + c0 + bj * 128) = (u32x4){cvtpk(v0[0], v0[1]), cvtpk(v0[2], v0[3]), cvtpk(v1[0], v1[1]), cvtpk(v1[2], v1[3])}; } }
        return false;
    }
};
struct EpiDown {
    static constexpr bool PERM = false;
    float* Y;
    __device__ __forceinline__ bool operator()(f32x4 (&acc)[2][2][4][2], const pg8::Unit& u, int wr, int wc, int fr, int fq) const {
        const int row0 = u.pm * 256 + wr * 64 + fr, c0 = u.pn * 256 + wc * 32 + 4 * fq;
#pragma unroll
        for (int ai = 0; ai < 2; ++ai)
#pragma unroll
            for (int m = 0; m < 4; ++m) { float* yr = Y + (size_t)(row0 + ai * 128 + m * 16) * DM + c0;
#pragma unroll
                for (int bj = 0; bj < 2; ++bj)
#pragma unroll
                    for (int n = 0; n < 2; ++n) { f32x4* p = (f32x4*)(yr + bj * 128 + n * 16); *p = *p + acc[ai][bj][m][n]; } }
        return false;
    }
};


struct SchedB {
    const unsigned char* ws; int G, c;
    __device__ __forceinline__ bool next(int i, pg8::Unit& u) const {
        const long L = (long)i * G + c; constexpr int N0 = 34 * 37, N1 = 2 * 8; if (L >= N0 + N1) return false;
        int pm, pn; u.lda2 = 4096u; u.ldb2 = 4096u; u.nt = 32;
        if (L < N0) { pg8::tile_of((int)L, 34, 37, pm, pn); u.A = (const char*)(ws + WS_H + (size_t)pm * 256 * 4096); u.B = (const char*)(ws + WS_WIN + (size_t)pn * 256 * 4096); u.kind = 0; }
        else { pg8::tile_of((int)L - N0, 2, 8, pm, pn); u.A = (const char*)(ws + WS_HM + (size_t)pm * 256 * 4096); u.B = (const char*)(ws + WS_WMEMKV + (size_t)pn * 256 * 4096); u.kind = 1; }
        u.pm = pm; u.pn = pn; return true;
    }
};
struct SchedD {
    const unsigned char* ws; const unsigned char* ob; int G, c;
    __device__ __forceinline__ bool next(int i, pg8::Unit& u) const {
        const long L = (long)i * G + c; constexpr int N0 = (NBS * KPAD / 256) * 8, N1 = N0 + 34 * 12, N2 = N1 + 32 * 8, N3 = N2 + 32 * 8; if (L >= N3) return false;
        int pm, pn; u.lda2 = 1024u; u.ldb2 = 1024u; u.nt = 8;
        if (L < N0) { pg8::tile_of((int)L, NBS * KPAD / 256, 8, pm, pn); u.A = (const char*)(ws + WS_LATS + (size_t)pm * 256 * 1024); u.B = (const char*)(ws + WS_WKB + (size_t)pn * 256 * 1024); u.kind = 3; }
        else if (L < N1) { pg8::tile_of((int)L - N0, 34, 12, pm, pn); u.A = (const char*)(ws + WS_QN + (size_t)pm * 256 * 1024); u.B = (const char*)(ws + WS_WQB + (size_t)pn * 256 * 1024); u.kind = 0; }
        else if (L < N2) { pg8::tile_of((int)L - N1, 32, 8, pm, pn); u.A = (const char*)(ob + DO_CKVP + (size_t)pm * 256 * 1024); u.B = (const char*)(ws + WS_WKB + (size_t)pn * 256 * 1024); u.kind = 1; }
        else { pg8::tile_of((int)L - N2, 32, 8, pm, pn); u.A = (const char*)(ob + DO_CKVP + (size_t)pm * 256 * 1024); u.B = (const char*)(ws + WS_WVB + (size_t)pn * 256 * 1024); u.kind = 2; }
        u.pm = pm; u.pn = pn; return true;
    }
};

constexpr int CW_BAR = 4096;
#ifndef ONLY
#define ONLY -1
#endif
#define PH(x) (ONLY < 0 || ONLY == (x))
__global__ void __launch_bounds__(NWAVES * 64, 2) mega_fwd(Args P) {
    extern __shared__ __attribute__((aligned(16))) unsigned char lds_raw[];
    LAS unsigned char* lds = (LAS unsigned char*)lds_raw;
    const int tid = threadIdx.x, lane = tid & 63, wave = __builtin_amdgcn_readfirstlane(tid >> 6);
    const int G = gridDim.x, bx = blockIdx.x;
    const int vcu = (G % 8 == 0) ? (bx % 8) * (G / 8) + bx / 8 : bx;
    const int gw = vcu * NWAVES + wave, NGW = G * NWAVES;
    volatile LAS unsigned* MISC = (volatile LAS unsigned*)(lds + MISC_OFF);
    if (tid < 64) MISC[tid] = 0u;
    __syncthreads();
    unsigned* ctl = (unsigned*)(P.ws + WS_CTL);
    XcdBarrier bar = xcd_barrier_post(ctl + CW_BAR, MISC + 8);
    unsigned char* ws = P.ws;

    if (PH(0)) phase_prep(P, lds, gw, NGW, wave, lane);
    xcd_barrier(bar);
    if (PH(1)) {
        SchedB S{ws, G, bx};
        EpiIn E{(bf16_t*)(ws + WS_ZS), (bf16_t*)(ws + WS_G), (float*)(ws + WS_M), P.in[I_BGATE]};
        pg8::gemm_stream<EpiIn, SchedB>(lds, S, E);
    }
    xcd_barrier(bar);
    if (PH(2)) phase_rows(P, lds, gw, NGW, wave, lane);
    xcd_barrier(bar);
    if (PH(3)) {
        SchedD S{ws, (const unsigned char*)P.out, G, bx};
        EpiQKV E{(bf16_t*)(ws + WS_Q), (bf16_t*)((unsigned char*)P.out + DO_K), (bf16_t*)(ws + WS_V), (float*)(ws + WS_KSS)};
        pg8::gemm_stream<EpiQKV, SchedD>(lds, S, E);
    }
    xcd_barrier(bar);
    if (PH(4)) phase_heads(P, gw, NGW, lane);
    xcd_barrier(bar);
    {
        const int bh = vcu >> 3, s = vcu & 7, b = bh >> 4, h = bh & 15;
        const bf16_t* Qg = (const bf16_t*)(ws + WS_Q); const bf16_t* Kg = (const bf16_t*)((unsigned char*)P.out + DO_K); const bf16_t* Vg = (const bf16_t*)(ws + WS_V);
        bf16_t* Og = (bf16_t*)(ws + WS_OMLA);
        if (PH(5)) for (int i = 0; i < 2; ++i) { const int qb = i == 0 ? s : 15 - s;
            pat::unit(Qg + ((size_t)(b * 4096 + qb * 256) * QLD + h * 192), Kg + ((size_t)b * 4096 * QLD + h * 192), Vg + ((size_t)b * 4096 * 2048 + h * 128),
                      Og + ((size_t)(b * 4096 + qb * 256) * 2048 + h * 128), qb, (LAS char*)lds); }
        if (PH(6)) if (vcu < 128) sat::unit(P, vcu >> 3, vcu & 7, (LAS char*)lds);
        if (PH(7)) for (int it = gw; it < (TT / 32) * 4; it += NGW) mem_attn_item(P, it, lane);
    }
    xcd_barrier(bar);
    if (PH(8)) {
        MergeSched S{(const bf16_t*)(ws + WS_DP), (const bf16_t*)(ws + WS_WPOOL), (const bf16_t*)(ws + WS_OMLA), (const bf16_t*)(ws + WS_WMLAO),
                     (const bf16_t*)(ws + WS_OMEM), (const bf16_t*)(ws + WS_WMEMO), G, bx};
        EpiMerge E{(const bf16_t*)(ws + WS_G), P.in[I_PSCALE], (bf16_t*)(ws + WS_MG)};
        pg8::gemm_stream<EpiMerge, MergeSched>(lds, S, E);
    }
    xcd_barrier(bar);
    if (PH(9)) {
        pg8::JobSched1 S; S.j0 = pg8::Job{(const bf16_t*)(ws + WS_MG), (const bf16_t*)(ws + WS_WOUT), 2048, 2048, 34, 8, 0}; S.finish(G, bx);
        EpiOut E{P.in[I_XP], P.in[I_XS], P.out + O_YP, (bf16_t*)(ws + WS_X1B), (float*)(ws + WS_SSX)};
        pg8::gemm_stream<EpiOut, pg8::JobSched1>(lds, S, E);
    }
    xcd_barrier(bar);
    if (PH(10)) {
        pg8::JobSched1 S; S.j0 = pg8::Job{(const bf16_t*)(ws + WS_X1B), (const bf16_t*)(ws + WS_WUP), 2048, 2048, 34, 32, 0}; S.finish(G, bx);
        EpiUp E{(const float*)(ws + WS_SSX), (bf16_t*)(ws + WS_A)};
        pg8::gemm_stream<EpiUp, pg8::JobSched1>(lds, S, E);
    }
    xcd_barrier(bar);
    if (PH(11)) {
        pg8::JobSched1 S; S.j0 = pg8::Job{(const bf16_t*)(ws + WS_A), (const bf16_t*)(ws + WS_WDOWN), 8192, 8192, 34, 8, 0}; S.finish(G, bx);
        EpiDown E{P.out + O_YP};
        pg8::gemm_stream<EpiDown, pg8::JobSched1>(lds, S, E);
    }
}

extern "C" void kernel_launch(void* const* d_in, const int* in_sizes, int n_in, void* d_out, int out_size, void* d_ws, size_t ws_size, hipStream_t stream) {
    static int grid = 0;
    if (grid == 0) {
        if (n_in != 30 || ws_size < WS_END || out_size != 24164352) { fprintf(stderr, "kernel_launch: unexpected problem: n_in %d out %d ws %zu (need %zu)\n", n_in, out_size, ws_size, (size_t)WS_END); grid = -1; return; }
        int dev = 0, cus = 0, per_cu = 0;
        if (hipGetDevice(&dev) != hipSuccess || hipDeviceGetAttribute(&cus, hipDeviceAttributeMultiprocessorCount, dev) != hipSuccess) { grid = -1; return; }
        if (hipFuncSetAttribute((const void*)mega_fwd, hipFuncAttributeMaxDynamicSharedMemorySize, LDS_BYTES) != hipSuccess) { fprintf(stderr, "kernel_launch: hipFuncSetAttribute(%d) failed\n", LDS_BYTES); grid = -1; return; }
        if (hipOccupancyMaxActiveBlocksPerMultiprocessor(&per_cu, (const void*)mega_fwd, NWAVES * 64, LDS_BYTES) != hipSuccess || per_cu < 1) { fprintf(stderr, "kernel_launch: occupancy query says %d blocks per CU\n", per_cu); grid = -1; (void)hipGetLastError(); return; }
        grid = cus;
    }
    if (grid < 0) return;
    (void)hipMemsetAsync((char*)d_ws + WS_CTL, 0, CTL_ZERO_BYTES, stream);
    Args a{};
    for (int i = 0; i < 30; ++i) a.in[i] = (const float*)d_in[i];
    a.out = (float*)d_out; a.ws = (unsigned char*)d_ws;
    hipLaunchKernelGGL(mega_fwd, dim3(grid), dim3(NWAVES * 64), LDS_BYTES, stream, a);
}
```

```cpp
#include <hip/hip_runtime.h>
#include <cstdio>
#include <cstdint>

#define LAS __attribute__((address_space(3)))
#define GAS __attribute__((address_space(1)))
typedef unsigned short bf16_t;
typedef short bf16x8 __attribute__((ext_vector_type(8)));
typedef short s16x4 __attribute__((ext_vector_type(4)));
typedef float f32x2 __attribute__((ext_vector_type(2)));
typedef float f32x4 __attribute__((ext_vector_type(4)));
typedef float f32x16 __attribute__((ext_vector_type(16)));
typedef unsigned u32x2 __attribute__((ext_vector_type(2)));
typedef unsigned u32x4 __attribute__((ext_vector_type(4)));
typedef __bf16 bf16x2_t __attribute__((ext_vector_type(2)));

constexpr int DM = 2048, TP = 8192, TS = 512, TT = TP + TS, SEQ = 4096, LS = 32, NBS = 16;
constexpr int KPAD = 4160;
constexpr int ZS_LD = 3136, G_LD = 6144, QLD = 3072, NHEAD = 16;
constexpr float EPS = 1e-6f;
constexpr float MLA_C = 0.07216878364870322f * 1.4426950408889634f;
constexpr float MEM_C = 0.0625f * 1.4426950408889634f;
constexpr size_t O_YP = 0, O_YS = 16777216, O_LATP = 17825792, O_KPEP = 22020096, O_POOLP = 22544384, O_MEMK = 22575104, O_MEMV = 23099392,
                 O_LATS = 23623680, O_KPES = 23885824, O_POOLS = 23918592;
constexpr size_t MiB = 1u << 20;
constexpr size_t WS_CTL = 0, CTL_ZERO_BYTES = 1 * MiB;
constexpr size_t WS_WIN = 1 * MiB, WS_WMEMKV = 38 * MiB, WS_WQB = 46 * MiB, WS_WKB = 49 * MiB, WS_WVB = 51 * MiB, WS_WKBN = 53 * MiB, WS_WPOOL = 55 * MiB,
                 WS_WMLAO = 56 * MiB, WS_WMEMO = 64 * MiB, WS_WOUT = 68 * MiB, WS_WUP = 76 * MiB, WS_WDOWN = 108 * MiB;
constexpr size_t WS_G = 140 * MiB, WS_ZS = 242 * MiB, WS_Q = 242 * MiB, WS_A = 140 * MiB;
constexpr size_t WS_LATS = 295 * MiB, WS_KRS = 360 * MiB, WS_KPESS = 368 * MiB + 512 * 1024, WS_MG = 295 * MiB, WS_X1B = 329 * MiB;
constexpr size_t WS_H = 369 * MiB, WS_DP = 369 * MiB, WS_QN = 386 * MiB, WS_OMEM = 386 * MiB, WS_OMLA = 1 * MiB;
constexpr size_t WS_HM = 403 * MiB, WS_M = 405 * MiB, WS_QM = 409 * MiB, WS_V = 426 * MiB, WS_KSS = 458 * MiB, WS_MK = 475 * MiB, WS_MVT = 484 * MiB,
                 WS_KRP = 493 * MiB, WS_KPESSP = 494 * MiB, WS_SSX = 494 * MiB + 256 * 1024, WS_END = 496 * MiB;
constexpr size_t DO_K = 0, DO_CKVP = 56 * MiB;

constexpr int LDS_BYTES = 160 * 1024, MISC_OFF = LDS_BYTES - 256;
constexpr int NWAVES = 8;

#define LDS_WAIT() asm volatile("s_waitcnt lgkmcnt(0)" ::: "memory")
#define VM_WAIT() asm volatile("s_waitcnt vmcnt(0)" ::: "memory")
#define SBAR() __builtin_amdgcn_sched_barrier(0)
__device__ __forceinline__ unsigned cvtpk(float lo, float hi) { f32x2 v = {lo, hi}; bf16x2_t b = __builtin_convertvector(v, bf16x2_t); return __builtin_bit_cast(unsigned, b); }
__device__ __forceinline__ float bflo(unsigned u) { return __uint_as_float(u << 16); }
__device__ __forceinline__ float bfhi(unsigned u) { return __uint_as_float(u & 0xffff0000u); }
__device__ __forceinline__ float bf2f(bf16_t b) { return __uint_as_float((unsigned)b << 16); }
__device__ __forceinline__ bf16_t f2bf(float f) { return (bf16_t)(cvtpk(f, 0.f) & 0xffffu); }
__device__ __forceinline__ float wave_sum(float v) {
#pragma unroll
    for (int o = 1; o < 64; o <<= 1) v += __shfl_xor(v, o);
    return v;
}
__device__ __forceinline__ int crow(int r, int hi) { return (r & 3) + 8 * (r >> 2) + 4 * hi; }
__device__ __forceinline__ float rope_inv(int j) { return __builtin_amdgcn_exp2f(-(float)j * (13.287712379549449f / 32.0f)); }

#define XB_TMO      128
#define XB_XCNT(j)  (256  + 64 * (j))
#define XB_XSUB(j)  (1280 + 64 * (j))
#define XB_XGEN(j)  (2304 + 64 * (j))
#define XB_TOP      3328
#define XB_TOPGEN   3392
#define XCD_BAR_WORDS 3456
#define XB_SPIN_CAP (1u << 20)
__device__ __forceinline__ unsigned xb_ld(unsigned* p)              { return __hip_atomic_load(p, __ATOMIC_RELAXED, __HIP_MEMORY_SCOPE_AGENT); }
__device__ __forceinline__ unsigned xb_add(unsigned* p, unsigned v) { return __hip_atomic_fetch_add(p, v, __ATOMIC_RELAXED, __HIP_MEMORY_SCOPE_AGENT); }
__device__ __forceinline__ unsigned xb_xcc_id() { return (unsigned)__builtin_amdgcn_s_getreg((3 << 11) | 20) & 0xFu; }
#define XB_SPIN(cond, bar) do { unsigned _sp = 0; while (cond) { __builtin_amdgcn_s_sleep(1); \
    if ((++_sp & 255u) == 0u) { if (xb_ld(&(bar)[XB_TMO])) break; if (_sp > XB_SPIN_CAP) { atomicAdd(&(bar)[XB_TMO], 1u); break; } } } } while (0)
struct XcdBarrier { unsigned* bar; unsigned x; volatile LAS unsigned* st; };
__device__ __forceinline__ XcdBarrier xcd_barrier_post(unsigned* bar, volatile LAS unsigned* st) {
    XcdBarrier b; b.bar = bar; b.x = xb_xcc_id(); b.st = st;
    if (threadIdx.x == 0) (void)xb_add(&bar[XB_XCNT(b.x)], 1u);
    return b;
}
__device__ __forceinline__ void xcd_barrier_complete(unsigned* bar, unsigned x, unsigned& nloc, unsigned& nx) {
    const unsigned G = gridDim.x * gridDim.y * gridDim.z;
    unsigned sum, cnt, mine, sp = 0u;
    for (;;) {
        sum = 0u; cnt = 0u; mine = 0u;
#pragma unroll
        for (unsigned j = 0; j < 16; ++j) { const unsigned c = xb_ld(&bar[XB_XCNT(j)]); sum += c; cnt += (c > 0u) ? 1u : 0u; mine = (j == x) ? c : mine; }
        if (sum == G) break;
        __builtin_amdgcn_s_sleep(1);
        if ((++sp & 255u) == 0u) { if (xb_ld(&bar[XB_TMO])) break; if (sp > XB_SPIN_CAP) { atomicAdd(&bar[XB_TMO], 1u); break; } }
    }
    nloc = mine > 0u ? mine : 1u; nx = cnt > 0u ? cnt : 1u;
}
__device__ __forceinline__ void xcd_barrier(const XcdBarrier& b) {
    asm volatile("s_waitcnt vmcnt(0)" ::: "memory");
    __syncthreads();
    if (threadIdx.x == 0) {
        unsigned* bar = b.bar;
        __builtin_amdgcn_s_waitcnt(0);
        unsigned nloc = b.st[0], nx = b.st[1];
        if (nloc == 0u) { xcd_barrier_complete(bar, b.x, nloc, nx); b.st[0] = nloc; b.st[1] = nx; }
        const unsigned old = xb_add(&bar[XB_XSUB(b.x)], 1u);
        const unsigned gen = old / nloc;
        if (old + 1u == (gen + 1u) * nloc) {
            __builtin_amdgcn_fence(__ATOMIC_RELEASE, "agent");
            asm volatile("s_waitcnt vmcnt(0)" ::: "memory");
            const unsigned og = xb_add(&bar[XB_TOP], 1u);
            const unsigned tg = og / nx;
            if (og + 1u == (tg + 1u) * nx) xb_add(&bar[XB_TOPGEN], 1u);
            else XB_SPIN(xb_ld(&bar[XB_TOPGEN]) == tg, bar);
            __builtin_amdgcn_fence(__ATOMIC_ACQUIRE, "agent");
            xb_add(&bar[XB_XGEN(b.x)], 1u);
            asm volatile("s_waitcnt vmcnt(0)" ::: "memory");
        } else {
            XB_SPIN(xb_ld(&bar[XB_XGEN(b.x)]) == gen, bar);
            __builtin_amdgcn_fence(__ATOMIC_ACQUIRE, "agent");
            asm volatile("s_waitcnt vmcnt(0)" ::: "memory");
        }
    }
    __syncthreads();
}

namespace pg8 {
constexpr int BM = 256, BK = 64, HALF = 128, HTB = HALF * BK * 2, STAGE_BYTES = 8 * HTB, NXCD = 8, WGM = 8;
__device__ __forceinline__ int lds_byte(int r, int c) { const int st = (r >> 4) * 2 + (c >> 5), rr = r & 15, cc = c & 31, ob = rr * 64 + cc * 2; return st * 1024 + (ob ^ (((ob >> 9) & 1) << 5)); }
__device__ __forceinline__ void stage_rc(int b, int& R, int& C) { const int st = b / 1024, sb = b % 1024, swz = sb ^ (((sb >> 9) & 1) << 5); R = (st >> 1) * 16 + swz / 64; C = (st & 1) * 32 + (swz % 64) / 2; }
__device__ __forceinline__ int perm32(int rho) { const int n = rho >> 4, i = rho & 15; return 8 * (i >> 2) + 4 * n + (i & 3); }

struct Unit { const char* A; const char* B; unsigned lda2, ldb2; int nt, pm, pn, kind, aux; };

__device__ __forceinline__ void tile_of(int wgid, int nM, int nN, int& pm, int& pn) {
    const int nwg = nM * nN;
    { const int q = nwg / NXCD, r = nwg % NXCD, xcd = wgid % NXCD, off = wgid / NXCD; wgid = (xcd < r ? xcd * (q + 1) : r * (q + 1) + (xcd - r) * q) + off; }
    const int nig = WGM * nN, gid = wgid / nig, fm = gid * WGM, gsz = (nM - fm) < WGM ? (nM - fm) : WGM;
    pm = fm + ((wgid % nig) % gsz); pn = (wgid % nig) / gsz;
}

struct Job { const bf16_t* A; const bf16_t* B; int lda, K, nM, nN, kind; };
struct JobSched1 {
    Job j0; int G, c;
    __device__ __forceinline__ void finish(int G_, int c_) { G = G_; c = c_; }
    __device__ __forceinline__ bool next(int i, Unit& u) const {
        const long L = (long)i * G + c; if (L >= j0.nM * j0.nN) return false;
        int pm, pn; tile_of((int)L, j0.nM, j0.nN, pm, pn);
        u.A = (const char*)(j0.A + (size_t)pm * BM * j0.lda); u.B = (const char*)(j0.B + (size_t)pn * BM * j0.K);
        u.lda2 = (unsigned)j0.lda * 2u; u.ldb2 = (unsigned)j0.K * 2u; u.nt = j0.K / BK; u.pm = pm; u.pn = pn; u.kind = j0.kind; return true;
    }
};

#define PG8_SA(b, h) (((b) * 2 + (h)) * HTB)
#define PG8_SB(b, h) ((4 + (b) * 2 + (h)) * HTB)
#define PG8_STAGE(bufoff, gbase, Rv, ld2) do { const unsigned _vo = (unsigned)(Rv) * (ld2) + c2; \
        __builtin_amdgcn_global_load_lds((const unsigned*)((gbase) + _vo), (LAS unsigned*)(lds + (bufoff) + ldsw), 16, 0, 0); \
        __builtin_amdgcn_global_load_lds((const unsigned*)((gbase) + 64u * (ld2) + _vo), (LAS unsigned*)(lds + (bufoff) + ldsw + 8192), 16, 0, 0); } while (0)
#define PG8_LDA(dst, b, h) do { _Pragma("unroll") for (int m = 0; m < 4; ++m) _Pragma("unroll") for (int k = 0; k < 2; ++k) dst[m][k] = *(const LAS bf16x8*)(lds + PG8_SA(b, h) + aoff + m * 2048 + k * 1024); } while (0)
#define PG8_LDB(dst, b, h) do { _Pragma("unroll") for (int n = 0; n < 2; ++n) _Pragma("unroll") for (int k = 0; k < 2; ++k) dst[n][k] = *(const LAS bf16x8*)(lds + PG8_SB(b, h) + boff + n * 2048 + k * 1024); } while (0)
#define PG8_MMA(ai, bj, At, Bt) do { __builtin_amdgcn_s_setprio(1); _Pragma("unroll") for (int m = 0; m < 4; ++m) _Pragma("unroll") for (int n = 0; n < 2; ++n) _Pragma("unroll") for (int k = 0; k < 2; ++k) \
        acc[ai][bj][m][n] = __builtin_amdgcn_mfma_f32_16x16x32_bf16(Bt[n][k], At[m][k], acc[ai][bj][m][n], 0, 0, 0); __builtin_amdgcn_s_setprio(0); } while (0)
#define PG8_WAIT_V(n) asm volatile("s_waitcnt vmcnt(" #n ")" ::: "memory")
#define PG8_WAIT_L(n) asm volatile("s_waitcnt lgkmcnt(" #n ")" ::: "memory")
#define PG8_BAR __builtin_amdgcn_s_barrier()
#define PG8_SCHED __builtin_amdgcn_sched_barrier(0)

template <class Epi, class Sched>
__device__ __forceinline__ void gemm_stream(LAS unsigned char* lds, const Sched& S, const Epi& E) {
    int tid = threadIdx.x; asm volatile("" : "+v"(tid));
    const int wid = __builtin_amdgcn_readfirstlane(tid >> 6), lane = tid & 63, wr = wid >> 2, wc = wid & 3, fr = lane & 15, fq = lane >> 4;
    int R0, C0; stage_rc(tid * 16, R0, C0);
    const int Rb0 = Epi::PERM ? ((R0 & ~31) + perm32(R0 & 31)) : R0;
    const unsigned c2 = (unsigned)C0 * 2u;
    const unsigned ldsw = (unsigned)wid * 1024u;
    const int aoff = lds_byte(wr * 64 + fr, fq * 8), boff = lds_byte(wc * 32 + fr, fq * 8);
    Unit cur, nxt; int ui = 0;
    if (!S.next(0, cur)) return;
    f32x4 acc[2][2][4][2];
#pragma unroll
    for (int a = 0; a < 2; ++a)
#pragma unroll
        for (int b = 0; b < 2; ++b)
#pragma unroll
            for (int m = 0; m < 4; ++m)
#pragma unroll
                for (int n = 0; n < 2; ++n) acc[a][b][m][n] = (f32x4){0.f, 0.f, 0.f, 0.f};
    bf16x8 At[4][2], B0[2][2], B1[2][2];
    const char* cA = cur.A; const char* cB = cur.B; unsigned la = cur.lda2, lb = cur.ldb2;
    const size_t kstep = (size_t)(BK * 2);
    PG8_STAGE(PG8_SB(0, 0), cB, Rb0, lb); PG8_STAGE(PG8_SB(0, 1), cB + (size_t)HALF * lb, Rb0, lb); PG8_STAGE(PG8_SA(0, 0), cA, R0, la); PG8_STAGE(PG8_SA(0, 1), cA + (size_t)HALF * la, R0, la);
    if (wr == 1) PG8_BAR;
    PG8_WAIT_V(2); PG8_BAR;
    PG8_STAGE(PG8_SB(1, 0), cB + kstep, Rb0, lb); PG8_STAGE(PG8_SA(1, 0), cA + kstep, R0, la); PG8_STAGE(PG8_SB(1, 1), cB + (size_t)HALF * lb + kstep, Rb0, lb);
    PG8_WAIT_V(6); PG8_BAR;
    for (;;) {
        const bool has_next = S.next(ui + 1, nxt);
        const char* nA = has_next ? nxt.A : cA; const char* nB = has_next ? nxt.B : cB;
        const unsigned nla = has_next ? nxt.lda2 : la, nlb = has_next ? nxt.ldb2 : lb;
        const int nt = cur.nt;
        for (int t = 0; t < nt; t += 2) {
            const bool last = (t == nt - 2);
            const char* a1 = cA + (size_t)(t + 1) * kstep;
            const char* a2 = last ? nA : cA + (size_t)(t + 2) * kstep; const char* b2 = last ? nB : cB + (size_t)(t + 2) * kstep;
            const unsigned la2 = last ? nla : la, lb2 = last ? nlb : lb;
            const char* a3 = a2 + kstep; const char* b3 = b2 + kstep;
            PG8_LDB(B0, 0, 0); PG8_LDB(B1, 0, 1); PG8_SCHED; PG8_LDA(At, 0, 0); PG8_STAGE(PG8_SA(1, 1), a1 + (size_t)HALF * la, R0, la);
            PG8_WAIT_V(8); PG8_WAIT_L(0); PG8_BAR; PG8_MMA(0, 0, At, B0); PG8_MMA(0, 1, At, B1); PG8_BAR; PG8_SCHED;
            PG8_LDA(At, 0, 1); PG8_STAGE(PG8_SB(0, 0), b2, Rb0, lb2); PG8_STAGE(PG8_SB(0, 1), b2 + (size_t)HALF * lb2, Rb0, lb2); PG8_STAGE(PG8_SA(0, 0), a2, R0, la2);
            PG8_WAIT_V(8); PG8_WAIT_L(0); PG8_BAR; PG8_MMA(1, 0, At, B0); PG8_MMA(1, 1, At, B1); PG8_BAR; PG8_SCHED;
            PG8_LDB(B0, 1, 0); PG8_LDB(B1, 1, 1); PG8_SCHED; PG8_LDA(At, 1, 0); PG8_STAGE(PG8_SA(0, 1), a2 + (size_t)HALF * la2, R0, la2);
            PG8_WAIT_V(8); PG8_WAIT_L(0); PG8_BAR; PG8_MMA(0, 0, At, B0); PG8_MMA(0, 1, At, B1); PG8_BAR; PG8_SCHED;
            PG8_LDA(At, 1, 1); PG8_STAGE(PG8_SB(1, 0), b3, Rb0, lb2); PG8_STAGE(PG8_SB(1, 1), b3 + (size_t)HALF * lb2, Rb0, lb2); PG8_STAGE(PG8_SA(1, 0), a3, R0, la2);
            PG8_WAIT_V(8); PG8_WAIT_L(0); PG8_BAR; PG8_MMA(1, 0, At, B0); PG8_MMA(1, 1, At, B1); PG8_BAR; PG8_SCHED;
        }
        if (wr == 0) PG8_BAR;
        const bool keep = E(acc, cur, wr, wc, fr, fq);
        if (!has_next) break;
        if (!keep) {
#pragma unroll
            for (int a = 0; a < 2; ++a)
#pragma unroll
                for (int b = 0; b < 2; ++b)
#pragma unroll
                    for (int m = 0; m < 4; ++m)
#pragma unroll
                        for (int n = 0; n < 2; ++n) acc[a][b][m][n] = (f32x4){0.f, 0.f, 0.f, 0.f};
        }
        cur = nxt; cA = nA; cB = nB; la = nla; lb = nlb; ++ui;
        if (wr == 1) PG8_BAR;
    }
    PG8_WAIT_V(0);
    PG8_BAR;
}
}

struct Args { const float* in[30]; float* out; unsigned char* ws; };
enum { I_XP = 0, I_MEMP, I_XS, I_CLAT, I_CKPE, I_SPOOL, I_CMK, I_CMV, I_GMIX, I_WIN, I_BGATE, I_WPOOL, I_PSCALE, I_GQLAT, I_WQB, I_GQHEAD, I_GKVLAT, I_WKB, I_WVB,
       I_GKHEAD, I_WMLAO, I_GMEM, I_WMEMKV, I_GMEMQ, I_GMEMK, I_WMEMO, I_WOUT, I_GFF, I_WUP, I_WDOWN };

__device__ __forceinline__ void transpose_item(const float* __restrict__ W, int ldw, int K, bf16_t* __restrict__ WT, LAS float* scr, int kb, int n0src, int nrow_dst, int lane, const float* __restrict__ kscale) {
    const int k0 = 64 * kb;
#pragma unroll 8
    for (int i = 0; i < 32; ++i) { const int kk = 2 * i + (lane >> 5); float v = W[(size_t)(k0 + kk) * ldw + n0src + (lane & 31)]; if (kscale) v *= kscale[k0 + kk]; scr[kk * 33 + (lane & 31)] = v; }
    LDS_WAIT(); asm volatile("" ::: "memory");
    const int c = lane & 7;
#pragma unroll
    for (int j = 0; j < 4; ++j) { const int n = (lane >> 3) + 8 * j; const LAS float* s = scr + (8 * c) * 33 + n;
        u32x4 o; o.x = cvtpk(s[0 * 33], s[1 * 33]); o.y = cvtpk(s[2 * 33], s[3 * 33]); o.z = cvtpk(s[4 * 33], s[5 * 33]); o.w = cvtpk(s[6 * 33], s[7 * 33]);
        *(u32x4*)(WT + (size_t)(nrow_dst + n) * K + k0 + 8 * c) = o; }
    LDS_WAIT(); asm volatile("" ::: "memory");
}
__device__ __forceinline__ void rms_row_2048(const float* __restrict__ xrow, const float* __restrict__ g, bf16_t* __restrict__ orow, int lane) {
    const f32x4* xr = (const f32x4*)xrow + lane; const f32x4* gr = (const f32x4*)g + lane;
    f32x4 v[8]; float s = 0.f;
#pragma unroll
    for (int j = 0; j < 8; ++j) { v[j] = xr[64 * j]; s += (v[j].x * v[j].x + v[j].y * v[j].y) + (v[j].z * v[j].z + v[j].w * v[j].w); }
    const float r = rsqrtf(wave_sum(s) * (1.f / 2048.f) + EPS);
    u32x2* o8 = (u32x2*)orow + lane;
#pragma unroll
    for (int j = 0; j < 8; ++j) { const f32x4 gg = gr[64 * j]; u32x2 w; w.x = cvtpk(v[j].x * r * gg.x, v[j].y * r * gg.y); w.y = cvtpk(v[j].z * r * gg.z, v[j].w * r * gg.w); o8[64 * j] = w; }
}
__device__ __forceinline__ float rope_lane(float w, int lane, float pos) {
    const float partner = __shfl_xor(w, 32);
    float sn, cs; sincosf(pos * rope_inv(lane & 31), &sn, &cs);
    return lane < 32 ? w * cs - partner * sn : w * cs + partner * sn;
}

__device__ __forceinline__ void phase_prep(const Args& P, LAS unsigned char* lds, int gw, int NGW, int wave, int lane) {
    unsigned char* ws = P.ws;
    LAS float* scr = (LAS float*)(lds + wave * 16384);
    {
        constexpr int I_IN = 32 * 290, I_MKV = 32 * 64, I_QB = 8 * 96, I_KB = 8 * 64, I_VB = 8 * 64, I_PL = 4 * 4 * 16, I_MLAO = 32 * 64, I_MEMO = 16 * 64, I_OUT = 32 * 64, I_UP = 32 * 256, I_DN = 128 * 64,
                      I_MV = 16 * 4 * 32;
        constexpr int NITEMS = I_IN + I_MKV + I_QB + I_KB + I_VB + I_PL + I_MLAO + I_MEMO + I_OUT + I_UP + I_DN + I_MV;
        for (int it = gw; it < NITEMS; it += NGW) {
            int r = it;
            if (r < I_IN) { const int kb = r / 290, nb = r % 290, n0 = nb * 32; const int nd = n0 < 2048 ? n0 : (n0 < 2112 ? 9216 + (n0 - 2048) : n0 - 64);
                transpose_item(P.in[I_WIN], 9280, 2048, (bf16_t*)(ws + WS_WIN), scr, kb, n0, nd, lane, nullptr); continue; } r -= I_IN;
            if (r < I_MKV) { transpose_item(P.in[I_WMEMKV], 2048, 2048, (bf16_t*)(ws + WS_WMEMKV), scr, r / 64, (r % 64) * 32, (r % 64) * 32, lane, nullptr); continue; } r -= I_MKV;
            if (r < I_QB) { transpose_item(P.in[I_WQB], 3072, 512, (bf16_t*)(ws + WS_WQB), scr, r / 96, (r % 96) * 32, (r % 96) * 32, lane, nullptr); continue; } r -= I_QB;
            if (r < I_KB) { transpose_item(P.in[I_WKB], 2048, 512, (bf16_t*)(ws + WS_WKB), scr, r / 64, (r % 64) * 32, (r % 64) * 32, lane, nullptr); continue; } r -= I_KB;
            if (r < I_VB) { transpose_item(P.in[I_WVB], 2048, 512, (bf16_t*)(ws + WS_WVB), scr, r / 64, (r % 64) * 32, (r % 64) * 32, lane, nullptr); continue; } r -= I_VB;
            if (r < I_PL) { const int g = r / 64, q = r % 64; transpose_item(P.in[I_WPOOL] + (size_t)g * 256 * 512, 512, 256, (bf16_t*)(ws + WS_WPOOL), scr, q / 16, (q % 16) * 32, g * 512 + (q % 16) * 32, lane, nullptr); continue; } r -= I_PL;
            if (r < I_MLAO) { transpose_item(P.in[I_WMLAO], 2048, 2048, (bf16_t*)(ws + WS_WMLAO), scr, r / 64, (r % 64) * 32, (r % 64) * 32, lane, nullptr); continue; } r -= I_MLAO;
            if (r < I_MEMO) { transpose_item(P.in[I_WMEMO], 2048, 1024, (bf16_t*)(ws + WS_WMEMO), scr, r / 64, (r % 64) * 32, (r % 64) * 32, lane, nullptr); continue; } r -= I_MEMO;
            if (r < I_OUT) { transpose_item(P.in[I_WOUT], 2048, 2048, (bf16_t*)(ws + WS_WOUT), scr, r / 64, (r % 64) * 32, (r % 64) * 32, lane, nullptr); continue; } r -= I_OUT;
            if (r < I_UP) { transpose_item(P.in[I_WUP], 8192, 2048, (bf16_t*)(ws + WS_WUP), scr, r / 256, (r % 256) * 32, (r % 256) * 32, lane, P.in[I_GFF]); continue; } r -= I_UP;
            if (r < I_DN) { transpose_item(P.in[I_WDOWN], 2048, 8192, (bf16_t*)(ws + WS_WDOWN), scr, r / 64, (r % 64) * 32, (r % 64) * 32, lane, nullptr); continue; } r -= I_DN;
            { const int b = r / 128, q = r % 128;
              transpose_item(P.in[I_CMV] + (size_t)b * 262144, 1024, 256, (bf16_t*)(ws + WS_MVT) + (size_t)(2 + b) * 262144, scr, q / 32, (q % 32) * 32, (q % 32) * 32, lane, nullptr); }
        }
    }
    for (int m = gw; m < TT + 512; m += NGW) {
        if (m < TP) rms_row_2048(P.in[I_XP] + (size_t)m * DM, P.in[I_GMIX], (bf16_t*)(ws + WS_H) + (size_t)m * DM, lane);
        else if (m < TT) rms_row_2048(P.in[I_XS] + (size_t)(m - TP) * DM, P.in[I_GMIX], (bf16_t*)(ws + WS_H) + (size_t)m * DM, lane);
        else rms_row_2048(P.in[I_MEMP] + (size_t)(m - TT) * DM, P.in[I_GMEM], (bf16_t*)(ws + WS_HM) + (size_t)(m - TT) * DM, lane);
    }
    {
        bf16_t* KRs = (bf16_t*)(ws + WS_KRS); float* KPESS = (float*)(ws + WS_KPESS); bf16_t* LATs = (bf16_t*)(ws + WS_LATS);
        const float gk = P.in[I_GKHEAD][128 + lane];
        for (int rr = gw; rr < NBS * 4096; rr += NGW) { const int b = rr >> 12, pos = rr & 4095;
            const float v = P.in[I_CKPE][(size_t)rr * 64 + lane]; const float ss = wave_sum(v * v);
            const float o = rope_lane(v * gk, lane, (float)pos);
            const size_t kidx = (size_t)b * KPAD + pos; KRs[kidx * 64 + lane] = f2bf(o); if (lane == 0) KPESS[kidx] = ss; }
        for (int rr = gw; rr < NBS * 32; rr += NGW) { const size_t kidx = (size_t)(rr >> 5) * KPAD + 4128 + (rr & 31);
            KRs[kidx * 64 + lane] = 0; if (lane == 0) KPESS[kidx] = 0.f;
            *(u32x4*)(LATs + kidx * 512 + lane * 8) = (u32x4){0u, 0u, 0u, 0u}; }
    }
    {
        const long tid_g = (long)gw * 64 + lane, NT_G = (long)NGW * 64;
        bf16_t* LATs = (bf16_t*)(ws + WS_LATS);
        for (long i = tid_g; i < (long)NBS * 4096 * 64; i += NT_G) { const long b = i >> 18, rem = i & 262143;
            const f32x4 a = *(const f32x4*)(P.in[I_CLAT] + i * 8), c = *(const f32x4*)(P.in[I_CLAT] + i * 8 + 4);
            *(u32x4*)(LATs + (size_t)b * KPAD * 512 + rem * 8) = (u32x4){cvtpk(a.x, a.y), cvtpk(a.z, a.w), cvtpk(c.x, c.y), cvtpk(c.z, c.w)}; }
        bf16_t* MKs = (bf16_t*)(ws + WS_MK) + (size_t)2 * 262144;
        for (long i = tid_g; i < (long)NBS * 262144 / 8; i += NT_G) {
            const f32x4 a = *(const f32x4*)(P.in[I_CMK] + i * 8), c = *(const f32x4*)(P.in[I_CMK] + i * 8 + 4);
            *(u32x4*)(MKs + i * 8) = (u32x4){cvtpk(a.x, a.y), cvtpk(a.z, a.w), cvtpk(c.x, c.y), cvtpk(c.z, c.w)}; }
        bf16_t* WKN = (bf16_t*)(ws + WS_WKBN);
        for (long i = tid_g; i < 512L * 2048 / 8; i += NT_G) {
            const f32x4 a = *(const f32x4*)(P.in[I_WKB] + i * 8), c = *(const f32x4*)(P.in[I_WKB] + i * 8 + 4);
            *(u32x4*)(WKN + i * 8) = (u32x4){cvtpk(a.x, a.y), cvtpk(a.z, a.w), cvtpk(c.x, c.y), cvtpk(c.z, c.w)}; }
    }
}

struct EpiIn {
    static constexpr bool PERM = true;
    bf16_t* ZS; bf16_t* G; float* M; const float* bgate;
    __device__ __forceinline__ bool operator()(f32x4 (&acc)[2][2][4][2], const pg8::Unit& u, int wr, int wc, int fr_, int fq) const {
        int fr = fr_; asm volatile("" : "+v"(fr));
        const int row0 = u.pm * 256 + wr * 64 + fr, ct = wc * 32 + 8 * fq;
        if (u.kind == 1) {
#pragma unroll
            for (int ai = 0; ai < 2; ++ai)
#pragma unroll
                for (int m = 0; m < 4; ++m) { float* rp = M + (size_t)(row0 + ai * 128 + m * 16) * 2048 + u.pn * 256 + ct;
#pragma unroll
                    for (int bj = 0; bj < 2; ++bj) { *(f32x4*)(rp + bj * 128) = acc[ai][bj][m][0]; *(f32x4*)(rp + bj * 128 + 4) = acc[ai][bj][m][1]; } }
            return false;
        }
        const int pn = u.pn;
        if (pn >= 12 && pn < 36) {
            const int gc = (pn - 12) * 256 + ct;
            f32x4 bv[2][2];
#pragma unroll
            for (int bj = 0; bj < 2; ++bj) { bv[bj][0] = *(const f32x4*)(bgate + gc + bj * 128); bv[bj][1] = *(const f32x4*)(bgate + gc + bj * 128 + 4); }
#pragma unroll
            for (int ai = 0; ai < 2; ++ai)
#pragma unroll
                for (int m = 0; m < 4; ++m) { bf16_t* rp = G + (size_t)(row0 + ai * 128 + m * 16) * G_LD + gc;
#pragma unroll
                    for (int bj = 0; bj < 2; ++bj) { f32x4 v0 = acc[ai][bj][m][0] + bv[bj][0], v1 = acc[ai][bj][m][1] + bv[bj][1];
#pragma unroll
                        for (int e = 0; e < 4; ++e) { v0[e] = __builtin_amdgcn_rcpf(1.f + __builtin_amdgcn_exp2f(-1.4426950408889634f * v0[e])); v1[e] = __builtin_amdgcn_rcpf(1.f + __builtin_amdgcn_exp2f(-1.4426950408889634f * v1[e])); }
                        *(u32x4*)(rp + bj * 128) = (u32x4){cvtpk(v0[0], v0[1]), cvtpk(v0[2], v0[3]), cvtpk(v1[0], v1[1]), cvtpk(v1[2], v1[3])}; } }
            return false;
        }
        const int zc = (pn < 12 ? pn * 256 : 3072) + ct;
#pragma unroll
        for (int ai = 0; ai < 2; ++ai)
#pragma unroll
            for (int m = 0; m < 4; ++m) { bf16_t* rp = ZS + (size_t)(row0 + ai * 128 + m * 16) * ZS_LD + zc;
#pragma unroll
                for (int bj = 0; bj < 2; ++bj) { if (pn == 36 && (bj == 1 || wc >= 2)) continue;
                    const f32x4 v0 = acc[ai][bj][m][0], v1 = acc[ai][bj][m][1];
                    *(u32x4*)(rp + bj * 128) = (u32x4){cvtpk(v0[0], v0[1]), cvtpk(v0[2], v0[3]), cvtpk(v1[0], v1[1]), cvtpk(v1[2], v1[3])}; } }
        return false;
    }
};

__device__ __forceinline__ void unpack8(const u32x4 w, float (&f)[8]) { f[0] = bflo(w.x); f[1] = bfhi(w.x); f[2] = bflo(w.y); f[3] = bfhi(w.y); f[4] = bflo(w.z); f[5] = bfhi(w.z); f[6] = bflo(w.w); f[7] = bfhi(w.w); }
__device__ __forceinline__ u32x4 pack8(const float (&f)[8]) { return (u32x4){cvtpk(f[0], f[1]), cvtpk(f[2], f[3]), cvtpk(f[4], f[5]), cvtpk(f[6], f[7])}; }

__device__ __forceinline__ void phase_rows(const Args& P, LAS unsigned char* lds, int gw, int NGW, int wave, int lane) {
    unsigned char* ws = P.ws; float* out = P.out;
    const bf16_t* ZS = (const bf16_t*)(ws + WS_ZS);
    for (int t = gw; t < TT; t += NGW) {
        const bool prm = t < TP; const int b = prm ? (t >> 12) : ((t - TP) >> 5), li = prm ? (t & 4095) : ((t - TP) & 31), pos = prm ? li : 4096 + li;
        const bf16_t* z = ZS + (size_t)t * ZS_LD;
        { float v[8]; unpack8(*(const u32x4*)(z + 1536 + lane * 8), v); float s = 0.f;
#pragma unroll
          for (int j = 0; j < 8; ++j) s += v[j] * v[j];
          const float r = rsqrtf(wave_sum(s) * (1.f / 512.f) + EPS);
          const f32x4 g0 = *(const f32x4*)(P.in[I_GKVLAT] + lane * 8), g1 = *(const f32x4*)(P.in[I_GKVLAT] + lane * 8 + 4);
          v[0] *= r * g0.x; v[1] *= r * g0.y; v[2] *= r * g0.z; v[3] *= r * g0.w; v[4] *= r * g1.x; v[5] *= r * g1.y; v[6] *= r * g1.z; v[7] *= r * g1.w;
          float* lo = prm ? out + O_LATP + (size_t)t * 512 : out + O_LATS + (size_t)(t - TP) * 512;
          *(f32x4*)(lo + lane * 8) = (f32x4){v[0], v[1], v[2], v[3]}; *(f32x4*)(lo + lane * 8 + 4) = (f32x4){v[4], v[5], v[6], v[7]};
          bf16_t* dst = prm ? (bf16_t*)((unsigned char*)out + DO_CKVP) + (size_t)t * 512 : (bf16_t*)(ws + WS_LATS) + ((size_t)b * KPAD + 4096 + li) * 512;
          *(u32x4*)(dst + lane * 8) = pack8(v); }
        { const float v = bf2f(z[3072 + lane]);
          (prm ? out + O_KPEP + (size_t)t * 64 : out + O_KPES + (size_t)(t - TP) * 64)[lane] = v;
          const float ss = wave_sum(v * v); const float o = rope_lane(v * P.in[I_GKHEAD][128 + lane], lane, (float)pos);
          if (prm) { ((bf16_t*)(ws + WS_KRP))[(size_t)t * 64 + lane] = f2bf(o); if (lane == 0) ((float*)(ws + WS_KPESSP))[t] = ss; }
          else { const size_t kidx = (size_t)b * KPAD + 4096 + li; ((bf16_t*)(ws + WS_KRS))[kidx * 64 + lane] = f2bf(o); if (lane == 0) ((float*)(ws + WS_KPESS))[kidx] = ss; } }
        { float v[8]; unpack8(*(const u32x4*)(z + 1024 + lane * 8), v); float s = 0.f;
#pragma unroll
          for (int j = 0; j < 8; ++j) s += v[j] * v[j];
          const float r = rsqrtf(wave_sum(s) * (1.f / 512.f) + EPS);
          const f32x4 g0 = *(const f32x4*)(P.in[I_GQLAT] + lane * 8), g1 = *(const f32x4*)(P.in[I_GQLAT] + lane * 8 + 4);
          v[0] *= r * g0.x; v[1] *= r * g0.y; v[2] *= r * g0.z; v[3] *= r * g0.w; v[4] *= r * g1.x; v[5] *= r * g1.y; v[6] *= r * g1.z; v[7] *= r * g1.w;
          *(u32x4*)((bf16_t*)(ws + WS_QN) + (size_t)t * 512 + lane * 8) = pack8(v); }
        { const f32x4 g = *(const f32x4*)(P.in[I_GMEMQ] + lane * 4);
#pragma unroll
          for (int h = 0; h < 4; ++h) { const u32x2 w = *(const u32x2*)(z + 2048 + h * 256 + lane * 4);
              const float a0 = bflo(w.x), a1 = bfhi(w.x), a2 = bflo(w.y), a3 = bfhi(w.y);
              const float r = rsqrtf(wave_sum((a0 * a0 + a1 * a1) + (a2 * a2 + a3 * a3)) * (1.f / 256.f) + EPS) * MEM_C;
              *(u32x2*)((bf16_t*)(ws + WS_QM) + (size_t)t * 1024 + h * 256 + lane * 4) = (u32x2){cvtpk(a0 * r * g.x, a1 * r * g.y), cvtpk(a2 * r * g.z, a3 * r * g.w)}; } }
        { const int ca = lane * 8, cb = 512 + lane * 8, wa = lane < 32 ? 2 : 4, wb = lane < 32 ? 8 : 16;
          float sa[8], sb[8], ua[8], ub[8];
          unpack8(*(const u32x4*)(z + ca), ua); unpack8(*(const u32x4*)(z + cb), ub);
#pragma unroll
          for (int j = 0; j < 8; ++j) { sa[j] = ua[j]; sb[j] = ub[j]; }
          for (int k = 1; k < 16; ++k) {
              if (k > li && prm) break;
              if (k <= li) { const bf16_t* zk = z - (size_t)k * ZS_LD; float tmp[8];
                  if (k < wa) { unpack8(*(const u32x4*)(zk + ca), tmp);
#pragma unroll
                      for (int j = 0; j < 8; ++j) sa[j] += tmp[j]; }
                  if (k < wb) { unpack8(*(const u32x4*)(zk + cb), tmp);
#pragma unroll
                      for (int j = 0; j < 8; ++j) sb[j] += tmp[j]; } }
              else { const float* sp = P.in[I_SPOOL] + ((size_t)b * 15 + (15 + li - k)) * 1024;
                  if (k < wa) { const f32x4 p0 = *(const f32x4*)(sp + ca), p1 = *(const f32x4*)(sp + ca + 4); sa[0] += p0.x; sa[1] += p0.y; sa[2] += p0.z; sa[3] += p0.w; sa[4] += p1.x; sa[5] += p1.y; sa[6] += p1.z; sa[7] += p1.w; }
                  if (k < wb) { const f32x4 p0 = *(const f32x4*)(sp + cb), p1 = *(const f32x4*)(sp + cb + 4); sb[0] += p0.x; sb[1] += p0.y; sb[2] += p0.z; sb[3] += p0.w; sb[4] += p1.x; sb[5] += p1.y; sb[6] += p1.z; sb[7] += p1.w; } }
          }
          const float ia = 1.f / (float)(pos + 1 < wa ? pos + 1 : wa), ib = 1.f / (float)(pos + 1 < wb ? pos + 1 : wb);
#pragma unroll
          for (int j = 0; j < 8; ++j) { sa[j] = sa[j] * ia - ua[j]; sb[j] = sb[j] * ib - ub[j]; }
          bf16_t* dp = (bf16_t*)(ws + WS_DP) + (size_t)t * 1024;
          *(u32x4*)(dp + ca) = pack8(sa); *(u32x4*)(dp + cb) = pack8(sb);
          const int last0 = prm ? 4081 : 17;
          if (li >= last0) { float* po = (prm ? out + O_POOLP : out + O_POOLS) + ((size_t)b * 15 + (li - last0)) * 1024;
              *(f32x4*)(po + ca) = (f32x4){ua[0], ua[1], ua[2], ua[3]}; *(f32x4*)(po + ca + 4) = (f32x4){ua[4], ua[5], ua[6], ua[7]};
              *(f32x4*)(po + cb) = (f32x4){ub[0], ub[1], ub[2], ub[3]}; *(f32x4*)(po + cb + 4) = (f32x4){ub[4], ub[5], ub[6], ub[7]}; } }
    }
    for (int m = gw; m < 512; m += NGW) {
        const float* mr = (const float*)(ws + WS_M) + (size_t)m * 2048; const f32x4 g = *(const f32x4*)(P.in[I_GMEMK] + lane * 4);
#pragma unroll
        for (int h = 0; h < 4; ++h) { f32x4 v = *(const f32x4*)(mr + h * 256 + lane * 4);
            const float r = rsqrtf(wave_sum((v.x * v.x + v.y * v.y) + (v.z * v.z + v.w * v.w)) * (1.f / 256.f) + EPS);
            v.x *= r * g.x; v.y *= r * g.y; v.z *= r * g.z; v.w *= r * g.w;
            *(f32x4*)(out + O_MEMK + (size_t)m * 1024 + h * 256 + lane * 4) = v;
            *(u32x2*)((bf16_t*)(ws + WS_MK) + (size_t)m * 1024 + h * 256 + lane * 4) = (u32x2){cvtpk(v.x, v.y), cvtpk(v.z, v.w)};
            *(f32x4*)(out + O_MEMV + (size_t)m * 1024 + h * 256 + lane * 4) = *(const f32x4*)(mr + 1024 + h * 256 + lane * 4); }
    }
    { LAS float* scr = (LAS float*)(lds + wave * 16384);
      for (int it = gw; it < 2 * 128; it += NGW) { const int b = it / 128, q = it % 128;
          transpose_item((const float*)(ws + WS_M) + (size_t)b * 256 * 2048 + 1024, 2048, 256, (bf16_t*)(ws + WS_MVT) + (size_t)b * 262144, scr, q / 32, (q % 32) * 32, (q % 32) * 32, lane, nullptr); } }
}


struct EpiQKV {
    static constexpr bool PERM = true;
    bf16_t* Q; bf16_t* K; bf16_t* V; float* KSS;
    __device__ __forceinline__ bool operator()(f32x4 (&acc)[2][2][4][2], const pg8::Unit& u, int wr, int wc, int fr_, int fq) const {
        int fr = fr_; asm volatile("" : "+v"(fr));
        const int row0 = u.pm * 256 + wr * 64 + fr, ct = wc * 32 + 8 * fq;
        if (u.kind == 3) {
#pragma unroll
            for (int ai = 0; ai < 2; ++ai)
#pragma unroll
                for (int m = 0; m < 4; ++m)
#pragma unroll
                    for (int bj = 0; bj < 2; ++bj) { const f32x4 a = acc[ai][bj][m][0], b = acc[ai][bj][m][1];
                        float s = ((a.x * a.x + a.y * a.y) + (a.z * a.z + a.w * a.w)) + ((b.x * b.x + b.y * b.y) + (b.z * b.z + b.w * b.w));
                        s += __shfl_xor(s, 16); s += __shfl_xor(s, 32);
                        if (fq == 0) KSS[((size_t)(row0 + ai * 128 + m * 16) * 16 + (u.pn * 2 + bj)) * 4 + wc] = s; }
            return false;
        }
        bf16_t* base; int ld, c0, c1;
        if (u.kind == 0) { base = Q; ld = QLD; c0 = u.pn * 256 + ct; c1 = c0 + 128; }
        else if (u.kind == 1) { base = K; ld = QLD; c0 = (u.pn * 2) * 192 + ct; c1 = c0 + 192; }
        else { base = V; ld = 2048; c0 = u.pn * 256 + ct; c1 = c0 + 128; }
#pragma unroll
        for (int ai = 0; ai < 2; ++ai)
#pragma unroll
            for (int m = 0; m < 4; ++m) { bf16_t* rp = base + (size_t)(row0 + ai * 128 + m * 16) * ld;
#pragma unroll
                for (int bj = 0; bj < 2; ++bj) { const f32x4 v0 = acc[ai][bj][m][0], v1 = acc[ai][bj][m][1];
                    *(u32x4*)(rp + (bj ? c1 : c0)) = (u32x4){cvtpk(v0[0], v0[1]), cvtpk(v0[2], v0[3]), cvtpk(v1[0], v1[1]), cvtpk(v1[2], v1[3])}; } }
        return false;
    }
};

__device__ __forceinline__ void phase_heads(const Args& P, int gw, int NGW, int lane) {
    unsigned char* ws = P.ws;
    bf16_t* Q = (bf16_t*)(ws + WS_Q); bf16_t* K = (bf16_t*)((unsigned char*)P.out + DO_K);
    const float gq0 = P.in[I_GQHEAD][lane], gq1 = P.in[I_GQHEAD][64 + lane], gq2 = P.in[I_GQHEAD][128 + lane];
    const float gk0 = P.in[I_GKHEAD][lane], gk1 = P.in[I_GKHEAD][64 + lane];
    const float inv = rope_inv(lane & 31);
    for (int t = gw; t < TT; t += NGW) {
        const bool prm = t < TP; const int pos = prm ? (t & 4095) : 4096 + ((t - TP) & 31);
        float sn, cs; sincosf((float)pos * inv, &sn, &cs);
        bf16_t* q = Q + (size_t)t * QLD;
#pragma unroll 4
        for (int h = 0; h < 16; ++h) { bf16_t* qh = q + h * 192;
            const float v0 = bf2f(qh[lane]), v1 = bf2f(qh[64 + lane]), v2 = bf2f(qh[128 + lane]);
            const float r = rsqrtf(wave_sum(v0 * v0 + v1 * v1 + v2 * v2) * (1.f / 192.f) + EPS);
            const float y2 = v2 * r * gq2, pr = __shfl_xor(y2, 32);
            qh[lane] = f2bf(v0 * r * gq0); qh[64 + lane] = f2bf(v1 * r * gq1);
            qh[128 + lane] = f2bf(lane < 32 ? y2 * cs - pr * sn : y2 * cs + pr * sn); }
        if (prm) { bf16_t* k = K + (size_t)t * QLD; const float kss = ((const float*)(ws + WS_KPESSP))[t]; const float kr = bf2f(((const bf16_t*)(ws + WS_KRP))[(size_t)t * 64 + lane]);
#pragma unroll 4
            for (int h = 0; h < 16; ++h) { bf16_t* kh = k + h * 192;
                const float v0 = bf2f(kh[lane]), v1 = bf2f(kh[64 + lane]);
                const float r = rsqrtf((wave_sum(v0 * v0 + v1 * v1) + kss) * (1.f / 192.f) + EPS);
                kh[lane] = f2bf(v0 * r * gk0); kh[64 + lane] = f2bf(v1 * r * gk1); kh[128 + lane] = f2bf(kr * r); } }
    }
}


typedef short v4i16_t __attribute__((ext_vector_type(4)));
__device__ __forceinline__ s16x4 vtr(const LAS char* p) { return __builtin_bit_cast(s16x4, __builtin_amdgcn_ds_read_tr16_b64_v4i16((LAS v4i16_t*)p)); }
#define SWZF(row) ((((((row) & 2) << 1) | (((row) >> 2) & 3))) << 4)
__device__ __forceinline__ void partialSM(f32x16& p0, f32x16& p1, float& m_reg, float& mn, float& alpha, const float C) {
    float pmax = p0[0];
#pragma unroll
    for (int r = 1; r < 16; ++r) pmax = fmaxf(pmax, p0[r]);
#pragma unroll
    for (int r = 0; r < 16; ++r) pmax = fmaxf(pmax, p1[r]);
    { auto rr = __builtin_amdgcn_permlane32_swap(__float_as_uint(pmax), __float_as_uint(pmax), false, false);
      pmax = fmaxf(__uint_as_float(rr[0]), __uint_as_float(rr[1])); }
    if (__builtin_expect(__all((pmax - m_reg) * C <= 11.5f), 1)) { mn = m_reg; alpha = 1.f; }
    else { mn = fmaxf(m_reg, pmax); alpha = __builtin_amdgcn_exp2f((m_reg - mn) * C); m_reg = mn; }
    const float mnC = -mn * C;
#pragma unroll
    for (int r = 0; r < 16; ++r) p0[r] = fmaf(p0[r], C, mnC);
#pragma unroll
    for (int r = 0; r < 16; ++r) p1[r] = fmaf(p1[r], C, mnC);
#pragma unroll
    for (int r = 0; r < 16; ++r) p0[r] = __builtin_amdgcn_exp2f(p0[r]);
}
__device__ __forceinline__ void finishSM(f32x16& p0, f32x16& p1, float alpha, float& l_reg, bf16x8& pa0, bf16x8& pa1, bf16x8& pa2, bf16x8& pa3) {
#pragma unroll
    for (int r = 0; r < 16; ++r) p1[r] = __builtin_amdgcn_exp2f(p1[r]);
    float ps = 0;
#pragma unroll
    for (int r = 0; r < 16; ++r) ps += p0[r];
#pragma unroll
    for (int r = 0; r < 16; ++r) ps += p1[r];
    { auto rr = __builtin_amdgcn_permlane32_swap(__float_as_uint(ps), __float_as_uint(ps), false, false);
      ps = __uint_as_float(rr[0]) + __uint_as_float(rr[1]); }
    l_reg = l_reg * alpha + ps;
#define PK4(P, BASE, OUT) do { unsigned a0 = cvtpk(P[BASE + 0], P[BASE + 1]), a1 = cvtpk(P[BASE + 2], P[BASE + 3]);   \
    unsigned b0 = cvtpk(P[BASE + 4], P[BASE + 5]), b1 = cvtpk(P[BASE + 6], P[BASE + 7]);                              \
    auto r0 = __builtin_amdgcn_permlane32_swap(a0, b0, false, false); auto r1 = __builtin_amdgcn_permlane32_swap(a1, b1, false, false); \
    u32x4 w = {r0[0], r1[0], r0[1], r1[1]}; OUT = __builtin_bit_cast(bf16x8, w); } while (0)
    PK4(p0, 0, pa0); PK4(p0, 8, pa1); PK4(p1, 0, pa2); PK4(p1, 8, pa3);
#undef PK4
}
#define PKV(L, H) (bf16x8){L[0], L[1], L[2], L[3], H[0], H[1], H[2], H[3]}

namespace pat {
constexpr int LDQ = 3072, LDK = 3072, LDV = 2048, LDO = 2048;
constexpr int SHM_V = 16384, SHM_K = 24576, OFF_K = 2 * SHM_V, OFF_WS = OFF_K + 2 * SHM_K;
#define KSW(row, colB) ((row) * 384 + ((colB) ^ SWZF(row)))
__device__ __forceinline__ void qkt(f32x16& p0, f32x16& p1, const LAS char* Ks, const bf16x8* qr, int r32, int hi) {
    p0 = f32x16{}; p1 = f32x16{};
#pragma unroll
    for (int d0 = 0; d0 < 12; ++d0) { const int cb = (d0 * 16 + hi * 8) * 2;
        const bf16x8 b0 = *(const LAS bf16x8*)(Ks + KSW(r32, cb));
        const bf16x8 b1 = *(const LAS bf16x8*)(Ks + KSW(32 + r32, cb));
        p0 = __builtin_amdgcn_mfma_f32_32x32x16_bf16(b0, qr[d0], p0, 0, 0, 0);
        p1 = __builtin_amdgcn_mfma_f32_32x32x16_bf16(b1, qr[d0], p1, 0, 0, 0);
        if ((d0 % 3) == 2) asm volatile("" ::: "memory"); }
}
__device__ __forceinline__ int v_st(int k, int c) { const int kk = (k & ~0xC) | ((k & 4) << 1) | ((k & 8) >> 1); return ((kk >> 3) * 4 + (c >> 5)) * 512 + ((kk & 7) * 32 + (c & 31)) * 2; }
__device__ __forceinline__ int v_rd_base(int lane) { return ((lane & 3) << 3) | (((lane >> 2) & 3) << 6) | (((lane >> 4) & 1) << 5) | (((lane >> 5) & 1) << 8); }
constexpr int v_rd_off(int d0, int ks, int half) { return d0 * 512 + ks * 4096 + half * 2048; }
template <int OFF> __device__ __forceinline__ s16x4 tr_read(int vb) {
    s16x4 r; asm volatile("ds_read_b64_tr_b16 %0, %1 offset:%2" : "=&v"(r) : "v"(vb), "i"(OFF) : "memory"); return r;
}
template <int D0> __device__ __forceinline__ void pv_one(f32x16& od, int vb, bf16x8 pa0, bf16x8 pa1, bf16x8 pa2, bf16x8 pa3) {
    const s16x4 l0 = tr_read<v_rd_off(D0, 0, 0)>(vb), h0 = tr_read<v_rd_off(D0, 0, 1)>(vb), l1 = tr_read<v_rd_off(D0, 1, 0)>(vb), h1 = tr_read<v_rd_off(D0, 1, 1)>(vb);
    const s16x4 l2 = tr_read<v_rd_off(D0, 2, 0)>(vb), h2 = tr_read<v_rd_off(D0, 2, 1)>(vb), l3 = tr_read<v_rd_off(D0, 3, 0)>(vb), h3 = tr_read<v_rd_off(D0, 3, 1)>(vb);
    asm volatile("s_waitcnt lgkmcnt(0)" ::: "memory"); SBAR();
    od = __builtin_amdgcn_mfma_f32_32x32x16_bf16(pa0, PKV(l0, h0), od, 0, 0, 0);
    od = __builtin_amdgcn_mfma_f32_32x32x16_bf16(pa1, PKV(l1, h1), od, 0, 0, 0);
    od = __builtin_amdgcn_mfma_f32_32x32x16_bf16(pa2, PKV(l2, h2), od, 0, 0, 0);
    od = __builtin_amdgcn_mfma_f32_32x32x16_bf16(pa3, PKV(l3, h3), od, 0, 0, 0);
}
__device__ __forceinline__ void pv_d0(f32x16* o, int vb, bf16x8 pa0, bf16x8 pa1, bf16x8 pa2, bf16x8 pa3) {
    pv_one<0>(o[0], vb, pa0, pa1, pa2, pa3); pv_one<1>(o[1], vb, pa0, pa1, pa2, pa3); pv_one<2>(o[2], vb, pa0, pa1, pa2, pa3); pv_one<3>(o[3], vb, pa0, pa1, pa2, pa3);
}
__device__ __forceinline__ void unit(const bf16_t* __restrict__ Qb, const bf16_t* __restrict__ Kh, const bf16_t* __restrict__ Vh, bf16_t* __restrict__ Ob, int qb, LAS char* lds) {
    constexpr float C = MLA_C;
    int tid = threadIdx.x; asm volatile("" : "+v"(tid));
    const int wid = __builtin_amdgcn_readfirstlane(tid >> 6), lane = tid & 63, r32 = lane & 31, hi = lane >> 5;
    LAS char* V_lds = lds; LAS char* K_lds = lds + OFF_K;
    LAS float* wsf = (LAS float*)(lds + OFF_WS) + wid * 64; LAS float* li_l = wsf; LAS float* al_l = wsf + 32;
    float m_reg = -1e30f, l_reg = 0; f32x16 o[4] = {}; bf16x8 qr[12];
    const bf16_t* Qw = Qb + (size_t)(wid * 32 + r32) * LDQ + hi * 8;
#pragma unroll
    for (int d0 = 0; d0 < 12; ++d0) qr[d0] = *(const bf16x8*)(Qw + d0 * 16);
    const int srow = tid >> 3, c8 = tid & 7;
    const int vst = v_st(srow, c8 * 8), kst = KSW(srow, c8 * 16);
    const bf16_t* Vsrc = Vh + (size_t)srow * LDV + c8 * 8; const bf16_t* Ksrc = Kh + (size_t)srow * LDK + c8 * 8;
    const int vb0 = (int)(uintptr_t)V_lds + v_rd_base(lane);
    bf16x8 vs0, vs1, ks0, ks1, ks2;
#define SLOAD(k0) do { const bf16_t* vp_ = Vsrc + (size_t)(k0) * LDV; const bf16_t* kp_ = Ksrc + (size_t)(k0) * LDK; \
    vs0 = *(const bf16x8*)(vp_); vs1 = *(const bf16x8*)(vp_ + 64); ks0 = *(const bf16x8*)(kp_); ks1 = *(const bf16x8*)(kp_ + 64); ks2 = *(const bf16x8*)(kp_ + 128); } while (0)
#define SWRITE(b) do { *(LAS bf16x8*)(V_lds + (b) * SHM_V + vst) = vs0; *(LAS bf16x8*)(V_lds + (b) * SHM_V + vst + 1024) = vs1; \
    *(LAS bf16x8*)(K_lds + (b) * SHM_K + kst) = ks0; *(LAS bf16x8*)(K_lds + (b) * SHM_K + kst + 128) = ks1; *(LAS bf16x8*)(K_lds + (b) * SHM_K + kst + 256) = ks2; } while (0)
#define RESC(a) do { if (__any((a) < 1.f)) { if (hi == 0) al_l[r32] = (a); LDS_WAIT(); \
    _Pragma("unroll") for (int d = 0; d < 4; ++d) _Pragma("unroll") for (int r = 0; r < 16; ++r) o[d][r] *= al_l[crow(r, hi)]; } } while (0)
#define MASKT(P0, P1, tix) do { if ((tix) > mylast) { _Pragma("unroll") for (int r = 0; r < 16; ++r) { P0[r] = -1e30f; P1[r] = -1e30f; } } } while (0)
    const int NT = 4 * qb + 4, mylast = 4 * qb + (wid >> 1);
    SLOAD(0); SWRITE(0); __syncthreads();
    SLOAD(64);
    for (int j = 0; j < NT; ++j) {
        const int b = j & 1;
        f32x16 p0, p1; float mn, alpha; bf16x8 pa0, pa1, pa2, pa3;
        qkt(p0, p1, K_lds + b * SHM_K, qr, r32, hi); MASKT(p0, p1, j);
        partialSM(p0, p1, m_reg, mn, alpha, C);
        RESC(alpha);
        finishSM(p0, p1, alpha, l_reg, pa0, pa1, pa2, pa3); SBAR();
        pv_d0(o, vb0 + b * SHM_V, pa0, pa1, pa2, pa3);
        if (j + 1 < NT) { SWRITE(b ^ 1); if (j + 2 < NT) SLOAD((j + 2) * 64); }
        __syncthreads();
    }
    if (hi == 0) li_l[r32] = l_reg; LDS_WAIT();
    float rli[16];
#pragma unroll
    for (int r = 0; r < 16; ++r) rli[r] = __builtin_amdgcn_rcpf(li_l[crow(r, hi)]);
    bf16_t* Ow = Ob + (size_t)(wid * 32) * LDO;
#pragma unroll
    for (int r = 0; r < 16; ++r) { const int orow = crow(r, hi);
#pragma unroll
        for (int d0 = 0; d0 < 4; ++d0) Ow[(size_t)orow * LDO + d0 * 32 + r32] = f2bf(o[d0][r] * rli[r]); }
    __syncthreads();
#undef SLOAD
#undef SWRITE
#undef RESC
#undef MASKT
}
}

template <int NB> __device__ __forceinline__ void resc_shfl(f32x16 (&o)[NB], float alpha, int hi) {
    if (__any(alpha < 1.f)) {
#pragma unroll
        for (int r = 0; r < 16; ++r) { const float a = __shfl(alpha, crow(r, hi));
#pragma unroll
            for (int d = 0; d < NB; ++d) o[d][r] *= a; }
    }
}

__device__ __forceinline__ void mem_attn_item(const Args& P, int item, int lane_) {
    int lane = lane_; asm volatile("" : "+v"(lane));
    unsigned char* ws = P.ws; const int r32 = lane & 31, hi = lane >> 5;
    const int rb = item >> 2, h = item & 3, t0 = rb * 32;
    const int bsel = t0 < TP ? (t0 >> 12) : 2 + ((t0 - TP) >> 5);
    const bf16_t* Kb = (const bf16_t*)(ws + WS_MK) + (size_t)bsel * 262144 + h * 256;
    const bf16_t* VTb = (const bf16_t*)(ws + WS_MVT) + (size_t)bsel * 262144 + (size_t)h * 65536;
    const bf16_t* Qw = (const bf16_t*)(ws + WS_QM) + (size_t)(t0 + r32) * 1024 + h * 256 + hi * 8;
    bf16x8 qf[16];
#pragma unroll
    for (int ks = 0; ks < 16; ++ks) qf[ks] = *(const bf16x8*)(Qw + ks * 16);
    for (int dh = 0; dh < 2; ++dh) {
        float m_reg = -1e30f, l_reg = 0.f; f32x16 o[4];
#pragma unroll
        for (int d = 0; d < 4; ++d) o[d] = f32x16{};
        for (int tile = 0; tile < 4; ++tile) {
            f32x16 p0 = f32x16{}, p1 = f32x16{};
            const bf16_t* Kt = Kb + (size_t)(tile * 64 + r32) * 1024 + hi * 8;
#pragma unroll
            for (int ks = 0; ks < 16; ++ks) {
                const bf16x8 a0 = *(const bf16x8*)(Kt + ks * 16), a1 = *(const bf16x8*)(Kt + 32 * 1024 + ks * 16);
                p0 = __builtin_amdgcn_mfma_f32_32x32x16_bf16(a0, qf[ks], p0, 0, 0, 0);
                p1 = __builtin_amdgcn_mfma_f32_32x32x16_bf16(a1, qf[ks], p1, 0, 0, 0);
                if ((ks & 1) == 1) asm volatile("" ::: "memory"); }
            float mn, alpha; bf16x8 pa0, pa1, pa2, pa3;
            partialSM(p0, p1, m_reg, mn, alpha, 1.0f);
            resc_shfl<4>(o, alpha, hi);
            finishSM(p0, p1, alpha, l_reg, pa0, pa1, pa2, pa3);
            const bf16_t* Vt = VTb + (size_t)(dh * 128 + r32) * 256 + tile * 64 + hi * 8;
#pragma unroll
            for (int db = 0; db < 4; ++db) { const bf16_t* vp = Vt + (size_t)db * 32 * 256;
                const bf16x8 b0 = *(const bf16x8*)(vp), b1 = *(const bf16x8*)(vp + 16), b2 = *(const bf16x8*)(vp + 32), b3 = *(const bf16x8*)(vp + 48);
                o[db] = __builtin_amdgcn_mfma_f32_32x32x16_bf16(pa0, b0, o[db], 0, 0, 0);
                o[db] = __builtin_amdgcn_mfma_f32_32x32x16_bf16(pa1, b1, o[db], 0, 0, 0);
                o[db] = __builtin_amdgcn_mfma_f32_32x32x16_bf16(pa2, b2, o[db], 0, 0, 0);
                o[db] = __builtin_amdgcn_mfma_f32_32x32x16_bf16(pa3, b3, o[db], 0, 0, 0);
                asm volatile("" ::: "memory"); }
        }
        const float rl = __builtin_amdgcn_rcpf(l_reg);
        bf16_t* Ow = (bf16_t*)(ws + WS_OMEM) + (size_t)t0 * 1024 + h * 256 + dh * 128 + r32;
#pragma unroll
        for (int r = 0; r < 16; ++r) { const float a = __shfl(rl, crow(r, hi)); const int orow = crow(r, hi);
#pragma unroll
            for (int db = 0; db < 4; ++db) Ow[(size_t)orow * 1024 + db * 32] = f2bf(o[db][r] * a); }
    }
}

namespace sat {
constexpr int ROWB = 1152, TKEYS = 32, CT_BYTES = TKEYS * ROWB, OFF_X = 2 * CT_BYTES, OFF_RK = OFF_X + 32768, NT = 4128 / TKEYS, OLB = 1040;
__device__ __forceinline__ int coff(int row, int colB) { return row * ROWB + (colB ^ SWZF(row)); }
__device__ __forceinline__ void partialSM1(f32x16& p0, float& m_reg, float& alpha) {
    float pmax = p0[0];
#pragma unroll
    for (int r = 1; r < 16; ++r) pmax = fmaxf(pmax, p0[r]);
    { auto rr = __builtin_amdgcn_permlane32_swap(__float_as_uint(pmax), __float_as_uint(pmax), false, false);
      pmax = fmaxf(__uint_as_float(rr[0]), __uint_as_float(rr[1])); }
    float mn;
    if (__builtin_expect(__all(pmax - m_reg <= 11.5f), 1)) { mn = m_reg; alpha = 1.f; }
    else { mn = fmaxf(m_reg, pmax); alpha = __builtin_amdgcn_exp2f(m_reg - mn); m_reg = mn; }
#pragma unroll
    for (int r = 0; r < 16; ++r) p0[r] = __builtin_amdgcn_exp2f(p0[r] - mn);
}
__device__ __forceinline__ void finishSM1(f32x16& p0, float alpha, float& l_reg, bf16x8& pa0, bf16x8& pa1) {
    float ps = 0;
#pragma unroll
    for (int r = 0; r < 16; ++r) ps += p0[r];
    { auto rr = __builtin_amdgcn_permlane32_swap(__float_as_uint(ps), __float_as_uint(ps), false, false);
      ps = __uint_as_float(rr[0]) + __uint_as_float(rr[1]); }
    l_reg = l_reg * alpha + ps;
#define PK4(P, BASE, OUT) do { unsigned a0 = cvtpk(P[BASE + 0], P[BASE + 1]), a1 = cvtpk(P[BASE + 2], P[BASE + 3]);   \
    unsigned b0 = cvtpk(P[BASE + 4], P[BASE + 5]), b1 = cvtpk(P[BASE + 6], P[BASE + 7]);                              \
    auto r0 = __builtin_amdgcn_permlane32_swap(a0, b0, false, false); auto r1 = __builtin_amdgcn_permlane32_swap(a1, b1, false, false); \
    u32x4 w = {r0[0], r1[0], r0[1], r1[1]}; OUT = __builtin_bit_cast(bf16x8, w); } while (0)
    PK4(p0, 0, pa0); PK4(p0, 8, pa1);
#undef PK4
}
__device__ __forceinline__ void unit(const Args& P, int b, int hp, LAS char* lds) {
    unsigned char* ws = P.ws;
    int tid = threadIdx.x; asm volatile("" : "+v"(tid));
    const int wid = __builtin_amdgcn_readfirstlane(tid >> 6), lane = tid & 63, r32 = lane & 31, hi = lane >> 5;
    const int hl = wid >> 2, wq = wid & 3, h = 2 * hp + hl;
    const bf16_t* LATb = (const bf16_t*)(ws + WS_LATS) + (size_t)b * KPAD * 512;
    const bf16_t* KRb = (const bf16_t*)(ws + WS_KRS) + (size_t)b * KPAD * 64;
    const float* KPESSb = (const float*)(ws + WS_KPESS) + (size_t)b * KPAD;
    const float* KSSb = (const float*)(ws + WS_KSS) + (size_t)b * KPAD * 64;
    LAS char* CT = lds; LAS char* XCH = lds + OFF_X; LAS float* RK = (LAS float*)(lds + OFF_RK);
    bf16x8 qa[9];
    { const bf16_t* Qh = (const bf16_t*)(ws + WS_Q) + (size_t)(TP + b * 32 + r32) * QLD + h * 192;
      const float* gk = P.in[I_GKHEAD];
      bf16x8 qg[8];
#pragma unroll
      for (int ks = 0; ks < 8; ++ks) { float f[8]; unpack8(*(const u32x4*)(Qh + ks * 16 + hi * 8), f);
          const f32x4 g0 = *(const f32x4*)(gk + ks * 16 + hi * 8), g1 = *(const f32x4*)(gk + ks * 16 + hi * 8 + 4);
          f[0] *= g0.x; f[1] *= g0.y; f[2] *= g0.z; f[3] *= g0.w; f[4] *= g1.x; f[5] *= g1.y; f[6] *= g1.z; f[7] *= g1.w;
          qg[ks] = __builtin_bit_cast(bf16x8, pack8(f)); }
      const int prow = (r32 & ~12) | ((r32 & 4) << 1) | ((r32 & 8) >> 1);
      const bf16_t* Wn = (const bf16_t*)(ws + WS_WKBN) + (size_t)(128 * wq + prow) * 2048 + h * 128 + hi * 8;
#pragma unroll
      for (int cb = 0; cb < 4; ++cb) { f32x16 acc = f32x16{};
#pragma unroll
          for (int ks = 0; ks < 8; ++ks) { const bf16x8 a = *(const bf16x8*)(Wn + (size_t)cb * 32 * 2048 + ks * 16); acc = __builtin_amdgcn_mfma_f32_32x32x16_bf16(a, qg[ks], acc, 0, 0, 0); }
          qa[2 * cb] = __builtin_bit_cast(bf16x8, (u32x4){cvtpk(acc[0], acc[1]), cvtpk(acc[2], acc[3]), cvtpk(acc[4], acc[5]), cvtpk(acc[6], acc[7])});
          qa[2 * cb + 1] = __builtin_bit_cast(bf16x8, (u32x4){cvtpk(acc[8], acc[9]), cvtpk(acc[10], acc[11]), cvtpk(acc[12], acc[13]), cvtpk(acc[14], acc[15])});
          asm volatile("" ::: "memory"); }
      qa[8] = *(const bf16x8*)(Qh + 128 + 16 * wq + 8 * hi); }
    int soff[5]; bool iskr[5];
#pragma unroll
    for (int k = 0; k < 5; ++k) { const int d = (wid + 8 * k) * 1024 + lane * 16, row = d / ROWB, cs = (d - row * ROWB) >> 4, ch = cs ^ (SWZF(row) >> 4);
        iskr[k] = ch >= 64; soff[k] = ch >= 64 ? row * 64 + (ch - 64) * 8 : row * 512 + ch * 8; }
#define TDMA(j, buf) do { _Pragma("unroll") for (int k = 0; k < 5; ++k) { if (k < 4 || wid < 4) { \
        const bf16_t* sp_ = iskr[k] ? KRb + (size_t)(j) * TKEYS * 64 + soff[k] : LATb + (size_t)(j) * TKEYS * 512 + soff[k]; \
        __builtin_amdgcn_global_load_lds((const unsigned*)sp_, (LAS unsigned*)(CT + (buf) * CT_BYTES + (wid + 8 * k) * 1024), 16, 0, 0); } } } while (0)
#define RKVAL(j) (rsqrtf(((rk4.x + rk4.y) + (rk4.z + rk4.w) + rkp) * (1.f / 192.f) + EPS) * MLA_C)
#define RKLOAD(j) do { if (tid < 64) { const int key = (j) * TKEYS + (tid & 31); rk4 = *(const f32x4*)(KSSb + ((size_t)key * 16 + 2 * hp + (tid >> 5)) * 4); rkp = KPESSb[key]; } } while (0)
    f32x4 rk4 = {0.f, 0.f, 0.f, 0.f}; float rkp = 0.f;
    int trb[2][2];
#pragma unroll
    for (int t = 0; t < 2; ++t)
#pragma unroll
        for (int c1 = 0; c1 < 2; ++c1) trb[t][c1] = coff(8 * hi + 4 * t + ((r32 & 15) >> 2), 256 * wq + 64 * c1 + 32 * (r32 >> 4) + 8 * (r32 & 3));
    int aoff[5];
#pragma unroll
    for (int k = 0; k < 4; ++k) aoff[k] = coff(r32, 256 * wq + 32 * k + 16 * hi);
    aoff[4] = coff(r32, 1024 + 32 * wq + 16 * hi);
    float m_reg = -1e30f, l_reg = 0.f; f32x16 o[4];
#pragma unroll
    for (int d = 0; d < 4; ++d) o[d] = f32x16{};
    TDMA(0, 0); RKLOAD(0);
    if (tid < 64) RK[tid] = RKVAL(0);
    asm volatile("s_waitcnt vmcnt(0) lgkmcnt(0)" ::: "memory"); __builtin_amdgcn_s_barrier(); asm volatile("" ::: "memory");
    for (int j = 0; j < NT; ++j) {
        const int bf = j & 1; const LAS char* CTb = CT + bf * CT_BYTES;
        if (j + 1 < NT) { TDMA(j + 1, bf ^ 1); RKLOAD(j + 1); }
        f32x16 p0 = f32x16{};
#pragma unroll
        for (int ks = 0; ks < 9; ++ks) { const bf16x8 a0 = *(const LAS bf16x8*)(CTb + (ks < 8 ? aoff[ks & 3] + 128 * (ks >> 2) : aoff[4]));
            p0 = __builtin_amdgcn_mfma_f32_32x32x16_bf16(a0, qa[ks], p0, 0, 0, 0); }
        { LAS char* xw = XCH + wid * 4096 + lane * 16;
#pragma unroll
          for (int a = 0; a < 4; ++a) *(LAS f32x4*)(xw + a * 1024) = (f32x4){p0[4 * a], p0[4 * a + 1], p0[4 * a + 2], p0[4 * a + 3]}; }
        asm volatile("s_waitcnt lgkmcnt(0)" ::: "memory"); __builtin_amdgcn_s_barrier(); asm volatile("" ::: "memory");
        { const LAS char* xr = XCH + hl * 16384 + lane * 16;
#pragma unroll
          for (int a = 0; a < 4; ++a) {
              f32x4 s0 = *(const LAS f32x4*)(xr + a * 1024);
#pragma unroll
              for (int w = 1; w < 4; ++w) s0 += *(const LAS f32x4*)(xr + w * 4096 + a * 1024);
              s0 *= *(const LAS f32x4*)(RK + bf * 64 + hl * 32 + 8 * a + 4 * hi);
              p0[4 * a] = s0.x; p0[4 * a + 1] = s0.y; p0[4 * a + 2] = s0.z; p0[4 * a + 3] = s0.w; } }
        float alpha; bf16x8 pa0, pa1;
        partialSM1(p0, m_reg, alpha);
        resc_shfl<4>(o, alpha, hi);
        finishSM1(p0, alpha, l_reg, pa0, pa1);
#pragma unroll
        for (int cb = 0; cb < 4; ++cb) {
            const LAS char* b0 = CTb + trb[0][cb & 1] + (cb >> 1) * 128; const LAS char* b1 = CTb + trb[1][cb & 1] + (cb >> 1) * 128;
            const s16x4 l0 = vtr(b0), h0 = vtr(b1), l1 = vtr(b0 + 16 * ROWB), h1 = vtr(b1 + 16 * ROWB);
            o[cb] = __builtin_amdgcn_mfma_f32_32x32x16_bf16(pa0, PKV(l0, h0), o[cb], 0, 0, 0);
            o[cb] = __builtin_amdgcn_mfma_f32_32x32x16_bf16(pa1, PKV(l1, h1), o[cb], 0, 0, 0); }
        if (j + 1 < NT && tid < 64) RK[(bf ^ 1) * 64 + tid] = RKVAL(j + 1);
        asm volatile("s_waitcnt vmcnt(0) lgkmcnt(0)" ::: "memory"); __builtin_amdgcn_s_barrier(); asm volatile("" ::: "memory");
    }
    { const float rl = __builtin_amdgcn_rcpf(l_reg);
      LAS bf16_t* OL = (LAS bf16_t*)(CT + hl * 32 * OLB);
#pragma unroll
      for (int r = 0; r < 16; ++r) { const float a = __shfl(rl, crow(r, hi)); const int orow = crow(r, hi);
#pragma unroll
          for (int cb = 0; cb < 4; ++cb) OL[orow * (OLB / 2) + 128 * wq + 32 * cb + r32] = f2bf(o[cb][r] * a); }
      __syncthreads();
      f32x16 acc = f32x16{};
      const bf16_t* Wv = (const bf16_t*)(ws + WS_WVB) + (size_t)(h * 128 + 32 * wq + r32) * 512 + hi * 8;
      const LAS char* ar = CT + hl * 32 * OLB + r32 * OLB + hi * 16;
#pragma unroll 8
      for (int ks = 0; ks < 32; ++ks) { const bf16x8 a = *(const LAS bf16x8*)(ar + ks * 32); const bf16x8 bw = *(const bf16x8*)(Wv + ks * 16);
          acc = __builtin_amdgcn_mfma_f32_32x32x16_bf16(a, bw, acc, 0, 0, 0); }
      bf16_t* Ow = (bf16_t*)(ws + WS_OMLA) + (size_t)(TP + b * 32) * 2048 + h * 128 + 32 * wq + r32;
#pragma unroll
      for (int r = 0; r < 16; ++r) Ow[(size_t)crow(r, hi) * 2048] = f2bf(acc[r]);
      __syncthreads(); }
#undef TDMA
#undef RKLOAD
#undef RKVAL
}
}


struct MergeSched {
    const bf16_t *D, *WP, *OML, *WML, *OME, *WME; int G, c;
    __device__ __forceinline__ void seg_ptrs(pg8::Unit& u, int seg, int pm, int pn, int kt0) const {
        if (seg == 0) { u.A = (const char*)(D + (size_t)pm * 256 * 1024 + (pn >> 1) * 256); u.lda2 = 2048u; u.B = (const char*)(WP + (size_t)pn * 256 * 256); u.ldb2 = 512u; }
        else if (seg == 1) { u.A = (const char*)(OML + (size_t)pm * 256 * 2048 + kt0 * 64); u.lda2 = 4096u; u.B = (const char*)(WML + (size_t)pn * 256 * 2048 + kt0 * 64); u.ldb2 = 4096u; }
        else { u.A = (const char*)(OME + (size_t)pm * 256 * 1024 + kt0 * 64); u.lda2 = 2048u; u.B = (const char*)(WME + (size_t)pn * 256 * 1024 + kt0 * 64); u.ldb2 = 2048u; }
    }
    __device__ __forceinline__ bool next(int i, pg8::Unit& u) const {
        const int nmain = c < 256 ? (256 - c + G - 1) / G : 0;
        if (i < 3 * nmain) { const int ti = i / 3, seg = i - 3 * ti; int pm, pn; pg8::tile_of(ti * G + c, 32, 8, pm, pn); u.pm = pm; u.pn = pn; u.kind = seg; u.aux = 0;
            seg_ptrs(u, seg, pm, pn, 0); u.nt = seg == 0 ? 4 : (seg == 1 ? 32 : 16); return true; }
        const long p = (long)(i - 3 * nmain) * G + c; if (p >= 16 * 13) return false;
        const int t = (int)p / 13, piece = (int)p - 13 * t, pm = 32 + (t >> 3), pn = t & 7, seg = piece == 0 ? 0 : (piece < 9 ? 1 : 2);
        u.pm = pm; u.pn = pn; u.kind = 3 + seg; u.aux = (int)p; u.nt = 4;
        seg_ptrs(u, seg, pm, pn, seg == 1 ? (piece - 1) * 4 : (seg == 2 ? (piece - 9) * 4 : 0)); return true;
    }
};
struct TailSched {
    const bf16_t* A; const bf16_t* B; int K, G, c;
    __device__ __forceinline__ bool next(int i, pg8::Unit& u) const {
        const int nmain = c < 256 ? (256 - c + G - 1) / G : 0;
        u.lda2 = (unsigned)K * 2u; u.ldb2 = u.lda2;
        if (i < nmain) { int pm, pn; pg8::tile_of(i * G + c, 32, 8, pm, pn); u.pm = pm; u.pn = pn; u.kind = 0; u.aux = 0; u.nt = K / 64;
            u.A = (const char*)(A + (size_t)pm * 256 * K); u.B = (const char*)(B + (size_t)pn * 256 * K); return true; }
        const long p = (long)(i - nmain) * G + c; if (p >= 256) return false;
        const int t = (int)p >> 4, piece = (int)p & 15, pm = 32 + (t >> 3), pn = t & 7, ntp = K / 64 / 16;
        u.pm = pm; u.pn = pn; u.kind = 1; u.aux = (int)p; u.nt = ntp;
        u.A = (const char*)(A + (size_t)pm * 256 * K + piece * ntp * 64); u.B = (const char*)(B + (size_t)pn * 256 * K + piece * ntp * 64); return true;
    }
};
struct EpiMerge {
    static constexpr bool PERM = true;
    const bf16_t* G; const float* ps; bf16_t* MG; float* slab;
    __device__ __forceinline__ bool operator()(f32x4 (&acc)[2][2][4][2], const pg8::Unit& u, int wr, int wc, int fr_, int fq) const {
        int fr = fr_; asm volatile("" : "+v"(fr));
        const int row0 = u.pm * 256 + wr * 64 + fr, c0 = u.pn * 256 + wc * 32 + 8 * fq;
        const int kind = u.kind, sg = kind >= 3 ? kind - 3 : kind;
        const bool ratio = kind < 2;
        float* sl = slab + (size_t)u.aux * 65536 + (wr * 64 + fr) * 256 + wc * 32 + 8 * fq;
        f32x4 pv[2][2];
#pragma unroll
        for (int bj = 0; bj < 2; ++bj) { pv[bj][0] = (f32x4){1.f, 1.f, 1.f, 1.f}; pv[bj][1] = pv[bj][0]; }
        if (sg == 0) {
#pragma unroll
            for (int bj = 0; bj < 2; ++bj) { pv[bj][0] = *(const f32x4*)(ps + c0 + bj * 128); pv[bj][1] = *(const f32x4*)(ps + c0 + bj * 128 + 4); }
        }
#pragma unroll
        for (int ai = 0; ai < 2; ++ai)
#pragma unroll
            for (int m = 0; m < 4; ++m) { const size_t row = (size_t)(row0 + ai * 128 + m * 16); const bf16_t* gr = G + row * G_LD + sg * 2048 + c0;
#pragma unroll
                for (int bj = 0; bj < 2; ++bj) {
                    float f[8]; unpack8(*(const u32x4*)(gr + bj * 128), f);
                    if (ratio) { float b[8]; unpack8(*(const u32x4*)(gr + 2048 + bj * 128), b);
#pragma unroll
                        for (int e = 0; e < 8; ++e) f[e] *= __builtin_amdgcn_rcpf(b[e]); }
#pragma unroll
                    for (int e = 0; e < 8; ++e) f[e] *= pv[bj][e >> 2][e & 3];
                    f32x4& v0 = acc[ai][bj][m][0]; f32x4& v1 = acc[ai][bj][m][1];
                    v0[0] *= f[0]; v0[1] *= f[1]; v0[2] *= f[2]; v0[3] *= f[3]; v1[0] *= f[4]; v1[1] *= f[5]; v1[2] *= f[6]; v1[3] *= f[7];
                    if (kind == 2) *(u32x4*)(MG + row * 2048 + c0 + bj * 128) = (u32x4){cvtpk(v0[0], v0[1]), cvtpk(v0[2], v0[3]), cvtpk(v1[0], v1[1]), cvtpk(v1[2], v1[3])};
                    else if (kind >= 3) { float* sp = sl + (ai * 128 + m * 16) * 256 + bj * 128; *(f32x4*)sp = v0; *(f32x4*)(sp + 4) = v1; }
                }
                asm volatile("" ::: "memory"); }
        return kind < 2;
    }
};
__device__ __forceinline__ void store_slab(const f32x4 (&acc)[2][2][4][2], float* sl, int wr, int wc, int fr, int fq) {
    float* s0 = sl + (wr * 64 + fr) * 256 + wc * 32 + 4 * fq;
#pragma unroll
    for (int ai = 0; ai < 2; ++ai)
#pragma unroll
        for (int m = 0; m < 4; ++m)
#pragma unroll
            for (int bj = 0; bj < 2; ++bj)
#pragma unroll
                for (int n = 0; n < 2; ++n) *(f32x4*)(s0 + (ai * 128 + m * 16) * 256 + bj * 128 + n * 16) = acc[ai][bj][m][n];
}
struct EpiOut {
    static constexpr bool PERM = false;
    const float* xp; const float* xs; float* X1; bf16_t* X1b; float* SSX; float* slab;
    __device__ __forceinline__ bool operator()(f32x4 (&acc)[2][2][4][2], const pg8::Unit& u, int wr, int wc, int fr_, int fq) const {
        int fr = fr_; asm volatile("" : "+v"(fr));
        const int row0 = u.pm * 256 + wr * 64 + fr, c0 = u.pn * 256 + wc * 32 + 4 * fq;
        if (u.kind == 1) { store_slab(acc, slab + (size_t)u.aux * 65536, wr, wc, fr, fq); return false; }
#pragma unroll
        for (int ai = 0; ai < 2; ++ai)
#pragma unroll
            for (int m = 0; m < 4; ++m) { const int row = row0 + ai * 128 + m * 16;
                const float* xr = (row < TP ? xp + (size_t)row * DM : xs + (size_t)(row - TP) * DM) + c0;
                float s = 0.f;
#pragma unroll
                for (int bj = 0; bj < 2; ++bj)
#pragma unroll
                    for (int n = 0; n < 2; ++n) { const f32x4 v = acc[ai][bj][m][n] + *(const f32x4*)(xr + bj * 128 + n * 16);
                        s += (v.x * v.x + v.y * v.y) + (v.z * v.z + v.w * v.w);
                        *(f32x4*)(X1 + (size_t)row * DM + c0 + bj * 128 + n * 16) = v;
                        *(u32x2*)(X1b + (size_t)row * DM + c0 + bj * 128 + n * 16) = (u32x2){cvtpk(v.x, v.y), cvtpk(v.z, v.w)}; }
                s += __shfl_xor(s, 16); s += __shfl_xor(s, 32);
                if (fq == 0) SSX[(size_t)row * 32 + u.pn * 4 + wc] = s; }
        return false;
    }
};
struct EpiUp {
    static constexpr bool PERM = true;
    const float* SSX; bf16_t* A;
    __device__ __forceinline__ bool operator()(f32x4 (&acc)[2][2][4][2], const pg8::Unit& u, int wr, int wc, int fr_, int fq) const {
        int fr = fr_; asm volatile("" : "+v"(fr));
        const int row0 = u.pm * 256 + wr * 64 + fr, c0 = u.pn * 256 + wc * 32 + 8 * fq;
#pragma unroll
        for (int ai = 0; ai < 2; ++ai)
#pragma unroll
            for (int m = 0; m < 4; ++m) { const size_t row = (size_t)(row0 + ai * 128 + m * 16);
                const f32x4 s0 = *(const f32x4*)(SSX + row * 32 + fq * 8), s1 = *(const f32x4*)(SSX + row * 32 + fq * 8 + 4);
                float s = ((s0.x + s0.y) + (s0.z + s0.w)) + ((s1.x + s1.y) + (s1.z + s1.w));
                s += __shfl_xor(s, 16); s += __shfl_xor(s, 32);
                const float r = rsqrtf(s * (1.f / 2048.f) + EPS);
#pragma unroll
                for (int bj = 0; bj < 2; ++bj) { f32x4 v0 = acc[ai][bj][m][0] * r, v1 = acc[ai][bj][m][1] * r;
#pragma unroll
                    for (int e = 0; e < 4; ++e) { const float a = fmaxf(v0[e], 0.f), b = fmaxf(v1[e], 0.f); v0[e] = a * a; v1[e] = b * b; }
                    *(u32x4*)(A + row * 8192 + c0 + bj * 128) = (u32x4){cvtpk(v0[0], v0[1]), cvtpk(v0[2], v0[3]), cvtpk(v1[0], v1[1]), cvtpk(v1[2], v1[3])}; } }
        return false;
    }
};
struct EpiDown {
    static constexpr bool PERM = false;
    float* Y; float* slab;
    __device__ __forceinline__ bool operator()(f32x4 (&acc)[2][2][4][2], const pg8::Unit& u, int wr, int wc, int fr_, int fq) const {
        int fr = fr_; asm volatile("" : "+v"(fr));
        const int row0 = u.pm * 256 + wr * 64 + fr, c0 = u.pn * 256 + wc * 32 + 4 * fq;
        if (u.kind == 1) { store_slab(acc, slab + (size_t)u.aux * 65536, wr, wc, fr, fq); return false; }
#pragma unroll
        for (int ai = 0; ai < 2; ++ai)
#pragma unroll
            for (int m = 0; m < 4; ++m) { float* yr = Y + (size_t)(row0 + ai * 128 + m * 16) * DM + c0;
#pragma unroll
                for (int bj = 0; bj < 2; ++bj)
#pragma unroll
                    for (int n = 0; n < 2; ++n) { f32x4* p = (f32x4*)(yr + bj * 128 + n * 16); *p = *p + acc[ai][bj][m][n]; } }
        return false;
    }
};


template <int NP> __device__ __forceinline__ f32x4 slab_sum(const float* slab, int t, int r, int lane) {
    const float* sp = slab + ((size_t)t * NP) * 65536 + r * 256 + lane * 4;
    f32x4 s = *(const f32x4*)sp;
#pragma unroll
    for (int p = 1; p < NP; ++p) s += *(const f32x4*)(sp + (size_t)p * 65536);
    return s;
}
__device__ __forceinline__ void reduce_merge(const float* slab, bf16_t* MG, int gw, int NGW, int lane) {
    for (int rs = gw; rs < TS; rs += NGW) { const int r = rs & 255, t0 = (rs >> 8) * 8;
#pragma unroll 2
        for (int pn = 0; pn < 8; ++pn) { const f32x4 s = slab_sum<13>(slab, t0 + pn, r, lane);
            *(u32x2*)(MG + (size_t)(TP + rs) * DM + pn * 256 + lane * 4) = (u32x2){cvtpk(s.x, s.y), cvtpk(s.z, s.w)}; } }
}
__device__ __forceinline__ void reduce_out(const float* slab, const float* xs, float* X1, bf16_t* X1b, float* SSX, int gw, int NGW, int lane) {
    for (int rs = gw; rs < TS; rs += NGW) { const int r = rs & 255, t0 = (rs >> 8) * 8; float ss = 0.f;
#pragma unroll 2
        for (int pn = 0; pn < 8; ++pn) { const size_t o = (size_t)rs * DM + pn * 256 + lane * 4;
            const f32x4 v = slab_sum<16>(slab, t0 + pn, r, lane) + *(const f32x4*)(xs + o);
            ss += (v.x * v.x + v.y * v.y) + (v.z * v.z + v.w * v.w);
            *(f32x4*)(X1 + (size_t)TP * DM + o) = v; *(u32x2*)(X1b + (size_t)TP * DM + o) = (u32x2){cvtpk(v.x, v.y), cvtpk(v.z, v.w)}; }
        ss = wave_sum(ss);
        if (lane < 32) SSX[(size_t)(TP + rs) * 32 + lane] = lane == 0 ? ss : 0.f; }
}
__device__ __forceinline__ void reduce_down(const float* slab, float* Y, int gw, int NGW, int lane) {
    for (int rs = gw; rs < TS; rs += NGW) { const int r = rs & 255, t0 = (rs >> 8) * 8;
#pragma unroll 2
        for (int pn = 0; pn < 8; ++pn) { f32x4* yp = (f32x4*)(Y + (size_t)(TP + rs) * DM + pn * 256 + lane * 4); *yp = *yp + slab_sum<16>(slab, t0 + pn, r, lane); } }
}

struct SchedB {
    const unsigned char* ws; int G, c;
    __device__ __forceinline__ bool next(int i, pg8::Unit& u) const {
        const long L = (long)i * G + c; constexpr int N0 = 34 * 37, N1 = 2 * 8; if (L >= N0 + N1) return false;
        int pm, pn; u.lda2 = 4096u; u.ldb2 = 4096u; u.nt = 32;
        if (L < N0) { pg8::tile_of((int)L, 34, 37, pm, pn); u.A = (const char*)(ws + WS_H + (size_t)pm * 256 * 4096); u.B = (const char*)(ws + WS_WIN + (size_t)pn * 256 * 4096); u.kind = 0; }
        else { pg8::tile_of((int)L - N0, 2, 8, pm, pn); u.A = (const char*)(ws + WS_HM + (size_t)pm * 256 * 4096); u.B = (const char*)(ws + WS_WMEMKV + (size_t)pn * 256 * 4096); u.kind = 1; }
        u.pm = pm; u.pn = pn; return true;
    }
};
struct SchedD {
    const unsigned char* ws; const unsigned char* ob; int G, c;
    __device__ __forceinline__ bool next(int i, pg8::Unit& u) const {
        const long L = (long)i * G + c; constexpr int N0 = (NBS * KPAD / 256) * 8, N1 = N0 + 34 * 12, N2 = N1 + 32 * 8, N3 = N2 + 32 * 8; if (L >= N3) return false;
        int pm, pn; u.lda2 = 1024u; u.ldb2 = 1024u; u.nt = 8;
        if (L < N0) { pg8::tile_of((int)L, NBS * KPAD / 256, 8, pm, pn); u.A = (const char*)(ws + WS_LATS + (size_t)pm * 256 * 1024); u.B = (const char*)(ws + WS_WKB + (size_t)pn * 256 * 1024); u.kind = 3; }
        else if (L < N1) { pg8::tile_of((int)L - N0, 34, 12, pm, pn); u.A = (const char*)(ws + WS_QN + (size_t)pm * 256 * 1024); u.B = (const char*)(ws + WS_WQB + (size_t)pn * 256 * 1024); u.kind = 0; }
        else if (L < N2) { pg8::tile_of((int)L - N1, 32, 8, pm, pn); u.A = (const char*)(ob + DO_CKVP + (size_t)pm * 256 * 1024); u.B = (const char*)(ws + WS_WKB + (size_t)pn * 256 * 1024); u.kind = 1; }
        else { pg8::tile_of((int)L - N2, 32, 8, pm, pn); u.A = (const char*)(ob + DO_CKVP + (size_t)pm * 256 * 1024); u.B = (const char*)(ws + WS_WVB + (size_t)pn * 256 * 1024); u.kind = 2; }
        u.pm = pm; u.pn = pn; return true;
    }
};

constexpr int CW_BAR = 4096, CW_QUEUE = 64;
#ifndef ONLY
#define ONLY -1
#endif
#define PH(x) (ONLY < 0 || ONLY == (x))
__global__ void __launch_bounds__(NWAVES * 64, 2) mega_fwd(Args P) {
    extern __shared__ __attribute__((aligned(16))) unsigned char lds_raw[];
    LAS unsigned char* lds = (LAS unsigned char*)lds_raw;
    const int tid = threadIdx.x, lane = tid & 63, wave = __builtin_amdgcn_readfirstlane(tid >> 6);
    const int G = gridDim.x, bx = blockIdx.x;
    const int vcu = (G % 8 == 0) ? (bx % 8) * (G / 8) + bx / 8 : bx;
    const int gw = vcu * NWAVES + wave, NGW = G * NWAVES;
    volatile LAS unsigned* MISC = (volatile LAS unsigned*)(lds + MISC_OFF);
    if (tid < 64) MISC[tid] = 0u;
    __syncthreads();
    unsigned* ctl = (unsigned*)(P.ws + WS_CTL);
    XcdBarrier bar = xcd_barrier_post(ctl + CW_BAR, MISC + 8);
    unsigned char* ws = P.ws;

#define LAUNDER() int lane_l = lane, gw_l = gw; asm volatile("" : "+v"(lane_l)); asm volatile("" : "+s"(gw_l))
    if (PH(0)) { LAUNDER(); phase_prep(P, lds, gw_l, NGW, wave, lane_l); }
    xcd_barrier(bar);
    if (PH(1)) {
        SchedB S{ws, G, bx};
        EpiIn E{(bf16_t*)(ws + WS_ZS), (bf16_t*)(ws + WS_G), (float*)(ws + WS_M), P.in[I_BGATE]};
        pg8::gemm_stream<EpiIn, SchedB>(lds, S, E);
    }
    xcd_barrier(bar);
    if (PH(2)) { LAUNDER(); phase_rows(P, lds, gw_l, NGW, wave, lane_l); }
    xcd_barrier(bar);
    if (PH(3)) {
        SchedD S{ws, (const unsigned char*)P.out, G, bx};
        EpiQKV E{(bf16_t*)(ws + WS_Q), (bf16_t*)((unsigned char*)P.out + DO_K), (bf16_t*)(ws + WS_V), (float*)(ws + WS_KSS)};
        pg8::gemm_stream<EpiQKV, SchedD>(lds, S, E);
    }
    xcd_barrier(bar);
    if (PH(4)) { LAUNDER(); phase_heads(P, gw_l, NGW, lane_l); }
    xcd_barrier(bar);
    {
        const bf16_t* Qg = (const bf16_t*)(ws + WS_Q); const bf16_t* Kg = (const bf16_t*)((unsigned char*)P.out + DO_K); const bf16_t* Vg = (const bf16_t*)(ws + WS_V);
        bf16_t* Og = (bf16_t*)(ws + WS_OMLA);
        constexpr int NI_S = 128, NI_P = 512, NI_M = (TT / 32) * 4 / 8, NI = NI_S + NI_P + NI_M;
        for (;;) {
            if (tid == 0) MISC[16] = __hip_atomic_fetch_add(ctl + CW_QUEUE, 1u, __ATOMIC_RELAXED, __HIP_MEMORY_SCOPE_AGENT);
            __syncthreads();
            const int it = (int)MISC[16];
            __syncthreads();
            if (it >= NI) break;
            if (it < NI_S) { if (PH(6)) sat::unit(P, it >> 3, it & 7, (LAS char*)lds); }
            else if (it < NI_S + NI_P) { const int idx = it - NI_S, qb = 15 - (idx >> 5), bh = idx & 31, b = bh >> 4, h = bh & 15;
                if (PH(5)) pat::unit(Qg + ((size_t)(b * 4096 + qb * 256) * QLD + h * 192), Kg + ((size_t)b * 4096 * QLD + h * 192), Vg + ((size_t)b * 4096 * 2048 + h * 128),
                          Og + ((size_t)(b * 4096 + qb * 256) * 2048 + h * 128), qb, (LAS char*)lds); }
            else { if (PH(7)) mem_attn_item(P, (it - NI_S - NI_P) * 8 + wave, lane); }
        }
    }
    xcd_barrier(bar);
    if (PH(8)) {
        MergeSched S{(const bf16_t*)(ws + WS_DP), (const bf16_t*)(ws + WS_WPOOL), (const bf16_t*)(ws + WS_OMLA), (const bf16_t*)(ws + WS_WMLAO),
                     (const bf16_t*)(ws + WS_OMEM), (const bf16_t*)(ws + WS_WMEMO), G, bx};
        EpiMerge E{(const bf16_t*)(ws + WS_G), P.in[I_PSCALE], (bf16_t*)(ws + WS_MG), (float*)(ws + WS_Q)};
        pg8::gemm_stream<EpiMerge, MergeSched>(lds, S, E);
        xcd_barrier(bar);
        { LAUNDER(); reduce_merge((const float*)(ws + WS_Q), (bf16_t*)(ws + WS_MG), gw_l, NGW, lane_l); }
    }
    xcd_barrier(bar);
    if (PH(9)) {
        TailSched S{(const bf16_t*)(ws + WS_MG), (const bf16_t*)(ws + WS_WOUT), 2048, G, bx};
        EpiOut E{P.in[I_XP], P.in[I_XS], P.out + O_YP, (bf16_t*)(ws + WS_X1B), (float*)(ws + WS_SSX), (float*)(ws + WS_G)};
        pg8::gemm_stream<EpiOut, TailSched>(lds, S, E);
        xcd_barrier(bar);
        { LAUNDER(); reduce_out((const float*)(ws + WS_G), P.in[I_XS], P.out + O_YP, (bf16_t*)(ws + WS_X1B), (float*)(ws + WS_SSX), gw_l, NGW, lane_l); }
    }
    xcd_barrier(bar);
    if (PH(10)) {
        pg8::JobSched1 S; S.j0 = pg8::Job{(const bf16_t*)(ws + WS_X1B), (const bf16_t*)(ws + WS_WUP), 2048, 2048, 34, 32, 0}; S.finish(G, bx);
        EpiUp E{(const float*)(ws + WS_SSX), (bf16_t*)(ws + WS_A)};
        pg8::gemm_stream<EpiUp, pg8::JobSched1>(lds, S, E);
    }
    xcd_barrier(bar);
    if (PH(11)) {
        TailSched S{(const bf16_t*)(ws + WS_A), (const bf16_t*)(ws + WS_WDOWN), 8192, G, bx};
        EpiDown E{P.out + O_YP, (float*)(ws + WS_MG)};
        pg8::gemm_stream<EpiDown, TailSched>(lds, S, E);
        xcd_barrier(bar);
        { LAUNDER(); reduce_down((const float*)(ws + WS_MG), P.out + O_YP, gw_l, NGW, lane_l); }
    }
}

extern "C" void kernel_launch(void* const* d_in, const int* in_sizes, int n_in, void* d_out, int out_size, void* d_ws, size_t ws_size, hipStream_t stream) {
    static int grid = 0;
    if (grid == 0) {
        if (n_in != 30 || ws_size < WS_END || out_size != 24164352) { fprintf(stderr, "kernel_launch: unexpected problem: n_in %d out %d ws %zu (need %zu)\n", n_in, out_size, ws_size, (size_t)WS_END); grid = -1; return; }
        int dev = 0, cus = 0, per_cu = 0;
        if (hipGetDevice(&dev) != hipSuccess || hipDeviceGetAttribute(&cus, hipDeviceAttributeMultiprocessorCount, dev) != hipSuccess) { grid = -1; return; }
        if (hipFuncSetAttribute((const void*)mega_fwd, hipFuncAttributeMaxDynamicSharedMemorySize, LDS_BYTES) != hipSuccess) { fprintf(stderr, "kernel_launch: hipFuncSetAttribute(%d) failed\n", LDS_BYTES); grid = -1; return; }
        if (hipOccupancyMaxActiveBlocksPerMultiprocessor(&per_cu, (const void*)mega_fwd, NWAVES * 64, LDS_BYTES) != hipSuccess || per_cu < 1) { fprintf(stderr, "kernel_launch: occupancy query says %d blocks per CU\n", per_cu); grid = -1; (void)hipGetLastError(); return; }
        grid = cus;
    }
    if (grid < 0) return;
    (void)hipMemsetAsync((char*)d_ws + WS_CTL, 0, CTL_ZERO_BYTES, stream);
    Args a{};
    for (int i = 0; i < 30; ++i) a.in[i] = (const float*)d_in[i];
    a.out = (float*)d_out; a.ws = (unsigned char*)d_ws;
    hipLaunchKernelGGL(mega_fwd, dim3(grid), dim3(NWAVES * 64), LDS_BYTES, stream, a);
}
```

```cpp
#include <hip/hip_runtime.h>
#include <cstdio>
#include <cstdint>

#define LAS __attribute__((address_space(3)))
#define GAS __attribute__((address_space(1)))
typedef unsigned short bf16_t;
typedef short bf16x8 __attribute__((ext_vector_type(8)));
typedef short s16x4 __attribute__((ext_vector_type(4)));
typedef float f32x2 __attribute__((ext_vector_type(2)));
typedef float f32x4 __attribute__((ext_vector_type(4)));
typedef float f32x16 __attribute__((ext_vector_type(16)));
typedef unsigned u32x2 __attribute__((ext_vector_type(2)));
typedef unsigned u32x4 __attribute__((ext_vector_type(4)));
typedef __bf16 bf16x2_t __attribute__((ext_vector_type(2)));

constexpr int DM = 2048, TP = 8192, TS = 512, TT = TP + TS, SEQ = 4096, LS = 32, NBS = 16;
constexpr int KPAD = 4160;
constexpr int ZS_LD = 3136, G_LD = 6144, QLD = 3072, NHEAD = 16;
constexpr float EPS = 1e-6f;
constexpr float MLA_C = 0.07216878364870322f * 1.4426950408889634f;
constexpr float MEM_C = 0.0625f * 1.4426950408889634f;
constexpr size_t O_YP = 0, O_YS = 16777216, O_LATP = 17825792, O_KPEP = 22020096, O_POOLP = 22544384, O_MEMK = 22575104, O_MEMV = 23099392,
                 O_LATS = 23623680, O_KPES = 23885824, O_POOLS = 23918592;
constexpr size_t MiB = 1u << 20;
constexpr size_t WS_CTL = 0, CTL_ZERO_BYTES = 1 * MiB;
constexpr size_t WS_WIN = 1 * MiB, WS_WMEMKV = 38 * MiB, WS_WQB = 46 * MiB, WS_WKB = 49 * MiB, WS_WVB = 51 * MiB, WS_WKBN = 53 * MiB, WS_WPOOL = 55 * MiB,
                 WS_WMLAO = 56 * MiB, WS_WMEMO = 64 * MiB, WS_WOUT = 68 * MiB, WS_WUP = 76 * MiB, WS_WDOWN = 108 * MiB;
constexpr size_t WS_G = 140 * MiB, WS_ZS = 242 * MiB, WS_Q = 242 * MiB, WS_A = 140 * MiB;
constexpr size_t WS_LATS = 295 * MiB, WS_KRS = 360 * MiB, WS_KPESS = 368 * MiB + 512 * 1024, WS_MG = 295 * MiB, WS_X1B = 329 * MiB;
constexpr size_t WS_H = 369 * MiB, WS_DP = 369 * MiB, WS_QN = 386 * MiB, WS_OMEM = 386 * MiB, WS_OMLA = 1 * MiB;
constexpr size_t WS_RKG = 403 * MiB;
constexpr size_t WS_HM = 403 * MiB, WS_M = 405 * MiB, WS_QM = 409 * MiB, WS_V = 426 * MiB, WS_KSS = 458 * MiB, WS_MK = 475 * MiB, WS_MVT = 484 * MiB,
                 WS_KRP = 493 * MiB, WS_KPESSP = 494 * MiB, WS_SSX = 494 * MiB + 256 * 1024,
                 WS_PM = 496 * MiB  , WS_PS = 514 * MiB  , WS_END = 515 * MiB;
constexpr size_t DO_K = 0, DO_CKVP = 56 * MiB;

constexpr int LDS_BYTES = 160 * 1024, MISC_OFF = LDS_BYTES - 256;
constexpr int NWAVES = 8;

#define LDS_WAIT() asm volatile("s_waitcnt lgkmcnt(0)" ::: "memory")
#define VM_WAIT() asm volatile("s_waitcnt vmcnt(0)" ::: "memory")
#define SBAR() __builtin_amdgcn_sched_barrier(0)
__device__ __forceinline__ unsigned cvtpk(float lo, float hi) { f32x2 v = {lo, hi}; bf16x2_t b = __builtin_convertvector(v, bf16x2_t); return __builtin_bit_cast(unsigned, b); }
__device__ __forceinline__ float bflo(unsigned u) { return __uint_as_float(u << 16); }
__device__ __forceinline__ float bfhi(unsigned u) { return __uint_as_float(u & 0xffff0000u); }
__device__ __forceinline__ float bf2f(bf16_t b) { return __uint_as_float((unsigned)b << 16); }
__device__ __forceinline__ bf16_t f2bf(float f) { return (bf16_t)(cvtpk(f, 0.f) & 0xffffu); }
__device__ __forceinline__ float wave_sum(float v) {
#pragma unroll
    for (int o = 1; o < 64; o <<= 1) v += __shfl_xor(v, o);
    return v;
}
__device__ __forceinline__ int lane_id() { int r; asm volatile("v_mbcnt_lo_u32_b32 %0, -1, 0\n\tv_mbcnt_hi_u32_b32 %0, -1, %0" : "=v"(r)); return r; }
__device__ __forceinline__ int crow(int r, int hi) { return (r & 3) + 8 * (r >> 2) + 4 * hi; }
__device__ __forceinline__ void fast_sincos(float ang, float& sn, float& cs) {
    float t = ang * 0.15915494309189535f; t = t - floorf(t);
    sn = __builtin_amdgcn_sinf(t); cs = __builtin_amdgcn_cosf(t);
}
__device__ __forceinline__ float rope_inv(int j) { return __builtin_amdgcn_exp2f(-(float)j * (13.287712379549449f / 32.0f)); }

typedef short v4i16_t __attribute__((ext_vector_type(4)));
__device__ __forceinline__ s16x4 vtr(const LAS char* p) { return __builtin_bit_cast(s16x4, __builtin_amdgcn_ds_read_tr16_b64_v4i16((LAS v4i16_t*)p)); }
#define PKV(L, H) (bf16x8){L[0], L[1], L[2], L[3], H[0], H[1], H[2], H[3]}

#define XB_TMO      128
#define XB_XCNT(j)  (256  + 64 * (j))
#define XB_XSUB(j)  (1280 + 64 * (j))
#define XB_XGEN(j)  (2304 + 64 * (j))
#define XB_TOP      3328
#define XB_TOPGEN   3392
#define XCD_BAR_WORDS 3456
#define XB_SPIN_CAP (1u << 20)
__device__ __forceinline__ unsigned xb_ld(unsigned* p)              { return __hip_atomic_load(p, __ATOMIC_RELAXED, __HIP_MEMORY_SCOPE_AGENT); }
__device__ __forceinline__ unsigned xb_add(unsigned* p, unsigned v) { return __hip_atomic_fetch_add(p, v, __ATOMIC_RELAXED, __HIP_MEMORY_SCOPE_AGENT); }
__device__ __forceinline__ unsigned xb_xcc_id() { return (unsigned)__builtin_amdgcn_s_getreg((3 << 11) | 20) & 0xFu; }
#define XB_SPIN(cond, bar) do { unsigned _sp = 0; while (cond) { __builtin_amdgcn_s_sleep(1); \
    if ((++_sp & 255u) == 0u) { if (xb_ld(&(bar)[XB_TMO])) break; if (_sp > XB_SPIN_CAP) { atomicAdd(&(bar)[XB_TMO], 1u); break; } } } } while (0)
struct XcdBarrier { unsigned* bar; unsigned x; volatile LAS unsigned* st; int wv; };
__device__ __forceinline__ XcdBarrier xcd_barrier_post(unsigned* bar, volatile LAS unsigned* st) {
    XcdBarrier b; b.bar = bar; b.x = xb_xcc_id(); b.st = st; b.wv = 0;
    if (threadIdx.x == 0) (void)xb_add(&bar[XB_XCNT(b.x)], 1u);
    return b;
}
__device__ __forceinline__ void xcd_barrier_complete(unsigned* bar, unsigned x, unsigned& nloc, unsigned& nx) {
    const unsigned G = gridDim.x * gridDim.y * gridDim.z;
    unsigned sum, cnt, mine, sp = 0u;
    for (;;) {
        sum = 0u; cnt = 0u; mine = 0u;
#pragma unroll
        for (unsigned j = 0; j < 16; ++j) { const unsigned c = xb_ld(&bar[XB_XCNT(j)]); sum += c; cnt += (c > 0u) ? 1u : 0u; mine = (j == x) ? c : mine; }
        if (sum == G) break;
        __builtin_amdgcn_s_sleep(1);
        if ((++sp & 255u) == 0u) { if (xb_ld(&bar[XB_TMO])) break; if (sp > XB_SPIN_CAP) { atomicAdd(&bar[XB_TMO], 1u); break; } }
    }
    nloc = mine > 0u ? mine : 1u; nx = cnt > 0u ? cnt : 1u;
}
__device__ __forceinline__ void xcd_barrier(const XcdBarrier& b) {
    asm volatile("s_waitcnt vmcnt(0)" ::: "memory");
    __syncthreads();
    if (threadIdx.x == 0) {
        unsigned* bar = b.bar;
        __builtin_amdgcn_s_waitcnt(0);
        unsigned nloc = b.st[0], nx = b.st[1];
        if (nloc == 0u) { xcd_barrier_complete(bar, b.x, nloc, nx); b.st[0] = nloc; b.st[1] = nx; }
        const unsigned old = xb_add(&bar[XB_XSUB(b.x)], 1u);
        const unsigned gen = old / nloc;
        if (old + 1u == (gen + 1u) * nloc) {
            __builtin_amdgcn_fence(__ATOMIC_RELEASE, "agent");
            asm volatile("s_waitcnt vmcnt(0)" ::: "memory");
            const unsigned og = xb_add(&bar[XB_TOP], 1u);
            const unsigned tg = og / nx;
            if (og + 1u == (tg + 1u) * nx) xb_add(&bar[XB_TOPGEN], 1u);
            else XB_SPIN(xb_ld(&bar[XB_TOPGEN]) == tg, bar);
            __builtin_amdgcn_fence(__ATOMIC_ACQUIRE, "agent");
            xb_add(&bar[XB_XGEN(b.x)], 1u);
            asm volatile("s_waitcnt vmcnt(0)" ::: "memory");
        } else {
            XB_SPIN(xb_ld(&bar[XB_XGEN(b.x)]) == gen, bar);
            __builtin_amdgcn_fence(__ATOMIC_ACQUIRE, "agent");
            asm volatile("s_waitcnt vmcnt(0)" ::: "memory");
        }
    }
    __syncthreads();
}

namespace pg8 {
constexpr int BM = 256, BK = 64, HALF = 128, HTB = HALF * BK * 2, STAGE_BYTES = 8 * HTB, NXCD = 8, WGM = 8;
__device__ __forceinline__ int lds_byte(int r, int c) { const int st = (r >> 4) * 2 + (c >> 5), rr = r & 15, cc = c & 31, ob = rr * 64 + cc * 2; return st * 1024 + (ob ^ (((ob >> 9) & 1) << 5)); }
__device__ __forceinline__ void stage_rc(int b, int& R, int& C) { const int st = b / 1024, sb = b % 1024, swz = sb ^ (((sb >> 9) & 1) << 5); R = (st >> 1) * 16 + swz / 64; C = (st & 1) * 32 + (swz % 64) / 2; }
__device__ __forceinline__ int perm32(int rho) { const int n = rho >> 4, i = rho & 15; return 8 * (i >> 2) + 4 * n + (i & 3); }

struct Unit { const char* A; const char* B; unsigned lda2, ldb2; int nt, pm, pn, kind, aux; };

__device__ __forceinline__ void tile_of(int wgid, int nM, int nN, int& pm, int& pn) {
    const int nwg = nM * nN;
    { const int q = nwg / NXCD, r = nwg % NXCD, xcd = wgid % NXCD, off = wgid / NXCD; wgid = (xcd < r ? xcd * (q + 1) : r * (q + 1) + (xcd - r) * q) + off; }
    const int nig = WGM * nN, gid = wgid / nig, fm = gid * WGM, gsz = (nM - fm) < WGM ? (nM - fm) : WGM;
    pm = fm + ((wgid % nig) % gsz); pn = (wgid % nig) / gsz;
}

struct Job { const bf16_t* A; const bf16_t* B; int lda, K, nM, nN, kind; };
struct JobSched1 {
    Job j0; int G, c;
    __device__ __forceinline__ void finish(int G_, int c_) { G = G_; c = c_; }
    __device__ __forceinline__ bool next(int i, Unit& u) const {
        const long L = (long)i * G + c; if (L >= j0.nM * j0.nN) return false;
        int pm, pn; tile_of((int)L, j0.nM, j0.nN, pm, pn);
        u.A = (const char*)(j0.A + (size_t)pm * BM * j0.lda); u.B = (const char*)(j0.B + (size_t)pn * BM * j0.K);
        u.lda2 = (unsigned)j0.lda * 2u; u.ldb2 = (unsigned)j0.K * 2u; u.nt = j0.K / BK; u.pm = pm; u.pn = pn; u.kind = j0.kind; return true;
    }
};

#define PG8_SA(b, h) (((b) * 2 + (h)) * HTB)
#define PG8_SB(b, h) ((4 + (b) * 2 + (h)) * HTB)
#define PG8_STAGE(bufoff, gbase, Rv, ld2) do { const unsigned _vo = (unsigned)(Rv) * (ld2) + c2; \
        __builtin_amdgcn_global_load_lds((const unsigned*)((gbase) + _vo), (LAS unsigned*)(lds + (bufoff) + ldsw), 16, 0, 0); \
        __builtin_amdgcn_global_load_lds((const unsigned*)((gbase) + 64u * (ld2) + _vo), (LAS unsigned*)(lds + (bufoff) + ldsw + 8192), 16, 0, 0); } while (0)
#define PG8_LDA(dst, b, h) do { _Pragma("unroll") for (int m = 0; m < 4; ++m) _Pragma("unroll") for (int k = 0; k < 2; ++k) dst[m][k] = *(const LAS bf16x8*)(lds + PG8_SA(b, h) + aoff + m * 2048 + k * 1024); } while (0)
#define PG8_LDB(dst, b, h) do { _Pragma("unroll") for (int n = 0; n < 2; ++n) _Pragma("unroll") for (int k = 0; k < 2; ++k) dst[n][k] = *(const LAS bf16x8*)(lds + PG8_SB(b, h) + boff + n * 2048 + k * 1024); } while (0)
#define PG8_MMA(ai, bj, At, Bt) do { __builtin_amdgcn_s_setprio(1); _Pragma("unroll") for (int m = 0; m < 4; ++m) _Pragma("unroll") for (int n = 0; n < 2; ++n) _Pragma("unroll") for (int k = 0; k < 2; ++k) \
        acc[ai][bj][m][n] = __builtin_amdgcn_mfma_f32_16x16x32_bf16(Bt[n][k], At[m][k], acc[ai][bj][m][n], 0, 0, 0); __builtin_amdgcn_s_setprio(0); } while (0)
#define PG8_WAIT_V(n) asm volatile("s_waitcnt vmcnt(" #n ")" ::: "memory")
#define PG8_WAIT_L(n) asm volatile("s_waitcnt lgkmcnt(" #n ")" ::: "memory")
#define PG8_BAR __builtin_amdgcn_s_barrier()
#define PG8_SCHED __builtin_amdgcn_sched_barrier(0)

template <class Epi, class Sched>
__device__ __forceinline__ void gemm_stream(LAS unsigned char* lds, const Sched& S, const Epi& E, int wv) {
    int wvl = wv; asm volatile("" : "+s"(wvl)); int tid = wvl * 64 + lane_id(); asm volatile("" : "+v"(tid));
    const int wid = __builtin_amdgcn_readfirstlane(tid >> 6), lane = tid & 63, wr = wid >> 2, wc = wid & 3, fr = lane & 15, fq = lane >> 4;
    int R0, C0; stage_rc(tid * 16, R0, C0);
    const int Rb0 = Epi::PERM ? ((R0 & ~31) + perm32(R0 & 31)) : R0;
    const unsigned c2 = (unsigned)C0 * 2u;
    const unsigned ldsw = (unsigned)wid * 1024u;
    const int aoff = lds_byte(wr * 64 + fr, fq * 8), boff = lds_byte(wc * 32 + fr, fq * 8);
    Unit cur, nxt; int ui = 0;
    if (!S.next(0, cur)) return;
    f32x4 acc[2][2][4][2];
#pragma unroll
    for (int a = 0; a < 2; ++a)
#pragma unroll
        for (int b = 0; b < 2; ++b)
#pragma unroll
            for (int m = 0; m < 4; ++m)
#pragma unroll
                for (int n = 0; n < 2; ++n) acc[a][b][m][n] = (f32x4){0.f, 0.f, 0.f, 0.f};
    bf16x8 At[4][2], B0[2][2], B1[2][2];
    const char* cA = cur.A; const char* cB = cur.B; unsigned la = cur.lda2, lb = cur.ldb2;
    const size_t kstep = (size_t)(BK * 2);
    PG8_STAGE(PG8_SB(0, 0), cB, Rb0, lb); PG8_STAGE(PG8_SB(0, 1), cB + (size_t)HALF * lb, Rb0, lb); PG8_STAGE(PG8_SA(0, 0), cA, R0, la); PG8_STAGE(PG8_SA(0, 1), cA + (size_t)HALF * la, R0, la);
    if (wr == 1) PG8_BAR;
    PG8_WAIT_V(2); PG8_BAR;
    PG8_STAGE(PG8_SB(1, 0), cB + kstep, Rb0, lb); PG8_STAGE(PG8_SA(1, 0), cA + kstep, R0, la); PG8_STAGE(PG8_SB(1, 1), cB + (size_t)HALF * lb + kstep, Rb0, lb);
    PG8_WAIT_V(6); PG8_BAR;
    for (;;) {
        const bool has_next = S.next(ui + 1, nxt);
        const char* nA = has_next ? nxt.A : cA; const char* nB = has_next ? nxt.B : cB;
        const unsigned nla = has_next ? nxt.lda2 : la, nlb = has_next ? nxt.ldb2 : lb;
        const int nt = cur.nt;
        for (int t = 0; t < nt; t += 2) {
            const bool last = (t == nt - 2);
            const char* a1 = cA + (size_t)(t + 1) * kstep;
            const char* a2 = last ? nA : cA + (size_t)(t + 2) * kstep; const char* b2 = last ? nB : cB + (size_t)(t + 2) * kstep;
            const unsigned la2 = last ? nla : la, lb2 = last ? nlb : lb;
            const char* a3 = a2 + kstep; const char* b3 = b2 + kstep;
            PG8_LDB(B0, 0, 0); PG8_LDB(B1, 0, 1); PG8_SCHED; PG8_LDA(At, 0, 0); PG8_STAGE(PG8_SA(1, 1), a1 + (size_t)HALF * la, R0, la);
            PG8_WAIT_V(8); PG8_WAIT_L(0); PG8_BAR; PG8_MMA(0, 0, At, B0); PG8_MMA(0, 1, At, B1); PG8_BAR; PG8_SCHED;
            PG8_LDA(At, 0, 1); PG8_STAGE(PG8_SB(0, 0), b2, Rb0, lb2); PG8_STAGE(PG8_SB(0, 1), b2 + (size_t)HALF * lb2, Rb0, lb2); PG8_STAGE(PG8_SA(0, 0), a2, R0, la2);
            PG8_WAIT_V(8); PG8_WAIT_L(0); PG8_BAR; PG8_MMA(1, 0, At, B0); PG8_MMA(1, 1, At, B1); PG8_BAR; PG8_SCHED;
            PG8_LDB(B0, 1, 0); PG8_LDB(B1, 1, 1); PG8_SCHED; PG8_LDA(At, 1, 0); PG8_STAGE(PG8_SA(0, 1), a2 + (size_t)HALF * la2, R0, la2);
            PG8_WAIT_V(8); PG8_WAIT_L(0); PG8_BAR; PG8_MMA(0, 0, At, B0); PG8_MMA(0, 1, At, B1); PG8_BAR; PG8_SCHED;
            PG8_LDA(At, 1, 1); PG8_STAGE(PG8_SB(1, 0), b3, Rb0, lb2); PG8_STAGE(PG8_SB(1, 1), b3 + (size_t)HALF * lb2, Rb0, lb2); PG8_STAGE(PG8_SA(1, 0), a3, R0, la2);
            PG8_WAIT_V(8); PG8_WAIT_L(0); PG8_BAR; PG8_MMA(1, 0, At, B0); PG8_MMA(1, 1, At, B1); PG8_BAR; PG8_SCHED;
        }
        if (wr == 0) PG8_BAR;
        const bool keep = E(acc, cur, wr, wc, fr, fq);
        if (!has_next) break;
        if (!keep) {
#pragma unroll
            for (int a = 0; a < 2; ++a)
#pragma unroll
                for (int b = 0; b < 2; ++b)
#pragma unroll
                    for (int m = 0; m < 4; ++m)
#pragma unroll
                        for (int n = 0; n < 2; ++n) acc[a][b][m][n] = (f32x4){0.f, 0.f, 0.f, 0.f};
        }
        cur = nxt; cA = nA; cB = nB; la = nla; lb = nlb; ++ui;
        if (wr == 1) PG8_BAR;
    }
    PG8_WAIT_V(0);
    PG8_BAR;
}
}

struct Args { const float* in[30]; float* out; unsigned char* ws; };
enum { I_XP = 0, I_MEMP, I_XS, I_CLAT, I_CKPE, I_SPOOL, I_CMK, I_CMV, I_GMIX, I_WIN, I_BGATE, I_WPOOL, I_PSCALE, I_GQLAT, I_WQB, I_GQHEAD, I_GKVLAT, I_WKB, I_WVB,
       I_GKHEAD, I_WMLAO, I_GMEM, I_WMEMKV, I_GMEMQ, I_GMEMK, I_WMEMO, I_WOUT, I_GFF, I_WUP, I_WDOWN };

__device__ __forceinline__ void transpose_item(const float* __restrict__ W, int ldw, int K, bf16_t* __restrict__ WT, LAS unsigned char* scr, int kb, int n0src, int nrow_dst, int lane, const float* __restrict__ kscale) {
    const int k0 = 64 * kb, kq = lane >> 4, cq = lane & 15;
    f32x4 v[16];
#pragma unroll
    for (int i = 0; i < 16; ++i) v[i] = __builtin_nontemporal_load((const f32x4*)(W + (size_t)(k0 + 4 * i + kq) * ldw + n0src + cq * 4));
#pragma unroll
    for (int i = 0; i < 16; ++i) { const int kk = 4 * i + kq; f32x4 x = v[i]; if (kscale) x = x * kscale[k0 + kk];
        const int fk = (kk & 2) | ((kk & 8) >> 1);
        *(LAS u32x2*)(scr + kk * 128 + (((cq >> 1) ^ fk) << 4) + (cq & 1) * 8) = (u32x2){cvtpk(x.x, x.y), cvtpk(x.z, x.w)}; }
    LDS_WAIT(); asm volatile("" ::: "memory");
    const int g = lane >> 4, i16 = lane & 15;
#pragma unroll
    for (int s = 0; s < 8; ++s) { const int nb = s >> 1, c = (s & 1) * 4 + g;
        const int ka = 8 * c + (i16 >> 2), kb2 = ka + 4, chunk = 2 * nb + ((i16 & 3) >> 1);
        const int fa = (ka & 2) | ((ka & 8) >> 1), fb = (kb2 & 2) | ((kb2 & 8) >> 1);
        const s16x4 lo = vtr((const LAS char*)scr + ka * 128 + ((chunk ^ fa) << 4) + (i16 & 1) * 8);
        const s16x4 hi = vtr((const LAS char*)scr + kb2 * 128 + ((chunk ^ fb) << 4) + (i16 & 1) * 8);
        *(bf16x8*)(WT + (size_t)(nrow_dst + 16 * nb + i16) * K + k0 + 8 * c) = PKV(lo, hi); }
    LDS_WAIT(); asm volatile("" ::: "memory");
}
__device__ __forceinline__ void rms_row_2048(const float* __restrict__ xrow, const float* __restrict__ g, bf16_t* __restrict__ orow, int lane) {
    const f32x4* xr = (const f32x4*)xrow + lane; const f32x4* gr = (const f32x4*)g + lane;
    f32x4 v[8]; float s = 0.f;
#pragma unroll
    for (int j = 0; j < 8; ++j) { v[j] = __builtin_nontemporal_load(xr + 64 * j); s += (v[j].x * v[j].x + v[j].y * v[j].y) + (v[j].z * v[j].z + v[j].w * v[j].w); }
    const float r = rsqrtf(wave_sum(s) * (1.f / 2048.f) + EPS);
    u32x2* o8 = (u32x2*)orow + lane;
#pragma unroll
    for (int j = 0; j < 8; ++j) { const f32x4 gg = gr[64 * j]; u32x2 w; w.x = cvtpk(v[j].x * r * gg.x, v[j].y * r * gg.y); w.y = cvtpk(v[j].z * r * gg.z, v[j].w * r * gg.w); o8[64 * j] = w; }
}
__device__ __forceinline__ float rope_lane(float w, int lane, float pos) {
    const float partner = __shfl_xor(w, 32);
    float sn, cs; fast_sincos(pos * rope_inv(lane & 31), sn, cs);
    return lane < 32 ? w * cs - partner * sn : w * cs + partner * sn;
}

__device__ __forceinline__ void phase_prep(const Args& P, LAS unsigned char* lds, int gw, int NGW, int wave, int lane) {
    unsigned char* ws = P.ws;
    LAS unsigned char* scr = lds + wave * 16384;
    {
        constexpr int I_IN = 32 * 145, I_MKV = 32 * 32, I_QB = 8 * 48, I_KB = 8 * 32, I_VB = 8 * 32, I_PL = 4 * 4 * 8, I_MLAO = 32 * 32, I_MEMO = 16 * 32, I_OUT = 32 * 32, I_UP = 32 * 128, I_DN = 128 * 32,
                      I_MV = 16 * 4 * 16;
        constexpr int NITEMS = I_IN + I_MKV + I_QB + I_KB + I_VB + I_PL + I_MLAO + I_MEMO + I_OUT + I_UP + I_DN + I_MV;
        for (int it = gw; it < NITEMS; it += NGW) {
            int r = it;
            if (r < I_IN) { const int kb = r / 145, nb = r % 145, n0 = nb * 64; const int nd = n0 < 2048 ? n0 : (n0 < 2112 ? 9216 + (n0 - 2048) : n0 - 64);
                transpose_item(P.in[I_WIN], 9280, 2048, (bf16_t*)(ws + WS_WIN), scr, kb, n0, nd, lane, nullptr); continue; } r -= I_IN;
            if (r < I_MKV) { transpose_item(P.in[I_WMEMKV], 2048, 2048, (bf16_t*)(ws + WS_WMEMKV), scr, r / 32, (r % 32) * 64, (r % 32) * 64, lane, nullptr); continue; } r -= I_MKV;
            if (r < I_QB) { transpose_item(P.in[I_WQB], 3072, 512, (bf16_t*)(ws + WS_WQB), scr, r / 48, (r % 48) * 64, (r % 48) * 64, lane, nullptr); continue; } r -= I_QB;
            if (r < I_KB) { transpose_item(P.in[I_WKB], 2048, 512, (bf16_t*)(ws + WS_WKB), scr, r / 32, (r % 32) * 64, (r % 32) * 64, lane, nullptr); continue; } r -= I_KB;
            if (r < I_VB) { transpose_item(P.in[I_WVB], 2048, 512, (bf16_t*)(ws + WS_WVB), scr, r / 32, (r % 32) * 64, (r % 32) * 64, lane, nullptr); continue; } r -= I_VB;
            if (r < I_PL) { const int g = r / 32, q = r % 32; transpose_item(P.in[I_WPOOL] + (size_t)g * 256 * 512, 512, 256, (bf16_t*)(ws + WS_WPOOL), scr, q / 8, (q % 8) * 64, g * 512 + (q % 8) * 64, lane, nullptr); continue; } r -= I_PL;
            if (r < I_MLAO) { transpose_item(P.in[I_WMLAO], 2048, 2048, (bf16_t*)(ws + WS_WMLAO), scr, r / 32, (r % 32) * 64, (r % 32) * 64, lane, nullptr); continue; } r -= I_MLAO;
            if (r < I_MEMO) { transpose_item(P.in[I_WMEMO], 2048, 1024, (bf16_t*)(ws + WS_WMEMO), scr, r / 32, (r % 32) * 64, (r % 32) * 64, lane, nullptr); continue; } r -= I_MEMO;
            if (r < I_OUT) { transpose_item(P.in[I_WOUT], 2048, 2048, (bf16_t*)(ws + WS_WOUT), scr, r / 32, (r % 32) * 64, (r % 32) * 64, lane, nullptr); continue; } r -= I_OUT;
            if (r < I_UP) { transpose_item(P.in[I_WUP], 8192, 2048, (bf16_t*)(ws + WS_WUP), scr, r / 128, (r % 128) * 64, (r % 128) * 64, lane, P.in[I_GFF]); continue; } r -= I_UP;
            if (r < I_DN) { transpose_item(P.in[I_WDOWN], 2048, 8192, (bf16_t*)(ws + WS_WDOWN), scr, r / 32, (r % 32) * 64, (r % 32) * 64, lane, nullptr); continue; } r -= I_DN;
            { const int b = r / 64, q = r % 64;
              transpose_item(P.in[I_CMV] + (size_t)b * 262144, 1024, 256, (bf16_t*)(ws + WS_MVT) + (size_t)(2 + b) * 262144, scr, q / 16, (q % 16) * 64, (q % 16) * 64, lane, nullptr); }
        }
    }
    for (int m = gw; m < TT + 512; m += NGW) {
        if (m < TP) rms_row_2048(P.in[I_XP] + (size_t)m * DM, P.in[I_GMIX], (bf16_t*)(ws + WS_H) + (size_t)m * DM, lane);
        else if (m < TT) rms_row_2048(P.in[I_XS] + (size_t)(m - TP) * DM, P.in[I_GMIX], (bf16_t*)(ws + WS_H) + (size_t)m * DM, lane);
        else rms_row_2048(P.in[I_MEMP] + (size_t)(m - TT) * DM, P.in[I_GMEM], (bf16_t*)(ws + WS_HM) + (size_t)(m - TT) * DM, lane);
    }
    {
        bf16_t* KRs = (bf16_t*)(ws + WS_KRS); float* KPESS = (float*)(ws + WS_KPESS); bf16_t* LATs = (bf16_t*)(ws + WS_LATS);
        const float gk = P.in[I_GKHEAD][128 + lane];
        const float inv = rope_inv(lane & 31);
        for (int pos = gw; pos < 4096; pos += NGW) {
            float sn, cs; fast_sincos((float)pos * inv, sn, cs);
            float v[NBS];
#pragma unroll
            for (int b = 0; b < NBS; ++b) v[b] = __builtin_nontemporal_load(P.in[I_CKPE] + ((size_t)b * 4096 + pos) * 64 + lane);
#pragma unroll
            for (int b = 0; b < NBS; ++b) { const float ss = wave_sum(v[b] * v[b]); const float w = v[b] * gk, pr = __shfl_xor(w, 32);
                const float o = lane < 32 ? w * cs - pr * sn : w * cs + pr * sn;
                const size_t kidx = (size_t)b * KPAD + pos; KRs[kidx * 64 + lane] = f2bf(o); if (lane == 0) KPESS[kidx] = ss; } }
        for (int rr = gw; rr < NBS * 32; rr += NGW) { const size_t kidx = (size_t)(rr >> 5) * KPAD + 4128 + (rr & 31);
            KRs[kidx * 64 + lane] = 0; if (lane == 0) KPESS[kidx] = 0.f;
            *(u32x4*)(LATs + kidx * 512 + lane * 8) = (u32x4){0u, 0u, 0u, 0u}; }
    }
    {
        const long tid_g = (long)gw * 64 + lane, NT_G = (long)NGW * 64;
        bf16_t* LATs = (bf16_t*)(ws + WS_LATS);
        for (long i0 = tid_g; i0 < (long)NBS * 4096 * 64; i0 += 4 * NT_G) {
            f32x4 a[4], c[4];
#pragma unroll
            for (int q = 0; q < 4; ++q) { long i = i0 + q * NT_G; if (i >= (long)NBS * 4096 * 64) i = i0; a[q] = __builtin_nontemporal_load((const f32x4*)(P.in[I_CLAT] + i * 8)); c[q] = __builtin_nontemporal_load((const f32x4*)(P.in[I_CLAT] + i * 8 + 4)); }
#pragma unroll
            for (int q = 0; q < 4; ++q) { long i = i0 + q * NT_G; if (i >= (long)NBS * 4096 * 64) i = i0; const long b = i >> 18, rem = i & 262143;
                *(u32x4*)(LATs + (size_t)b * KPAD * 512 + rem * 8) = (u32x4){cvtpk(a[q].x, a[q].y), cvtpk(a[q].z, a[q].w), cvtpk(c[q].x, c[q].y), cvtpk(c[q].z, c[q].w)}; } }
        bf16_t* MKs = (bf16_t*)(ws + WS_MK) + (size_t)2 * 262144;
        for (long i0 = tid_g; i0 < (long)NBS * 262144 / 8; i0 += 4 * NT_G) {
            f32x4 a[4], c[4];
#pragma unroll
            for (int q = 0; q < 4; ++q) { long i = i0 + q * NT_G; if (i >= (long)NBS * 262144 / 8) i = i0; a[q] = __builtin_nontemporal_load((const f32x4*)(P.in[I_CMK] + i * 8)); c[q] = __builtin_nontemporal_load((const f32x4*)(P.in[I_CMK] + i * 8 + 4)); }
#pragma unroll
            for (int q = 0; q < 4; ++q) { long i = i0 + q * NT_G; if (i >= (long)NBS * 262144 / 8) i = i0;
                *(u32x4*)(MKs + i * 8) = (u32x4){cvtpk(a[q].x, a[q].y), cvtpk(a[q].z, a[q].w), cvtpk(c[q].x, c[q].y), cvtpk(c[q].z, c[q].w)}; } }
        bf16_t* WKN = (bf16_t*)(ws + WS_WKBN);
        for (long i = tid_g; i < 512L * 2048 / 8; i += NT_G) {
            const f32x4 a = *(const f32x4*)(P.in[I_WKB] + i * 8), c = *(const f32x4*)(P.in[I_WKB] + i * 8 + 4);
            *(u32x4*)(WKN + i * 8) = (u32x4){cvtpk(a.x, a.y), cvtpk(a.z, a.w), cvtpk(c.x, c.y), cvtpk(c.z, c.w)}; }
    }
}

struct EpiIn {
    static constexpr bool PERM = true;
    bf16_t* ZS; bf16_t* G; float* M; const float* bgate;
    __device__ __forceinline__ bool operator()(f32x4 (&acc)[2][2][4][2], const pg8::Unit& u, int wr, int wc, int fr_, int fq) const {
        int fr = fr_; asm volatile("" : "+v"(fr));
        const int row0 = u.pm * 256 + wr * 64 + fr, ct = wc * 32 + 8 * fq;
        if (u.kind == 1) {
#pragma unroll
            for (int ai = 0; ai < 2; ++ai)
#pragma unroll
                for (int m = 0; m < 4; ++m) { float* rp = M + (size_t)(row0 + ai * 128 + m * 16) * 2048 + u.pn * 256 + ct;
#pragma unroll
                    for (int bj = 0; bj < 2; ++bj) { *(f32x4*)(rp + bj * 128) = acc[ai][bj][m][0]; *(f32x4*)(rp + bj * 128 + 4) = acc[ai][bj][m][1]; } }
            return false;
        }
        const int pn = u.pn;
        if (pn >= 12 && pn < 36) {
            const int gc = (pn - 12) * 256 + ct;
            f32x4 bv[2][2];
#pragma unroll
            for (int bj = 0; bj < 2; ++bj) { bv[bj][0] = *(const f32x4*)(bgate + gc + bj * 128); bv[bj][1] = *(const f32x4*)(bgate + gc + bj * 128 + 4); }
#pragma unroll
            for (int ai = 0; ai < 2; ++ai)
#pragma unroll
                for (int m = 0; m < 4; ++m) { bf16_t* rp = G + (size_t)(row0 + ai * 128 + m * 16) * G_LD + gc;
#pragma unroll
                    for (int bj = 0; bj < 2; ++bj) { f32x4 v0 = acc[ai][bj][m][0] + bv[bj][0], v1 = acc[ai][bj][m][1] + bv[bj][1];
#pragma unroll
                        for (int e = 0; e < 4; ++e) { v0[e] = __builtin_amdgcn_rcpf(1.f + __builtin_amdgcn_exp2f(-1.4426950408889634f * v0[e])); v1[e] = __builtin_amdgcn_rcpf(1.f + __builtin_amdgcn_exp2f(-1.4426950408889634f * v1[e])); }
                        __builtin_nontemporal_store((u32x4){cvtpk(v0[0], v0[1]), cvtpk(v0[2], v0[3]), cvtpk(v1[0], v1[1]), cvtpk(v1[2], v1[3])}, (u32x4*)(rp + bj * 128)); } }
            return false;
        }
        const int zc = (pn < 12 ? pn * 256 : 3072) + ct;
#pragma unroll
        for (int ai = 0; ai < 2; ++ai)
#pragma unroll
            for (int m = 0; m < 4; ++m) { bf16_t* rp = ZS + (size_t)(row0 + ai * 128 + m * 16) * ZS_LD + zc;
#pragma unroll
                for (int bj = 0; bj < 2; ++bj) { if (pn == 36 && (bj == 1 || wc >= 2)) continue;
                    const f32x4 v0 = acc[ai][bj][m][0], v1 = acc[ai][bj][m][1];
                    *(u32x4*)(rp + bj * 128) = (u32x4){cvtpk(v0[0], v0[1]), cvtpk(v0[2], v0[3]), cvtpk(v1[0], v1[1]), cvtpk(v1[2], v1[3])}; } }
        return false;
    }
};

__device__ __forceinline__ void unpack8(const u32x4 w, float (&f)[8]) { f[0] = bflo(w.x); f[1] = bfhi(w.x); f[2] = bflo(w.y); f[3] = bfhi(w.y); f[4] = bflo(w.z); f[5] = bfhi(w.z); f[6] = bflo(w.w); f[7] = bfhi(w.w); }
__device__ __forceinline__ u32x4 pack8(const float (&f)[8]) { return (u32x4){cvtpk(f[0], f[1]), cvtpk(f[2], f[3]), cvtpk(f[4], f[5]), cvtpk(f[6], f[7])}; }

__device__ __forceinline__ void phase_rows(const Args& P, LAS unsigned char* lds, int gw, int NGW, int wave, int lane) {
    unsigned char* ws = P.ws; float* out = P.out;
    const bf16_t* ZS = (const bf16_t*)(ws + WS_ZS);
    const f32x4 gkv0 = *(const f32x4*)(P.in[I_GKVLAT] + lane * 8), gkv1 = *(const f32x4*)(P.in[I_GKVLAT] + lane * 8 + 4);
    const f32x4 gql0 = *(const f32x4*)(P.in[I_GQLAT] + lane * 8), gql1 = *(const f32x4*)(P.in[I_GQLAT] + lane * 8 + 4);
    const f32x4 gmq = *(const f32x4*)(P.in[I_GMEMQ] + lane * 4);
    const float gkr = P.in[I_GKHEAD][128 + lane];
    for (int t = gw; t < TT; t += NGW) {
        const bool prm = t < TP; const int b = prm ? (t >> 12) : ((t - TP) >> 5), li = prm ? (t & 4095) : ((t - TP) & 31), pos = prm ? li : 4096 + li;
        const bf16_t* z = ZS + (size_t)t * ZS_LD;
        const int ca = lane * 8, cb = 512 + lane * 8, wa = lane < 32 ? 2 : 4, wb = lane < 32 ? 8 : 16;
        const u32x4 kvw = *(const u32x4*)(z + 1536 + lane * 8), qlw = *(const u32x4*)(z + 1024 + lane * 8), uaw = *(const u32x4*)(z + ca), ubw = *(const u32x4*)(z + cb);
        const bf16_t kpw = z[3072 + lane];
        u32x2 mqw[4];
#pragma unroll
        for (int h = 0; h < 4; ++h) mqw[h] = *(const u32x2*)(z + 2048 + h * 256 + lane * 4);
        u32x4 ra[3], rb[15];
        if (prm) {
#pragma unroll
            for (int k = 1; k < 4; ++k) ra[k - 1] = *(const u32x4*)(z - (size_t)(k <= li ? k : 0) * ZS_LD + ca);
#pragma unroll
            for (int k = 1; k < 16; ++k) rb[k - 1] = *(const u32x4*)(z - (size_t)(k <= li ? k : 0) * ZS_LD + cb);
        }
        asm volatile("" ::: "memory");
        { float v[8]; unpack8(kvw, v); float s = 0.f;
#pragma unroll
          for (int j = 0; j < 8; ++j) s += v[j] * v[j];
          const float r = rsqrtf(wave_sum(s) * (1.f / 512.f) + EPS);
          v[0] *= r * gkv0.x; v[1] *= r * gkv0.y; v[2] *= r * gkv0.z; v[3] *= r * gkv0.w; v[4] *= r * gkv1.x; v[5] *= r * gkv1.y; v[6] *= r * gkv1.z; v[7] *= r * gkv1.w;
          float* lo = prm ? out + O_LATP + (size_t)t * 512 : out + O_LATS + (size_t)(t - TP) * 512;
          *(f32x4*)(lo + lane * 8) = (f32x4){v[0], v[1], v[2], v[3]}; *(f32x4*)(lo + lane * 8 + 4) = (f32x4){v[4], v[5], v[6], v[7]};
          bf16_t* dst = prm ? (bf16_t*)((unsigned char*)out + DO_CKVP) + (size_t)t * 512 : (bf16_t*)(ws + WS_LATS) + ((size_t)b * KPAD + 4096 + li) * 512;
          *(u32x4*)(dst + lane * 8) = pack8(v); }
        { const float v = bf2f(kpw);
          (prm ? out + O_KPEP + (size_t)t * 64 : out + O_KPES + (size_t)(t - TP) * 64)[lane] = v;
          const float ss = wave_sum(v * v); const float o = rope_lane(v * gkr, lane, (float)pos);
          if (prm) { ((bf16_t*)(ws + WS_KRP))[(size_t)t * 64 + lane] = f2bf(o); if (lane == 0) ((float*)(ws + WS_KPESSP))[t] = ss; }
          else { const size_t kidx = (size_t)b * KPAD + 4096 + li; ((bf16_t*)(ws + WS_KRS))[kidx * 64 + lane] = f2bf(o); if (lane == 0) ((float*)(ws + WS_KPESS))[kidx] = ss; } }
        { float v[8]; unpack8(qlw, v); float s = 0.f;
#pragma unroll
          for (int j = 0; j < 8; ++j) s += v[j] * v[j];
          const float r = rsqrtf(wave_sum(s) * (1.f / 512.f) + EPS);
          v[0] *= r * gql0.x; v[1] *= r * gql0.y; v[2] *= r * gql0.z; v[3] *= r * gql0.w; v[4] *= r * gql1.x; v[5] *= r * gql1.y; v[6] *= r * gql1.z; v[7] *= r * gql1.w;
          *(u32x4*)((bf16_t*)(ws + WS_QN) + (size_t)t * 512 + lane * 8) = pack8(v); }
#pragma unroll
        for (int h = 0; h < 4; ++h) { const u32x2 w = mqw[h];
            const float a0 = bflo(w.x), a1 = bfhi(w.x), a2 = bflo(w.y), a3 = bfhi(w.y);
            const float r = rsqrtf(wave_sum((a0 * a0 + a1 * a1) + (a2 * a2 + a3 * a3)) * (1.f / 256.f) + EPS) * MEM_C;
            *(u32x2*)((bf16_t*)(ws + WS_QM) + (size_t)t * 1024 + h * 256 + lane * 4) = (u32x2){cvtpk(a0 * r * gmq.x, a1 * r * gmq.y), cvtpk(a2 * r * gmq.z, a3 * r * gmq.w)}; }
        { float sa[8], sb[8], ua[8], ub[8];
          unpack8(uaw, ua); unpack8(ubw, ub);
#pragma unroll
          for (int j = 0; j < 8; ++j) { sa[j] = ua[j]; sb[j] = ub[j]; }
          if (prm) {
#pragma unroll
              for (int k = 1; k < 4; ++k) { float tmp[8]; unpack8(ra[k - 1], tmp); const float w = (k <= li && k < wa) ? 1.f : 0.f;
#pragma unroll
                  for (int j = 0; j < 8; ++j) sa[j] += w * tmp[j]; }
#pragma unroll
              for (int k = 1; k < 16; ++k) { float tmp[8]; unpack8(rb[k - 1], tmp); const float w = (k <= li && k < wb) ? 1.f : 0.f;
#pragma unroll
                  for (int j = 0; j < 8; ++j) sb[j] += w * tmp[j]; }
          } else
          for (int k = 1; k < 16; ++k) {
              if (k <= li) { const bf16_t* zk = z - (size_t)k * ZS_LD; float tmp[8];
                  if (k < wa) { unpack8(*(const u32x4*)(zk + ca), tmp);
#pragma unroll
                      for (int j = 0; j < 8; ++j) sa[j] += tmp[j]; }
                  if (k < wb) { unpack8(*(const u32x4*)(zk + cb), tmp);
#pragma unroll
                      for (int j = 0; j < 8; ++j) sb[j] += tmp[j]; } }
              else { const float* sp = P.in[I_SPOOL] + ((size_t)b * 15 + (15 + li - k)) * 1024;
                  if (k < wa) { const f32x4 p0 = *(const f32x4*)(sp + ca), p1 = *(const f32x4*)(sp + ca + 4); sa[0] += p0.x; sa[1] += p0.y; sa[2] += p0.z; sa[3] += p0.w; sa[4] += p1.x; sa[5] += p1.y; sa[6] += p1.z; sa[7] += p1.w; }
                  if (k < wb) { const f32x4 p0 = *(const f32x4*)(sp + cb), p1 = *(const f32x4*)(sp + cb + 4); sb[0] += p0.x; sb[1] += p0.y; sb[2] += p0.z; sb[3] += p0.w; sb[4] += p1.x; sb[5] += p1.y; sb[6] += p1.z; sb[7] += p1.w; } }
          }
          const float ia = 1.f / (float)(pos + 1 < wa ? pos + 1 : wa), ib = 1.f / (float)(pos + 1 < wb ? pos + 1 : wb);
#pragma unroll
          for (int j = 0; j < 8; ++j) { sa[j] = sa[j] * ia - ua[j]; sb[j] = sb[j] * ib - ub[j]; }
          bf16_t* dp = (bf16_t*)(ws + WS_DP) + (size_t)t * 1024;
          *(u32x4*)(dp + ca) = pack8(sa); *(u32x4*)(dp + cb) = pack8(sb);
          const int last0 = prm ? 4081 : 17;
          if (li >= last0) { float* po = (prm ? out + O_POOLP : out + O_POOLS) + ((size_t)b * 15 + (li - last0)) * 1024;
              *(f32x4*)(po + ca) = (f32x4){ua[0], ua[1], ua[2], ua[3]}; *(f32x4*)(po + ca + 4) = (f32x4){ua[4], ua[5], ua[6], ua[7]};
              *(f32x4*)(po + cb) = (f32x4){ub[0], ub[1], ub[2], ub[3]}; *(f32x4*)(po + cb + 4) = (f32x4){ub[4], ub[5], ub[6], ub[7]}; } }
    }
    for (int m = gw; m < 512; m += NGW) {
        const float* mr = (const float*)(ws + WS_M) + (size_t)m * 2048; const f32x4 g = *(const f32x4*)(P.in[I_GMEMK] + lane * 4);
#pragma unroll
        for (int h = 0; h < 4; ++h) { f32x4 v = *(const f32x4*)(mr + h * 256 + lane * 4);
            const float r = rsqrtf(wave_sum((v.x * v.x + v.y * v.y) + (v.z * v.z + v.w * v.w)) * (1.f / 256.f) + EPS);
            v.x *= r * g.x; v.y *= r * g.y; v.z *= r * g.z; v.w *= r * g.w;
            *(f32x4*)(out + O_MEMK + (size_t)m * 1024 + h * 256 + lane * 4) = v;
            *(u32x2*)((bf16_t*)(ws + WS_MK) + (size_t)m * 1024 + h * 256 + lane * 4) = (u32x2){cvtpk(v.x, v.y), cvtpk(v.z, v.w)};
            *(f32x4*)(out + O_MEMV + (size_t)m * 1024 + h * 256 + lane * 4) = *(const f32x4*)(mr + 1024 + h * 256 + lane * 4); }
    }
    { LAS unsigned char* scr = lds + wave * 16384;
      for (int it = gw; it < 2 * 64; it += NGW) { const int b = it / 64, q = it % 64;
          transpose_item((const float*)(ws + WS_M) + (size_t)b * 256 * 2048 + 1024, 2048, 256, (bf16_t*)(ws + WS_MVT) + (size_t)b * 262144, scr, q / 16, (q % 16) * 64, (q % 16) * 64, lane, nullptr); } }
}

struct EpiQKV {
    static constexpr bool PERM = true;
    bf16_t* Q; bf16_t* K; bf16_t* V; float* RKG; bf16_t* PM; float* PS; const float* KPESS; const float* KPESSP; const bf16_t* KRP; const float* gk; LAS unsigned char* lds;
    __device__ __forceinline__ void half_sumsq(const f32x4 (&acc)[2][2][4][2], float (&tot)[2][4][2], int wr, int wc, int fr, int fq) const {
        LAS float* part = (LAS float*)(lds + 131072);
#pragma unroll
        for (int ai = 0; ai < 2; ++ai)
#pragma unroll
            for (int m = 0; m < 4; ++m)
#pragma unroll
                for (int bj = 0; bj < 2; ++bj) { const f32x4 a = acc[ai][bj][m][0], b = acc[ai][bj][m][1];
                    float s = ((a.x * a.x + a.y * a.y) + (a.z * a.z + a.w * a.w)) + ((b.x * b.x + b.y * b.y) + (b.z * b.z + b.w * b.w));
                    s += __shfl_xor(s, 16); s += __shfl_xor(s, 32);
                    if (fq == 0) part[((ai * 128 + wr * 64 + m * 16 + fr) * 2 + bj) * 4 + wc] = s; }
        asm volatile("s_waitcnt lgkmcnt(0)" ::: "memory"); __builtin_amdgcn_s_barrier(); asm volatile("" ::: "memory");
#pragma unroll
        for (int ai = 0; ai < 2; ++ai)
#pragma unroll
            for (int m = 0; m < 4; ++m)
#pragma unroll
                for (int bj = 0; bj < 2; ++bj) { const f32x4 p4 = *(const LAS f32x4*)(part + ((ai * 128 + wr * 64 + m * 16 + fr) * 2 + bj) * 4); tot[ai][m][bj] = (p4.x + p4.y) + (p4.z + p4.w); }
    }
    __device__ __forceinline__ bool operator()(f32x4 (&acc)[2][2][4][2], const pg8::Unit& u, int wr, int wc, int fr_, int fq) const {
        int fr = fr_; asm volatile("" : "+v"(fr));
        const int row0 = u.pm * 256 + wr * 64 + fr, ct = wc * 32 + 8 * fq;
        if (u.kind == 3) {
            float tot[2][4][2]; half_sumsq(acc, tot, wr, wc, fr, fq);
            if (wc == 0 && fq == 0) {
#pragma unroll
                for (int ai = 0; ai < 2; ++ai)
#pragma unroll
                    for (int m = 0; m < 4; ++m) { const size_t row = (size_t)(row0 + ai * 128 + m * 16); const float kp = KPESS[row];
#pragma unroll
                        for (int bj = 0; bj < 2; ++bj) RKG[row * 16 + u.pn * 2 + bj] = rsqrtf((tot[ai][m][bj] + kp) * (1.f / 192.f) + EPS) * MLA_C; } }
            return false;
        }
        if (u.kind == 1) {
            float tot[2][4][2]; half_sumsq(acc, tot, wr, wc, fr, fq);
            const f32x4 g0 = *(const f32x4*)(gk + ct), g1 = *(const f32x4*)(gk + ct + 4);
#pragma unroll
            for (int ai = 0; ai < 2; ++ai) {
                float kp[4]; u32x2 kr[4];
#pragma unroll
                for (int m = 0; m < 4; ++m) { const size_t row = (size_t)(row0 + ai * 128 + m * 16); kp[m] = KPESSP[row]; kr[m] = *(const u32x2*)(KRP + row * 64 + wc * 16 + fq * 4); }
                asm volatile("" ::: "memory");
#pragma unroll
                for (int m = 0; m < 4; ++m) { bf16_t* rp = K + (size_t)(row0 + ai * 128 + m * 16) * QLD;
#pragma unroll
                    for (int bj = 0; bj < 2; ++bj) { const float rk = rsqrtf((tot[ai][m][bj] + kp[m]) * (1.f / 192.f) + EPS);
                        const f32x4 v0 = acc[ai][bj][m][0] * rk * g0, v1 = acc[ai][bj][m][1] * rk * g1; bf16_t* hp = rp + (u.pn * 2 + bj) * 192;
                        *(u32x4*)(hp + ct) = (u32x4){cvtpk(v0[0], v0[1]), cvtpk(v0[2], v0[3]), cvtpk(v1[0], v1[1]), cvtpk(v1[2], v1[3])};
                        *(u32x2*)(hp + 128 + wc * 16 + fq * 4) = (u32x2){cvtpk(bflo(kr[m].x) * rk, bfhi(kr[m].x) * rk), cvtpk(bflo(kr[m].y) * rk, bfhi(kr[m].y) * rk)}; } }
            }
            return false;
        }
        if (u.kind >= 4) {
            const int cc = u.pn * 256 + ct;
#pragma unroll
            for (int ai = 0; ai < 2; ++ai)
#pragma unroll
                for (int m = 0; m < 4; ++m) { const int rl = ai * 128 + wr * 64 + m * 16 + fr; const size_t row = (size_t)(u.pm + rl); float s = 0.f;
#pragma unroll
                    for (int bj = 0; bj < 2; ++bj) { f32x4 v0 = acc[ai][bj][m][0], v1 = acc[ai][bj][m][1];
#pragma unroll
                        for (int e = 0; e < 4; ++e) { v0[e] = __builtin_amdgcn_exp2f(v0[e]); v1[e] = __builtin_amdgcn_exp2f(v1[e]); }
                        s += ((v0[0] + v0[1]) + (v0[2] + v0[3])) + ((v1[0] + v1[1]) + (v1[2] + v1[3]));
                        if (u.kind == 4 || rl < 32) *(u32x4*)(PM + row * 1024 + cc + bj * 128) = (u32x4){cvtpk(v0[0], v0[1]), cvtpk(v0[2], v0[3]), cvtpk(v1[0], v1[1]), cvtpk(v1[2], v1[3])}; }
                    s += __shfl_xor(s, 16); s += __shfl_xor(s, 32);
                    if (fq == 0 && (u.kind == 4 || rl < 32)) PS[row * 16 + u.pn * 4 + wc] = s; }
            return false;
        }
        bf16_t* base; int ld;
        if (u.kind == 0) { base = Q; ld = QLD; } else { base = V; ld = 2048; }
        const int c0 = u.pn * 256 + ct;
#pragma unroll
        for (int ai = 0; ai < 2; ++ai)
#pragma unroll
            for (int m = 0; m < 4; ++m) { bf16_t* rp = base + (size_t)(row0 + ai * 128 + m * 16) * ld;
#pragma unroll
                for (int bj = 0; bj < 2; ++bj) { const f32x4 v0 = acc[ai][bj][m][0], v1 = acc[ai][bj][m][1];
                    *(u32x4*)(rp + c0 + bj * 128) = (u32x4){cvtpk(v0[0], v0[1]), cvtpk(v0[2], v0[3]), cvtpk(v1[0], v1[1]), cvtpk(v1[2], v1[3])}; } }
        return false;
    }
};

#define SWZF(row) ((((((row) & 2) << 1) | (((row) >> 2) & 3))) << 4)
__device__ __forceinline__ void partialSM(f32x16& p0, f32x16& p1, float& m_reg, float& mn, float& alpha, const float C) {
    float pmax = p0[0];
#pragma unroll
    for (int r = 1; r < 16; ++r) pmax = fmaxf(pmax, p0[r]);
#pragma unroll
    for (int r = 0; r < 16; ++r) pmax = fmaxf(pmax, p1[r]);
    { auto rr = __builtin_amdgcn_permlane32_swap(__float_as_uint(pmax), __float_as_uint(pmax), false, false);
      pmax = fmaxf(__uint_as_float(rr[0]), __uint_as_float(rr[1])); }
    if (__builtin_expect(__all((pmax - m_reg) * C <= 11.5f), 1)) { mn = m_reg; alpha = 1.f; }
    else { mn = fmaxf(m_reg, pmax); alpha = __builtin_amdgcn_exp2f((m_reg - mn) * C); m_reg = mn; }
    const float mnC = -mn * C;
#pragma unroll
    for (int r = 0; r < 16; ++r) p0[r] = fmaf(p0[r], C, mnC);
#pragma unroll
    for (int r = 0; r < 16; ++r) p1[r] = fmaf(p1[r], C, mnC);
#pragma unroll
    for (int r = 0; r < 16; ++r) p0[r] = __builtin_amdgcn_exp2f(p0[r]);
}
__device__ __forceinline__ void finishSM(f32x16& p0, f32x16& p1, float alpha, float& l_reg, bf16x8& pa0, bf16x8& pa1, bf16x8& pa2, bf16x8& pa3) {
#pragma unroll
    for (int r = 0; r < 16; ++r) p1[r] = __builtin_amdgcn_exp2f(p1[r]);
    float ps = 0;
#pragma unroll
    for (int r = 0; r < 16; ++r) ps += p0[r];
#pragma unroll
    for (int r = 0; r < 16; ++r) ps += p1[r];
    { auto rr = __builtin_amdgcn_permlane32_swap(__float_as_uint(ps), __float_as_uint(ps), false, false);
      ps = __uint_as_float(rr[0]) + __uint_as_float(rr[1]); }
    l_reg = l_reg * alpha + ps;
#define PK4(P, BASE, OUT) do { unsigned a0 = cvtpk(P[BASE + 0], P[BASE + 1]), a1 = cvtpk(P[BASE + 2], P[BASE + 3]);   \
    unsigned b0 = cvtpk(P[BASE + 4], P[BASE + 5]), b1 = cvtpk(P[BASE + 6], P[BASE + 7]);                              \
    auto r0 = __builtin_amdgcn_permlane32_swap(a0, b0, false, false); auto r1 = __builtin_amdgcn_permlane32_swap(a1, b1, false, false); \
    u32x4 w = {r0[0], r1[0], r0[1], r1[1]}; OUT = __builtin_bit_cast(bf16x8, w); } while (0)
    PK4(p0, 0, pa0); PK4(p0, 8, pa1); PK4(p1, 0, pa2); PK4(p1, 8, pa3);
#undef PK4
}

namespace pat {
constexpr int LDQ = 3072, LDK = 3072, LDV = 2048, LDO = 2048;
constexpr int SHM_V = 16384, SHM_K = 24576, OFF_WS = 3 * SHM_K + 3 * SHM_V, OFF_QR = OFF_WS + 2048;
#define KSW(row, colB) ((row) * 384 + ((colB) ^ SWZF(row)))
#define DSR128(dst, addr, OFF) asm volatile("ds_read_b128 %0, %1 offset:%2" : "=v"(dst) : "v"(addr), "i"(OFF) : "memory")
#define WAITK4(N, F) asm volatile("s_waitcnt lgkmcnt(" #N ")" : "+v"(F[0]), "+v"(F[1]), "+v"(F[2]), "+v"(F[3]) :: "memory")
#define WAITK6(N, F, Q) asm volatile("s_waitcnt lgkmcnt(" #N ")" : "+v"(F[0]), "+v"(F[1]), "+v"(F[2]), "+v"(F[3]), "+v"(Q[0]), "+v"(Q[1]) :: "memory")
__device__ __forceinline__ void qkt(f32x16& p0, f32x16& p1, int ks, const bf16x8* qr, int qrow, int hi, int qsw, const int (&kbo)[2]) {
    p0 = f32x16{}; p1 = f32x16{};
    bf16x8 fa[4], fb[4], qa[2], qb[2];
    const int k0 = ks + kbo[0] + kbo[1], k1 = ks + kbo[0] + (kbo[1] ^ 32), k2 = ks + kbo[0] + (kbo[1] ^ 64), k3 = ks + kbo[0] + (kbo[1] ^ 96);
    const int q0 = qrow + (((0 + hi) ^ qsw) << 4), q1 = qrow + (((2 + hi) ^ qsw) << 4), q2 = qrow + (((4 + hi) ^ qsw) << 4), q3 = qrow + (((6 + hi) ^ qsw) << 4);
#define RDK(F, KA, KB, OFF) do { DSR128(F[0], KA, OFF); DSR128(F[1], KA, OFF + 12288); DSR128(F[2], KB, OFF); DSR128(F[3], KB, OFF + 12288); } while (0)
#define MMK(F, QA, QB) do { p0 = __builtin_amdgcn_mfma_f32_32x32x16_bf16(F[0], QA, p0, 0, 0, 0); p1 = __builtin_amdgcn_mfma_f32_32x32x16_bf16(F[1], QA, p1, 0, 0, 0); \
        p0 = __builtin_amdgcn_mfma_f32_32x32x16_bf16(F[2], QB, p0, 0, 0, 0); p1 = __builtin_amdgcn_mfma_f32_32x32x16_bf16(F[3], QB, p1, 0, 0, 0); } while (0)
    RDK(fa, k0, k1, 0);
    RDK(fb, k2, k3, 0);    WAITK4(4, fa); MMK(fa, qr[0], qr[1]);
    RDK(fa, k0, k1, 128);  WAITK4(4, fb); MMK(fb, qr[2], qr[3]);
    RDK(fb, k2, k3, 128);  WAITK4(4, fa); MMK(fa, qr[4], qr[5]);
    RDK(fa, k0, k1, 256); DSR128(qa[0], q0, 0); DSR128(qa[1], q1, 0);  WAITK4(6, fb); MMK(fb, qr[6], qr[7]);
    RDK(fb, k2, k3, 256); DSR128(qb[0], q2, 0); DSR128(qb[1], q3, 0);  WAITK6(6, fa, qa); MMK(fa, qa[0], qa[1]);
    WAITK6(0, fb, qb); MMK(fb, qb[0], qb[1]);
#undef RDK
#undef MMK
}
__device__ __forceinline__ int v_st(int k, int c) { const int kk = (k & ~0xC) | ((k & 4) << 1) | ((k & 8) >> 1); return ((kk >> 3) * 4 + (c >> 5)) * 512 + ((kk & 7) * 32 + (c & 31)) * 2; }
__device__ __forceinline__ int v_rd_base(int lane) { return ((lane & 3) << 3) | (((lane >> 2) & 3) << 6) | (((lane >> 4) & 1) << 5) | (((lane >> 5) & 1) << 8); }
constexpr int v_rd_off(int d0, int ks, int half) { return d0 * 512 + ks * 4096 + half * 2048; }
#define TRR(dst, base, OFF) asm volatile("ds_read_b64_tr_b16 %0, %1 offset:%2" : "=v"(dst) : "v"(base), "i"(OFF) : "memory")
#define WAITV8(N, L, H) asm volatile("s_waitcnt lgkmcnt(" #N ")" : "+v"(L[0]), "+v"(L[1]), "+v"(L[2]), "+v"(L[3]), "+v"(H[0]), "+v"(H[1]), "+v"(H[2]), "+v"(H[3]) :: "memory")
__device__ __forceinline__ void pv_d0(f32x16* o, int vb, bf16x8 pa0, bf16x8 pa1, bf16x8 pa2, bf16x8 pa3) {
    s16x4 la[4], ha[4], lb[4], hb[4];
#define RDV(L, H, D0) do { TRR(L[0], vb, v_rd_off(D0, 0, 0)); TRR(H[0], vb, v_rd_off(D0, 0, 1)); TRR(L[1], vb, v_rd_off(D0, 1, 0)); TRR(H[1], vb, v_rd_off(D0, 1, 1)); \
        TRR(L[2], vb, v_rd_off(D0, 2, 0)); TRR(H[2], vb, v_rd_off(D0, 2, 1)); TRR(L[3], vb, v_rd_off(D0, 3, 0)); TRR(H[3], vb, v_rd_off(D0, 3, 1)); } while (0)
#define MMV(L, H, D0) do { o[D0] = __builtin_amdgcn_mfma_f32_32x32x16_bf16(pa0, PKV(L[0], H[0]), o[D0], 0, 0, 0); o[D0] = __builtin_amdgcn_mfma_f32_32x32x16_bf16(pa1, PKV(L[1], H[1]), o[D0], 0, 0, 0); \
        o[D0] = __builtin_amdgcn_mfma_f32_32x32x16_bf16(pa2, PKV(L[2], H[2]), o[D0], 0, 0, 0); o[D0] = __builtin_amdgcn_mfma_f32_32x32x16_bf16(pa3, PKV(L[3], H[3]), o[D0], 0, 0, 0); } while (0)
    RDV(la, ha, 0);
    RDV(lb, hb, 1); WAITV8(8, la, ha); MMV(la, ha, 0);
    RDV(la, ha, 2); WAITV8(8, lb, hb); MMV(lb, hb, 1);
    RDV(lb, hb, 3); WAITV8(8, la, ha); MMV(la, ha, 2);
    WAITV8(0, lb, hb); MMV(lb, hb, 3);
#undef RDV
#undef MMV
}
__device__ __forceinline__ void unit(const bf16_t* __restrict__ Qb, const bf16_t* __restrict__ Kh, const bf16_t* __restrict__ Vh, bf16_t* __restrict__ Ob, int qb, LAS char* lds, const float* __restrict__ gq, int wv) {
    constexpr float C = MLA_C;
    int wvl = wv; asm volatile("" : "+s"(wvl)); int tid = wvl * 64 + lane_id(); asm volatile("" : "+v"(tid));
    const int wid = __builtin_amdgcn_readfirstlane(tid >> 6), lane = tid & 63, r32 = lane & 31, hi = lane >> 5;
    LAS char* K_lds = lds; LAS char* V_lds = lds + 3 * SHM_K;
    LAS float* wsf = (LAS float*)(lds + OFF_WS) + wid * 64; LAS float* li_l = wsf; LAS float* al_l = wsf + 32;
    LAS char* qlds = lds + OFF_QR + (wid * 32 + r32) * 128; const int qsw = r32 & 7; const int qrow = (int)(uintptr_t)qlds, klds = (int)(uintptr_t)K_lds;
    const int kbo[2] = {r32 * 384, (16 * hi) ^ SWZF(r32)};
    float m_reg = -1e30f, l_reg = 0; f32x16 o[4] = {}; bf16x8 qr[8];
    const bf16_t* Qw = Qb + (size_t)(wid * 32 + r32) * LDQ + hi * 8;
    {
        float ss = 0.f;
#pragma unroll
        for (int d0 = 0; d0 < 12; ++d0) { float t8[8]; unpack8(*(const u32x4*)(Qw + d0 * 16), t8);
#pragma unroll
            for (int j = 0; j < 8; ++j) ss += t8[j] * t8[j]; }
        ss += __shfl_xor(ss, 32);
        const float r = rsqrtf(ss * (1.f / 192.f) + EPS);
#define QSCALE(F, d0) do { unpack8(*(const u32x4*)(Qw + (d0) * 16), F); const f32x4 g0 = *(const f32x4*)(gq + (d0) * 16 + hi * 8), g1 = *(const f32x4*)(gq + (d0) * 16 + hi * 8 + 4); \
            F[0] *= r * g0.x; F[1] *= r * g0.y; F[2] *= r * g0.z; F[3] *= r * g0.w; F[4] *= r * g1.x; F[5] *= r * g1.y; F[6] *= r * g1.z; F[7] *= r * g1.w; } while (0)
#pragma unroll
        for (int d0 = 0; d0 < 8; ++d0) { float t8[8]; QSCALE(t8, d0); qr[d0] = __builtin_bit_cast(bf16x8, pack8(t8)); }
        const float pos = (float)(qb * 256 + wid * 32 + r32);
#pragma unroll
        for (int dd = 0; dd < 2; ++dd) { float a8[8], b8[8]; QSCALE(a8, 8 + dd); QSCALE(b8, 10 + dd);
#pragma unroll
            for (int j = 0; j < 8; ++j) { float sn, cs; fast_sincos(pos * rope_inv(16 * dd + 8 * hi + j), sn, cs);
                const float x1 = a8[j], x2 = b8[j]; a8[j] = x1 * cs - x2 * sn; b8[j] = x2 * cs + x1 * sn; }
            *(LAS u32x4*)(qlds + (((dd * 2 + hi) ^ qsw) << 4)) = pack8(a8); *(LAS u32x4*)(qlds + ((((2 + dd) * 2 + hi) ^ qsw) << 4)) = pack8(b8); }
#undef QSCALE
    }
    asm volatile("s_waitcnt vmcnt(0)" ::: "memory");
    unsigned ksrc[3], vsrc[2];
#pragma unroll
    for (int k = 0; k < 3; ++k) { const int d = (wid + 8 * k) * 1024 + lane * 16, row = d / 384, cs = (d - row * 384) >> 4, c = (cs & ~7) | ((cs & 7) ^ (SWZF(row) >> 4));
        ksrc[k] = (unsigned)(row * LDK + c * 8) * 2u; }
#pragma unroll
    for (int k = 0; k < 2; ++k) { const int d = (wid + 8 * k) * 1024 + lane * 16, sub = d >> 9, win = d & 511, kk = (sub >> 2) * 8 + (win >> 6), col = (sub & 3) * 32 + ((win & 63) >> 1);
        const int key = (kk & ~0xC) | ((kk & 4) << 1) | ((kk & 8) >> 1);
        vsrc[k] = (unsigned)(key * LDV + col) * 2u; }
#define DMA_K(t, slot) do { _Pragma("unroll") for (int k = 0; k < 3; ++k) \
        __builtin_amdgcn_global_load_lds((const unsigned*)((const char*)Kh + (size_t)(t) * (64 * LDK * 2) + ksrc[k]), (LAS unsigned*)(K_lds + (slot) + (wid + 8 * k) * 1024), 16, 0, 0); } while (0)
#define DMA_V(t, slot) do { _Pragma("unroll") for (int k = 0; k < 2; ++k) \
        __builtin_amdgcn_global_load_lds((const unsigned*)((const char*)Vh + (size_t)(t) * (64 * LDV * 2) + vsrc[k]), (LAS unsigned*)(V_lds + (slot) + (wid + 8 * k) * 1024), 16, 0, 0); } while (0)
#define WAITBAR(N) do { asm volatile("s_waitcnt vmcnt(" #N ") lgkmcnt(0)" ::: "memory"); __builtin_amdgcn_s_barrier(); asm volatile("" ::: "memory"); } while (0)
    const int vbase = (int)(uintptr_t)V_lds + v_rd_base(lane);
#define RESC(a) do { if (__any((a) < 1.f)) { if (hi == 0) al_l[r32] = (a); LDS_WAIT(); \
    _Pragma("unroll") for (int d = 0; d < 4; ++d) _Pragma("unroll") for (int r = 0; r < 16; ++r) o[d][r] *= al_l[crow(r, hi)]; } } while (0)
#define MASKT(P0, P1, tix) do { if ((tix) > mylast) { _Pragma("unroll") for (int r = 0; r < 16; ++r) { P0[r] = -1e30f; P1[r] = -1e30f; } } } while (0)
    f32x16 pA0, pA1, pB0, pB1; float mnA, mnB, alA, alB; bf16x8 pa0, pa1, pa2, pa3;
    const int NT = 4 * qb + 4, mylast = 4 * qb + (wid >> 1);
    int kc = 0, kn = SHM_K, kf = 2 * SHM_K, vp = 2 * SHM_V, vc = 0, vf = SHM_V;
#define ROT() do { const int t_ = kc; kc = kn; kn = kf; kf = t_; const int u_ = vp; vp = vc; vc = vf; vf = u_; } while (0)
    DMA_K(0, 0); DMA_V(0, 0); DMA_K(1, SHM_K);
    WAITBAR(5);
    qkt(pA0, pA1, klds + kc, qr, qrow, hi, qsw, kbo); partialSM(pA0, pA1, m_reg, mnA, alA, C);
    DMA_K(2, 2 * SHM_K); DMA_V(1, SHM_V);
    WAITBAR(5);
    ROT();
#define STEP(PC0, PC1, mnC, alC, PP0, PP1, alP, t) do { \
        SBAR(); qkt(PC0, PC1, klds + kc, qr, qrow, hi, qsw, kbo); MASKT(PC0, PC1, t); \
        finishSM(PP0, PP1, alP, l_reg, pa0, pa1, pa2, pa3); SBAR(); \
        if ((t) + 2 < NT) DMA_K((t) + 2, kf); if ((t) + 1 < NT) DMA_V((t) + 1, vf); \
        pv_d0(o, vbase + vp, pa0, pa1, pa2, pa3); partialSM(PC0, PC1, m_reg, mnC, alC, C); \
        RESC(alC); \
        if ((t) + 2 < NT) WAITBAR(5); else if ((t) + 1 < NT) WAITBAR(2); else WAITBAR(0); \
        ROT(); } while (0)
    for (int t = 1; t + 1 < NT; t += 2) {
        STEP(pB0, pB1, mnB, alB, pA0, pA1, alA, t);
        STEP(pA0, pA1, mnA, alA, pB0, pB1, alB, t + 1);
    }
    STEP(pB0, pB1, mnB, alB, pA0, pA1, alA, NT - 1);
    finishSM(pB0, pB1, alB, l_reg, pa0, pa1, pa2, pa3); SBAR();
    pv_d0(o, vbase + vp, pa0, pa1, pa2, pa3);
    if (hi == 0) li_l[r32] = l_reg; LDS_WAIT();
    float rli[16];
#pragma unroll
    for (int r = 0; r < 16; ++r) rli[r] = __builtin_amdgcn_rcpf(li_l[crow(r, hi)]);
    bf16_t* Ow = Ob + (size_t)(wid * 32) * LDO;
#pragma unroll
    for (int r = 0; r < 16; ++r) { const int orow = crow(r, hi);
#pragma unroll
        for (int d0 = 0; d0 < 4; ++d0) Ow[(size_t)orow * LDO + d0 * 32 + r32] = f2bf(o[d0][r] * rli[r]); }
    asm volatile("s_waitcnt lgkmcnt(0)" ::: "memory"); __builtin_amdgcn_s_barrier(); asm volatile("" ::: "memory");
#undef DMA_K
#undef DMA_V
#undef WAITBAR
#undef RESC
#undef MASKT
#undef ROT
#undef STEP
}
}

template <int NB> __device__ __forceinline__ void resc_shfl(f32x16 (&o)[NB], float alpha, int hi) {
    if (__any(alpha < 1.f)) {
#pragma unroll
        for (int r = 0; r < 16; ++r) { const float a = __shfl(alpha, crow(r, hi));
#pragma unroll
            for (int d = 0; d < NB; ++d) o[d][r] *= a; }
    }
}

namespace sat {
constexpr int ROWB = 1152, TKEYS = 64, CT_BYTES = TKEYS * ROWB, BUF_BYTES = CT_BYTES + 1024, NT = 4160 / TKEYS, OLB = 1040;
typedef float f32x4v __attribute__((ext_vector_type(4)));
__device__ __forceinline__ int swz2(int row) { return (((row & 2) << 1) | ((row & 4) >> 1)) << 4; }
__device__ __forceinline__ int coff(int row, int colB) { return row * ROWB + (colB ^ swz2(row)); }
template <int MODE = 0>
__device__ __forceinline__ void unit(const Args& P, int b, int hp, LAS char* lds, int wv) {
    unsigned char* ws = P.ws;
    int wvl = wv; asm volatile("" : "+s"(wvl)); int tid = wvl * 64 + lane_id(); asm volatile("" : "+v"(tid));
    const int wid = __builtin_amdgcn_readfirstlane(tid >> 6), lane = tid & 63, i16 = lane & 15, g = lane >> 4;
    const int hl = wid >> 2, qb = (wid >> 1) & 1, ch = wid & 1, h = 2 * hp + hl;
    const char* LATb = (const char*)((const bf16_t*)(ws + WS_LATS) + (size_t)b * KPAD * 512);
    const char* KRb = (const char*)((const bf16_t*)(ws + WS_KRS) + (size_t)b * KPAD * 64);
    const char* RKb = (const char*)((const float*)(ws + WS_RKG) + (size_t)b * KPAD * 16 + (2 * hp & ~3));
    bf16x8 qa[18];
    { const bf16_t* Qh = (const bf16_t*)(ws + WS_Q) + (size_t)(TP + b * 32 + 16 * qb + i16) * QLD + h * 192;
      const float* gk = P.in[I_GKHEAD]; const float* gq = P.in[I_GQHEAD];
      bf16x8 qg[4];
      float fn[4][8], fr[2][8]; float ss = 0.f;
#pragma unroll
      for (int kd = 0; kd < 4; ++kd) { unpack8(*(const u32x4*)(Qh + kd * 32 + g * 8), fn[kd]);
#pragma unroll
          for (int j = 0; j < 8; ++j) ss += fn[kd][j] * fn[kd][j]; }
#pragma unroll
      for (int kr = 0; kr < 2; ++kr) { unpack8(*(const u32x4*)(Qh + 128 + kr * 32 + g * 8), fr[kr]);
#pragma unroll
          for (int j = 0; j < 8; ++j) ss += fr[kr][j] * fr[kr][j]; }
      ss += __shfl_xor(ss, 16); ss += __shfl_xor(ss, 32);
      const float rq = rsqrtf(ss * (1.f / 192.f) + EPS);
#pragma unroll
      for (int kd = 0; kd < 4; ++kd) { float f[8];
#pragma unroll
          for (int j = 0; j < 8; ++j) f[j] = fn[kd][j] * rq * gq[kd * 32 + g * 8 + j] * gk[kd * 32 + g * 8 + j];
          qg[kd] = __builtin_bit_cast(bf16x8, pack8(f)); }
      { const float pos = (float)(4096 + 16 * qb + i16);
#pragma unroll
        for (int j = 0; j < 8; ++j) { float sn, cs; fast_sincos(pos * rope_inv(8 * g + j), sn, cs);
            const float x1 = fr[0][j] * rq * gq[128 + 8 * g + j], x2 = fr[1][j] * rq * gq[160 + 8 * g + j]; fr[0][j] = x1 * cs - x2 * sn; fr[1][j] = x2 * cs + x1 * sn; } }
      const bf16_t* Wn = (const bf16_t*)(ws + WS_WKBN) + (size_t)(8 * (i16 >> 2) + (i16 & 3)) * 2048 + h * 128 + g * 8;
#pragma unroll
      for (int ks = 0; ks < 16; ++ks) { f32x4 a0 = {0.f, 0.f, 0.f, 0.f}, a1 = a0;
#pragma unroll
          for (int kd = 0; kd < 4; ++kd) {
              const bf16x8 w0 = *(const bf16x8*)(Wn + (size_t)(32 * ks) * 2048 + kd * 32), w1 = *(const bf16x8*)(Wn + (size_t)(32 * ks + 4) * 2048 + kd * 32);
              a0 = __builtin_amdgcn_mfma_f32_16x16x32_bf16(w0, qg[kd], a0, 0, 0, 0); a1 = __builtin_amdgcn_mfma_f32_16x16x32_bf16(w1, qg[kd], a1, 0, 0, 0); }
          qa[ks] = __builtin_bit_cast(bf16x8, (u32x4){cvtpk(a0[0], a0[1]), cvtpk(a0[2], a0[3]), cvtpk(a1[0], a1[1]), cvtpk(a1[2], a1[3])});
          if ((ks & 3) == 3) asm volatile("" ::: "memory"); }
      qa[16] = __builtin_bit_cast(bf16x8, pack8(fr[0])); qa[17] = __builtin_bit_cast(bf16x8, pack8(fr[1])); }
    asm volatile("s_waitcnt vmcnt(0)" ::: "memory");
    unsigned soff[10]; unsigned kmask = 0u;
#pragma unroll
    for (int k = 0; k < 10; ++k) { const int p = wid + 8 * k;
        if (p < 72) { const int d = p * 1024 + lane * 16, row = d / ROWB, cs = (d - row * ROWB) >> 4, c = (cs & ~7) | ((cs & 7) ^ (swz2(row) >> 4));
            if (c >= 64) { kmask |= 1u << (2 * k); soff[k] = (unsigned)(row * 128 + (c - 64) * 16); } else soff[k] = (unsigned)(row * 1024 + c * 16); }
        else { kmask |= 2u << (2 * k); soff[k] = (unsigned)(lane * 64); } }
#define TDMA(j, bufoff) do { _Pragma("unroll") for (int k = 0; k < 10; ++k) { const int p_ = wid + 8 * k; if (p_ < 73) { const unsigned kd_ = (kmask >> (2 * k)) & 3u; \
        const char* sp_ = kd_ == 0u ? LATb + (size_t)(j) * (64 * 1024) + soff[k] : (kd_ == 1u ? KRb + (size_t)(j) * (64 * 128) + soff[k] : RKb + (size_t)(j) * (64 * 64) + soff[k]); \
        __builtin_amdgcn_global_load_lds((const unsigned*)sp_, (LAS unsigned*)(lds + (bufoff) + p_ * 1024), 16, 0, 0); } } } while (0)
    const int sw = swz2(i16);
    const int ao0 = i16 * ROWB + ((16 * g) ^ sw), ao1 = i16 * ROWB + ((64 + 16 * g) ^ sw);
    int trb[4];
    { const int row = 4 * g + (i16 >> 2), sr = swz2(row);
#pragma unroll
      for (int c4 = 0; c4 < 4; ++c4) trb[c4] = row * ROWB + ((512 * ch + 32 * c4 + 8 * (i16 & 3)) ^ sr) - ((512 * ch) & 0) ; }
    const int rko = CT_BYTES + (4 * g) * 16 + ((2 * hp & 3) + hl) * 4;
    float m_reg = 0.f, l_reg = 0.f; f32x4 o[16]; bf16x8 pown, poth;
#pragma unroll
    for (int d = 0; d < 16; ++d) o[d] = (f32x4){0.f, 0.f, 0.f, 0.f};
    TDMA(0, 0);
    asm volatile("s_waitcnt vmcnt(0)" ::: "memory");
    __builtin_amdgcn_s_barrier(); asm volatile("" ::: "memory");
    int cur = 0;
    for (int j = 0; j < NT; ++j) {
        const LAS char* CTb = lds + cur;
        if (MODE != 1) { if (j + 1 < NT) TDMA(j + 1, cur ? 0 : BUF_BYTES); }
        if (MODE != 2) {
        f32x4 sk[2] = {(f32x4){0.f, 0.f, 0.f, 0.f}, (f32x4){0.f, 0.f, 0.f, 0.f}};
        { const int sa0 = (int)(uintptr_t)CTb + ao0 + ch * 32 * ROWB, sa1 = (int)(uintptr_t)CTb + ao1 + ch * 32 * ROWB;
          bf16x8 fa[4], fb[4];
#define RDS(F, n) do { DSR128(F[0], sa0, (n) * 128); DSR128(F[1], sa0, (n) * 128 + 16 * ROWB); DSR128(F[2], sa1, (n) * 128); DSR128(F[3], sa1, (n) * 128 + 16 * ROWB); } while (0)
#define MMS(F, n) do { sk[0] = __builtin_amdgcn_mfma_f32_16x16x32_bf16(F[0], qa[2 * (n)], sk[0], 0, 0, 0); sk[1] = __builtin_amdgcn_mfma_f32_16x16x32_bf16(F[1], qa[2 * (n)], sk[1], 0, 0, 0); \
              sk[0] = __builtin_amdgcn_mfma_f32_16x16x32_bf16(F[2], qa[2 * (n) + 1], sk[0], 0, 0, 0); sk[1] = __builtin_amdgcn_mfma_f32_16x16x32_bf16(F[3], qa[2 * (n) + 1], sk[1], 0, 0, 0); } while (0)
          RDS(fa, 0);
#pragma unroll
          for (int n = 0; n < 8; n += 2) {
              RDS(fb, n + 1); WAITK4(4, fa); MMS(fa, n);
              RDS(fa, n + 2); WAITK4(4, fb); MMS(fb, n + 1);
          }
          WAITK4(0, fa); MMS(fa, 8);
#undef RDS
#undef MMS
        }
        float e8[8]; float mloc = -1e30f;
#pragma unroll
        for (int kb = 0; kb < 2; ++kb)
#pragma unroll
            for (int r = 0; r < 4; ++r) { float v = sk[kb][r] * *(const LAS float*)(CTb + rko + (32 * ch + 16 * kb + r) * 16);
                if (j == NT - 1 && ch == 1) v = -1e30f;
                mloc = fmaxf(mloc, v); e8[4 * kb + r] = __builtin_amdgcn_exp2f(v - m_reg); }
        mloc = fmaxf(mloc, __shfl_xor(mloc, 16)); mloc = fmaxf(mloc, __shfl_xor(mloc, 32));
        { LAS char* xb = (LAS char*)lds + 2 * BUF_BYTES;
          *(LAS u32x4*)(xb + wid * 1024 + lane * 16) = (u32x4){cvtpk(e8[0], e8[1]), cvtpk(e8[2], e8[3]), cvtpk(e8[4], e8[5]), cvtpk(e8[6], e8[7])};
          if (g == 0) *(LAS float*)(xb + 8192 + wid * 64 + i16 * 4) = mloc;
          asm volatile("s_waitcnt lgkmcnt(0)" ::: "memory"); __builtin_amdgcn_s_barrier(); asm volatile("" ::: "memory");
          const u32x4 pp = *(const LAS u32x4*)(xb + (wid ^ 1) * 1024 + lane * 16); const float mp = *(const LAS float*)(xb + 8192 + (wid ^ 1) * 64 + i16 * 4);
          const float mc = fmaxf(mloc, mp); float f = 1.f;
          if (!__builtin_expect(__all(mc - m_reg <= 11.5f), 1)) { const float mn = fmaxf(m_reg, mc); f = __builtin_amdgcn_exp2f(m_reg - mn); m_reg = mn; }
          float q8[8]; unpack8(pp, q8);
          float ps = 0.f;
#pragma unroll
          for (int i = 0; i < 8; ++i) { e8[i] *= f; q8[i] *= f; ps += e8[i] + q8[i]; }
          ps += __shfl_xor(ps, 16); ps += __shfl_xor(ps, 32);
          l_reg = l_reg * f + ps;
          if (__any(f < 1.f)) {
              const float a0 = __shfl(f, 4 * g), a1 = __shfl(f, 4 * g + 1), a2 = __shfl(f, 4 * g + 2), a3 = __shfl(f, 4 * g + 3);
#pragma unroll
              for (int d = 0; d < 16; ++d) { o[d][0] *= a0; o[d][1] *= a1; o[d][2] *= a2; o[d][3] *= a3; } }
          e8[0] = e8[0];
          pown = __builtin_bit_cast(bf16x8, pack8(e8)); poth = __builtin_bit_cast(bf16x8, pack8(q8)); }
        const bf16x8 pa0 = ch == 0 ? pown : poth, pa1 = ch == 0 ? poth : pown;
        const int ctb = (int)(uintptr_t)CTb;
        { s16x4 la[4], ha[4], lb[4], hb[4];
#define RDP(L, H, G) do { const int tb_ = ctb + trb[(G) & 3]; constexpr int o_ = ((G) >> 2) * 256; \
            TRR(L[0], tb_, o_); TRR(H[0], tb_, o_ + 16 * ROWB); TRR(L[1], tb_, o_ + 32 * ROWB); TRR(H[1], tb_, o_ + 48 * ROWB); \
            TRR(L[2], tb_, o_ + 128); TRR(H[2], tb_, o_ + 128 + 16 * ROWB); TRR(L[3], tb_, o_ + 128 + 32 * ROWB); TRR(H[3], tb_, o_ + 128 + 48 * ROWB); } while (0)
#define MMP(L, H, G) do { constexpr int d_ = ((G) & 3) + 8 * ((G) >> 2); \
            o[d_] = __builtin_amdgcn_mfma_f32_16x16x32_bf16(pa0, PKV(L[0], H[0]), o[d_], 0, 0, 0); o[d_] = __builtin_amdgcn_mfma_f32_16x16x32_bf16(pa1, PKV(L[1], H[1]), o[d_], 0, 0, 0); \
            o[d_ + 4] = __builtin_amdgcn_mfma_f32_16x16x32_bf16(pa0, PKV(L[2], H[2]), o[d_ + 4], 0, 0, 0); o[d_ + 4] = __builtin_amdgcn_mfma_f32_16x16x32_bf16(pa1, PKV(L[3], H[3]), o[d_ + 4], 0, 0, 0); } while (0)
          RDP(la, ha, 0);
          RDP(lb, hb, 1); WAITV8(8, la, ha); MMP(la, ha, 0);
          RDP(la, ha, 2); WAITV8(8, lb, hb); MMP(lb, hb, 1);
          RDP(lb, hb, 3); WAITV8(8, la, ha); MMP(la, ha, 2);
          RDP(la, ha, 4); WAITV8(8, lb, hb); MMP(lb, hb, 3);
          RDP(lb, hb, 5); WAITV8(8, la, ha); MMP(la, ha, 4);
          RDP(la, ha, 6); WAITV8(8, lb, hb); MMP(lb, hb, 5);
          RDP(lb, hb, 7); WAITV8(8, la, ha); MMP(la, ha, 6);
          WAITV8(0, lb, hb); MMP(lb, hb, 7);
#undef RDP
#undef MMP
        }
        }
        asm volatile("s_waitcnt vmcnt(0) lgkmcnt(0)" ::: "memory");
        __builtin_amdgcn_s_barrier(); asm volatile("" ::: "memory");
        cur = cur ? 0 : BUF_BYTES;
    }
    asm volatile("s_waitcnt vmcnt(0)" ::: "memory");
    { const float rl = __builtin_amdgcn_rcpf(l_reg);
      const float r0 = __shfl(rl, 4 * g), r1 = __shfl(rl, 4 * g + 1), r2 = __shfl(rl, 4 * g + 2), r3 = __shfl(rl, 4 * g + 3);
      LAS bf16_t* OL = (LAS bf16_t*)(lds + hl * 32 * OLB) + (16 * qb + 4 * g) * (OLB / 2) + 256 * ch + i16;
#pragma unroll
      for (int d = 0; d < 16; ++d) { OL[16 * d] = f2bf(o[d][0] * r0); OL[(OLB / 2) + 16 * d] = f2bf(o[d][1] * r1); OL[2 * (OLB / 2) + 16 * d] = f2bf(o[d][2] * r2); OL[3 * (OLB / 2) + 16 * d] = f2bf(o[d][3] * r3); }
      __syncthreads();
      const int r32 = lane & 31, hi = lane >> 5, wq = wid & 3;
      f32x16 acc = f32x16{};
      const bf16_t* Wv = (const bf16_t*)(ws + WS_WVB) + (size_t)(h * 128 + 32 * wq + r32) * 512 + hi * 8;
      const LAS char* ar = lds + hl * 32 * OLB + r32 * OLB + hi * 16;
#pragma unroll 8
      for (int ks = 0; ks < 32; ++ks) { const bf16x8 a = *(const LAS bf16x8*)(ar + ks * 32); const bf16x8 bw = *(const bf16x8*)(Wv + ks * 16);
          acc = __builtin_amdgcn_mfma_f32_32x32x16_bf16(a, bw, acc, 0, 0, 0); }
      bf16_t* Ow = (bf16_t*)(ws + WS_OMLA) + (size_t)(TP + b * 32) * 2048 + h * 128 + 32 * wq + r32;
#pragma unroll
      for (int r = 0; r < 16; ++r) Ow[(size_t)crow(r, hi) * 2048] = f2bf(acc[r]);
      __syncthreads(); }
#undef TDMA
}
}


struct MergeSched {
    const bf16_t *D, *WP, *OML, *WML, *OME, *WME; int G, c;
    __device__ __forceinline__ void seg_ptrs(pg8::Unit& u, int seg, int pm, int pn, int kt0) const {
        if (seg == 0) { u.A = (const char*)(D + (size_t)pm * 256 * 1024 + (pn >> 1) * 256); u.lda2 = 2048u; u.B = (const char*)(WP + (size_t)pn * 256 * 256); u.ldb2 = 512u; }
        else if (seg == 1) { u.A = (const char*)(OML + (size_t)pm * 256 * 2048 + kt0 * 64); u.lda2 = 4096u; u.B = (const char*)(WML + (size_t)pn * 256 * 2048 + kt0 * 64); u.ldb2 = 4096u; }
        else { u.A = (const char*)(OME + (size_t)pm * 256 * 1024 + kt0 * 64); u.lda2 = 2048u; u.B = (const char*)(WME + (size_t)pn * 256 * 1024 + kt0 * 64); u.ldb2 = 2048u; }
    }
    __device__ __forceinline__ bool next(int i, pg8::Unit& u) const {
        const int nmain = c < 256 ? (256 - c + G - 1) / G : 0;
        if (i < 3 * nmain) { const int ti = i / 3, seg = i - 3 * ti; int pm, pn; pg8::tile_of(ti * G + c, 32, 8, pm, pn); u.pm = pm; u.pn = pn; u.kind = seg; u.aux = 0;
            seg_ptrs(u, seg, pm, pn, 0); u.nt = seg == 0 ? 4 : (seg == 1 ? 32 : 16); return true; }
        const long p = (long)(i - 3 * nmain) * G + c; if (p >= 16 * 13) return false;
        const int t = (int)p / 13, piece = (int)p - 13 * t, pm = 32 + (t >> 3), pn = t & 7, seg = piece == 0 ? 0 : (piece < 9 ? 1 : 2);
        u.pm = pm; u.pn = pn; u.kind = 3 + seg; u.aux = (int)p; u.nt = 4;
        seg_ptrs(u, seg, pm, pn, seg == 1 ? (piece - 1) * 4 : (seg == 2 ? (piece - 9) * 4 : 0)); return true;
    }
};
struct TailSched {
    const bf16_t* A; const bf16_t* B; int K, G, c;
    __device__ __forceinline__ bool next(int i, pg8::Unit& u) const {
        const int nmain = c < 256 ? (256 - c + G - 1) / G : 0;
        u.lda2 = (unsigned)K * 2u; u.ldb2 = u.lda2;
        if (i < nmain) { int pm, pn; pg8::tile_of(i * G + c, 32, 8, pm, pn); u.pm = pm; u.pn = pn; u.kind = 0; u.aux = 0; u.nt = K / 64;
            u.A = (const char*)(A + (size_t)pm * 256 * K); u.B = (const char*)(B + (size_t)pn * 256 * K); return true; }
        const long p = (long)(i - nmain) * G + c; if (p >= 256) return false;
        const int t = (int)p >> 4, piece = (int)p & 15, pm = 32 + (t >> 3), pn = t & 7, ntp = K / 64 / 16;
        u.pm = pm; u.pn = pn; u.kind = 1; u.aux = (int)p; u.nt = ntp;
        u.A = (const char*)(A + (size_t)pm * 256 * K + piece * ntp * 64); u.B = (const char*)(B + (size_t)pn * 256 * K + piece * ntp * 64); return true;
    }
};
template <int NP> __device__ __forceinline__ f32x4 slab_sum(const float* slab, int t, int r, int lane) {
    const float* sp = slab + ((size_t)t * NP) * 65536 + r * 256 + lane * 4;
    f32x4 s = *(const f32x4*)sp;
#pragma unroll
    for (int p = 1; p < NP; ++p) s += *(const f32x4*)(sp + (size_t)p * 65536);
    return s;
}
struct UpSched {
    const bf16_t* A; const bf16_t* B; int G, c;
    __device__ __forceinline__ bool next(int i, pg8::Unit& u) const {
        u.lda2 = 4096u; u.ldb2 = 4096u;
        const int nmain = c < 1024 ? (1024 - c + G - 1) / G : 0;
        if (i < nmain) { int pm, pn; pg8::tile_of(i * G + c, 32, 32, pm, pn); u.pm = pm; u.pn = pn; u.kind = 0; u.aux = 0; u.nt = 32;
            u.A = (const char*)(A + (size_t)pm * 256 * 2048); u.B = (const char*)(B + (size_t)pn * 256 * 2048); return true; }
        const long p = (long)(i - nmain) * G + c; if (p >= 256) return false;
        const int t = (int)p >> 2, piece = (int)p & 3, pm = 32 + (t >> 5), pn = t & 31;
        u.pm = pm; u.pn = pn; u.kind = 1; u.aux = (int)p; u.nt = 8;
        u.A = (const char*)(A + (size_t)pm * 256 * 2048 + piece * 512); u.B = (const char*)(B + (size_t)pn * 256 * 2048 + piece * 512); return true;
    }
};
__device__ __forceinline__ void store_slab_p(const f32x4 (&acc)[2][2][4][2], float* sl, int wr, int wc, int fr, int fq) {
    float* s0 = sl + (wr * 64 + fr) * 256 + wc * 32 + 8 * fq;
#pragma unroll
    for (int ai = 0; ai < 2; ++ai)
#pragma unroll
        for (int m = 0; m < 4; ++m)
#pragma unroll
            for (int bj = 0; bj < 2; ++bj) { float* sp = s0 + (ai * 128 + m * 16) * 256 + bj * 128; *(f32x4*)sp = acc[ai][bj][m][0]; *(f32x4*)(sp + 4) = acc[ai][bj][m][1]; }
}
__device__ __forceinline__ void reduce_up(const float* slab, const float* SSX, bf16_t* Aout, int gw, int NGW, int lane) {
    for (int it = gw; it < TS * 8; it += NGW) { const int rs = it >> 3, q = it & 7, r = rs & 255, t0 = (rs >> 8) * 32 + q * 4;
        const f32x4 s0 = *(const f32x4*)(SSX + (size_t)(TP + rs) * 32), s1 = *(const f32x4*)(SSX + (size_t)(TP + rs) * 32 + 4);
        const f32x4 s2 = *(const f32x4*)(SSX + (size_t)(TP + rs) * 32 + 8), s3 = *(const f32x4*)(SSX + (size_t)(TP + rs) * 32 + 12);
        const f32x4 s4 = *(const f32x4*)(SSX + (size_t)(TP + rs) * 32 + 16), s5 = *(const f32x4*)(SSX + (size_t)(TP + rs) * 32 + 20);
        const f32x4 s6 = *(const f32x4*)(SSX + (size_t)(TP + rs) * 32 + 24), s7 = *(const f32x4*)(SSX + (size_t)(TP + rs) * 32 + 28);
        const f32x4 sa = ((s0 + s1) + (s2 + s3)) + ((s4 + s5) + (s6 + s7));
        const float rr = rsqrtf(((sa.x + sa.y) + (sa.z + sa.w)) * (1.f / 2048.f) + EPS);
        f32x4 v[4];
#pragma unroll
        for (int pn = 0; pn < 4; ++pn) v[pn] = slab_sum<4>(slab, t0 + pn, r, lane);
#pragma unroll
        for (int pn = 0; pn < 4; ++pn) { f32x4 x = v[pn] * rr;
#pragma unroll
            for (int e = 0; e < 4; ++e) { const float a = fmaxf(x[e], 0.f); x[e] = a * a; }
            *(u32x2*)(Aout + (size_t)(TP + rs) * 8192 + (q * 4 + pn) * 256 + lane * 4) = (u32x2){cvtpk(x.x, x.y), cvtpk(x.z, x.w)}; } }
}
struct EpiMerge {
    static constexpr bool PERM = true;
    const bf16_t* G; const float* ps; bf16_t* MG; float* slab;
    __device__ __forceinline__ bool operator()(f32x4 (&acc)[2][2][4][2], const pg8::Unit& u, int wr, int wc, int fr_, int fq) const {
        int fr = fr_; asm volatile("" : "+v"(fr));
        const int row0 = u.pm * 256 + wr * 64 + fr, c0 = u.pn * 256 + wc * 32 + 8 * fq;
        const int kind = u.kind, sg = kind >= 3 ? kind - 3 : kind;
        const bool ratio = kind < 2;
        float* sl = slab + (size_t)u.aux * 65536 + (wr * 64 + fr) * 256 + wc * 32 + 8 * fq;
        f32x4 pv[2][2];
#pragma unroll
        for (int bj = 0; bj < 2; ++bj) { pv[bj][0] = (f32x4){1.f, 1.f, 1.f, 1.f}; pv[bj][1] = pv[bj][0]; }
        if (sg == 0) {
#pragma unroll
            for (int bj = 0; bj < 2; ++bj) { pv[bj][0] = *(const f32x4*)(ps + c0 + bj * 128); pv[bj][1] = *(const f32x4*)(ps + c0 + bj * 128 + 4); }
        }
#pragma unroll
        for (int ai = 0; ai < 2; ++ai) {
            u32x4 ga[4][2], gb[4][2];
#pragma unroll
            for (int m = 0; m < 4; ++m) { const bf16_t* gr = G + (size_t)(row0 + ai * 128 + m * 16) * G_LD + sg * 2048 + c0;
#pragma unroll
                for (int bj = 0; bj < 2; ++bj) { ga[m][bj] = *(const u32x4*)(gr + bj * 128); gb[m][bj] = ratio ? *(const u32x4*)(gr + 2048 + bj * 128) : (u32x4){0u, 0u, 0u, 0u}; } }
            asm volatile("" ::: "memory");
#pragma unroll
            for (int m = 0; m < 4; ++m) { const size_t row = (size_t)(row0 + ai * 128 + m * 16);
#pragma unroll
                for (int bj = 0; bj < 2; ++bj) {
                    float f[8]; unpack8(ga[m][bj], f);
                    if (ratio) { float b[8]; unpack8(gb[m][bj], b);
#pragma unroll
                        for (int e = 0; e < 8; ++e) f[e] *= __builtin_amdgcn_rcpf(b[e]); }
#pragma unroll
                    for (int e = 0; e < 8; ++e) f[e] *= pv[bj][e >> 2][e & 3];
                    f32x4& v0 = acc[ai][bj][m][0]; f32x4& v1 = acc[ai][bj][m][1];
                    v0[0] *= f[0]; v0[1] *= f[1]; v0[2] *= f[2]; v0[3] *= f[3]; v1[0] *= f[4]; v1[1] *= f[5]; v1[2] *= f[6]; v1[3] *= f[7];
                    if (kind == 2) *(u32x4*)(MG + row * 2048 + c0 + bj * 128) = (u32x4){cvtpk(v0[0], v0[1]), cvtpk(v0[2], v0[3]), cvtpk(v1[0], v1[1]), cvtpk(v1[2], v1[3])};
                    else if (kind >= 3) { float* sp = sl + (ai * 128 + m * 16) * 256 + bj * 128; *(f32x4*)sp = v0; *(f32x4*)(sp + 4) = v1; }
                } }
            asm volatile("" ::: "memory");
        }
        return kind < 2;
    }
};
__device__ __forceinline__ void store_slab(const f32x4 (&acc)[2][2][4][2], float* sl, int wr, int wc, int fr, int fq) {
    float* s0 = sl + (wr * 64 + fr) * 256 + wc * 32 + 4 * fq;
#pragma unroll
    for (int ai = 0; ai < 2; ++ai)
#pragma unroll
        for (int m = 0; m < 4; ++m)
#pragma unroll
            for (int bj = 0; bj < 2; ++bj)
#pragma unroll
                for (int n = 0; n < 2; ++n) *(f32x4*)(s0 + (ai * 128 + m * 16) * 256 + bj * 128 + n * 16) = acc[ai][bj][m][n];
}
struct EpiOut {
    static constexpr bool PERM = false;
    const float* xp; const float* xs; float* X1; bf16_t* X1b; float* SSX; float* slab;
    __device__ __forceinline__ bool operator()(f32x4 (&acc)[2][2][4][2], const pg8::Unit& u, int wr, int wc, int fr_, int fq) const {
        int fr = fr_; asm volatile("" : "+v"(fr));
        const int row0 = u.pm * 256 + wr * 64 + fr, c0 = u.pn * 256 + wc * 32 + 4 * fq;
        if (u.kind == 1) { store_slab(acc, slab + (size_t)u.aux * 65536, wr, wc, fr, fq); return false; }
#pragma unroll
        for (int ai = 0; ai < 2; ++ai) {
            f32x4 xv[4][2][2];
#pragma unroll
            for (int m = 0; m < 4; ++m) { const int row = row0 + ai * 128 + m * 16;
                const float* xr = (row < TP ? xp + (size_t)row * DM : xs + (size_t)(row - TP) * DM) + c0;
#pragma unroll
                for (int bj = 0; bj < 2; ++bj)
#pragma unroll
                    for (int n = 0; n < 2; ++n) xv[m][bj][n] = __builtin_nontemporal_load((const f32x4*)(xr + bj * 128 + n * 16)); }
            asm volatile("" ::: "memory");
#pragma unroll
            for (int m = 0; m < 4; ++m) { const int row = row0 + ai * 128 + m * 16; float s = 0.f;
#pragma unroll
                for (int bj = 0; bj < 2; ++bj)
#pragma unroll
                    for (int n = 0; n < 2; ++n) { const f32x4 v = acc[ai][bj][m][n] + xv[m][bj][n];
                        s += (v.x * v.x + v.y * v.y) + (v.z * v.z + v.w * v.w);
                        *(u32x2*)(X1b + (size_t)row * DM + c0 + bj * 128 + n * 16) = (u32x2){cvtpk(v.x, v.y), cvtpk(v.z, v.w)}; }
                s += __shfl_xor(s, 16); s += __shfl_xor(s, 32);
                if (fq == 0) SSX[(size_t)row * 32 + u.pn * 4 + wc] = s; }
            asm volatile("" ::: "memory");
        }
        return false;
    }
};
struct EpiUp {
    static constexpr bool PERM = true;
    const float* SSX; bf16_t* A; float* slab;
    __device__ __forceinline__ bool operator()(f32x4 (&acc)[2][2][4][2], const pg8::Unit& u, int wr, int wc, int fr_, int fq) const {
        int fr = fr_; asm volatile("" : "+v"(fr));
        const int row0 = u.pm * 256 + wr * 64 + fr, c0 = u.pn * 256 + wc * 32 + 8 * fq;
        if (u.kind == 1) { store_slab_p(acc, slab + (size_t)u.aux * 65536, wr, wc, fr, fq); return false; }
        f32x4 sv[2][4][2];
#pragma unroll
        for (int ai = 0; ai < 2; ++ai)
#pragma unroll
            for (int m = 0; m < 4; ++m) { const size_t row = (size_t)(row0 + ai * 128 + m * 16); sv[ai][m][0] = *(const f32x4*)(SSX + row * 32 + fq * 8); sv[ai][m][1] = *(const f32x4*)(SSX + row * 32 + fq * 8 + 4); }
        asm volatile("" ::: "memory");
#pragma unroll
        for (int ai = 0; ai < 2; ++ai)
#pragma unroll
            for (int m = 0; m < 4; ++m) { const size_t row = (size_t)(row0 + ai * 128 + m * 16);
                const f32x4 s0 = sv[ai][m][0], s1 = sv[ai][m][1];
                float s = ((s0.x + s0.y) + (s0.z + s0.w)) + ((s1.x + s1.y) + (s1.z + s1.w));
                s += __shfl_xor(s, 16); s += __shfl_xor(s, 32);
                const float r = rsqrtf(s * (1.f / 2048.f) + EPS);
#pragma unroll
                for (int bj = 0; bj < 2; ++bj) { f32x4 v0 = acc[ai][bj][m][0] * r, v1 = acc[ai][bj][m][1] * r;
#pragma unroll
                    for (int e = 0; e < 4; ++e) { const float a = fmaxf(v0[e], 0.f), b = fmaxf(v1[e], 0.f); v0[e] = a * a; v1[e] = b * b; }
                    *(u32x4*)(A + row * 8192 + c0 + bj * 128) = (u32x4){cvtpk(v0[0], v0[1]), cvtpk(v0[2], v0[3]), cvtpk(v1[0], v1[1]), cvtpk(v1[2], v1[3])}; } }
        return false;
    }
};
struct EpiDown {
    static constexpr bool PERM = false;
    float* Y; const bf16_t* X1b; float* slab;
    __device__ __forceinline__ bool operator()(f32x4 (&acc)[2][2][4][2], const pg8::Unit& u, int wr, int wc, int fr_, int fq) const {
        int fr = fr_; asm volatile("" : "+v"(fr));
        const int row0 = u.pm * 256 + wr * 64 + fr, c0 = u.pn * 256 + wc * 32 + 4 * fq;
        if (u.kind == 1) { store_slab(acc, slab + (size_t)u.aux * 65536, wr, wc, fr, fq); return false; }
        u32x2 xv[2][4][2][2];
#pragma unroll
        for (int ai = 0; ai < 2; ++ai)
#pragma unroll
            for (int m = 0; m < 4; ++m) { const bf16_t* xr = X1b + (size_t)(row0 + ai * 128 + m * 16) * DM + c0;
#pragma unroll
                for (int bj = 0; bj < 2; ++bj)
#pragma unroll
                    for (int n = 0; n < 2; ++n) xv[ai][m][bj][n] = *(const u32x2*)(xr + bj * 128 + n * 16); }
        asm volatile("" ::: "memory");
#pragma unroll
        for (int ai = 0; ai < 2; ++ai)
#pragma unroll
            for (int m = 0; m < 4; ++m) { float* yr = Y + (size_t)(row0 + ai * 128 + m * 16) * DM + c0;
#pragma unroll
                for (int bj = 0; bj < 2; ++bj)
#pragma unroll
                    for (int n = 0; n < 2; ++n) { const u32x2 w = xv[ai][m][bj][n];
                        __builtin_nontemporal_store((f32x4){bflo(w.x), bfhi(w.x), bflo(w.y), bfhi(w.y)} + acc[ai][bj][m][n], (f32x4*)(yr + bj * 128 + n * 16)); } }
        return false;
    }
};
__device__ __forceinline__ void reduce_merge(const float* slab, bf16_t* MG, int gw, int NGW, int lane) {
    for (int it = gw; it < TS * 4; it += NGW) { const int rs = it >> 2, q = it & 3, r = rs & 255, t0 = (rs >> 8) * 8;
#pragma unroll
        for (int pn = 2 * q; pn < 2 * q + 2; ++pn) { const f32x4 s = slab_sum<13>(slab, t0 + pn, r, lane);
            *(u32x2*)(MG + (size_t)(TP + rs) * DM + pn * 256 + lane * 4) = (u32x2){cvtpk(s.x, s.y), cvtpk(s.z, s.w)}; } }
}
__device__ __forceinline__ void reduce_out(const float* slab, const float* xs, float* X1, bf16_t* X1b, float* SSX, int gw, int NGW, int lane) {
    for (int it = gw; it < TS * 4; it += NGW) { const int rs = it >> 2, q = it & 3, r = rs & 255, t0 = (rs >> 8) * 8; float ss = 0.f;
#pragma unroll
        for (int pn = 2 * q; pn < 2 * q + 2; ++pn) { const size_t o = (size_t)rs * DM + pn * 256 + lane * 4;
            const f32x4 v = slab_sum<16>(slab, t0 + pn, r, lane) + *(const f32x4*)(xs + o);
            ss += (v.x * v.x + v.y * v.y) + (v.z * v.z + v.w * v.w);
            *(u32x2*)(X1b + (size_t)TP * DM + o) = (u32x2){cvtpk(v.x, v.y), cvtpk(v.z, v.w)}; }
        ss = wave_sum(ss);
        if (lane < 8) SSX[(size_t)(TP + rs) * 32 + q * 8 + lane] = lane == 0 ? ss : 0.f; }
}
__device__ __forceinline__ void reduce_down(const float* slab, const bf16_t* X1b, float* Y, int gw, int NGW, int lane) {
    for (int it = gw; it < TS * 4; it += NGW) { const int rs = it >> 2, q = it & 3, r = rs & 255, t0 = (rs >> 8) * 8;
#pragma unroll
        for (int pn = 2 * q; pn < 2 * q + 2; ++pn) { const size_t o = (size_t)(TP + rs) * DM + pn * 256 + lane * 4; const u32x2 w = *(const u32x2*)(X1b + o);
            *(f32x4*)(Y + o) = (f32x4){bflo(w.x), bfhi(w.x), bflo(w.y), bfhi(w.y)} + slab_sum<16>(slab, t0 + pn, r, lane); } }
}

struct SchedB {
    const unsigned char* ws; int G, c;
    __device__ __forceinline__ bool next(int i, pg8::Unit& u) const {
        const long L = (long)i * G + c; constexpr int N0 = 34 * 37, N1 = 2 * 8; if (L >= N0 + N1) return false;
        int pm, pn; u.lda2 = 4096u; u.ldb2 = 4096u; u.nt = 32;
        if (L < N0) { pg8::tile_of((int)L, 34, 37, pm, pn); u.A = (const char*)(ws + WS_H + (size_t)pm * 256 * 4096); u.B = (const char*)(ws + WS_WIN + (size_t)pn * 256 * 4096); u.kind = 0; }
        else { pg8::tile_of((int)L - N0, 2, 8, pm, pn); u.A = (const char*)(ws + WS_HM + (size_t)pm * 256 * 4096); u.B = (const char*)(ws + WS_WMEMKV + (size_t)pn * 256 * 4096); u.kind = 1; }
        u.pm = pm; u.pn = pn; return true;
    }
};
__device__ __forceinline__ void mem_unit(int u, int& row0, int& bsel, int& h) {
    h = u & 3;
    if (u < 128) { const int b = u >> 6, pt = (u >> 2) & 15; row0 = b * 4096 + pt * 256; bsel = b; }
    else { const int b = (u - 128) >> 2; row0 = TP + b * 32; bsel = 2 + b; }
}
struct SchedD {
    const unsigned char* ws; const unsigned char* ob; int G, c;
    __device__ __forceinline__ bool next(int i, pg8::Unit& u) const {
        const long L = (long)i * G + c; constexpr int N0 = (NBS * KPAD / 256) * 8, N1 = N0 + 34 * 12, N2 = N1 + 32 * 8, N3 = N2 + 32 * 8, N4 = N3 + 192; if (L >= N4) return false;
        int pm, pn; u.lda2 = 1024u; u.ldb2 = 1024u; u.nt = 8; u.aux = 0;
        if (L < N0) { pg8::tile_of((int)L, NBS * KPAD / 256, 8, pm, pn); u.A = (const char*)(ws + WS_LATS + (size_t)pm * 256 * 1024); u.B = (const char*)(ws + WS_WKB + (size_t)pn * 256 * 1024); u.kind = 3; }
        else if (L < N1) { pg8::tile_of((int)L - N0, 34, 12, pm, pn); u.A = (const char*)(ws + WS_QN + (size_t)pm * 256 * 1024); u.B = (const char*)(ws + WS_WQB + (size_t)pn * 256 * 1024); u.kind = 0; }
        else if (L < N2) { pg8::tile_of((int)L - N1, 32, 8, pm, pn); u.A = (const char*)(ob + DO_CKVP + (size_t)pm * 256 * 1024); u.B = (const char*)(ws + WS_WKB + (size_t)pn * 256 * 1024); u.kind = 1; }
        else if (L < N3) { pg8::tile_of((int)L - N2, 32, 8, pm, pn); u.A = (const char*)(ob + DO_CKVP + (size_t)pm * 256 * 1024); u.B = (const char*)(ws + WS_WVB + (size_t)pn * 256 * 1024); u.kind = 2; }
        else { const int mu = (int)L - N3; int row0, bsel, h; mem_unit(mu, row0, bsel, h);
            u.A = (const char*)(ws + WS_QM + ((size_t)row0 * 1024 + h * 256) * 2); u.B = (const char*)(ws + WS_MK + ((size_t)bsel * 262144 + h * 256) * 2); u.lda2 = 2048u; u.ldb2 = 2048u; u.nt = 4;
            u.kind = mu < 128 ? 4 : 5; pm = row0; pn = h; }
        u.pm = pm; u.pn = pn; return true;
    }
};
struct SchedMO {
    const unsigned char* ws; int G, c;
    __device__ __forceinline__ bool next(int i, pg8::Unit& u) const {
        const long L = (long)i * G + c; if (L >= 192) return false;
        int row0, bsel, h; mem_unit((int)L, row0, bsel, h);
        u.A = (const char*)(ws + WS_PM + ((size_t)row0 * 1024 + h * 256) * 2); u.B = (const char*)(ws + WS_MVT + ((size_t)bsel * 262144 + (size_t)h * 65536) * 2); u.lda2 = 2048u; u.ldb2 = 512u; u.nt = 4;
        u.kind = L < 128 ? 4 : 5; u.pm = row0; u.pn = h; u.aux = 0; return true;
    }
};
struct EpiMO {
    static constexpr bool PERM = true;
    const float* PS; bf16_t* O;
    __device__ __forceinline__ bool operator()(f32x4 (&acc)[2][2][4][2], const pg8::Unit& u, int wr, int wc, int fr_, int fq) const {
        int fr = fr_; asm volatile("" : "+v"(fr));
        const int c0 = u.pn * 256 + wc * 32 + 8 * fq;
        f32x4 sv[2][4];
#pragma unroll
        for (int ai = 0; ai < 2; ++ai)
#pragma unroll
            for (int m = 0; m < 4; ++m) { const int rl = ai * 128 + wr * 64 + m * 16 + fr; sv[ai][m] = *(const f32x4*)(PS + (size_t)(u.pm + ((u.kind == 5 && rl >= 32) ? 0 : rl)) * 16 + u.pn * 4); }
        asm volatile("" ::: "memory");
#pragma unroll
        for (int ai = 0; ai < 2; ++ai)
#pragma unroll
            for (int m = 0; m < 4; ++m) { const int rl = ai * 128 + wr * 64 + m * 16 + fr; if (u.kind == 5 && rl >= 32) continue;
                const size_t row = (size_t)(u.pm + rl); const f32x4 s4 = sv[ai][m];
                const float inv = __builtin_amdgcn_rcpf((s4.x + s4.y) + (s4.z + s4.w));
#pragma unroll
                for (int bj = 0; bj < 2; ++bj) { const f32x4 v0 = acc[ai][bj][m][0] * inv, v1 = acc[ai][bj][m][1] * inv;
                    *(u32x4*)(O + row * 1024 + c0 + bj * 128) = (u32x4){cvtpk(v0[0], v0[1]), cvtpk(v0[2], v0[3]), cvtpk(v1[0], v1[1]), cvtpk(v1[2], v1[3])}; } }
        return false;
    }
};

constexpr int CW_BAR = 4096, CW_QUEUE = 64;
#ifndef PROBE_K
#define PROBE_K -1
#endif
#ifndef PROBE_BX
#define PROBE_BX 0
#endif
#define STAMP(k) do { if (PROBE_K >= 0 && bx == 0 && tid == 0) { const unsigned long long t_ = __builtin_amdgcn_s_memrealtime(); MISC[32 + 2 * (k)] = (unsigned)t_; MISC[33 + 2 * (k)] = (unsigned)(t_ >> 32); } } while (0)
#ifndef ONLY
#define ONLY -1
#endif
#define PH(x) (ONLY < 0 || ONLY == (x))
__global__ void __launch_bounds__(NWAVES * 64, 2) mega_fwd(Args P) {
    extern __shared__ __attribute__((aligned(16))) unsigned char lds_raw[];
    LAS unsigned char* lds = (LAS unsigned char*)lds_raw;
    const int tid = threadIdx.x, lane = tid & 63, wave = __builtin_amdgcn_readfirstlane(tid >> 6);
    const int G = gridDim.x, bx = blockIdx.x;
    const int vcu = (G % 8 == 0) ? (bx % 8) * (G / 8) + bx / 8 : bx;
    const int gw = vcu * NWAVES + wave, NGW = G * NWAVES;
    volatile LAS unsigned* MISC = (volatile LAS unsigned*)(lds + MISC_OFF);
    if (tid < 64) MISC[tid] = 0u;
    __syncthreads();
    unsigned* ctl = (unsigned*)(P.ws + WS_CTL);
    XcdBarrier bar = xcd_barrier_post(ctl + CW_BAR, MISC + 8); bar.wv = wave;
    unsigned char* ws = P.ws;
    STAMP(0);

#define LAUNDER() int lane_l = lane_id(), gw_l = gw; asm volatile("" : "+v"(lane_l)); asm volatile("" : "+s"(gw_l))
    if (PH(0)) { LAUNDER(); phase_prep(P, lds, gw_l, NGW, wave, lane_l); }
    xcd_barrier(bar); STAMP(1);
    if (PH(1)) {
        SchedB S{ws, G, bx};
        EpiIn E{(bf16_t*)(ws + WS_ZS), (bf16_t*)(ws + WS_G), (float*)(ws + WS_M), P.in[I_BGATE]};
        pg8::gemm_stream<EpiIn, SchedB>(lds, S, E, wave);
    }
    xcd_barrier(bar); STAMP(2);
    if (PH(2)) { LAUNDER(); phase_rows(P, lds, gw_l, NGW, wave, lane_l); }
    xcd_barrier(bar); STAMP(3);
    if (PH(3)) {
        SchedD S{ws, (const unsigned char*)P.out, G, bx};
        EpiQKV E{(bf16_t*)(ws + WS_Q), (bf16_t*)((unsigned char*)P.out + DO_K), (bf16_t*)(ws + WS_V), (float*)(ws + WS_RKG), (bf16_t*)(ws + WS_PM), (float*)(ws + WS_PS),
                 (const float*)(ws + WS_KPESS), (const float*)(ws + WS_KPESSP), (const bf16_t*)(ws + WS_KRP), P.in[I_GKHEAD], lds};
        pg8::gemm_stream<EpiQKV, SchedD>(lds, S, E, wave);
    }
    xcd_barrier(bar); STAMP(4);
    {
        const bf16_t* Qg = (const bf16_t*)(ws + WS_Q); const bf16_t* Kg = (const bf16_t*)((unsigned char*)P.out + DO_K); const bf16_t* Vg = (const bf16_t*)(ws + WS_V);
        bf16_t* Og = (bf16_t*)(ws + WS_OMLA);
        constexpr int NI_P = 512;
#define DEQUEUE(qw) ({ LAS unsigned* mq_ = (LAS unsigned*)(lds + MISC_OFF + 64); asm volatile("" : "+s"(mq_));   \
        if (wave == 0 && lane_id() == 0) *(volatile LAS unsigned*)mq_ = __hip_atomic_fetch_add(ctl + (qw), 1u, __ATOMIC_RELAXED, __HIP_MEMORY_SCOPE_AGENT); __syncthreads(); const int it_ = (int)*(volatile LAS unsigned*)mq_; __syncthreads(); it_; })
#define PROBE_BEGIN() const bool pr_ = PROBE_K >= 20 && bx == PROBE_BX && tid == 0; unsigned long long ts_ = 0; if (pr_) ts_ = __builtin_amdgcn_s_memrealtime()
#define PROBE_END(pk) do { if (pr_ && (pk) == PROBE_K && MISC[20] == 0u) { MISC[20] = 1u; MISC[21] = (unsigned)(__builtin_amdgcn_s_memrealtime() - ts_); } } while (0)
        if (PH(7)) { SchedMO S{ws, G, bx}; EpiMO E{(const float*)(ws + WS_PS), (bf16_t*)(ws + WS_OMEM)};
            pg8::gemm_stream<EpiMO, SchedMO>(lds, S, E, wave); __syncthreads(); }
        const int xq = (int)(bar.x & 7u);
        unsigned long long tf0_ = 0; if (PROBE_K >= 40 && tid == 0) tf0_ = __builtin_amdgcn_s_memrealtime();
#define LOOP_T0() unsigned long long tl_ = 0; if (PROBE_K >= 23 && PROBE_K < 40 && bx == 0 && tid == 0) tl_ = __builtin_amdgcn_s_memrealtime()
#define LOOP_T1(pk) do { if (PROBE_K == (pk) && bx == 0 && tid == 0) MISC[21] = (unsigned)(__builtin_amdgcn_s_memrealtime() - tl_); \
        if (PROBE_K >= 40 && tid == 0) ctl[8192 + ((pk) - 23) * 256 + bx] = (unsigned)(__builtin_amdgcn_s_memrealtime() - tf0_); } while (0)
        { LOOP_T0();
        if (PH(6)) for (;;) { const int it = DEQUEUE(CW_QUEUE + 64 * (1 + xq)); if (it >= 16) break; PROBE_BEGIN();
            sat::unit(P, 2 * xq + (it & 1), it >> 1, (LAS char*)lds, wave); PROBE_END(20); }
        LOOP_T1(23); }
        if (PH(6)) for (int qq = 1; qq < 8; ++qq) { const int q = (xq + qq) & 7;
            for (;;) { const int it = DEQUEUE(CW_QUEUE + 64 * (1 + q)); if (it >= 16) break; sat::unit(P, 2 * q + (it & 1), it >> 1, (LAS char*)lds, wave); } }
        { LOOP_T0();
        if (PH(5)) for (;;) { const int it = DEQUEUE(CW_QUEUE + 64 * 9); if (it >= NI_P) break; PROBE_BEGIN();
            const int qb = 15 - (it >> 5), bh = it & 31, b = bh >> 4, h = bh & 15;
            pat::unit(Qg + ((size_t)(b * 4096 + qb * 256) * QLD + h * 192), Kg + ((size_t)b * 4096 * QLD + h * 192), Vg + ((size_t)b * 4096 * 2048 + h * 128),
                      Og + ((size_t)(b * 4096 + qb * 256) * 2048 + h * 128), qb, (LAS char*)lds, P.in[I_GQHEAD], wave); PROBE_END(21);
            if (pr_ && PROBE_K == 26) MISC[21] += (unsigned)(__builtin_amdgcn_s_memrealtime() - ts_);
            if (pr_ && PROBE_K == 27) MISC[21] += 25u * (unsigned)(4 * qb + 4); }
        LOOP_T1(24); }
    }
    xcd_barrier(bar); STAMP(5);
    if (PROBE_K >= 40 && bx == 0 && tid == 0) {
        const int lp = (PROBE_K - 40) >> 1; unsigned long long sum = 0; unsigned mx = 0;
        for (int i = 0; i < G; ++i) { const unsigned v = __hip_atomic_load(ctl + 8192 + lp * 256 + i, __ATOMIC_RELAXED, __HIP_MEMORY_SCOPE_AGENT); sum += v; mx = v > mx ? v : mx; }
        MISC[21] = (PROBE_K & 1) ? mx : (unsigned)(sum / G); }
    if (PH(8)) {
        MergeSched S{(const bf16_t*)(ws + WS_DP), (const bf16_t*)(ws + WS_WPOOL), (const bf16_t*)(ws + WS_OMLA), (const bf16_t*)(ws + WS_WMLAO),
                     (const bf16_t*)(ws + WS_OMEM), (const bf16_t*)(ws + WS_WMEMO), G, bx};
        EpiMerge E{(const bf16_t*)(ws + WS_G), P.in[I_PSCALE], (bf16_t*)(ws + WS_MG), (float*)(ws + WS_Q)};
        pg8::gemm_stream<EpiMerge, MergeSched>(lds, S, E, wave);
        xcd_barrier(bar); STAMP(6);
        { LAUNDER(); reduce_merge((const float*)(ws + WS_Q), (bf16_t*)(ws + WS_MG), gw_l, NGW, lane_l); }
    }
    xcd_barrier(bar); STAMP(7);
    if (PH(9)) {
        TailSched S{(const bf16_t*)(ws + WS_MG), (const bf16_t*)(ws + WS_WOUT), 2048, G, bx};
        EpiOut E{P.in[I_XP], P.in[I_XS], P.out + O_YP, (bf16_t*)(ws + WS_X1B), (float*)(ws + WS_SSX), (float*)(ws + WS_G)};
        pg8::gemm_stream<EpiOut, TailSched>(lds, S, E, wave);
        xcd_barrier(bar); STAMP(8);
        { LAUNDER(); reduce_out((const float*)(ws + WS_G), P.in[I_XS], P.out + O_YP, (bf16_t*)(ws + WS_X1B), (float*)(ws + WS_SSX), gw_l, NGW, lane_l); }
    }
    xcd_barrier(bar); STAMP(9);
    if (PH(10)) {
        UpSched S{(const bf16_t*)(ws + WS_X1B), (const bf16_t*)(ws + WS_WUP), G, bx};
        EpiUp E{(const float*)(ws + WS_SSX), (bf16_t*)(ws + WS_A), (float*)(ws + WS_H)};
        pg8::gemm_stream<EpiUp, UpSched>(lds, S, E, wave);
        xcd_barrier(bar);
        { LAUNDER(); reduce_up((const float*)(ws + WS_H), (const float*)(ws + WS_SSX), (bf16_t*)(ws + WS_A), gw_l, NGW, lane_l); }
    }
    xcd_barrier(bar); STAMP(10);
    if (PH(11)) {
        TailSched S{(const bf16_t*)(ws + WS_A), (const bf16_t*)(ws + WS_WDOWN), 8192, G, bx};
        EpiDown E{P.out + O_YP, (const bf16_t*)(ws + WS_X1B), (float*)(ws + WS_H)};
        pg8::gemm_stream<EpiDown, TailSched>(lds, S, E, wave);
        xcd_barrier(bar); STAMP(11);
        { LAUNDER(); reduce_down((const float*)(ws + WS_H), (const bf16_t*)(ws + WS_X1B), P.out + O_YP, gw_l, NGW, lane_l); }
    }
    if (PROBE_K == 30 && bx == 0) {
        __syncthreads(); unsigned long long ti_ = 0; if (tid == 0) ti_ = __builtin_amdgcn_s_memrealtime();
        pat::unit((const bf16_t*)(ws + WS_Q) + ((size_t)(15 * 256) * QLD), (const bf16_t*)((unsigned char*)P.out + DO_K), (const bf16_t*)(ws + WS_V), (bf16_t*)(ws + WS_OMLA) + ((size_t)(15 * 256) * 2048), 15, (LAS char*)lds, P.in[I_GQHEAD], wave);
        if (tid == 0) MISC[21] = (unsigned)(__builtin_amdgcn_s_memrealtime() - ti_);
    }
    if (PROBE_K == 32 || PROBE_K == 33) {
        __syncthreads(); unsigned long long ti_ = 0; if (tid == 0) ti_ = __builtin_amdgcn_s_memrealtime();
        const int bh_ = PROBE_K == 32 ? (bx & 31) : ((bx >> 3) & 31), b_ = bh_ >> 4, h_ = bh_ & 15;
        pat::unit((const bf16_t*)(ws + WS_Q) + ((size_t)(b_ * 4096 + 15 * 256) * QLD + h_ * 192), (const bf16_t*)((unsigned char*)P.out + DO_K) + ((size_t)b_ * 4096 * QLD + h_ * 192),
                  (const bf16_t*)(ws + WS_V) + ((size_t)b_ * 4096 * 2048 + h_ * 128), (bf16_t*)(ws + WS_OMLA) + ((size_t)(b_ * 4096 + 15 * 256) * 2048 + h_ * 128), 15, (LAS char*)lds, P.in[I_GQHEAD], wave);
        if (tid == 0 && bx == 0) MISC[21] = (unsigned)(__builtin_amdgcn_s_memrealtime() - ti_);
    }
    if ((PROBE_K == 34 || PROBE_K == 35) && bx == 0) {
        __syncthreads(); unsigned long long ti_ = 0; if (tid == 0) ti_ = __builtin_amdgcn_s_memrealtime();
        sat::unit<PROBE_K == 34 ? 1 : 2>(P, 0, 0, (LAS char*)lds, wave);
        if (tid == 0) MISC[21] = (unsigned)(__builtin_amdgcn_s_memrealtime() - ti_);
    }
    if (PROBE_K == 31 && bx == 0) {
        __syncthreads(); unsigned long long ti_ = 0; if (tid == 0) ti_ = __builtin_amdgcn_s_memrealtime();
        sat::unit(P, 0, 0, (LAS char*)lds, wave);
        if (tid == 0) MISC[21] = (unsigned)(__builtin_amdgcn_s_memrealtime() - ti_);
    }
    if (PROBE_K >= 0 && bx == 0) {
        __syncthreads();
        if (tid == 0) { STAMP(12);
            constexpr int PKI = PROBE_K >= 0 && PROBE_K < 13 ? PROBE_K : 0;
            const unsigned long long a_ = ((unsigned long long)MISC[33 + 2 * PKI] << 32) | MISC[32 + 2 * PKI], b_ = ((unsigned long long)MISC[35 + 2 * PKI] << 32) | MISC[34 + 2 * PKI];
            const unsigned long long t0_ = __builtin_amdgcn_s_memrealtime(), dl_ = PROBE_K >= 20 ? 4ull * MISC[21] : 4ull * (b_ - a_);
            while (__builtin_amdgcn_s_memrealtime() - t0_ < dl_) __builtin_amdgcn_s_sleep(16); }
    }
}

extern "C" void kernel_launch(void* const* d_in, const int* in_sizes, int n_in, void* d_out, int out_size, void* d_ws, size_t ws_size, hipStream_t stream) {
    static int grid = 0;
    if (grid == 0) {
        if (n_in != 30 || ws_size < WS_END || out_size != 24164352) { fprintf(stderr, "kernel_launch: unexpected problem: n_in %d out %d ws %zu (need %zu)\n", n_in, out_size, ws_size, (size_t)WS_END); grid = -1; return; }
        int dev = 0, cus = 0, per_cu = 0;
        if (hipGetDevice(&dev) != hipSuccess || hipDeviceGetAttribute(&cus, hipDeviceAttributeMultiprocessorCount, dev) != hipSuccess) { grid = -1; return; }
        if (hipFuncSetAttribute((const void*)mega_fwd, hipFuncAttributeMaxDynamicSharedMemorySize, LDS_BYTES) != hipSuccess) { fprintf(stderr, "kernel_launch: hipFuncSetAttribute(%d) failed\n", LDS_BYTES); grid = -1; return; }
        if (hipOccupancyMaxActiveBlocksPerMultiprocessor(&per_cu, (const void*)mega_fwd, NWAVES * 64, LDS_BYTES) != hipSuccess || per_cu < 1) { fprintf(stderr, "kernel_launch: occupancy query says %d blocks per CU\n", per_cu); grid = -1; (void)hipGetLastError(); return; }
        grid = cus;
    }
    if (grid < 0) return;
    (void)hipMemsetAsync((char*)d_ws + WS_CTL, 0, CTL_ZERO_BYTES, stream);
    Args a{};
    for (int i = 0; i < 30; ++i) a.in[i] = (const float*)d_in[i];
    a.out = (float*)d_out; a.ws = (unsigned char*)d_ws;
    hipLaunchKernelGGL(mega_fwd, dim3(grid), dim3(NWAVES * 64), LDS_BYTES, stream, a);
}
```

```cpp
#include <hip/hip_runtime.h>
#include <cstdio>
#include <cstdint>

#define LAS __attribute__((address_space(3)))
#define GAS __attribute__((address_space(1)))
typedef unsigned short bf16_t;
typedef short bf16x8 __attribute__((ext_vector_type(8)));
typedef short s16x4 __attribute__((ext_vector_type(4)));
typedef float f32x2 __attribute__((ext_vector_type(2)));
typedef float f32x4 __attribute__((ext_vector_type(4)));
typedef float f32x16 __attribute__((ext_vector_type(16)));
typedef unsigned u32x2 __attribute__((ext_vector_type(2)));
typedef unsigned u32x4 __attribute__((ext_vector_type(4)));
typedef __bf16 bf16x2_t __attribute__((ext_vector_type(2)));

constexpr int DM = 2048, TP = 8192, TS = 512, TT = TP + TS, SEQ = 4096, LS = 32, NBS = 16;
constexpr int KPAD = 4160;
constexpr int ZS_LD = 3136, G_LD = 6144, QLD = 3072, NHEAD = 16;
constexpr float EPS = 1e-6f;
constexpr float MLA_C = 0.07216878364870322f * 1.4426950408889634f;
constexpr float MEM_C = 0.0625f * 1.4426950408889634f;
constexpr size_t O_YP = 0, O_YS = 16777216, O_LATP = 17825792, O_KPEP = 22020096, O_POOLP = 22544384, O_MEMK = 22575104, O_MEMV = 23099392,
                 O_LATS = 23623680, O_KPES = 23885824, O_POOLS = 23918592;
constexpr size_t MiB = 1u << 20;
constexpr size_t WS_CTL = 0, CTL_ZERO_BYTES = 1 * MiB;
constexpr size_t WS_WIN = 1 * MiB, WS_WMEMKV = 38 * MiB, WS_WQB = 46 * MiB, WS_WKB = 49 * MiB, WS_WVB = 51 * MiB, WS_WKBN = 53 * MiB, WS_WPOOL = 55 * MiB,
                 WS_WMLAO = 56 * MiB, WS_WMEMO = 64 * MiB, WS_WOUT = 68 * MiB, WS_WUP = 76 * MiB, WS_WDOWN = 108 * MiB;
constexpr size_t WS_G = 140 * MiB, WS_ZS = 242 * MiB, WS_Q = 242 * MiB, WS_A = 140 * MiB;
constexpr size_t WS_LATS = 295 * MiB, WS_KRS = 360 * MiB, WS_KPESS = 368 * MiB + 512 * 1024, WS_MG = 295 * MiB, WS_X1B = 329 * MiB;
constexpr size_t WS_H = 369 * MiB, WS_DP = 369 * MiB, WS_QN = 386 * MiB, WS_OMEM = 386 * MiB, WS_OMLA = 1 * MiB;
constexpr size_t WS_RKG = 403 * MiB;
constexpr size_t WS_HM = 403 * MiB, WS_M = 405 * MiB, WS_QM = 409 * MiB, WS_V = 426 * MiB, WS_KSS = 458 * MiB, WS_MK = 475 * MiB, WS_MVT = 484 * MiB,
                 WS_KRP = 493 * MiB, WS_KPESSP = 494 * MiB, WS_SSX = 494 * MiB + 256 * 1024,
                 WS_PM = 496 * MiB  , WS_PS = 514 * MiB  , WS_END = 515 * MiB;
constexpr size_t DO_K = 0, DO_CKVP = 56 * MiB;

constexpr int LDS_BYTES = 160 * 1024, MISC_OFF = LDS_BYTES - 256;
constexpr int NWAVES = 8;

#define LDS_WAIT() asm volatile("s_waitcnt lgkmcnt(0)" ::: "memory")
#define VM_WAIT() asm volatile("s_waitcnt vmcnt(0)" ::: "memory")
#define SBAR() __builtin_amdgcn_sched_barrier(0)
__device__ __forceinline__ unsigned cvtpk(float lo, float hi) { f32x2 v = {lo, hi}; bf16x2_t b = __builtin_convertvector(v, bf16x2_t); return __builtin_bit_cast(unsigned, b); }
__device__ __forceinline__ float bflo(unsigned u) { return __uint_as_float(u << 16); }
__device__ __forceinline__ float bfhi(unsigned u) { return __uint_as_float(u & 0xffff0000u); }
__device__ __forceinline__ float bf2f(bf16_t b) { return __uint_as_float((unsigned)b << 16); }
__device__ __forceinline__ bf16_t f2bf(float f) { return (bf16_t)(cvtpk(f, 0.f) & 0xffffu); }
__device__ __forceinline__ float wave_sum(float v) {
#pragma unroll
    for (int o = 1; o < 64; o <<= 1) v += __shfl_xor(v, o);
    return v;
}
__device__ __forceinline__ int lane_id() { int r; asm volatile("v_mbcnt_lo_u32_b32 %0, -1, 0\n\tv_mbcnt_hi_u32_b32 %0, -1, %0" : "=v"(r)); return r; }
__device__ __forceinline__ int crow(int r, int hi) { return (r & 3) + 8 * (r >> 2) + 4 * hi; }
__device__ __forceinline__ void fast_sincos(float ang, float& sn, float& cs) {
    float t = ang * 0.15915494309189535f; t = t - floorf(t);
    sn = __builtin_amdgcn_sinf(t); cs = __builtin_amdgcn_cosf(t);
}
__device__ __forceinline__ float rope_inv(int j) { return __builtin_amdgcn_exp2f(-(float)j * (13.287712379549449f / 32.0f)); }

typedef short v4i16_t __attribute__((ext_vector_type(4)));
__device__ __forceinline__ s16x4 vtr(const LAS char* p) { return __builtin_bit_cast(s16x4, __builtin_amdgcn_ds_read_tr16_b64_v4i16((LAS v4i16_t*)p)); }
#define PKV(L, H) (bf16x8){L[0], L[1], L[2], L[3], H[0], H[1], H[2], H[3]}

#define XB_TMO      128
#define XB_XCNT(j)  (256  + 64 * (j))
#define XB_XSUB(j)  (1280 + 64 * (j))
#define XB_XGEN(j)  (2304 + 64 * (j))
#define XB_TOP      3328
#define XB_TOPGEN   3392
#define XCD_BAR_WORDS 3456
#define XB_SPIN_CAP (1u << 20)
__device__ __forceinline__ unsigned xb_ld(unsigned* p)              { return __hip_atomic_load(p, __ATOMIC_RELAXED, __HIP_MEMORY_SCOPE_AGENT); }
__device__ __forceinline__ unsigned xb_add(unsigned* p, unsigned v) { return __hip_atomic_fetch_add(p, v, __ATOMIC_RELAXED, __HIP_MEMORY_SCOPE_AGENT); }
__device__ __forceinline__ unsigned xb_xcc_id() { return (unsigned)__builtin_amdgcn_s_getreg((3 << 11) | 20) & 0xFu; }
#define XB_SPIN(cond, bar) do { unsigned _sp = 0; while (cond) { __builtin_amdgcn_s_sleep(1); \
    if ((++_sp & 255u) == 0u) { if (xb_ld(&(bar)[XB_TMO])) break; if (_sp > XB_SPIN_CAP) { atomicAdd(&(bar)[XB_TMO], 1u); break; } } } } while (0)
struct XcdBarrier { unsigned* bar; unsigned x; volatile LAS unsigned* st; int wv; };
__device__ __forceinline__ XcdBarrier xcd_barrier_post(unsigned* bar, volatile LAS unsigned* st) {
    XcdBarrier b; b.bar = bar; b.x = xb_xcc_id(); b.st = st; b.wv = 0;
    if (threadIdx.x == 0) (void)xb_add(&bar[XB_XCNT(b.x)], 1u);
    return b;
}
__device__ __forceinline__ void xcd_barrier_complete(unsigned* bar, unsigned x, unsigned& nloc, unsigned& nx) {
    const unsigned G = gridDim.x * gridDim.y * gridDim.z;
    unsigned sum, cnt, mine, sp = 0u;
    for (;;) {
        sum = 0u; cnt = 0u; mine = 0u;
#pragma unroll
        for (unsigned j = 0; j < 16; ++j) { const unsigned c = xb_ld(&bar[XB_XCNT(j)]); sum += c; cnt += (c > 0u) ? 1u : 0u; mine = (j == x) ? c : mine; }
        if (sum == G) break;
        __builtin_amdgcn_s_sleep(1);
        if ((++sp & 255u) == 0u) { if (xb_ld(&bar[XB_TMO])) break; if (sp > XB_SPIN_CAP) { atomicAdd(&bar[XB_TMO], 1u); break; } }
    }
    nloc = mine > 0u ? mine : 1u; nx = cnt > 0u ? cnt : 1u;
}
__device__ __forceinline__ void xcd_barrier(const XcdBarrier& b) {
    asm volatile("s_waitcnt vmcnt(0)" ::: "memory");
    __syncthreads();
    if (threadIdx.x == 0) {
        unsigned* bar = b.bar;
        __builtin_amdgcn_s_waitcnt(0);
        unsigned nloc = b.st[0], nx = b.st[1];
        if (nloc == 0u) { xcd_barrier_complete(bar, b.x, nloc, nx); b.st[0] = nloc; b.st[1] = nx; }
        const unsigned old = xb_add(&bar[XB_XSUB(b.x)], 1u);
        const unsigned gen = old / nloc;
        if (old + 1u == (gen + 1u) * nloc) {
            __builtin_amdgcn_fence(__ATOMIC_RELEASE, "agent");
            asm volatile("s_waitcnt vmcnt(0)" ::: "memory");
            const unsigned og = xb_add(&bar[XB_TOP], 1u);
            const unsigned tg = og / nx;
            if (og + 1u == (tg + 1u) * nx) xb_add(&bar[XB_TOPGEN], 1u);
            else XB_SPIN(xb_ld(&bar[XB_TOPGEN]) == tg, bar);
            __builtin_amdgcn_fence(__ATOMIC_ACQUIRE, "agent");
            xb_add(&bar[XB_XGEN(b.x)], 1u);
            asm volatile("s_waitcnt vmcnt(0)" ::: "memory");
        } else {
            XB_SPIN(xb_ld(&bar[XB_XGEN(b.x)]) == gen, bar);
            __builtin_amdgcn_fence(__ATOMIC_ACQUIRE, "agent");
            asm volatile("s_waitcnt vmcnt(0)" ::: "memory");
        }
    }
    __syncthreads();
}

namespace pg8 {
constexpr int BM = 256, BK = 64, HALF = 128, HTB = HALF * BK * 2, STAGE_BYTES = 8 * HTB, NXCD = 8, WGM = 8;
__device__ __forceinline__ int lds_byte(int r, int c) { const int st = (r >> 4) * 2 + (c >> 5), rr = r & 15, cc = c & 31, ob = rr * 64 + cc * 2; return st * 1024 + (ob ^ (((ob >> 9) & 1) << 5)); }
__device__ __forceinline__ void stage_rc(int b, int& R, int& C) { const int st = b / 1024, sb = b % 1024, swz = sb ^ (((sb >> 9) & 1) << 5); R = (st >> 1) * 16 + swz / 64; C = (st & 1) * 32 + (swz % 64) / 2; }
__device__ __forceinline__ int perm32(int rho) { const int n = rho >> 4, i = rho & 15; return 8 * (i >> 2) + 4 * n + (i & 3); }

struct Unit { const char* A; const char* B; unsigned lda2, ldb2; int nt, pm, pn, kind, aux; };

__device__ __forceinline__ void tile_of(int wgid, int nM, int nN, int& pm, int& pn) {
    const int nwg = nM * nN;
    { const int q = nwg / NXCD, r = nwg % NXCD, xcd = wgid % NXCD, off = wgid / NXCD; wgid = (xcd < r ? xcd * (q + 1) : r * (q + 1) + (xcd - r) * q) + off; }
    const int nig = WGM * nN, gid = wgid / nig, fm = gid * WGM, gsz = (nM - fm) < WGM ? (nM - fm) : WGM;
    pm = fm + ((wgid % nig) % gsz); pn = (wgid % nig) / gsz;
}

struct Job { const bf16_t* A; const bf16_t* B; int lda, K, nM, nN, kind; };
struct JobSched1 {
    Job j0; int G, c;
    __device__ __forceinline__ void finish(int G_, int c_) { G = G_; c = c_; }
    __device__ __forceinline__ bool next(int i, Unit& u) const {
        const long L = (long)i * G + c; if (L >= j0.nM * j0.nN) return false;
        int pm, pn; tile_of((int)L, j0.nM, j0.nN, pm, pn);
        u.A = (const char*)(j0.A + (size_t)pm * BM * j0.lda); u.B = (const char*)(j0.B + (size_t)pn * BM * j0.K);
        u.lda2 = (unsigned)j0.lda * 2u; u.ldb2 = (unsigned)j0.K * 2u; u.nt = j0.K / BK; u.pm = pm; u.pn = pn; u.kind = j0.kind; return true;
    }
};

#define PG8_SA(b, h) (((b) * 2 + (h)) * HTB)
#define PG8_SB(b, h) ((4 + (b) * 2 + (h)) * HTB)
#define PG8_STAGE(bufoff, gbase, Rv, ld2) do { const unsigned _vo = (unsigned)(Rv) * (ld2) + c2; \
        __builtin_amdgcn_global_load_lds((const unsigned*)((gbase) + _vo), (LAS unsigned*)(lds + (bufoff) + ldsw), 16, 0, 0); \
        __builtin_amdgcn_global_load_lds((const unsigned*)((gbase) + 64u * (ld2) + _vo), (LAS unsigned*)(lds + (bufoff) + ldsw + 8192), 16, 0, 0); } while (0)
#define PG8_LDA(dst, b, h) do { _Pragma("unroll") for (int m = 0; m < 4; ++m) _Pragma("unroll") for (int k = 0; k < 2; ++k) dst[m][k] = *(const LAS bf16x8*)(lds + PG8_SA(b, h) + aoff + m * 2048 + k * 1024); } while (0)
#define PG8_LDB(dst, b, h) do { _Pragma("unroll") for (int n = 0; n < 2; ++n) _Pragma("unroll") for (int k = 0; k < 2; ++k) dst[n][k] = *(const LAS bf16x8*)(lds + PG8_SB(b, h) + boff + n * 2048 + k * 1024); } while (0)
#define PG8_MMA(ai, bj, At, Bt) do { __builtin_amdgcn_s_setprio(1); _Pragma("unroll") for (int m = 0; m < 4; ++m) _Pragma("unroll") for (int n = 0; n < 2; ++n) _Pragma("unroll") for (int k = 0; k < 2; ++k) \
        acc[ai][bj][m][n] = __builtin_amdgcn_mfma_f32_16x16x32_bf16(Bt[n][k], At[m][k], acc[ai][bj][m][n], 0, 0, 0); __builtin_amdgcn_s_setprio(0); } while (0)
#define PG8_WAIT_V(n) asm volatile("s_waitcnt vmcnt(" #n ")" ::: "memory")
#define PG8_WAIT_L(n) asm volatile("s_waitcnt lgkmcnt(" #n ")" ::: "memory")
#define PG8_BAR __builtin_amdgcn_s_barrier()
#define PG8_SCHED __builtin_amdgcn_sched_barrier(0)

template <class Epi, class Sched>
__device__ __forceinline__ void gemm_stream(LAS unsigned char* lds, const Sched& S, const Epi& E, int wv) {
    int wvl = wv; asm volatile("" : "+s"(wvl)); int tid = wvl * 64 + lane_id(); asm volatile("" : "+v"(tid));
    const int wid = __builtin_amdgcn_readfirstlane(tid >> 6), lane = tid & 63, wr = wid >> 2, wc = wid & 3, fr = lane & 15, fq = lane >> 4;
    int R0, C0; stage_rc(tid * 16, R0, C0);
    const int Rb0 = Epi::PERM ? ((R0 & ~31) + perm32(R0 & 31)) : R0;
    const unsigned c2 = (unsigned)C0 * 2u;
    const unsigned ldsw = (unsigned)wid * 1024u;
    const int aoff = lds_byte(wr * 64 + fr, fq * 8), boff = lds_byte(wc * 32 + fr, fq * 8);
    Unit cur, nxt; int ui = 0;
    if (!S.next(0, cur)) return;
    f32x4 acc[2][2][4][2];
#pragma unroll
    for (int a = 0; a < 2; ++a)
#pragma unroll
        for (int b = 0; b < 2; ++b)
#pragma unroll
            for (int m = 0; m < 4; ++m)
#pragma unroll
                for (int n = 0; n < 2; ++n) acc[a][b][m][n] = (f32x4){0.f, 0.f, 0.f, 0.f};
    bf16x8 At[4][2], B0[2][2], B1[2][2];
    const char* cA = cur.A; const char* cB = cur.B; unsigned la = cur.lda2, lb = cur.ldb2;
    const size_t kstep = (size_t)(BK * 2);
    PG8_STAGE(PG8_SB(0, 0), cB, Rb0, lb); PG8_STAGE(PG8_SB(0, 1), cB + (size_t)HALF * lb, Rb0, lb); PG8_STAGE(PG8_SA(0, 0), cA, R0, la); PG8_STAGE(PG8_SA(0, 1), cA + (size_t)HALF * la, R0, la);
    if (wr == 1) PG8_BAR;
    PG8_WAIT_V(2); PG8_BAR;
    PG8_STAGE(PG8_SB(1, 0), cB + kstep, Rb0, lb); PG8_STAGE(PG8_SA(1, 0), cA + kstep, R0, la); PG8_STAGE(PG8_SB(1, 1), cB + (size_t)HALF * lb + kstep, Rb0, lb);
    PG8_WAIT_V(6); PG8_BAR;
    for (;;) {
        const bool has_next = S.next(ui + 1, nxt);
        const char* nA = has_next ? nxt.A : cA; const char* nB = has_next ? nxt.B : cB;
        const unsigned nla = has_next ? nxt.lda2 : la, nlb = has_next ? nxt.ldb2 : lb;
        const int nt = cur.nt;
        for (int t = 0; t < nt; t += 2) {
            const bool last = (t == nt - 2);
            const char* a1 = cA + (size_t)(t + 1) * kstep;
            const char* a2 = last ? nA : cA + (size_t)(t + 2) * kstep; const char* b2 = last ? nB : cB + (size_t)(t + 2) * kstep;
            const unsigned la2 = last ? nla : la, lb2 = last ? nlb : lb;
            const char* a3 = a2 + kstep; const char* b3 = b2 + kstep;
            PG8_LDB(B0, 0, 0); PG8_LDB(B1, 0, 1); PG8_SCHED; PG8_LDA(At, 0, 0); PG8_STAGE(PG8_SA(1, 1), a1 + (size_t)HALF * la, R0, la);
            PG8_WAIT_V(8); PG8_WAIT_L(0); PG8_BAR; PG8_MMA(0, 0, At, B0); PG8_MMA(0, 1, At, B1); PG8_BAR; PG8_SCHED;
            PG8_LDA(At, 0, 1); PG8_STAGE(PG8_SB(0, 0), b2, Rb0, lb2); PG8_STAGE(PG8_SB(0, 1), b2 + (size_t)HALF * lb2, Rb0, lb2); PG8_STAGE(PG8_SA(0, 0), a2, R0, la2);
            PG8_WAIT_V(8); PG8_WAIT_L(0); PG8_BAR; PG8_MMA(1, 0, At, B0); PG8_MMA(1, 1, At, B1); PG8_BAR; PG8_SCHED;
            PG8_LDB(B0, 1, 0); PG8_LDB(B1, 1, 1); PG8_SCHED; PG8_LDA(At, 1, 0); PG8_STAGE(PG8_SA(0, 1), a2 + (size_t)HALF * la2, R0, la2);
            PG8_WAIT_V(8); PG8_WAIT_L(0); PG8_BAR; PG8_MMA(0, 0, At, B0); PG8_MMA(0, 1, At, B1); PG8_BAR; PG8_SCHED;
            PG8_LDA(At, 1, 1); PG8_STAGE(PG8_SB(1, 0), b3, Rb0, lb2); PG8_STAGE(PG8_SB(1, 1), b3 + (size_t)HALF * lb2, Rb0, lb2); PG8_STAGE(PG8_SA(1, 0), a3, R0, la2);
            PG8_WAIT_V(8); PG8_WAIT_L(0); PG8_BAR; PG8_MMA(1, 0, At, B0); PG8_MMA(1, 1, At, B1); PG8_BAR; PG8_SCHED;
        }
        if (wr == 0) PG8_BAR;
        const bool keep = E(acc, cur, wr, wc, fr, fq);
        if (!has_next) break;
        if (!keep) {
#pragma unroll
            for (int a = 0; a < 2; ++a)
#pragma unroll
                for (int b = 0; b < 2; ++b)
#pragma unroll
                    for (int m = 0; m < 4; ++m)
#pragma unroll
                        for (int n = 0; n < 2; ++n) acc[a][b][m][n] = (f32x4){0.f, 0.f, 0.f, 0.f};
        }
        cur = nxt; cA = nA; cB = nB; la = nla; lb = nlb; ++ui;
        if (wr == 1) PG8_BAR;
    }
    PG8_WAIT_V(0);
    PG8_BAR;
}
}

struct Args { const float* in[30]; float* out; unsigned char* ws; };
enum { I_XP = 0, I_MEMP, I_XS, I_CLAT, I_CKPE, I_SPOOL, I_CMK, I_CMV, I_GMIX, I_WIN, I_BGATE, I_WPOOL, I_PSCALE, I_GQLAT, I_WQB, I_GQHEAD, I_GKVLAT, I_WKB, I_WVB,
       I_GKHEAD, I_WMLAO, I_GMEM, I_WMEMKV, I_GMEMQ, I_GMEMK, I_WMEMO, I_WOUT, I_GFF, I_WUP, I_WDOWN };

__device__ __forceinline__ void transpose_item(const float* __restrict__ W, int ldw, int K, bf16_t* __restrict__ WT, LAS unsigned char* scr, int kb, int n0src, int nrow_dst, int lane, const float* __restrict__ kscale) {
    const int k0 = 64 * kb, kq = lane >> 4, cq = lane & 15;
    f32x4 v[16];
#pragma unroll
    for (int i = 0; i < 16; ++i) v[i] = __builtin_nontemporal_load((const f32x4*)(W + (size_t)(k0 + 4 * i + kq) * ldw + n0src + cq * 4));
#pragma unroll
    for (int i = 0; i < 16; ++i) { const int kk = 4 * i + kq; f32x4 x = v[i]; if (kscale) x = x * kscale[k0 + kk];
        const int fk = (kk & 2) | ((kk & 8) >> 1);
        *(LAS u32x2*)(scr + kk * 128 + (((cq >> 1) ^ fk) << 4) + (cq & 1) * 8) = (u32x2){cvtpk(x.x, x.y), cvtpk(x.z, x.w)}; }
    LDS_WAIT(); asm volatile("" ::: "memory");
    const int g = lane >> 4, i16 = lane & 15;
#pragma unroll
    for (int s = 0; s < 8; ++s) { const int nb = s >> 1, c = (s & 1) * 4 + g;
        const int ka = 8 * c + (i16 >> 2), kb2 = ka + 4, chunk = 2 * nb + ((i16 & 3) >> 1);
        const int fa = (ka & 2) | ((ka & 8) >> 1), fb = (kb2 & 2) | ((kb2 & 8) >> 1);
        const s16x4 lo = vtr((const LAS char*)scr + ka * 128 + ((chunk ^ fa) << 4) + (i16 & 1) * 8);
        const s16x4 hi = vtr((const LAS char*)scr + kb2 * 128 + ((chunk ^ fb) << 4) + (i16 & 1) * 8);
        *(bf16x8*)(WT + (size_t)(nrow_dst + 16 * nb + i16) * K + k0 + 8 * c) = PKV(lo, hi); }
    LDS_WAIT(); asm volatile("" ::: "memory");
}
__device__ __forceinline__ void rms_row_2048(const float* __restrict__ xrow, const float* __restrict__ g, bf16_t* __restrict__ orow, int lane) {
    const f32x4* xr = (const f32x4*)xrow + lane; const f32x4* gr = (const f32x4*)g + lane;
    f32x4 v[8]; float s = 0.f;
#pragma unroll
    for (int j = 0; j < 8; ++j) { v[j] = __builtin_nontemporal_load(xr + 64 * j); s += (v[j].x * v[j].x + v[j].y * v[j].y) + (v[j].z * v[j].z + v[j].w * v[j].w); }
    const float r = rsqrtf(wave_sum(s) * (1.f / 2048.f) + EPS);
    u32x2* o8 = (u32x2*)orow + lane;
#pragma unroll
    for (int j = 0; j < 8; ++j) { const f32x4 gg = gr[64 * j]; u32x2 w; w.x = cvtpk(v[j].x * r * gg.x, v[j].y * r * gg.y); w.y = cvtpk(v[j].z * r * gg.z, v[j].w * r * gg.w); o8[64 * j] = w; }
}
__device__ __forceinline__ float rope_lane(float w, int lane, float pos) {
    const float partner = __shfl_xor(w, 32);
    float sn, cs; fast_sincos(pos * rope_inv(lane & 31), sn, cs);
    return lane < 32 ? w * cs - partner * sn : w * cs + partner * sn;
}

__device__ __forceinline__ void phase_prep(const Args& P, LAS unsigned char* lds, int gw, int NGW, int wave, int lane) {
    unsigned char* ws = P.ws;
    LAS unsigned char* scr = lds + wave * 16384;
    {
        constexpr int I_IN = 32 * 145, I_MKV = 32 * 32, I_QB = 8 * 48, I_KB = 8 * 32, I_VB = 8 * 32, I_PL = 4 * 4 * 8, I_MLAO = 32 * 32, I_MEMO = 16 * 32, I_OUT = 32 * 32, I_UP = 32 * 128, I_DN = 128 * 32,
                      I_MV = 16 * 4 * 16;
        constexpr int NITEMS = I_IN + I_MKV + I_QB + I_KB + I_VB + I_PL + I_MLAO + I_MEMO + I_OUT + I_UP + I_DN + I_MV;
        for (int it = gw; it < NITEMS; it += NGW) {
            int r = it;
            if (r < I_IN) { const int kb = r / 145, nb = r % 145, n0 = nb * 64; const int nd = n0 < 2048 ? n0 : (n0 < 2112 ? 9216 + (n0 - 2048) : n0 - 64);
                transpose_item(P.in[I_WIN], 9280, 2048, (bf16_t*)(ws + WS_WIN), scr, kb, n0, nd, lane, nullptr); continue; } r -= I_IN;
            if (r < I_MKV) { transpose_item(P.in[I_WMEMKV], 2048, 2048, (bf16_t*)(ws + WS_WMEMKV), scr, r / 32, (r % 32) * 64, (r % 32) * 64, lane, nullptr); continue; } r -= I_MKV;
            if (r < I_QB) { transpose_item(P.in[I_WQB], 3072, 512, (bf16_t*)(ws + WS_WQB), scr, r / 48, (r % 48) * 64, (r % 48) * 64, lane, nullptr); continue; } r -= I_QB;
            if (r < I_KB) { transpose_item(P.in[I_WKB], 2048, 512, (bf16_t*)(ws + WS_WKB), scr, r / 32, (r % 32) * 64, (r % 32) * 64, lane, nullptr); continue; } r -= I_KB;
            if (r < I_VB) { transpose_item(P.in[I_WVB], 2048, 512, (bf16_t*)(ws + WS_WVB), scr, r / 32, (r % 32) * 64, (r % 32) * 64, lane, nullptr); continue; } r -= I_VB;
            if (r < I_PL) { const int g = r / 32, q = r % 32; transpose_item(P.in[I_WPOOL] + (size_t)g * 256 * 512, 512, 256, (bf16_t*)(ws + WS_WPOOL), scr, q / 8, (q % 8) * 64, g * 512 + (q % 8) * 64, lane, nullptr); continue; } r -= I_PL;
            if (r < I_MLAO) { transpose_item(P.in[I_WMLAO], 2048, 2048, (bf16_t*)(ws + WS_WMLAO), scr, r / 32, (r % 32) * 64, (r % 32) * 64, lane, nullptr); continue; } r -= I_MLAO;
            if (r < I_MEMO) { transpose_item(P.in[I_WMEMO], 2048, 1024, (bf16_t*)(ws + WS_WMEMO), scr, r / 32, (r % 32) * 64, (r % 32) * 64, lane, nullptr); continue; } r -= I_MEMO;
            if (r < I_OUT) { transpose_item(P.in[I_WOUT], 2048, 2048, (bf16_t*)(ws + WS_WOUT), scr, r / 32, (r % 32) * 64, (r % 32) * 64, lane, nullptr); continue; } r -= I_OUT;
            if (r < I_UP) { transpose_item(P.in[I_WUP], 8192, 2048, (bf16_t*)(ws + WS_WUP), scr, r / 128, (r % 128) * 64, (r % 128) * 64, lane, P.in[I_GFF]); continue; } r -= I_UP;
            if (r < I_DN) { transpose_item(P.in[I_WDOWN], 2048, 8192, (bf16_t*)(ws + WS_WDOWN), scr, r / 32, (r % 32) * 64, (r % 32) * 64, lane, nullptr); continue; } r -= I_DN;
            { const int b = r / 64, q = r % 64;
              transpose_item(P.in[I_CMV] + (size_t)b * 262144, 1024, 256, (bf16_t*)(ws + WS_MVT) + (size_t)(2 + b) * 262144, scr, q / 16, (q % 16) * 64, (q % 16) * 64, lane, nullptr); }
        }
    }
    for (int m = gw; m < TT + 512; m += NGW) {
        if (m < TP) rms_row_2048(P.in[I_XP] + (size_t)m * DM, P.in[I_GMIX], (bf16_t*)(ws + WS_H) + (size_t)m * DM, lane);
        else if (m < TT) rms_row_2048(P.in[I_XS] + (size_t)(m - TP) * DM, P.in[I_GMIX], (bf16_t*)(ws + WS_H) + (size_t)m * DM, lane);
        else rms_row_2048(P.in[I_MEMP] + (size_t)(m - TT) * DM, P.in[I_GMEM], (bf16_t*)(ws + WS_HM) + (size_t)(m - TT) * DM, lane);
    }
    {
        bf16_t* KRs = (bf16_t*)(ws + WS_KRS); float* KPESS = (float*)(ws + WS_KPESS); bf16_t* LATs = (bf16_t*)(ws + WS_LATS);
        const float gk = P.in[I_GKHEAD][128 + lane];
        const float inv = rope_inv(lane & 31);
        for (int pos = gw; pos < 4096; pos += NGW) {
            float sn, cs; fast_sincos((float)pos * inv, sn, cs);
            float v[NBS];
#pragma unroll
            for (int b = 0; b < NBS; ++b) v[b] = __builtin_nontemporal_load(P.in[I_CKPE] + ((size_t)b * 4096 + pos) * 64 + lane);
#pragma unroll
            for (int b = 0; b < NBS; ++b) { const float ss = wave_sum(v[b] * v[b]); const float w = v[b] * gk, pr = __shfl_xor(w, 32);
                const float o = lane < 32 ? w * cs - pr * sn : w * cs + pr * sn;
                const size_t kidx = (size_t)b * KPAD + pos; KRs[kidx * 64 + lane] = f2bf(o); if (lane == 0) KPESS[kidx] = ss; } }
        for (int rr = gw; rr < NBS * 32; rr += NGW) { const size_t kidx = (size_t)(rr >> 5) * KPAD + 4128 + (rr & 31);
            KRs[kidx * 64 + lane] = 0; if (lane == 0) KPESS[kidx] = 0.f;
            *(u32x4*)(LATs + kidx * 512 + lane * 8) = (u32x4){0u, 0u, 0u, 0u}; }
    }
    {
        const long tid_g = (long)gw * 64 + lane, NT_G = (long)NGW * 64;
        bf16_t* LATs = (bf16_t*)(ws + WS_LATS);
        for (long i0 = tid_g; i0 < (long)NBS * 4096 * 64; i0 += 4 * NT_G) {
            f32x4 a[4], c[4];
#pragma unroll
            for (int q = 0; q < 4; ++q) { long i = i0 + q * NT_G; if (i >= (long)NBS * 4096 * 64) i = i0; a[q] = __builtin_nontemporal_load((const f32x4*)(P.in[I_CLAT] + i * 8)); c[q] = __builtin_nontemporal_load((const f32x4*)(P.in[I_CLAT] + i * 8 + 4)); }
#pragma unroll
            for (int q = 0; q < 4; ++q) { long i = i0 + q * NT_G; if (i >= (long)NBS * 4096 * 64) i = i0; const long b = i >> 18, rem = i & 262143;
                *(u32x4*)(LATs + (size_t)b * KPAD * 512 + rem * 8) = (u32x4){cvtpk(a[q].x, a[q].y), cvtpk(a[q].z, a[q].w), cvtpk(c[q].x, c[q].y), cvtpk(c[q].z, c[q].w)}; } }
        bf16_t* MKs = (bf16_t*)(ws + WS_MK) + (size_t)2 * 262144;
        for (long i0 = tid_g; i0 < (long)NBS * 262144 / 8; i0 += 4 * NT_G) {
            f32x4 a[4], c[4];
#pragma unroll
            for (int q = 0; q < 4; ++q) { long i = i0 + q * NT_G; if (i >= (long)NBS * 262144 / 8) i = i0; a[q] = __builtin_nontemporal_load((const f32x4*)(P.in[I_CMK] + i * 8)); c[q] = __builtin_nontemporal_load((const f32x4*)(P.in[I_CMK] + i * 8 + 4)); }
#pragma unroll
            for (int q = 0; q < 4; ++q) { long i = i0 + q * NT_G; if (i >= (long)NBS * 262144 / 8) i = i0;
                *(u32x4*)(MKs + i * 8) = (u32x4){cvtpk(a[q].x, a[q].y), cvtpk(a[q].z, a[q].w), cvtpk(c[q].x, c[q].y), cvtpk(c[q].z, c[q].w)}; } }
        bf16_t* WKN = (bf16_t*)(ws + WS_WKBN);
        for (long i = tid_g; i < 512L * 2048 / 8; i += NT_G) {
            const f32x4 a = *(const f32x4*)(P.in[I_WKB] + i * 8), c = *(const f32x4*)(P.in[I_WKB] + i * 8 + 4);
            *(u32x4*)(WKN + i * 8) = (u32x4){cvtpk(a.x, a.y), cvtpk(a.z, a.w), cvtpk(c.x, c.y), cvtpk(c.z, c.w)}; }
    }
}

struct EpiIn {
    static constexpr bool PERM = true;
    bf16_t* ZS; bf16_t* G; float* M; const float* bgate;
    __device__ __forceinline__ bool operator()(f32x4 (&acc)[2][2][4][2], const pg8::Unit& u, int wr, int wc, int fr_, int fq) const {
        int fr = fr_; asm volatile("" : "+v"(fr));
        const int row0 = u.pm * 256 + wr * 64 + fr, ct = wc * 32 + 8 * fq;
        if (u.kind == 1) {
#pragma unroll
            for (int ai = 0; ai < 2; ++ai)
#pragma unroll
                for (int m = 0; m < 4; ++m) { float* rp = M + (size_t)(row0 + ai * 128 + m * 16) * 2048 + u.pn * 256 + ct;
#pragma unroll
                    for (int bj = 0; bj < 2; ++bj) { *(f32x4*)(rp + bj * 128) = acc[ai][bj][m][0]; *(f32x4*)(rp + bj * 128 + 4) = acc[ai][bj][m][1]; } }
            return false;
        }
        const int pn = u.pn;
        if (pn >= 12 && pn < 36) {
            const int gc = (pn - 12) * 256 + ct;
            f32x4 bv[2][2];
#pragma unroll
            for (int bj = 0; bj < 2; ++bj) { bv[bj][0] = *(const f32x4*)(bgate + gc + bj * 128); bv[bj][1] = *(const f32x4*)(bgate + gc + bj * 128 + 4); }
#pragma unroll
            for (int ai = 0; ai < 2; ++ai)
#pragma unroll
                for (int m = 0; m < 4; ++m) { bf16_t* rp = G + (size_t)(row0 + ai * 128 + m * 16) * G_LD + gc;
#pragma unroll
                    for (int bj = 0; bj < 2; ++bj) { f32x4 v0 = acc[ai][bj][m][0] + bv[bj][0], v1 = acc[ai][bj][m][1] + bv[bj][1];
#pragma unroll
                        for (int e = 0; e < 4; ++e) { v0[e] = __builtin_amdgcn_rcpf(1.f + __builtin_amdgcn_exp2f(-1.4426950408889634f * v0[e])); v1[e] = __builtin_amdgcn_rcpf(1.f + __builtin_amdgcn_exp2f(-1.4426950408889634f * v1[e])); }
                        __builtin_nontemporal_store((u32x4){cvtpk(v0[0], v0[1]), cvtpk(v0[2], v0[3]), cvtpk(v1[0], v1[1]), cvtpk(v1[2], v1[3])}, (u32x4*)(rp + bj * 128)); } }
            return false;
        }
        const int zc = (pn < 12 ? pn * 256 : 3072) + ct;
#pragma unroll
        for (int ai = 0; ai < 2; ++ai)
#pragma unroll
            for (int m = 0; m < 4; ++m) { bf16_t* rp = ZS + (size_t)(row0 + ai * 128 + m * 16) * ZS_LD + zc;
#pragma unroll
                for (int bj = 0; bj < 2; ++bj) { if (pn == 36 && (bj == 1 || wc >= 2)) continue;
                    const f32x4 v0 = acc[ai][bj][m][0], v1 = acc[ai][bj][m][1];
                    *(u32x4*)(rp + bj * 128) = (u32x4){cvtpk(v0[0], v0[1]), cvtpk(v0[2], v0[3]), cvtpk(v1[0], v1[1]), cvtpk(v1[2], v1[3])}; } }
        return false;
    }
};

__device__ __forceinline__ void unpack8(const u32x4 w, float (&f)[8]) { f[0] = bflo(w.x); f[1] = bfhi(w.x); f[2] = bflo(w.y); f[3] = bfhi(w.y); f[4] = bflo(w.z); f[5] = bfhi(w.z); f[6] = bflo(w.w); f[7] = bfhi(w.w); }
__device__ __forceinline__ u32x4 pack8(const float (&f)[8]) { return (u32x4){cvtpk(f[0], f[1]), cvtpk(f[2], f[3]), cvtpk(f[4], f[5]), cvtpk(f[6], f[7])}; }

__device__ __forceinline__ void phase_rows(const Args& P, LAS unsigned char* lds, int gw, int NGW, int wave, int lane) {
    unsigned char* ws = P.ws; float* out = P.out;
    const bf16_t* ZS = (const bf16_t*)(ws + WS_ZS);
    const f32x4 gkv0 = *(const f32x4*)(P.in[I_GKVLAT] + lane * 8), gkv1 = *(const f32x4*)(P.in[I_GKVLAT] + lane * 8 + 4);
    const f32x4 gql0 = *(const f32x4*)(P.in[I_GQLAT] + lane * 8), gql1 = *(const f32x4*)(P.in[I_GQLAT] + lane * 8 + 4);
    const f32x4 gmq = *(const f32x4*)(P.in[I_GMEMQ] + lane * 4);
    const float gkr = P.in[I_GKHEAD][128 + lane];
    for (int t = gw; t < TT; t += NGW) {
        const bool prm = t < TP; const int b = prm ? (t >> 12) : ((t - TP) >> 5), li = prm ? (t & 4095) : ((t - TP) & 31), pos = prm ? li : 4096 + li;
        const bf16_t* z = ZS + (size_t)t * ZS_LD;
        const int ca = lane * 8, cb = 512 + lane * 8, wa = lane < 32 ? 2 : 4, wb = lane < 32 ? 8 : 16;
        const u32x4 kvw = *(const u32x4*)(z + 1536 + lane * 8), qlw = *(const u32x4*)(z + 1024 + lane * 8), uaw = *(const u32x4*)(z + ca), ubw = *(const u32x4*)(z + cb);
        const bf16_t kpw = z[3072 + lane];
        u32x2 mqw[4];
#pragma unroll
        for (int h = 0; h < 4; ++h) mqw[h] = *(const u32x2*)(z + 2048 + h * 256 + lane * 4);
        u32x4 ra[3], rb[15];
        if (prm) {
#pragma unroll
            for (int k = 1; k < 4; ++k) ra[k - 1] = *(const u32x4*)(z - (size_t)(k <= li ? k : 0) * ZS_LD + ca);
#pragma unroll
            for (int k = 1; k < 16; ++k) rb[k - 1] = *(const u32x4*)(z - (size_t)(k <= li ? k : 0) * ZS_LD + cb);
        }
        asm volatile("" ::: "memory");
        { float v[8]; unpack8(kvw, v); float s = 0.f;
#pragma unroll
          for (int j = 0; j < 8; ++j) s += v[j] * v[j];
          const float r = rsqrtf(wave_sum(s) * (1.f / 512.f) + EPS);
          v[0] *= r * gkv0.x; v[1] *= r * gkv0.y; v[2] *= r * gkv0.z; v[3] *= r * gkv0.w; v[4] *= r * gkv1.x; v[5] *= r * gkv1.y; v[6] *= r * gkv1.z; v[7] *= r * gkv1.w;
          float* lo = prm ? out + O_LATP + (size_t)t * 512 : out + O_LATS + (size_t)(t - TP) * 512;
          *(f32x4*)(lo + lane * 8) = (f32x4){v[0], v[1], v[2], v[3]}; *(f32x4*)(lo + lane * 8 + 4) = (f32x4){v[4], v[5], v[6], v[7]};
          bf16_t* dst = prm ? (bf16_t*)((unsigned char*)out + DO_CKVP) + (size_t)t * 512 : (bf16_t*)(ws + WS_LATS) + ((size_t)b * KPAD + 4096 + li) * 512;
          *(u32x4*)(dst + lane * 8) = pack8(v); }
        { const float v = bf2f(kpw);
          (prm ? out + O_KPEP + (size_t)t * 64 : out + O_KPES + (size_t)(t - TP) * 64)[lane] = v;
          const float ss = wave_sum(v * v); const float o = rope_lane(v * gkr, lane, (float)pos);
          if (prm) { ((bf16_t*)(ws + WS_KRP))[(size_t)t * 64 + lane] = f2bf(o); if (lane == 0) ((float*)(ws + WS_KPESSP))[t] = ss; }
          else { const size_t kidx = (size_t)b * KPAD + 4096 + li; ((bf16_t*)(ws + WS_KRS))[kidx * 64 + lane] = f2bf(o); if (lane == 0) ((float*)(ws + WS_KPESS))[kidx] = ss; } }
        { float v[8]; unpack8(qlw, v); float s = 0.f;
#pragma unroll
          for (int j = 0; j < 8; ++j) s += v[j] * v[j];
          const float r = rsqrtf(wave_sum(s) * (1.f / 512.f) + EPS);
          v[0] *= r * gql0.x; v[1] *= r * gql0.y; v[2] *= r * gql0.z; v[3] *= r * gql0.w; v[4] *= r * gql1.x; v[5] *= r * gql1.y; v[6] *= r * gql1.z; v[7] *= r * gql1.w;
          *(u32x4*)((bf16_t*)(ws + WS_QN) + (size_t)t * 512 + lane * 8) = pack8(v); }
#pragma unroll
        for (int h = 0; h < 4; ++h) { const u32x2 w = mqw[h];
            const float a0 = bflo(w.x), a1 = bfhi(w.x), a2 = bflo(w.y), a3 = bfhi(w.y);
            const float r = rsqrtf(wave_sum((a0 * a0 + a1 * a1) + (a2 * a2 + a3 * a3)) * (1.f / 256.f) + EPS) * MEM_C;
            *(u32x2*)((bf16_t*)(ws + WS_QM) + (size_t)t * 1024 + h * 256 + lane * 4) = (u32x2){cvtpk(a0 * r * gmq.x, a1 * r * gmq.y), cvtpk(a2 * r * gmq.z, a3 * r * gmq.w)}; }
        { float sa[8], sb[8], ua[8], ub[8];
          unpack8(uaw, ua); unpack8(ubw, ub);
#pragma unroll
          for (int j = 0; j < 8; ++j) { sa[j] = ua[j]; sb[j] = ub[j]; }
          if (prm) {
#pragma unroll
              for (int k = 1; k < 4; ++k) { float tmp[8]; unpack8(ra[k - 1], tmp); const float w = (k <= li && k < wa) ? 1.f : 0.f;
#pragma unroll
                  for (int j = 0; j < 8; ++j) sa[j] += w * tmp[j]; }
#pragma unroll
              for (int k = 1; k < 16; ++k) { float tmp[8]; unpack8(rb[k - 1], tmp); const float w = (k <= li && k < wb) ? 1.f : 0.f;
#pragma unroll
                  for (int j = 0; j < 8; ++j) sb[j] += w * tmp[j]; }
          } else
          for (int k = 1; k < 16; ++k) {
              if (k <= li) { const bf16_t* zk = z - (size_t)k * ZS_LD; float tmp[8];
                  if (k < wa) { unpack8(*(const u32x4*)(zk + ca), tmp);
#pragma unroll
                      for (int j = 0; j < 8; ++j) sa[j] += tmp[j]; }
                  if (k < wb) { unpack8(*(const u32x4*)(zk + cb), tmp);
#pragma unroll
                      for (int j = 0; j < 8; ++j) sb[j] += tmp[j]; } }
              else { const float* sp = P.in[I_SPOOL] + ((size_t)b * 15 + (15 + li - k)) * 1024;
                  if (k < wa) { const f32x4 p0 = *(const f32x4*)(sp + ca), p1 = *(const f32x4*)(sp + ca + 4); sa[0] += p0.x; sa[1] += p0.y; sa[2] += p0.z; sa[3] += p0.w; sa[4] += p1.x; sa[5] += p1.y; sa[6] += p1.z; sa[7] += p1.w; }
                  if (k < wb) { const f32x4 p0 = *(const f32x4*)(sp + cb), p1 = *(const f32x4*)(sp + cb + 4); sb[0] += p0.x; sb[1] += p0.y; sb[2] += p0.z; sb[3] += p0.w; sb[4] += p1.x; sb[5] += p1.y; sb[6] += p1.z; sb[7] += p1.w; } }
          }
          const float ia = 1.f / (float)(pos + 1 < wa ? pos + 1 : wa), ib = 1.f / (float)(pos + 1 < wb ? pos + 1 : wb);
#pragma unroll
          for (int j = 0; j < 8; ++j) { sa[j] = sa[j] * ia - ua[j]; sb[j] = sb[j] * ib - ub[j]; }
          bf16_t* dp = (bf16_t*)(ws + WS_DP) + (size_t)t * 1024;
          *(u32x4*)(dp + ca) = pack8(sa); *(u32x4*)(dp + cb) = pack8(sb);
          const int last0 = prm ? 4081 : 17;
          if (li >= last0) { float* po = (prm ? out + O_POOLP : out + O_POOLS) + ((size_t)b * 15 + (li - last0)) * 1024;
              *(f32x4*)(po + ca) = (f32x4){ua[0], ua[1], ua[2], ua[3]}; *(f32x4*)(po + ca + 4) = (f32x4){ua[4], ua[5], ua[6], ua[7]};
              *(f32x4*)(po + cb) = (f32x4){ub[0], ub[1], ub[2], ub[3]}; *(f32x4*)(po + cb + 4) = (f32x4){ub[4], ub[5], ub[6], ub[7]}; } }
    }
    for (int m = gw; m < 512; m += NGW) {
        const float* mr = (const float*)(ws + WS_M) + (size_t)m * 2048; const f32x4 g = *(const f32x4*)(P.in[I_GMEMK] + lane * 4);
#pragma unroll
        for (int h = 0; h < 4; ++h) { f32x4 v = *(const f32x4*)(mr + h * 256 + lane * 4);
            const float r = rsqrtf(wave_sum((v.x * v.x + v.y * v.y) + (v.z * v.z + v.w * v.w)) * (1.f / 256.f) + EPS);
            v.x *= r * g.x; v.y *= r * g.y; v.z *= r * g.z; v.w *= r * g.w;
            *(f32x4*)(out + O_MEMK + (size_t)m * 1024 + h * 256 + lane * 4) = v;
            *(u32x2*)((bf16_t*)(ws + WS_MK) + (size_t)m * 1024 + h * 256 + lane * 4) = (u32x2){cvtpk(v.x, v.y), cvtpk(v.z, v.w)};
            *(f32x4*)(out + O_MEMV + (size_t)m * 1024 + h * 256 + lane * 4) = *(const f32x4*)(mr + 1024 + h * 256 + lane * 4); }
    }
    { LAS unsigned char* scr = lds + wave * 16384;
      for (int it = gw; it < 2 * 64; it += NGW) { const int b = it / 64, q = it % 64;
          transpose_item((const float*)(ws + WS_M) + (size_t)b * 256 * 2048 + 1024, 2048, 256, (bf16_t*)(ws + WS_MVT) + (size_t)b * 262144, scr, q / 16, (q % 16) * 64, (q % 16) * 64, lane, nullptr); } }
}

struct EpiQKV {
    static constexpr bool PERM = true;
    bf16_t* Q; bf16_t* K; bf16_t* V; float* RKG; bf16_t* PM; float* PS; const float* KPESS; const float* KPESSP; const bf16_t* KRP; const float* gk; LAS unsigned char* lds;
    __device__ __forceinline__ void half_sumsq(const f32x4 (&acc)[2][2][4][2], float (&tot)[2][4][2], int wr, int wc, int fr, int fq) const {
        LAS float* part = (LAS float*)(lds + 131072);
#pragma unroll
        for (int ai = 0; ai < 2; ++ai)
#pragma unroll
            for (int m = 0; m < 4; ++m)
#pragma unroll
                for (int bj = 0; bj < 2; ++bj) { const f32x4 a = acc[ai][bj][m][0], b = acc[ai][bj][m][1];
                    float s = ((a.x * a.x + a.y * a.y) + (a.z * a.z + a.w * a.w)) + ((b.x * b.x + b.y * b.y) + (b.z * b.z + b.w * b.w));
                    s += __shfl_xor(s, 16); s += __shfl_xor(s, 32);
                    if (fq == 0) part[((ai * 128 + wr * 64 + m * 16 + fr) * 2 + bj) * 4 + wc] = s; }
        asm volatile("s_waitcnt lgkmcnt(0)" ::: "memory"); __builtin_amdgcn_s_barrier(); asm volatile("" ::: "memory");
#pragma unroll
        for (int ai = 0; ai < 2; ++ai)
#pragma unroll
            for (int m = 0; m < 4; ++m)
#pragma unroll
                for (int bj = 0; bj < 2; ++bj) { const f32x4 p4 = *(const LAS f32x4*)(part + ((ai * 128 + wr * 64 + m * 16 + fr) * 2 + bj) * 4); tot[ai][m][bj] = (p4.x + p4.y) + (p4.z + p4.w); }
    }
    __device__ __forceinline__ bool operator()(f32x4 (&acc)[2][2][4][2], const pg8::Unit& u, int wr, int wc, int fr_, int fq) const {
        int fr = fr_; asm volatile("" : "+v"(fr));
        const int row0 = u.pm * 256 + wr * 64 + fr, ct = wc * 32 + 8 * fq;
        if (u.kind == 3) {
            float tot[2][4][2]; half_sumsq(acc, tot, wr, wc, fr, fq);
            if (wc == 0 && fq == 0) {
#pragma unroll
                for (int ai = 0; ai < 2; ++ai)
#pragma unroll
                    for (int m = 0; m < 4; ++m) { const size_t row = (size_t)(row0 + ai * 128 + m * 16); const float kp = KPESS[row];
#pragma unroll
                        for (int bj = 0; bj < 2; ++bj) RKG[row * 16 + u.pn * 2 + bj] = rsqrtf((tot[ai][m][bj] + kp) * (1.f / 192.f) + EPS) * MLA_C; } }
            return false;
        }
        if (u.kind == 1) {
            float tot[2][4][2]; half_sumsq(acc, tot, wr, wc, fr, fq);
            const f32x4 g0 = *(const f32x4*)(gk + ct), g1 = *(const f32x4*)(gk + ct + 4);
#pragma unroll
            for (int ai = 0; ai < 2; ++ai) {
                float kp[4]; u32x2 kr[4];
#pragma unroll
                for (int m = 0; m < 4; ++m) { const size_t row = (size_t)(row0 + ai * 128 + m * 16); kp[m] = KPESSP[row]; kr[m] = *(const u32x2*)(KRP + row * 64 + wc * 16 + fq * 4); }
                asm volatile("" ::: "memory");
#pragma unroll
                for (int m = 0; m < 4; ++m) { bf16_t* rp = K + (size_t)(row0 + ai * 128 + m * 16) * QLD;
#pragma unroll
                    for (int bj = 0; bj < 2; ++bj) { const float rk = rsqrtf((tot[ai][m][bj] + kp[m]) * (1.f / 192.f) + EPS);
                        const f32x4 v0 = acc[ai][bj][m][0] * rk * g0, v1 = acc[ai][bj][m][1] * rk * g1; bf16_t* hp = rp + (u.pn * 2 + bj) * 192;
                        *(u32x4*)(hp + ct) = (u32x4){cvtpk(v0[0], v0[1]), cvtpk(v0[2], v0[3]), cvtpk(v1[0], v1[1]), cvtpk(v1[2], v1[3])};
                        *(u32x2*)(hp + 128 + wc * 16 + fq * 4) = (u32x2){cvtpk(bflo(kr[m].x) * rk, bfhi(kr[m].x) * rk), cvtpk(bflo(kr[m].y) * rk, bfhi(kr[m].y) * rk)}; } }
            }
            return false;
        }
        if (u.kind >= 4) {
            const int cc = u.pn * 256 + ct;
#pragma unroll
            for (int ai = 0; ai < 2; ++ai)
#pragma unroll
                for (int m = 0; m < 4; ++m) { const int rl = ai * 128 + wr * 64 + m * 16 + fr; const size_t row = (size_t)(u.pm + rl); float s = 0.f;
#pragma unroll
                    for (int bj = 0; bj < 2; ++bj) { f32x4 v0 = acc[ai][bj][m][0], v1 = acc[ai][bj][m][1];
#pragma unroll
                        for (int e = 0; e < 4; ++e) { v0[e] = __builtin_amdgcn_exp2f(v0[e]); v1[e] = __builtin_amdgcn_exp2f(v1[e]); }
                        s += ((v0[0] + v0[1]) + (v0[2] + v0[3])) + ((v1[0] + v1[1]) + (v1[2] + v1[3]));
                        if (u.kind == 4 || rl < 32) *(u32x4*)(PM + row * 1024 + cc + bj * 128) = (u32x4){cvtpk(v0[0], v0[1]), cvtpk(v0[2], v0[3]), cvtpk(v1[0], v1[1]), cvtpk(v1[2], v1[3])}; }
                    s += __shfl_xor(s, 16); s += __shfl_xor(s, 32);
                    if (fq == 0 && (u.kind == 4 || rl < 32)) PS[row * 16 + u.pn * 4 + wc] = s; }
            return false;
        }
        bf16_t* base; int ld;
        if (u.kind == 0) { base = Q; ld = QLD; } else { base = V; ld = 2048; }
        const int c0 = u.pn * 256 + ct;
#pragma unroll
        for (int ai = 0; ai < 2; ++ai)
#pragma unroll
            for (int m = 0; m < 4; ++m) { bf16_t* rp = base + (size_t)(row0 + ai * 128 + m * 16) * ld;
#pragma unroll
                for (int bj = 0; bj < 2; ++bj) { const f32x4 v0 = acc[ai][bj][m][0], v1 = acc[ai][bj][m][1];
                    *(u32x4*)(rp + c0 + bj * 128) = (u32x4){cvtpk(v0[0], v0[1]), cvtpk(v0[2], v0[3]), cvtpk(v1[0], v1[1]), cvtpk(v1[2], v1[3])}; } }
        return false;
    }
};

#define SWZF(row) ((((((row) & 2) << 1) | (((row) >> 2) & 3))) << 4)
__device__ __forceinline__ void partialSM(f32x16& p0, f32x16& p1, float& m_reg, float& mn, float& alpha, const float C) {
    float pmax = p0[0];
#pragma unroll
    for (int r = 1; r < 16; ++r) pmax = fmaxf(pmax, p0[r]);
#pragma unroll
    for (int r = 0; r < 16; ++r) pmax = fmaxf(pmax, p1[r]);
    { auto rr = __builtin_amdgcn_permlane32_swap(__float_as_uint(pmax), __float_as_uint(pmax), false, false);
      pmax = fmaxf(__uint_as_float(rr[0]), __uint_as_float(rr[1])); }
    if (__builtin_expect(__all((pmax - m_reg) * C <= 11.5f), 1)) { mn = m_reg; alpha = 1.f; }
    else { mn = fmaxf(m_reg, pmax); alpha = __builtin_amdgcn_exp2f((m_reg - mn) * C); m_reg = mn; }
    const float mnC = -mn * C;
#pragma unroll
    for (int r = 0; r < 16; ++r) p0[r] = fmaf(p0[r], C, mnC);
#pragma unroll
    for (int r = 0; r < 16; ++r) p1[r] = fmaf(p1[r], C, mnC);
#pragma unroll
    for (int r = 0; r < 16; ++r) p0[r] = __builtin_amdgcn_exp2f(p0[r]);
}
__device__ __forceinline__ void finishSM(f32x16& p0, f32x16& p1, float alpha, float& l_reg, bf16x8& pa0, bf16x8& pa1, bf16x8& pa2, bf16x8& pa3) {
#pragma unroll
    for (int r = 0; r < 16; ++r) p1[r] = __builtin_amdgcn_exp2f(p1[r]);
    float ps = 0;
#pragma unroll
    for (int r = 0; r < 16; ++r) ps += p0[r];
#pragma unroll
    for (int r = 0; r < 16; ++r) ps += p1[r];
    { auto rr = __builtin_amdgcn_permlane32_swap(__float_as_uint(ps), __float_as_uint(ps), false, false);
      ps = __uint_as_float(rr[0]) + __uint_as_float(rr[1]); }
    l_reg = l_reg * alpha + ps;
#define PK4(P, BASE, OUT) do { unsigned a0 = cvtpk(P[BASE + 0], P[BASE + 1]), a1 = cvtpk(P[BASE + 2], P[BASE + 3]);   \
    unsigned b0 = cvtpk(P[BASE + 4], P[BASE + 5]), b1 = cvtpk(P[BASE + 6], P[BASE + 7]);                              \
    auto r0 = __builtin_amdgcn_permlane32_swap(a0, b0, false, false); auto r1 = __builtin_amdgcn_permlane32_swap(a1, b1, false, false); \
    u32x4 w = {r0[0], r1[0], r0[1], r1[1]}; OUT = __builtin_bit_cast(bf16x8, w); } while (0)
    PK4(p0, 0, pa0); PK4(p0, 8, pa1); PK4(p1, 0, pa2); PK4(p1, 8, pa3);
#undef PK4
}

namespace pat {
constexpr int LDQ = 3072, LDK = 3072, LDV = 2048, LDO = 2048;
constexpr int SHM_V = 16384, SHM_K = 24576, OFF_WS = 3 * SHM_K + 3 * SHM_V, OFF_QR = OFF_WS + 2048;
#define KSW(row, colB) ((row) * 384 + ((colB) ^ SWZF(row)))
#define DSR128(dst, addr, OFF) asm volatile("ds_read_b128 %0, %1 offset:%2" : "=v"(dst) : "v"(addr), "i"(OFF) : "memory")
#define WAITK4(N, F) asm volatile("s_waitcnt lgkmcnt(" #N ")" : "+v"(F[0]), "+v"(F[1]), "+v"(F[2]), "+v"(F[3]) :: "memory")
#define WAITK6(N, F, Q) asm volatile("s_waitcnt lgkmcnt(" #N ")" : "+v"(F[0]), "+v"(F[1]), "+v"(F[2]), "+v"(F[3]), "+v"(Q[0]), "+v"(Q[1]) :: "memory")
__device__ __forceinline__ void qkt(f32x16& p0, f32x16& p1, int ks, const bf16x8* qr, int qrow, int hi, int qsw, const int (&kbo)[2]) {
    p0 = f32x16{}; p1 = f32x16{};
    bf16x8 fa[4], fb[4], qa[2], qb[2];
    const int k0 = ks + kbo[0] + kbo[1], k1 = ks + kbo[0] + (kbo[1] ^ 32), k2 = ks + kbo[0] + (kbo[1] ^ 64), k3 = ks + kbo[0] + (kbo[1] ^ 96);
    const int q0 = qrow + (((0 + hi) ^ qsw) << 4), q1 = qrow + (((2 + hi) ^ qsw) << 4), q2 = qrow + (((4 + hi) ^ qsw) << 4), q3 = qrow + (((6 + hi) ^ qsw) << 4);
#define RDK(F, KA, KB, OFF) do { DSR128(F[0], KA, OFF); DSR128(F[1], KA, OFF + 12288); DSR128(F[2], KB, OFF); DSR128(F[3], KB, OFF + 12288); } while (0)
#define MMK(F, QA, QB) do { p0 = __builtin_amdgcn_mfma_f32_32x32x16_bf16(F[0], QA, p0, 0, 0, 0); p1 = __builtin_amdgcn_mfma_f32_32x32x16_bf16(F[1], QA, p1, 0, 0, 0); \
        p0 = __builtin_amdgcn_mfma_f32_32x32x16_bf16(F[2], QB, p0, 0, 0, 0); p1 = __builtin_amdgcn_mfma_f32_32x32x16_bf16(F[3], QB, p1, 0, 0, 0); } while (0)
    RDK(fa, k0, k1, 0);
    RDK(fb, k2, k3, 0);    WAITK4(4, fa); MMK(fa, qr[0], qr[1]);
    RDK(fa, k0, k1, 128);  WAITK4(4, fb); MMK(fb, qr[2], qr[3]);
    RDK(fb, k2, k3, 128);  WAITK4(4, fa); MMK(fa, qr[4], qr[5]);
    RDK(fa, k0, k1, 256); DSR128(qa[0], q0, 0); DSR128(qa[1], q1, 0);  WAITK4(6, fb); MMK(fb, qr[6], qr[7]);
    RDK(fb, k2, k3, 256); DSR128(qb[0], q2, 0); DSR128(qb[1], q3, 0);  WAITK6(6, fa, qa); MMK(fa, qa[0], qa[1]);
    WAITK6(0, fb, qb); MMK(fb, qb[0], qb[1]);
#undef RDK
#undef MMK
}
__device__ __forceinline__ int v_st(int k, int c) { const int kk = (k & ~0xC) | ((k & 4) << 1) | ((k & 8) >> 1); return ((kk >> 3) * 4 + (c >> 5)) * 512 + ((kk & 7) * 32 + (c & 31)) * 2; }
__device__ __forceinline__ int v_rd_base(int lane) { return ((lane & 3) << 3) | (((lane >> 2) & 3) << 6) | (((lane >> 4) & 1) << 5) | (((lane >> 5) & 1) << 8); }
constexpr int v_rd_off(int d0, int ks, int half) { return d0 * 512 + ks * 4096 + half * 2048; }
#define TRR(dst, base, OFF) asm volatile("ds_read_b64_tr_b16 %0, %1 offset:%2" : "=v"(dst) : "v"(base), "i"(OFF) : "memory")
#define WAITV8(N, L, H) asm volatile("s_waitcnt lgkmcnt(" #N ")" : "+v"(L[0]), "+v"(L[1]), "+v"(L[2]), "+v"(L[3]), "+v"(H[0]), "+v"(H[1]), "+v"(H[2]), "+v"(H[3]) :: "memory")
__device__ __forceinline__ void pv_d0(f32x16* o, int vb, bf16x8 pa0, bf16x8 pa1, bf16x8 pa2, bf16x8 pa3) {
    s16x4 la[4], ha[4], lb[4], hb[4];
#define RDV(L, H, D0) do { TRR(L[0], vb, v_rd_off(D0, 0, 0)); TRR(H[0], vb, v_rd_off(D0, 0, 1)); TRR(L[1], vb, v_rd_off(D0, 1, 0)); TRR(H[1], vb, v_rd_off(D0, 1, 1)); \
        TRR(L[2], vb, v_rd_off(D0, 2, 0)); TRR(H[2], vb, v_rd_off(D0, 2, 1)); TRR(L[3], vb, v_rd_off(D0, 3, 0)); TRR(H[3], vb, v_rd_off(D0, 3, 1)); } while (0)
#define MMV(L, H, D0) do { o[D0] = __builtin_amdgcn_mfma_f32_32x32x16_bf16(pa0, PKV(L[0], H[0]), o[D0], 0, 0, 0); o[D0] = __builtin_amdgcn_mfma_f32_32x32x16_bf16(pa1, PKV(L[1], H[1]), o[D0], 0, 0, 0); \
        o[D0] = __builtin_amdgcn_mfma_f32_32x32x16_bf16(pa2, PKV(L[2], H[2]), o[D0], 0, 0, 0); o[D0] = __builtin_amdgcn_mfma_f32_32x32x16_bf16(pa3, PKV(L[3], H[3]), o[D0], 0, 0, 0); } while (0)
    RDV(la, ha, 0);
    RDV(lb, hb, 1); WAITV8(8, la, ha); MMV(la, ha, 0);
    RDV(la, ha, 2); WAITV8(8, lb, hb); MMV(lb, hb, 1);
    RDV(lb, hb, 3); WAITV8(8, la, ha); MMV(la, ha, 2);
    WAITV8(0, lb, hb); MMV(lb, hb, 3);
#undef RDV
#undef MMV
}
__device__ __forceinline__ void unit(const bf16_t* __restrict__ Qb, const bf16_t* __restrict__ Kh, const bf16_t* __restrict__ Vh, bf16_t* __restrict__ Ob, int qb, LAS char* lds, const float* __restrict__ gq, int wv) {
    constexpr float C = MLA_C;
    int wvl = wv; asm volatile("" : "+s"(wvl)); int tid = wvl * 64 + lane_id(); asm volatile("" : "+v"(tid));
    const int wid = __builtin_amdgcn_readfirstlane(tid >> 6), lane = tid & 63, r32 = lane & 31, hi = lane >> 5;
    LAS char* K_lds = lds; LAS char* V_lds = lds + 3 * SHM_K;
    LAS float* wsf = (LAS float*)(lds + OFF_WS) + wid * 64; LAS float* li_l = wsf; LAS float* al_l = wsf + 32;
    LAS char* qlds = lds + OFF_QR + (wid * 32 + r32) * 128; const int qsw = r32 & 7; const int qrow = (int)(uintptr_t)qlds, klds = (int)(uintptr_t)K_lds;
    const int kbo[2] = {r32 * 384, (16 * hi) ^ SWZF(r32)};
    float m_reg = -1e30f, l_reg = 0; f32x16 o[4] = {}; bf16x8 qr[8];
    const bf16_t* Qw = Qb + (size_t)(wid * 32 + r32) * LDQ + hi * 8;
    {
        float ss = 0.f;
#pragma unroll
        for (int d0 = 0; d0 < 12; ++d0) { float t8[8]; unpack8(*(const u32x4*)(Qw + d0 * 16), t8);
#pragma unroll
            for (int j = 0; j < 8; ++j) ss += t8[j] * t8[j]; }
        ss += __shfl_xor(ss, 32);
        const float r = rsqrtf(ss * (1.f / 192.f) + EPS);
#define QSCALE(F, d0) do { unpack8(*(const u32x4*)(Qw + (d0) * 16), F); const f32x4 g0 = *(const f32x4*)(gq + (d0) * 16 + hi * 8), g1 = *(const f32x4*)(gq + (d0) * 16 + hi * 8 + 4); \
            F[0] *= r * g0.x; F[1] *= r * g0.y; F[2] *= r * g0.z; F[3] *= r * g0.w; F[4] *= r * g1.x; F[5] *= r * g1.y; F[6] *= r * g1.z; F[7] *= r * g1.w; } while (0)
#pragma unroll
        for (int d0 = 0; d0 < 8; ++d0) { float t8[8]; QSCALE(t8, d0); qr[d0] = __builtin_bit_cast(bf16x8, pack8(t8)); }
        const float pos = (float)(qb * 256 + wid * 32 + r32);
#pragma unroll
        for (int dd = 0; dd < 2; ++dd) { float a8[8], b8[8]; QSCALE(a8, 8 + dd); QSCALE(b8, 10 + dd);
#pragma unroll
            for (int j = 0; j < 8; ++j) { float sn, cs; fast_sincos(pos * rope_inv(16 * dd + 8 * hi + j), sn, cs);
                const float x1 = a8[j], x2 = b8[j]; a8[j] = x1 * cs - x2 * sn; b8[j] = x2 * cs + x1 * sn; }
            *(LAS u32x4*)(qlds + (((dd * 2 + hi) ^ qsw) << 4)) = pack8(a8); *(LAS u32x4*)(qlds + ((((2 + dd) * 2 + hi) ^ qsw) << 4)) = pack8(b8); }
#undef QSCALE
    }
    asm volatile("s_waitcnt vmcnt(0)" ::: "memory");
    unsigned ksrc[3], vsrc[2];
#pragma unroll
    for (int k = 0; k < 3; ++k) { const int d = (wid + 8 * k) * 1024 + lane * 16, row = d / 384, cs = (d - row * 384) >> 4, c = (cs & ~7) | ((cs & 7) ^ (SWZF(row) >> 4));
        ksrc[k] = (unsigned)(row * LDK + c * 8) * 2u; }
#pragma unroll
    for (int k = 0; k < 2; ++k) { const int d = (wid + 8 * k) * 1024 + lane * 16, sub = d >> 9, win = d & 511, kk = (sub >> 2) * 8 + (win >> 6), col = (sub & 3) * 32 + ((win & 63) >> 1);
        const int key = (kk & ~0xC) | ((kk & 4) << 1) | ((kk & 8) >> 1);
        vsrc[k] = (unsigned)(key * LDV + col) * 2u; }
#define DMA_K(t, slot) do { _Pragma("unroll") for (int k = 0; k < 3; ++k) \
        __builtin_amdgcn_global_load_lds((const unsigned*)((const char*)Kh + (size_t)(t) * (64 * LDK * 2) + ksrc[k]), (LAS unsigned*)(K_lds + (slot) + (wid + 8 * k) * 1024), 16, 0, 0); } while (0)
#define DMA_V(t, slot) do { _Pragma("unroll") for (int k = 0; k < 2; ++k) \
        __builtin_amdgcn_global_load_lds((const unsigned*)((const char*)Vh + (size_t)(t) * (64 * LDV * 2) + vsrc[k]), (LAS unsigned*)(V_lds + (slot) + (wid + 8 * k) * 1024), 16, 0, 0); } while (0)
#define WAITBAR(N) do { asm volatile("s_waitcnt vmcnt(" #N ") lgkmcnt(0)" ::: "memory"); __builtin_amdgcn_s_barrier(); asm volatile("" ::: "memory"); } while (0)
    const int vbase = (int)(uintptr_t)V_lds + v_rd_base(lane);
#define RESC(a) do { if (__any((a) < 1.f)) { if (hi == 0) al_l[r32] = (a); LDS_WAIT(); \
    _Pragma("unroll") for (int d = 0; d < 4; ++d) _Pragma("unroll") for (int r = 0; r < 16; ++r) o[d][r] *= al_l[crow(r, hi)]; } } while (0)
#define MASKT(P0, P1, tix) do { if ((tix) > mylast) { _Pragma("unroll") for (int r = 0; r < 16; ++r) { P0[r] = -1e30f; P1[r] = -1e30f; } } } while (0)
    f32x16 pA0, pA1, pB0, pB1; float mnA, mnB, alA, alB; bf16x8 pa0, pa1, pa2, pa3;
    const int NT = 4 * qb + 4, mylast = 4 * qb + (wid >> 1);
    int kc = 0, kn = SHM_K, kf = 2 * SHM_K, vp = 2 * SHM_V, vc = 0, vf = SHM_V;
#define ROT() do { const int t_ = kc; kc = kn; kn = kf; kf = t_; const int u_ = vp; vp = vc; vc = vf; vf = u_; } while (0)
    DMA_K(0, 0); DMA_V(0, 0); DMA_K(1, SHM_K);
    WAITBAR(5);
    qkt(pA0, pA1, klds + kc, qr, qrow, hi, qsw, kbo); partialSM(pA0, pA1, m_reg, mnA, alA, C);
    DMA_K(2, 2 * SHM_K); DMA_V(1, SHM_V);
    WAITBAR(5);
    ROT();
#define STEP(PC0, PC1, mnC, alC, PP0, PP1, alP, t) do { \
        SBAR(); qkt(PC0, PC1, klds + kc, qr, qrow, hi, qsw, kbo); MASKT(PC0, PC1, t); \
        finishSM(PP0, PP1, alP, l_reg, pa0, pa1, pa2, pa3); SBAR(); \
        if ((t) + 2 < NT) DMA_K((t) + 2, kf); if ((t) + 1 < NT) DMA_V((t) + 1, vf); \
        pv_d0(o, vbase + vp, pa0, pa1, pa2, pa3); partialSM(PC0, PC1, m_reg, mnC, alC, C); \
        RESC(alC); \
        if ((t) + 2 < NT) WAITBAR(5); else if ((t) + 1 < NT) WAITBAR(2); else WAITBAR(0); \
        ROT(); } while (0)
    for (int t = 1; t + 1 < NT; t += 2) {
        STEP(pB0, pB1, mnB, alB, pA0, pA1, alA, t);
        STEP(pA0, pA1, mnA, alA, pB0, pB1, alB, t + 1);
    }
    STEP(pB0, pB1, mnB, alB, pA0, pA1, alA, NT - 1);
    finishSM(pB0, pB1, alB, l_reg, pa0, pa1, pa2, pa3); SBAR();
    pv_d0(o, vbase + vp, pa0, pa1, pa2, pa3);
    if (hi == 0) li_l[r32] = l_reg; LDS_WAIT();
    float rli[16];
#pragma unroll
    for (int r = 0; r < 16; ++r) rli[r] = __builtin_amdgcn_rcpf(li_l[crow(r, hi)]);
    bf16_t* Ow = Ob + (size_t)(wid * 32) * LDO;
#pragma unroll
    for (int r = 0; r < 16; ++r) { const int orow = crow(r, hi);
#pragma unroll
        for (int d0 = 0; d0 < 4; ++d0) Ow[(size_t)orow * LDO + d0 * 32 + r32] = f2bf(o[d0][r] * rli[r]); }
    asm volatile("s_waitcnt lgkmcnt(0)" ::: "memory"); __builtin_amdgcn_s_barrier(); asm volatile("" ::: "memory");
#undef DMA_K
#undef DMA_V
#undef WAITBAR
#undef RESC
#undef MASKT
#undef ROT
#undef STEP
}
}

template <int NB> __device__ __forceinline__ void resc_shfl(f32x16 (&o)[NB], float alpha, int hi) {
    if (__any(alpha < 1.f)) {
#pragma unroll
        for (int r = 0; r < 16; ++r) { const float a = __shfl(alpha, crow(r, hi));
#pragma unroll
            for (int d = 0; d < NB; ++d) o[d][r] *= a; }
    }
}

namespace sat {
constexpr int ROWB = 1152, TKEYS = 64, CT_BYTES = TKEYS * ROWB, BUF_BYTES = CT_BYTES + 1024, NT = 4160 / TKEYS, OLB = 1040;
typedef float f32x4v __attribute__((ext_vector_type(4)));
__device__ __forceinline__ int swz2(int row) { return (((row & 2) << 1) | ((row & 4) >> 1)) << 4; }
__device__ __forceinline__ int coff(int row, int colB) { return row * ROWB + (colB ^ swz2(row)); }
template <int MODE = 0>
__device__ __forceinline__ void unit(const Args& P, int b, int hp, LAS char* lds, int wv) {
    unsigned char* ws = P.ws;
    int wvl = wv; asm volatile("" : "+s"(wvl)); int tid = wvl * 64 + lane_id(); asm volatile("" : "+v"(tid));
    const int wid = __builtin_amdgcn_readfirstlane(tid >> 6), lane = tid & 63, i16 = lane & 15, g = lane >> 4;
    const int hl = wid >> 2, qb = (wid >> 1) & 1, ch = wid & 1, h = 2 * hp + hl;
    const char* LATb = (const char*)((const bf16_t*)(ws + WS_LATS) + (size_t)b * KPAD * 512);
    const char* KRb = (const char*)((const bf16_t*)(ws + WS_KRS) + (size_t)b * KPAD * 64);
    const char* RKb = (const char*)((const float*)(ws + WS_RKG) + (size_t)b * KPAD * 16 + (2 * hp & ~3));
    bf16x8 qa[18];
    { const bf16_t* Qh = (const bf16_t*)(ws + WS_Q) + (size_t)(TP + b * 32 + 16 * qb + i16) * QLD + h * 192;
      const float* gk = P.in[I_GKHEAD]; const float* gq = P.in[I_GQHEAD];
      bf16x8 qg[4];
      float fn[4][8], fr[2][8]; float ss = 0.f;
#pragma unroll
      for (int kd = 0; kd < 4; ++kd) { unpack8(*(const u32x4*)(Qh + kd * 32 + g * 8), fn[kd]);
#pragma unroll
          for (int j = 0; j < 8; ++j) ss += fn[kd][j] * fn[kd][j]; }
#pragma unroll
      for (int kr = 0; kr < 2; ++kr) { unpack8(*(const u32x4*)(Qh + 128 + kr * 32 + g * 8), fr[kr]);
#pragma unroll
          for (int j = 0; j < 8; ++j) ss += fr[kr][j] * fr[kr][j]; }
      ss += __shfl_xor(ss, 16); ss += __shfl_xor(ss, 32);
      const float rq = rsqrtf(ss * (1.f / 192.f) + EPS);
#pragma unroll
      for (int kd = 0; kd < 4; ++kd) { float f[8];
#pragma unroll
          for (int j = 0; j < 8; ++j) f[j] = fn[kd][j] * rq * gq[kd * 32 + g * 8 + j] * gk[kd * 32 + g * 8 + j];
          qg[kd] = __builtin_bit_cast(bf16x8, pack8(f)); }
      { const float pos = (float)(4096 + 16 * qb + i16);
#pragma unroll
        for (int j = 0; j < 8; ++j) { float sn, cs; fast_sincos(pos * rope_inv(8 * g + j), sn, cs);
            const float x1 = fr[0][j] * rq * gq[128 + 8 * g + j], x2 = fr[1][j] * rq * gq[160 + 8 * g + j]; fr[0][j] = x1 * cs - x2 * sn; fr[1][j] = x2 * cs + x1 * sn; } }
      const bf16_t* Wn = (const bf16_t*)(ws + WS_WKBN) + (size_t)(8 * (i16 >> 2) + (i16 & 3)) * 2048 + h * 128 + g * 8;
#pragma unroll
      for (int ks = 0; ks < 16; ++ks) { f32x4 a0 = {0.f, 0.f, 0.f, 0.f}, a1 = a0;
#pragma unroll
          for (int kd = 0; kd < 4; ++kd) {
              const bf16x8 w0 = *(const bf16x8*)(Wn + (size_t)(32 * ks) * 2048 + kd * 32), w1 = *(const bf16x8*)(Wn + (size_t)(32 * ks + 4) * 2048 + kd * 32);
              a0 = __builtin_amdgcn_mfma_f32_16x16x32_bf16(w0, qg[kd], a0, 0, 0, 0); a1 = __builtin_amdgcn_mfma_f32_16x16x32_bf16(w1, qg[kd], a1, 0, 0, 0); }
          qa[ks] = __builtin_bit_cast(bf16x8, (u32x4){cvtpk(a0[0], a0[1]), cvtpk(a0[2], a0[3]), cvtpk(a1[0], a1[1]), cvtpk(a1[2], a1[3])});
          if ((ks & 3) == 3) asm volatile("" ::: "memory"); }
      qa[16] = __builtin_bit_cast(bf16x8, pack8(fr[0])); qa[17] = __builtin_bit_cast(bf16x8, pack8(fr[1])); }
    asm volatile("s_waitcnt vmcnt(0)" ::: "memory");
    unsigned soff[10]; unsigned kmask = 0u;
#pragma unroll
    for (int k = 0; k < 10; ++k) { const int p = wid + 8 * k;
        if (p < 72) { const int d = p * 1024 + lane * 16, row = d / ROWB, cs = (d - row * ROWB) >> 4, c = (cs & ~7) | ((cs & 7) ^ (swz2(row) >> 4));
            if (c >= 64) { kmask |= 1u << (2 * k); soff[k] = (unsigned)(row * 128 + (c - 64) * 16); } else soff[k] = (unsigned)(row * 1024 + c * 16); }
        else { kmask |= 2u << (2 * k); soff[k] = (unsigned)(lane * 64); } }
#define TDMA(j, bufoff) do { _Pragma("unroll") for (int k = 0; k < 10; ++k) { const int p_ = wid + 8 * k; if (p_ < 73) { const unsigned kd_ = (kmask >> (2 * k)) & 3u; \
        const char* sp_ = kd_ == 0u ? LATb + (size_t)(j) * (64 * 1024) + soff[k] : (kd_ == 1u ? KRb + (size_t)(j) * (64 * 128) + soff[k] : RKb + (size_t)(j) * (64 * 64) + soff[k]); \
        __builtin_amdgcn_global_load_lds((const unsigned*)sp_, (LAS unsigned*)(lds + (bufoff) + p_ * 1024), 16, 0, 0); } } } while (0)
    const int sw = swz2(i16);
    const int ao0 = i16 * ROWB + ((16 * g) ^ sw), ao1 = i16 * ROWB + ((64 + 16 * g) ^ sw);
    int trb[4];
    { const int row = 4 * g + (i16 >> 2), sr = swz2(row);
#pragma unroll
      for (int c4 = 0; c4 < 4; ++c4) trb[c4] = row * ROWB + ((512 * ch + 32 * c4 + 8 * (i16 & 3)) ^ sr) - ((512 * ch) & 0) ; }
    const int rko = CT_BYTES + (4 * g) * 16 + ((2 * hp & 3) + hl) * 4;
    float m_reg = 0.f, l_reg = 0.f; f32x4 o[16]; bf16x8 pown, poth;
#pragma unroll
    for (int d = 0; d < 16; ++d) o[d] = (f32x4){0.f, 0.f, 0.f, 0.f};
    TDMA(0, 0);
    asm volatile("s_waitcnt vmcnt(0)" ::: "memory");
    __builtin_amdgcn_s_barrier(); asm volatile("" ::: "memory");
    int cur = 0;
    for (int j = 0; j < NT; ++j) {
        const LAS char* CTb = lds + cur;
        if (MODE != 1) { if (j + 1 < NT) TDMA(j + 1, cur ? 0 : BUF_BYTES); }
        if (MODE != 2) {
        f32x4 sk[2] = {(f32x4){0.f, 0.f, 0.f, 0.f}, (f32x4){0.f, 0.f, 0.f, 0.f}};
        { const int sa0 = (int)(uintptr_t)CTb + ao0 + ch * 32 * ROWB, sa1 = (int)(uintptr_t)CTb + ao1 + ch * 32 * ROWB;
          bf16x8 fa[4], fb[4];
#define RDS(F, n) do { DSR128(F[0], sa0, (n) * 128); DSR128(F[1], sa0, (n) * 128 + 16 * ROWB); DSR128(F[2], sa1, (n) * 128); DSR128(F[3], sa1, (n) * 128 + 16 * ROWB); } while (0)
#define MMS(F, n) do { sk[0] = __builtin_amdgcn_mfma_f32_16x16x32_bf16(F[0], qa[2 * (n)], sk[0], 0, 0, 0); sk[1] = __builtin_amdgcn_mfma_f32_16x16x32_bf16(F[1], qa[2 * (n)], sk[1], 0, 0, 0); \
              sk[0] = __builtin_amdgcn_mfma_f32_16x16x32_bf16(F[2], qa[2 * (n) + 1], sk[0], 0, 0, 0); sk[1] = __builtin_amdgcn_mfma_f32_16x16x32_bf16(F[3], qa[2 * (n) + 1], sk[1], 0, 0, 0); } while (0)
          RDS(fa, 0);
#pragma unroll
          for (int n = 0; n < 8; n += 2) {
              RDS(fb, n + 1); WAITK4(4, fa); MMS(fa, n);
              RDS(fa, n + 2); WAITK4(4, fb); MMS(fb, n + 1);
          }
          WAITK4(0, fa); MMS(fa, 8);
#undef RDS
#undef MMS
        }
        float e8[8]; float mloc = -1e30f;
#pragma unroll
        for (int kb = 0; kb < 2; ++kb)
#pragma unroll
            for (int r = 0; r < 4; ++r) { float v = sk[kb][r] * *(const LAS float*)(CTb + rko + (32 * ch + 16 * kb + r) * 16);
                if (j == NT - 1 && ch == 1) v = -1e30f;
                mloc = fmaxf(mloc, v); e8[4 * kb + r] = __builtin_amdgcn_exp2f(v - m_reg); }
        mloc = fmaxf(mloc, __shfl_xor(mloc, 16)); mloc = fmaxf(mloc, __shfl_xor(mloc, 32));
        { LAS char* xb = (LAS char*)lds + 2 * BUF_BYTES;
          *(LAS u32x4*)(xb + wid * 1024 + lane * 16) = (u32x4){cvtpk(e8[0], e8[1]), cvtpk(e8[2], e8[3]), cvtpk(e8[4], e8[5]), cvtpk(e8[6], e8[7])};
          if (g == 0) *(LAS float*)(xb + 8192 + wid * 64 + i16 * 4) = mloc;
          asm volatile("s_waitcnt lgkmcnt(0)" ::: "memory"); __builtin_amdgcn_s_barrier(); asm volatile("" ::: "memory");
          const u32x4 pp = *(const LAS u32x4*)(xb + (wid ^ 1) * 1024 + lane * 16); const float mp = *(const LAS float*)(xb + 8192 + (wid ^ 1) * 64 + i16 * 4);
          const float mc = fmaxf(mloc, mp); float f = 1.f;
          if (!__builtin_expect(__all(mc - m_reg <= 11.5f), 1)) { const float mn = fmaxf(m_reg, mc); f = __builtin_amdgcn_exp2f(m_reg - mn); m_reg = mn; }
          float q8[8]; unpack8(pp, q8);
          float ps = 0.f;
#pragma unroll
          for (int i = 0; i < 8; ++i) { e8[i] *= f; q8[i] *= f; ps += e8[i] + q8[i]; }
          ps += __shfl_xor(ps, 16); ps += __shfl_xor(ps, 32);
          l_reg = l_reg * f + ps;
          if (__any(f < 1.f)) {
              const float a0 = __shfl(f, 4 * g), a1 = __shfl(f, 4 * g + 1), a2 = __shfl(f, 4 * g + 2), a3 = __shfl(f, 4 * g + 3);
#pragma unroll
              for (int d = 0; d < 16; ++d) { o[d][0] *= a0; o[d][1] *= a1; o[d][2] *= a2; o[d][3] *= a3; } }
          e8[0] = e8[0];
          pown = __builtin_bit_cast(bf16x8, pack8(e8)); poth = __builtin_bit_cast(bf16x8, pack8(q8)); }
        const bf16x8 pa0 = ch == 0 ? pown : poth, pa1 = ch == 0 ? poth : pown;
        const int ctb = (int)(uintptr_t)CTb;
        { s16x4 la[4], ha[4], lb[4], hb[4];
#define RDP(L, H, G) do { const int tb_ = ctb + trb[(G) & 3]; constexpr int o_ = ((G) >> 2) * 256; \
            TRR(L[0], tb_, o_); TRR(H[0], tb_, o_ + 16 * ROWB); TRR(L[1], tb_, o_ + 32 * ROWB); TRR(H[1], tb_, o_ + 48 * ROWB); \
            TRR(L[2], tb_, o_ + 128); TRR(H[2], tb_, o_ + 128 + 16 * ROWB); TRR(L[3], tb_, o_ + 128 + 32 * ROWB); TRR(H[3], tb_, o_ + 128 + 48 * ROWB); } while (0)
#define MMP(L, H, G) do { constexpr int d_ = ((G) & 3) + 8 * ((G) >> 2); \
            o[d_] = __builtin_amdgcn_mfma_f32_16x16x32_bf16(pa0, PKV(L[0], H[0]), o[d_], 0, 0, 0); o[d_] = __builtin_amdgcn_mfma_f32_16x16x32_bf16(pa1, PKV(L[1], H[1]), o[d_], 0, 0, 0); \
            o[d_ + 4] = __builtin_amdgcn_mfma_f32_16x16x32_bf16(pa0, PKV(L[2], H[2]), o[d_ + 4], 0, 0, 0); o[d_ + 4] = __builtin_amdgcn_mfma_f32_16x16x32_bf16(pa1, PKV(L[3], H[3]), o[d_ + 4], 0, 0, 0); } while (0)
          RDP(la, ha, 0);
          RDP(lb, hb, 1); WAITV8(8, la, ha); MMP(la, ha, 0);
          RDP(la, ha, 2); WAITV8(8, lb, hb); MMP(lb, hb, 1);
          RDP(lb, hb, 3); WAITV8(8, la, ha); MMP(la, ha, 2);
          RDP(la, ha, 4); WAITV8(8, lb, hb); MMP(lb, hb, 3);
          RDP(lb, hb, 5); WAITV8(8, la, ha); MMP(la, ha, 4);
          RDP(la, ha, 6); WAITV8(8, lb, hb); MMP(lb, hb, 5);
          RDP(lb, hb, 7); WAITV8(8, la, ha); MMP(la, ha, 6);
          WAITV8(0, lb, hb); MMP(lb, hb, 7);
#undef RDP
#undef MMP
        }
        }
        asm volatile("s_waitcnt vmcnt(0) lgkmcnt(0)" ::: "memory");
        __builtin_amdgcn_s_barrier(); asm volatile("" ::: "memory");
        cur = cur ? 0 : BUF_BYTES;
    }
    asm volatile("s_waitcnt vmcnt(0)" ::: "memory");
    { const float rl = __builtin_amdgcn_rcpf(l_reg);
      const float r0 = __shfl(rl, 4 * g), r1 = __shfl(rl, 4 * g + 1), r2 = __shfl(rl, 4 * g + 2), r3 = __shfl(rl, 4 * g + 3);
      LAS bf16_t* OL = (LAS bf16_t*)(lds + hl * 32 * OLB) + (16 * qb + 4 * g) * (OLB / 2) + 256 * ch + i16;
#pragma unroll
      for (int d = 0; d < 16; ++d) { OL[16 * d] = f2bf(o[d][0] * r0); OL[(OLB / 2) + 16 * d] = f2bf(o[d][1] * r1); OL[2 * (OLB / 2) + 16 * d] = f2bf(o[d][2] * r2); OL[3 * (OLB / 2) + 16 * d] = f2bf(o[d][3] * r3); }
      __syncthreads();
      const int r32 = lane & 31, hi = lane >> 5, wq = wid & 3;
      f32x16 acc = f32x16{};
      const bf16_t* Wv = (const bf16_t*)(ws + WS_WVB) + (size_t)(h * 128 + 32 * wq + r32) * 512 + hi * 8;
      const LAS char* ar = lds + hl * 32 * OLB + r32 * OLB + hi * 16;
#pragma unroll 8
      for (int ks = 0; ks < 32; ++ks) { const bf16x8 a = *(const LAS bf16x8*)(ar + ks * 32); const bf16x8 bw = *(const bf16x8*)(Wv + ks * 16);
          acc = __builtin_amdgcn_mfma_f32_32x32x16_bf16(a, bw, acc, 0, 0, 0); }
      bf16_t* Ow = (bf16_t*)(ws + WS_OMLA) + (size_t)(TP + b * 32) * 2048 + h * 128 + 32 * wq + r32;
#pragma unroll
      for (int r = 0; r < 16; ++r) Ow[(size_t)crow(r, hi) * 2048] = f2bf(acc[r]);
      __syncthreads(); }
#undef TDMA
}
}


struct MergeSched {
    const bf16_t *D, *WP, *OML, *WML, *OME, *WME; int G, c;
    __device__ __forceinline__ void seg_ptrs(pg8::Unit& u, int seg, int pm, int pn, int kt0) const {
        if (seg == 0) { u.A = (const char*)(D + (size_t)pm * 256 * 1024 + (pn >> 1) * 256); u.lda2 = 2048u; u.B = (const char*)(WP + (size_t)pn * 256 * 256); u.ldb2 = 512u; }
        else if (seg == 1) { u.A = (const char*)(OML + (size_t)pm * 256 * 2048 + kt0 * 64); u.lda2 = 4096u; u.B = (const char*)(WML + (size_t)pn * 256 * 2048 + kt0 * 64); u.ldb2 = 4096u; }
        else { u.A = (const char*)(OME + (size_t)pm * 256 * 1024 + kt0 * 64); u.lda2 = 2048u; u.B = (const char*)(WME + (size_t)pn * 256 * 1024 + kt0 * 64); u.ldb2 = 2048u; }
    }
    __device__ __forceinline__ bool next(int i, pg8::Unit& u) const {
        const int nmain = c < 256 ? (256 - c + G - 1) / G : 0;
        if (i < 3 * nmain) { const int ti = i / 3, seg = i - 3 * ti; int pm, pn; pg8::tile_of(ti * G + c, 32, 8, pm, pn); u.pm = pm; u.pn = pn; u.kind = seg; u.aux = 0;
            seg_ptrs(u, seg, pm, pn, 0); u.nt = seg == 0 ? 4 : (seg == 1 ? 32 : 16); return true; }
        const long p = (long)(i - 3 * nmain) * G + c; if (p >= 16 * 13) return false;
        const int t = (int)p / 13, piece = (int)p - 13 * t, pm = 32 + (t >> 3), pn = t & 7, seg = piece == 0 ? 0 : (piece < 9 ? 1 : 2);
        u.pm = pm; u.pn = pn; u.kind = 3 + seg; u.aux = (int)p; u.nt = 4;
        seg_ptrs(u, seg, pm, pn, seg == 1 ? (piece - 1) * 4 : (seg == 2 ? (piece - 9) * 4 : 0)); return true;
    }
};
struct TailSched {
    const bf16_t* A; const bf16_t* B; int K, G, c;
    __device__ __forceinline__ bool next(int i, pg8::Unit& u) const {
        const int nmain = c < 256 ? (256 - c + G - 1) / G : 0;
        u.lda2 = (unsigned)K * 2u; u.ldb2 = u.lda2;
        if (i < nmain) { int pm, pn; pg8::tile_of(i * G + c, 32, 8, pm, pn); u.pm = pm; u.pn = pn; u.kind = 0; u.aux = 0; u.nt = K / 64;
            u.A = (const char*)(A + (size_t)pm * 256 * K); u.B = (const char*)(B + (size_t)pn * 256 * K); return true; }
        const long p = (long)(i - nmain) * G + c; if (p >= 256) return false;
        const int t = (int)p >> 4, piece = (int)p & 15, pm = 32 + (t >> 3), pn = t & 7, ntp = K / 64 / 16;
        u.pm = pm; u.pn = pn; u.kind = 1; u.aux = (int)p; u.nt = ntp;
        u.A = (const char*)(A + (size_t)pm * 256 * K + piece * ntp * 64); u.B = (const char*)(B + (size_t)pn * 256 * K + piece * ntp * 64); return true;
    }
};
struct EpiMerge {
    static constexpr bool PERM = true;
    const bf16_t* G; const float* ps; bf16_t* MG; float* slab;
    __device__ __forceinline__ bool operator()(f32x4 (&acc)[2][2][4][2], const pg8::Unit& u, int wr, int wc, int fr_, int fq) const {
        int fr = fr_; asm volatile("" : "+v"(fr));
        const int row0 = u.pm * 256 + wr * 64 + fr, c0 = u.pn * 256 + wc * 32 + 8 * fq;
        const int kind = u.kind, sg = kind >= 3 ? kind - 3 : kind;
        const bool ratio = kind < 2;
        float* sl = slab + (size_t)u.aux * 65536 + (wr * 64 + fr) * 256 + wc * 32 + 8 * fq;
        f32x4 pv[2][2];
#pragma unroll
        for (int bj = 0; bj < 2; ++bj) { pv[bj][0] = (f32x4){1.f, 1.f, 1.f, 1.f}; pv[bj][1] = pv[bj][0]; }
        if (sg == 0) {
#pragma unroll
            for (int bj = 0; bj < 2; ++bj) { pv[bj][0] = *(const f32x4*)(ps + c0 + bj * 128); pv[bj][1] = *(const f32x4*)(ps + c0 + bj * 128 + 4); }
        }
#pragma unroll
        for (int ai = 0; ai < 2; ++ai) {
            u32x4 ga[4][2], gb[4][2];
#pragma unroll
            for (int m = 0; m < 4; ++m) { const bf16_t* gr = G + (size_t)(row0 + ai * 128 + m * 16) * G_LD + sg * 2048 + c0;
#pragma unroll
                for (int bj = 0; bj < 2; ++bj) { ga[m][bj] = *(const u32x4*)(gr + bj * 128); gb[m][bj] = ratio ? *(const u32x4*)(gr + 2048 + bj * 128) : (u32x4){0u, 0u, 0u, 0u}; } }
            asm volatile("" ::: "memory");
#pragma unroll
            for (int m = 0; m < 4; ++m) { const size_t row = (size_t)(row0 + ai * 128 + m * 16);
#pragma unroll
                for (int bj = 0; bj < 2; ++bj) {
                    float f[8]; unpack8(ga[m][bj], f);
                    if (ratio) { float b[8]; unpack8(gb[m][bj], b);
#pragma unroll
                        for (int e = 0; e < 8; ++e) f[e] *= __builtin_amdgcn_rcpf(b[e]); }
#pragma unroll
                    for (int e = 0; e < 8; ++e) f[e] *= pv[bj][e >> 2][e & 3];
                    f32x4& v0 = acc[ai][bj][m][0]; f32x4& v1 = acc[ai][bj][m][1];
                    v0[0] *= f[0]; v0[1] *= f[1]; v0[2] *= f[2]; v0[3] *= f[3]; v1[0] *= f[4]; v1[1] *= f[5]; v1[2] *= f[6]; v1[3] *= f[7];
                    if (kind == 2) *(u32x4*)(MG + row * 2048 + c0 + bj * 128) = (u32x4){cvtpk(v0[0], v0[1]), cvtpk(v0[2], v0[3]), cvtpk(v1[0], v1[1]), cvtpk(v1[2], v1[3])};
                    else if (kind >= 3) { float* sp = sl + (ai * 128 + m * 16) * 256 + bj * 128; *(f32x4*)sp = v0; *(f32x4*)(sp + 4) = v1; }
                } }
            asm volatile("" ::: "memory");
        }
        return kind < 2;
    }
};
__device__ __forceinline__ void store_slab(const f32x4 (&acc)[2][2][4][2], float* sl, int wr, int wc, int fr, int fq) {
    float* s0 = sl + (wr * 64 + fr) * 256 + wc * 32 + 4 * fq;
#pragma unroll
    for (int ai = 0; ai < 2; ++ai)
#pragma unroll
        for (int m = 0; m < 4; ++m)
#pragma unroll
            for (int bj = 0; bj < 2; ++bj)
#pragma unroll
                for (int n = 0; n < 2; ++n) *(f32x4*)(s0 + (ai * 128 + m * 16) * 256 + bj * 128 + n * 16) = acc[ai][bj][m][n];
}
struct EpiOut {
    static constexpr bool PERM = false;
    const float* xp; const float* xs; float* X1; bf16_t* X1b; float* SSX; float* slab;
    __device__ __forceinline__ bool operator()(f32x4 (&acc)[2][2][4][2], const pg8::Unit& u, int wr, int wc, int fr_, int fq) const {
        int fr = fr_; asm volatile("" : "+v"(fr));
        const int row0 = u.pm * 256 + wr * 64 + fr, c0 = u.pn * 256 + wc * 32 + 4 * fq;
        if (u.kind == 1) { store_slab(acc, slab + (size_t)u.aux * 65536, wr, wc, fr, fq); return false; }
#pragma unroll
        for (int ai = 0; ai < 2; ++ai) {
            f32x4 xv[4][2][2];
#pragma unroll
            for (int m = 0; m < 4; ++m) { const int row = row0 + ai * 128 + m * 16;
                const float* xr = (row < TP ? xp + (size_t)row * DM : xs + (size_t)(row - TP) * DM) + c0;
#pragma unroll
                for (int bj = 0; bj < 2; ++bj)
#pragma unroll
                    for (int n = 0; n < 2; ++n) xv[m][bj][n] = __builtin_nontemporal_load((const f32x4*)(xr + bj * 128 + n * 16)); }
            asm volatile("" ::: "memory");
#pragma unroll
            for (int m = 0; m < 4; ++m) { const int row = row0 + ai * 128 + m * 16; float s = 0.f;
#pragma unroll
                for (int bj = 0; bj < 2; ++bj)
#pragma unroll
                    for (int n = 0; n < 2; ++n) { const f32x4 v = acc[ai][bj][m][n] + xv[m][bj][n];
                        s += (v.x * v.x + v.y * v.y) + (v.z * v.z + v.w * v.w);
                        *(u32x2*)(X1b + (size_t)row * DM + c0 + bj * 128 + n * 16) = (u32x2){cvtpk(v.x, v.y), cvtpk(v.z, v.w)}; }
                s += __shfl_xor(s, 16); s += __shfl_xor(s, 32);
                if (fq == 0) SSX[(size_t)row * 32 + u.pn * 4 + wc] = s; }
            asm volatile("" ::: "memory");
        }
        return false;
    }
};
struct EpiUp {
    static constexpr bool PERM = true;
    const float* SSX; bf16_t* A;
    __device__ __forceinline__ bool operator()(f32x4 (&acc)[2][2][4][2], const pg8::Unit& u, int wr, int wc, int fr_, int fq) const {
        int fr = fr_; asm volatile("" : "+v"(fr));
        const int row0 = u.pm * 256 + wr * 64 + fr, c0 = u.pn * 256 + wc * 32 + 8 * fq;
        f32x4 sv[2][4][2];
#pragma unroll
        for (int ai = 0; ai < 2; ++ai)
#pragma unroll
            for (int m = 0; m < 4; ++m) { const size_t row = (size_t)(row0 + ai * 128 + m * 16); sv[ai][m][0] = *(const f32x4*)(SSX + row * 32 + fq * 8); sv[ai][m][1] = *(const f32x4*)(SSX + row * 32 + fq * 8 + 4); }
        asm volatile("" ::: "memory");
#pragma unroll
        for (int ai = 0; ai < 2; ++ai)
#pragma unroll
            for (int m = 0; m < 4; ++m) { const size_t row = (size_t)(row0 + ai * 128 + m * 16);
                const f32x4 s0 = sv[ai][m][0], s1 = sv[ai][m][1];
                float s = ((s0.x + s0.y) + (s0.z + s0.w)) + ((s1.x + s1.y) + (s1.z + s1.w));
                s += __shfl_xor(s, 16); s += __shfl_xor(s, 32);
                const float r = rsqrtf(s * (1.f / 2048.f) + EPS);
#pragma unroll
                for (int bj = 0; bj < 2; ++bj) { f32x4 v0 = acc[ai][bj][m][0] * r, v1 = acc[ai][bj][m][1] * r;
#pragma unroll
                    for (int e = 0; e < 4; ++e) { const float a = fmaxf(v0[e], 0.f), b = fmaxf(v1[e], 0.f); v0[e] = a * a; v1[e] = b * b; }
                    *(u32x4*)(A + row * 8192 + c0 + bj * 128) = (u32x4){cvtpk(v0[0], v0[1]), cvtpk(v0[2], v0[3]), cvtpk(v1[0], v1[1]), cvtpk(v1[2], v1[3])}; } }
        return false;
    }
};
struct EpiDown {
    static constexpr bool PERM = false;
    float* Y; const bf16_t* X1b; float* slab;
    __device__ __forceinline__ bool operator()(f32x4 (&acc)[2][2][4][2], const pg8::Unit& u, int wr, int wc, int fr_, int fq) const {
        int fr = fr_; asm volatile("" : "+v"(fr));
        const int row0 = u.pm * 256 + wr * 64 + fr, c0 = u.pn * 256 + wc * 32 + 4 * fq;
        if (u.kind == 1) { store_slab(acc, slab + (size_t)u.aux * 65536, wr, wc, fr, fq); return false; }
        u32x2 xv[2][4][2][2];
#pragma unroll
        for (int ai = 0; ai < 2; ++ai)
#pragma unroll
            for (int m = 0; m < 4; ++m) { const bf16_t* xr = X1b + (size_t)(row0 + ai * 128 + m * 16) * DM + c0;
#pragma unroll
                for (int bj = 0; bj < 2; ++bj)
#pragma unroll
                    for (int n = 0; n < 2; ++n) xv[ai][m][bj][n] = *(const u32x2*)(xr + bj * 128 + n * 16); }
        asm volatile("" ::: "memory");
#pragma unroll
        for (int ai = 0; ai < 2; ++ai)
#pragma unroll
            for (int m = 0; m < 4; ++m) { float* yr = Y + (size_t)(row0 + ai * 128 + m * 16) * DM + c0;
#pragma unroll
                for (int bj = 0; bj < 2; ++bj)
#pragma unroll
                    for (int n = 0; n < 2; ++n) { const u32x2 w = xv[ai][m][bj][n];
                        __builtin_nontemporal_store((f32x4){bflo(w.x), bfhi(w.x), bflo(w.y), bfhi(w.y)} + acc[ai][bj][m][n], (f32x4*)(yr + bj * 128 + n * 16)); } }
        return false;
    }
};
template <int NP> __device__ __forceinline__ f32x4 slab_sum(const float* slab, int t, int r, int lane) {
    const float* sp = slab + ((size_t)t * NP) * 65536 + r * 256 + lane * 4;
    f32x4 s = *(const f32x4*)sp;
#pragma unroll
    for (int p = 1; p < NP; ++p) s += *(const f32x4*)(sp + (size_t)p * 65536);
    return s;
}
__device__ __forceinline__ void reduce_merge(const float* slab, bf16_t* MG, int gw, int NGW, int lane) {
    for (int it = gw; it < TS * 4; it += NGW) { const int rs = it >> 2, q = it & 3, r = rs & 255, t0 = (rs >> 8) * 8;
#pragma unroll
        for (int pn = 2 * q; pn < 2 * q + 2; ++pn) { const f32x4 s = slab_sum<13>(slab, t0 + pn, r, lane);
            *(u32x2*)(MG + (size_t)(TP + rs) * DM + pn * 256 + lane * 4) = (u32x2){cvtpk(s.x, s.y), cvtpk(s.z, s.w)}; } }
}
__device__ __forceinline__ void reduce_out(const float* slab, const float* xs, float* X1, bf16_t* X1b, float* SSX, int gw, int NGW, int lane) {
    for (int it = gw; it < TS * 4; it += NGW) { const int rs = it >> 2, q = it & 3, r = rs & 255, t0 = (rs >> 8) * 8; float ss = 0.f;
#pragma unroll
        for (int pn = 2 * q; pn < 2 * q + 2; ++pn) { const size_t o = (size_t)rs * DM + pn * 256 + lane * 4;
            const f32x4 v = slab_sum<16>(slab, t0 + pn, r, lane) + *(const f32x4*)(xs + o);
            ss += (v.x * v.x + v.y * v.y) + (v.z * v.z + v.w * v.w);
            *(u32x2*)(X1b + (size_t)TP * DM + o) = (u32x2){cvtpk(v.x, v.y), cvtpk(v.z, v.w)}; }
        ss = wave_sum(ss);
        if (lane < 8) SSX[(size_t)(TP + rs) * 32 + q * 8 + lane] = lane == 0 ? ss : 0.f; }
}
__device__ __forceinline__ void reduce_down(const float* slab, const bf16_t* X1b, float* Y, int gw, int NGW, int lane) {
    for (int it = gw; it < TS * 4; it += NGW) { const int rs = it >> 2, q = it & 3, r = rs & 255, t0 = (rs >> 8) * 8;
#pragma unroll
        for (int pn = 2 * q; pn < 2 * q + 2; ++pn) { const size_t o = (size_t)(TP + rs) * DM + pn * 256 + lane * 4; const u32x2 w = *(const u32x2*)(X1b + o);
            *(f32x4*)(Y + o) = (f32x4){bflo(w.x), bfhi(w.x), bflo(w.y), bfhi(w.y)} + slab_sum<16>(slab, t0 + pn, r, lane); } }
}

struct SchedB {
    const unsigned char* ws; int G, c;
    __device__ __forceinline__ bool next(int i, pg8::Unit& u) const {
        const long L = (long)i * G + c; constexpr int N0 = 34 * 37, N1 = 2 * 8; if (L >= N0 + N1) return false;
        int pm, pn; u.lda2 = 4096u; u.ldb2 = 4096u; u.nt = 32;
        if (L < N0) { pg8::tile_of((int)L, 34, 37, pm, pn); u.A = (const char*)(ws + WS_H + (size_t)pm * 256 * 4096); u.B = (const char*)(ws + WS_WIN + (size_t)pn * 256 * 4096); u.kind = 0; }
        else { pg8::tile_of((int)L - N0, 2, 8, pm, pn); u.A = (const char*)(ws + WS_HM + (size_t)pm * 256 * 4096); u.B = (const char*)(ws + WS_WMEMKV + (size_t)pn * 256 * 4096); u.kind = 1; }
        u.pm = pm; u.pn = pn; return true;
    }
};
__device__ __forceinline__ void mem_unit(int u, int& row0, int& bsel, int& h) {
    h = u & 3;
    if (u < 128) { const int b = u >> 6, pt = (u >> 2) & 15; row0 = b * 4096 + pt * 256; bsel = b; }
    else { const int b = (u - 128) >> 2; row0 = TP + b * 32; bsel = 2 + b; }
}
struct SchedD {
    const unsigned char* ws; const unsigned char* ob; int G, c;
    __device__ __forceinline__ bool next(int i, pg8::Unit& u) const {
        const long L = (long)i * G + c; constexpr int N0 = (NBS * KPAD / 256) * 8, N1 = N0 + 34 * 12, N2 = N1 + 32 * 8, N3 = N2 + 32 * 8, N4 = N3 + 192; if (L >= N4) return false;
        int pm, pn; u.lda2 = 1024u; u.ldb2 = 1024u; u.nt = 8; u.aux = 0;
        if (L < N0) { pg8::tile_of((int)L, NBS * KPAD / 256, 8, pm, pn); u.A = (const char*)(ws + WS_LATS + (size_t)pm * 256 * 1024); u.B = (const char*)(ws + WS_WKB + (size_t)pn * 256 * 1024); u.kind = 3; }
        else if (L < N1) { pg8::tile_of((int)L - N0, 34, 12, pm, pn); u.A = (const char*)(ws + WS_QN + (size_t)pm * 256 * 1024); u.B = (const char*)(ws + WS_WQB + (size_t)pn * 256 * 1024); u.kind = 0; }
        else if (L < N2) { pg8::tile_of((int)L - N1, 32, 8, pm, pn); u.A = (const char*)(ob + DO_CKVP + (size_t)pm * 256 * 1024); u.B = (const char*)(ws + WS_WKB + (size_t)pn * 256 * 1024); u.kind = 1; }
        else if (L < N3) { pg8::tile_of((int)L - N2, 32, 8, pm, pn); u.A = (const char*)(ob + DO_CKVP + (size_t)pm * 256 * 1024); u.B = (const char*)(ws + WS_WVB + (size_t)pn * 256 * 1024); u.kind = 2; }
        else { const int mu = (int)L - N3; int row0, bsel, h; mem_unit(mu, row0, bsel, h);
            u.A = (const char*)(ws + WS_QM + ((size_t)row0 * 1024 + h * 256) * 2); u.B = (const char*)(ws + WS_MK + ((size_t)bsel * 262144 + h * 256) * 2); u.lda2 = 2048u; u.ldb2 = 2048u; u.nt = 4;
            u.kind = mu < 128 ? 4 : 5; pm = row0; pn = h; }
        u.pm = pm; u.pn = pn; return true;
    }
};
struct SchedMO {
    const unsigned char* ws; int G, c;
    __device__ __forceinline__ bool next(int i, pg8::Unit& u) const {
        const long L = (long)i * G + c; if (L >= 192) return false;
        int row0, bsel, h; mem_unit((int)L, row0, bsel, h);
        u.A = (const char*)(ws + WS_PM + ((size_t)row0 * 1024 + h * 256) * 2); u.B = (const char*)(ws + WS_MVT + ((size_t)bsel * 262144 + (size_t)h * 65536) * 2); u.lda2 = 2048u; u.ldb2 = 512u; u.nt = 4;
        u.kind = L < 128 ? 4 : 5; u.pm = row0; u.pn = h; u.aux = 0; return true;
    }
};
struct EpiMO {
    static constexpr bool PERM = true;
    const float* PS; bf16_t* O;
    __device__ __forceinline__ bool operator()(f32x4 (&acc)[2][2][4][2], const pg8::Unit& u, int wr, int wc, int fr_, int fq) const {
        int fr = fr_; asm volatile("" : "+v"(fr));
        const int c0 = u.pn * 256 + wc * 32 + 8 * fq;
        f32x4 sv[2][4];
#pragma unroll
        for (int ai = 0; ai < 2; ++ai)
#pragma unroll
            for (int m = 0; m < 4; ++m) { const int rl = ai * 128 + wr * 64 + m * 16 + fr; sv[ai][m] = *(const f32x4*)(PS + (size_t)(u.pm + ((u.kind == 5 && rl >= 32) ? 0 : rl)) * 16 + u.pn * 4); }
        asm volatile("" ::: "memory");
#pragma unroll
        for (int ai = 0; ai < 2; ++ai)
#pragma unroll
            for (int m = 0; m < 4; ++m) { const int rl = ai * 128 + wr * 64 + m * 16 + fr; if (u.kind == 5 && rl >= 32) continue;
                const size_t row = (size_t)(u.pm + rl); const f32x4 s4 = sv[ai][m];
                const float inv = __builtin_amdgcn_rcpf((s4.x + s4.y) + (s4.z + s4.w));
#pragma unroll
                for (int bj = 0; bj < 2; ++bj) { const f32x4 v0 = acc[ai][bj][m][0] * inv, v1 = acc[ai][bj][m][1] * inv;
                    *(u32x4*)(O + row * 1024 + c0 + bj * 128) = (u32x4){cvtpk(v0[0], v0[1]), cvtpk(v0[2], v0[3]), cvtpk(v1[0], v1[1]), cvtpk(v1[2], v1[3])}; } }
        return false;
    }
};

constexpr int CW_BAR = 4096, CW_QUEUE = 64;
#ifndef PROBE_K
#define PROBE_K -1
#endif
#ifndef PROBE_BX
#define PROBE_BX 0
#endif
#define STAMP(k) do { if (PROBE_K >= 0 && bx == 0 && tid == 0) { const unsigned long long t_ = __builtin_amdgcn_s_memrealtime(); MISC[32 + 2 * (k)] = (unsigned)t_; MISC[33 + 2 * (k)] = (unsigned)(t_ >> 32); } } while (0)
#ifndef ONLY
#define ONLY -1
#endif
#define PH(x) (ONLY < 0 || ONLY == (x))
__global__ void __launch_bounds__(NWAVES * 64, 2) mega_fwd(Args P) {
    extern __shared__ __attribute__((aligned(16))) unsigned char lds_raw[];
    LAS unsigned char* lds = (LAS unsigned char*)lds_raw;
    const int tid = threadIdx.x, lane = tid & 63, wave = __builtin_amdgcn_readfirstlane(tid >> 6);
    const int G = gridDim.x, bx = blockIdx.x;
    const int vcu = (G % 8 == 0) ? (bx % 8) * (G / 8) + bx / 8 : bx;
    const int gw = vcu * NWAVES + wave, NGW = G * NWAVES;
    volatile LAS unsigned* MISC = (volatile LAS unsigned*)(lds + MISC_OFF);
    if (tid < 64) MISC[tid] = 0u;
    __syncthreads();
    unsigned* ctl = (unsigned*)(P.ws + WS_CTL);
    XcdBarrier bar = xcd_barrier_post(ctl + CW_BAR, MISC + 8); bar.wv = wave;
    unsigned char* ws = P.ws;
    STAMP(0);

#define LAUNDER() int lane_l = lane_id(), gw_l = gw; asm volatile("" : "+v"(lane_l)); asm volatile("" : "+s"(gw_l))
    if (PH(0)) { LAUNDER(); phase_prep(P, lds, gw_l, NGW, wave, lane_l); }
    xcd_barrier(bar); STAMP(1);
    if (PH(1)) {
        SchedB S{ws, G, bx};
        EpiIn E{(bf16_t*)(ws + WS_ZS), (bf16_t*)(ws + WS_G), (float*)(ws + WS_M), P.in[I_BGATE]};
        pg8::gemm_stream<EpiIn, SchedB>(lds, S, E, wave);
    }
    xcd_barrier(bar); STAMP(2);
    if (PH(2)) { LAUNDER(); phase_rows(P, lds, gw_l, NGW, wave, lane_l); }
    xcd_barrier(bar); STAMP(3);
    if (PH(3)) {
        SchedD S{ws, (const unsigned char*)P.out, G, bx};
        EpiQKV E{(bf16_t*)(ws + WS_Q), (bf16_t*)((unsigned char*)P.out + DO_K), (bf16_t*)(ws + WS_V), (float*)(ws + WS_RKG), (bf16_t*)(ws + WS_PM), (float*)(ws + WS_PS),
                 (const float*)(ws + WS_KPESS), (const float*)(ws + WS_KPESSP), (const bf16_t*)(ws + WS_KRP), P.in[I_GKHEAD], lds};
        pg8::gemm_stream<EpiQKV, SchedD>(lds, S, E, wave);
    }
    xcd_barrier(bar); STAMP(4);
    {
        const bf16_t* Qg = (const bf16_t*)(ws + WS_Q); const bf16_t* Kg = (const bf16_t*)((unsigned char*)P.out + DO_K); const bf16_t* Vg = (const bf16_t*)(ws + WS_V);
        bf16_t* Og = (bf16_t*)(ws + WS_OMLA);
        constexpr int NI_P = 512;
#define DEQUEUE(qw) ({ LAS unsigned* mq_ = (LAS unsigned*)(lds + MISC_OFF + 64); asm volatile("" : "+s"(mq_));   \
        if (wave == 0 && lane_id() == 0) *(volatile LAS unsigned*)mq_ = __hip_atomic_fetch_add(ctl + (qw), 1u, __ATOMIC_RELAXED, __HIP_MEMORY_SCOPE_AGENT); __syncthreads(); const int it_ = (int)*(volatile LAS unsigned*)mq_; __syncthreads(); it_; })
#define PROBE_BEGIN() const bool pr_ = PROBE_K >= 20 && bx == PROBE_BX && tid == 0; unsigned long long ts_ = 0; if (pr_) ts_ = __builtin_amdgcn_s_memrealtime()
#define PROBE_END(pk) do { if (pr_ && (pk) == PROBE_K && MISC[20] == 0u) { MISC[20] = 1u; MISC[21] = (unsigned)(__builtin_amdgcn_s_memrealtime() - ts_); } } while (0)
        if (PH(7)) { SchedMO S{ws, G, bx}; EpiMO E{(const float*)(ws + WS_PS), (bf16_t*)(ws + WS_OMEM)};
            pg8::gemm_stream<EpiMO, SchedMO>(lds, S, E, wave); __syncthreads(); }
        const int xq = (int)(bar.x & 7u);
        unsigned long long tf0_ = 0; if (PROBE_K >= 40 && tid == 0) tf0_ = __builtin_amdgcn_s_memrealtime();
#define LOOP_T0() unsigned long long tl_ = 0; if (PROBE_K >= 23 && PROBE_K < 40 && bx == 0 && tid == 0) tl_ = __builtin_amdgcn_s_memrealtime()
#define LOOP_T1(pk) do { if (PROBE_K == (pk) && bx == 0 && tid == 0) MISC[21] = (unsigned)(__builtin_amdgcn_s_memrealtime() - tl_); \
        if (PROBE_K >= 40 && tid == 0) ctl[8192 + ((pk) - 23) * 256 + bx] = (unsigned)(__builtin_amdgcn_s_memrealtime() - tf0_); } while (0)
        { LOOP_T0();
        if (PH(6)) for (;;) { const int it = DEQUEUE(CW_QUEUE + 64 * (1 + xq)); if (it >= 16) break; PROBE_BEGIN();
            sat::unit(P, 2 * xq + (it & 1), it >> 1, (LAS char*)lds, wave); PROBE_END(20); }
        LOOP_T1(23); }
        if (PH(6)) for (int qq = 1; qq < 8; ++qq) { const int q = (xq + qq) & 7;
            for (;;) { const int it = DEQUEUE(CW_QUEUE + 64 * (1 + q)); if (it >= 16) break; sat::unit(P, 2 * q + (it & 1), it >> 1, (LAS char*)lds, wave); } }
        { LOOP_T0();
        if (PH(5)) for (;;) { const int it = DEQUEUE(CW_QUEUE + 64 * 9); if (it >= NI_P) break; PROBE_BEGIN();
            const int qb = 15 - (it >> 5), bh = it & 31, b = bh >> 4, h = bh & 15;
            pat::unit(Qg + ((size_t)(b * 4096 + qb * 256) * QLD + h * 192), Kg + ((size_t)b * 4096 * QLD + h * 192), Vg + ((size_t)b * 4096 * 2048 + h * 128),
                      Og + ((size_t)(b * 4096 + qb * 256) * 2048 + h * 128), qb, (LAS char*)lds, P.in[I_GQHEAD], wave); PROBE_END(21);
            if (pr_ && PROBE_K == 26) MISC[21] += (unsigned)(__builtin_amdgcn_s_memrealtime() - ts_);
            if (pr_ && PROBE_K == 27) MISC[21] += 25u * (unsigned)(4 * qb + 4); }
        LOOP_T1(24); }
    }
    xcd_barrier(bar); STAMP(5);
    if (PROBE_K >= 40 && bx == 0 && tid == 0) {
        const int lp = (PROBE_K - 40) >> 1; unsigned long long sum = 0; unsigned mx = 0;
        for (int i = 0; i < G; ++i) { const unsigned v = __hip_atomic_load(ctl + 8192 + lp * 256 + i, __ATOMIC_RELAXED, __HIP_MEMORY_SCOPE_AGENT); sum += v; mx = v > mx ? v : mx; }
        MISC[21] = (PROBE_K & 1) ? mx : (unsigned)(sum / G); }
    if (PH(8)) {
        MergeSched S{(const bf16_t*)(ws + WS_DP), (const bf16_t*)(ws + WS_WPOOL), (const bf16_t*)(ws + WS_OMLA), (const bf16_t*)(ws + WS_WMLAO),
                     (const bf16_t*)(ws + WS_OMEM), (const bf16_t*)(ws + WS_WMEMO), G, bx};
        EpiMerge E{(const bf16_t*)(ws + WS_G), P.in[I_PSCALE], (bf16_t*)(ws + WS_MG), (float*)(ws + WS_Q)};
        pg8::gemm_stream<EpiMerge, MergeSched>(lds, S, E, wave);
        xcd_barrier(bar); STAMP(6);
        { LAUNDER(); reduce_merge((const float*)(ws + WS_Q), (bf16_t*)(ws + WS_MG), gw_l, NGW, lane_l); }
    }
    xcd_barrier(bar); STAMP(7);
    if (PH(9)) {
        TailSched S{(const bf16_t*)(ws + WS_MG), (const bf16_t*)(ws + WS_WOUT), 2048, G, bx};
        EpiOut E{P.in[I_XP], P.in[I_XS], P.out + O_YP, (bf16_t*)(ws + WS_X1B), (float*)(ws + WS_SSX), (float*)(ws + WS_G)};
        pg8::gemm_stream<EpiOut, TailSched>(lds, S, E, wave);
        xcd_barrier(bar); STAMP(8);
        { LAUNDER(); reduce_out((const float*)(ws + WS_G), P.in[I_XS], P.out + O_YP, (bf16_t*)(ws + WS_X1B), (float*)(ws + WS_SSX), gw_l, NGW, lane_l); }
    }
    xcd_barrier(bar); STAMP(9);
    if (PH(10)) {
        pg8::JobSched1 S; S.j0 = pg8::Job{(const bf16_t*)(ws + WS_X1B), (const bf16_t*)(ws + WS_WUP), 2048, 2048, 34, 32, 0}; S.finish(G, bx);
        EpiUp E{(const float*)(ws + WS_SSX), (bf16_t*)(ws + WS_A)};
        pg8::gemm_stream<EpiUp, pg8::JobSched1>(lds, S, E, wave);
    }
    xcd_barrier(bar); STAMP(10);
    if (PH(11)) {
        TailSched S{(const bf16_t*)(ws + WS_A), (const bf16_t*)(ws + WS_WDOWN), 8192, G, bx};
        EpiDown E{P.out + O_YP, (const bf16_t*)(ws + WS_X1B), (float*)(ws + WS_H)};
        pg8::gemm_stream<EpiDown, TailSched>(lds, S, E, wave);
        xcd_barrier(bar); STAMP(11);
        { LAUNDER(); reduce_down((const float*)(ws + WS_H), (const bf16_t*)(ws + WS_X1B), P.out + O_YP, gw_l, NGW, lane_l); }
    }
    if (PROBE_K == 30 && bx == 0) {
        __syncthreads(); unsigned long long ti_ = 0; if (tid == 0) ti_ = __builtin_amdgcn_s_memrealtime();
        pat::unit((const bf16_t*)(ws + WS_Q) + ((size_t)(15 * 256) * QLD), (const bf16_t*)((unsigned char*)P.out + DO_K), (const bf16_t*)(ws + WS_V), (bf16_t*)(ws + WS_OMLA) + ((size_t)(15 * 256) * 2048), 15, (LAS char*)lds, P.in[I_GQHEAD], wave);
        if (tid == 0) MISC[21] = (unsigned)(__builtin_amdgcn_s_memrealtime() - ti_);
    }
    if (PROBE_K == 32 || PROBE_K == 33) {
        __syncthreads(); unsigned long long ti_ = 0; if (tid == 0) ti_ = __builtin_amdgcn_s_memrealtime();
        const int bh_ = PROBE_K == 32 ? (bx & 31) : ((bx >> 3) & 31), b_ = bh_ >> 4, h_ = bh_ & 15;
        pat::unit((const bf16_t*)(ws + WS_Q) + ((size_t)(b_ * 4096 + 15 * 256) * QLD + h_ * 192), (const bf16_t*)((unsigned char*)P.out + DO_K) + ((size_t)b_ * 4096 * QLD + h_ * 192),
                  (const bf16_t*)(ws + WS_V) + ((size_t)b_ * 4096 * 2048 + h_ * 128), (bf16_t*)(ws + WS_OMLA) + ((size_t)(b_ * 4096 + 15 * 256) * 2048 + h_ * 128), 15, (LAS char*)lds, P.in[I_GQHEAD], wave);
        if (tid == 0 && bx == 0) MISC[21] = (unsigned)(__builtin_amdgcn_s_memrealtime() - ti_);
    }
    if ((PROBE_K == 34 || PROBE_K == 35) && bx == 0) {
        __syncthreads(); unsigned long long ti_ = 0; if (tid == 0) ti_ = __builtin_amdgcn_s_memrealtime();
        sat::unit<PROBE_K == 34 ? 1 : 2>(P, 0, 0, (LAS char*)lds, wave);
        if (tid == 0) MISC[21] = (unsigned)(__builtin_amdgcn_s_memrealtime() - ti_);
    }
    if (PROBE_K == 31 && bx == 0) {
        __syncthreads(); unsigned long long ti_ = 0; if (tid == 0) ti_ = __builtin_amdgcn_s_memrealtime();
        sat::unit(P, 0, 0, (LAS char*)lds, wave);
        if (tid == 0) MISC[21] = (unsigned)(__builtin_amdgcn_s_memrealtime() - ti_);
    }
    if (PROBE_K >= 0 && bx == 0) {
        __syncthreads();
        if (tid == 0) { STAMP(12);
            constexpr int PKI = PROBE_K >= 0 && PROBE_K < 13 ? PROBE_K : 0;
            const unsigned long long a_ = ((unsigned long long)MISC[33 + 2 * PKI] << 32) | MISC[32 + 2 * PKI], b_ = ((unsigned long long)MISC[35 + 2 * PKI] << 32) | MISC[34 + 2 * PKI];
            const unsigned long long t0_ = __builtin_amdgcn_s_memrealtime(), dl_ = PROBE_K >= 20 ? 4ull * MISC[21] : 4ull * (b_ - a_);
            while (__builtin_amdgcn_s_memrealtime() - t0_ < dl_) __builtin_amdgcn_s_sleep(16); }
    }
}

extern "C" void kernel_launch(void* const* d_in, const int* in_sizes, int n_in, void* d_out, int out_size, void* d_ws, size_t ws_size, hipStream_t stream) {
    static int grid = 0;
    if (grid == 0) {
        if (n_in != 30 || ws_size < WS_END || out_size != 24164352) { fprintf(stderr, "kernel_launch: unexpected problem: n_in %d out %d ws %zu (need %zu)\n", n_in, out_size, ws_size, (size_t)WS_END); grid = -1; return; }
        int dev = 0, cus = 0, per_cu = 0;
        if (hipGetDevice(&dev) != hipSuccess || hipDeviceGetAttribute(&cus, hipDeviceAttributeMultiprocessorCount, dev) != hipSuccess) { grid = -1; return; }
        if (hipFuncSetAttribute((const void*)mega_fwd, hipFuncAttributeMaxDynamicSharedMemorySize, LDS_BYTES) != hipSuccess) { fprintf(stderr, "kernel_launch: hipFuncSetAttribute(%d) failed\n", LDS_BYTES); grid = -1; return; }
        if (hipOccupancyMaxActiveBlocksPerMultiprocessor(&per_cu, (const void*)mega_fwd, NWAVES * 64, LDS_BYTES) != hipSuccess || per_cu < 1) { fprintf(stderr, "kernel_launch: occupancy query says %d blocks per CU\n", per_cu); grid = -1; (void)hipGetLastError(); return; }
        grid = cus;
    }
    if (grid < 0) return;
    (void)hipMemsetAsync((char*)d_ws + WS_CTL, 0, CTL_ZERO_BYTES, stream);
    Args a{};
    for (int i = 0; i < 30; ++i) a.in[i] = (const float*)d_in[i];
    a.out = (float*)d_out; a.ws = (unsigned char*)d_ws;
    hipLaunchKernelGGL(mega_fwd, dim3(grid), dim3(NWAVES * 64), LDS_BYTES, stream, a);
}
```

```cpp
#include <hip/hip_runtime.h>
#include <cstdio>
#include <cstdint>

#define LAS __attribute__((address_space(3)))
#define GAS __attribute__((address_space(1)))
typedef unsigned short bf16_t;
typedef short bf16x8 __attribute__((ext_vector_type(8)));
typedef short s16x4 __attribute__((ext_vector_type(4)));
typedef float f32x2 __attribute__((ext_vector_type(2)));
typedef float f32x4 __attribute__((ext_vector_type(4)));
typedef float f32x16 __attribute__((ext_vector_type(16)));
typedef unsigned u32x2 __attribute__((ext_vector_type(2)));
typedef unsigned u32x4 __attribute__((ext_vector_type(4)));
typedef __bf16 bf16x2_t __attribute__((ext_vector_type(2)));

constexpr int DM = 2048, TP = 8192, TS = 512, TT = TP + TS, SEQ = 4096, LS = 32, NBS = 16;
constexpr int KPAD = 4160;
constexpr int ZS_LD = 3136, G_LD = 6144, QLD = 3072, NHEAD = 16;
constexpr float EPS = 1e-6f;
constexpr float MLA_C = 0.07216878364870322f * 1.4426950408889634f;
constexpr float MEM_C = 0.0625f * 1.4426950408889634f;
constexpr size_t O_YP = 0, O_YS = 16777216, O_LATP = 17825792, O_KPEP = 22020096, O_POOLP = 22544384, O_MEMK = 22575104, O_MEMV = 23099392,
                 O_LATS = 23623680, O_KPES = 23885824, O_POOLS = 23918592;
constexpr size_t MiB = 1u << 20;
constexpr size_t WS_CTL = 0, CTL_ZERO_BYTES = 1 * MiB;
constexpr size_t WS_WIN = 1 * MiB, WS_WMEMKV = 38 * MiB, WS_WQB = 46 * MiB, WS_WKB = 49 * MiB, WS_WVB = 51 * MiB, WS_WKBN = 53 * MiB, WS_WPOOL = 55 * MiB,
                 WS_WMLAO = 56 * MiB, WS_WMEMO = 64 * MiB, WS_WOUT = 68 * MiB, WS_WUP = 76 * MiB, WS_WDOWN = 108 * MiB;
constexpr size_t WS_G = 140 * MiB, WS_ZS = 242 * MiB, WS_Q = 242 * MiB, WS_A = 140 * MiB;
constexpr size_t WS_LATS = 295 * MiB, WS_KRS = 360 * MiB, WS_KPESS = 368 * MiB + 512 * 1024, WS_MG = 295 * MiB, WS_X1B = 329 * MiB;
constexpr size_t WS_H = 369 * MiB, WS_DP = 369 * MiB, WS_QN = 386 * MiB, WS_OMEM = 386 * MiB, WS_OMLA = 1 * MiB;
constexpr size_t WS_RKG = 403 * MiB;
constexpr size_t WS_HM = 403 * MiB, WS_M = 405 * MiB, WS_QM = 409 * MiB, WS_V = 426 * MiB, WS_KSS = 458 * MiB, WS_MK = 475 * MiB, WS_MVT = 484 * MiB,
                 WS_KRP = 493 * MiB, WS_KPESSP = 494 * MiB, WS_SSX = 494 * MiB + 256 * 1024,
                 WS_PM = 496 * MiB  , WS_PS = 514 * MiB  , WS_END = 515 * MiB;
constexpr size_t DO_K = 0, DO_CKVP = 56 * MiB;

constexpr int LDS_BYTES = 160 * 1024, MISC_OFF = LDS_BYTES - 256;
constexpr int NWAVES = 8;

#define LDS_WAIT() asm volatile("s_waitcnt lgkmcnt(0)" ::: "memory")
#define VM_WAIT() asm volatile("s_waitcnt vmcnt(0)" ::: "memory")
#define SBAR() __builtin_amdgcn_sched_barrier(0)
__device__ __forceinline__ unsigned cvtpk(float lo, float hi) { f32x2 v = {lo, hi}; bf16x2_t b = __builtin_convertvector(v, bf16x2_t); return __builtin_bit_cast(unsigned, b); }
__device__ __forceinline__ float bflo(unsigned u) { return __uint_as_float(u << 16); }
__device__ __forceinline__ float bfhi(unsigned u) { return __uint_as_float(u & 0xffff0000u); }
__device__ __forceinline__ float bf2f(bf16_t b) { return __uint_as_float((unsigned)b << 16); }
__device__ __forceinline__ bf16_t f2bf(float f) { return (bf16_t)(cvtpk(f, 0.f) & 0xffffu); }
__device__ __forceinline__ float wave_sum(float v) {
#pragma unroll
    for (int o = 1; o < 64; o <<= 1) v += __shfl_xor(v, o);
    return v;
}
__device__ __forceinline__ int lane_id() { int r; asm volatile("v_mbcnt_lo_u32_b32 %0, -1, 0\n\tv_mbcnt_hi_u32_b32 %0, -1, %0" : "=v"(r)); return r; }
__device__ __forceinline__ int crow(int r, int hi) { return (r & 3) + 8 * (r >> 2) + 4 * hi; }
__device__ __forceinline__ void fast_sincos(float ang, float& sn, float& cs) {
    float t = ang * 0.15915494309189535f; t = t - floorf(t);
    sn = __builtin_amdgcn_sinf(t); cs = __builtin_amdgcn_cosf(t);
}
__device__ __forceinline__ float rope_inv(int j) { return __builtin_amdgcn_exp2f(-(float)j * (13.287712379549449f / 32.0f)); }

typedef short v4i16_t __attribute__((ext_vector_type(4)));
__device__ __forceinline__ s16x4 vtr(const LAS char* p) { return __builtin_bit_cast(s16x4, __builtin_amdgcn_ds_read_tr16_b64_v4i16((LAS v4i16_t*)p)); }
#define PKV(L, H) (bf16x8){L[0], L[1], L[2], L[3], H[0], H[1], H[2], H[3]}

#define XB_TMO      128
#define XB_XCNT(j)  (256  + 64 * (j))
#define XB_XSUB(j)  (1280 + 64 * (j))
#define XB_XGEN(j)  (2304 + 64 * (j))
#define XB_TOP      3328
#define XB_TOPGEN   3392
#define XCD_BAR_WORDS 3456
#define XB_SPIN_CAP (1u << 20)
__device__ __forceinline__ unsigned xb_ld(unsigned* p)              { return __hip_atomic_load(p, __ATOMIC_RELAXED, __HIP_MEMORY_SCOPE_AGENT); }
__device__ __forceinline__ unsigned xb_add(unsigned* p, unsigned v) { return __hip_atomic_fetch_add(p, v, __ATOMIC_RELAXED, __HIP_MEMORY_SCOPE_AGENT); }
__device__ __forceinline__ unsigned xb_xcc_id() { return (unsigned)__builtin_amdgcn_s_getreg((3 << 11) | 20) & 0xFu; }
#define XB_SPIN(cond, bar) do { unsigned _sp = 0; while (cond) { __builtin_amdgcn_s_sleep(1); \
    if ((++_sp & 255u) == 0u) { if (xb_ld(&(bar)[XB_TMO])) break; if (_sp > XB_SPIN_CAP) { atomicAdd(&(bar)[XB_TMO], 1u); break; } } } } while (0)
struct XcdBarrier { unsigned* bar; unsigned x; volatile LAS unsigned* st; int wv; };
__device__ __forceinline__ XcdBarrier xcd_barrier_post(unsigned* bar, volatile LAS unsigned* st) {
    XcdBarrier b; b.bar = bar; b.x = xb_xcc_id(); b.st = st; b.wv = 0;
    if (threadIdx.x == 0) (void)xb_add(&bar[XB_XCNT(b.x)], 1u);
    return b;
}
__device__ __forceinline__ void xcd_barrier_complete(unsigned* bar, unsigned x, unsigned& nloc, unsigned& nx) {
    const unsigned G = gridDim.x * gridDim.y * gridDim.z;
    unsigned sum, cnt, mine, sp = 0u;
    for (;;) {
        sum = 0u; cnt = 0u; mine = 0u;
#pragma unroll
        for (unsigned j = 0; j < 16; ++j) { const unsigned c = xb_ld(&bar[XB_XCNT(j)]); sum += c; cnt += (c > 0u) ? 1u : 0u; mine = (j == x) ? c : mine; }
        if (sum == G) break;
        __builtin_amdgcn_s_sleep(1);
        if ((++sp & 255u) == 0u) { if (xb_ld(&bar[XB_TMO])) break; if (sp > XB_SPIN_CAP) { atomicAdd(&bar[XB_TMO], 1u); break; } }
    }
    nloc = mine > 0u ? mine : 1u; nx = cnt > 0u ? cnt : 1u;
}
__device__ __forceinline__ void xcd_barrier(const XcdBarrier& b) {
    asm volatile("s_waitcnt vmcnt(0)" ::: "memory");
    __syncthreads();
    if (threadIdx.x == 0) {
        unsigned* bar = b.bar;
        __builtin_amdgcn_s_waitcnt(0);
        unsigned nloc = b.st[0], nx = b.st[1];
        if (nloc == 0u) { xcd_barrier_complete(bar, b.x, nloc, nx); b.st[0] = nloc; b.st[1] = nx; }
        const unsigned old = xb_add(&bar[XB_XSUB(b.x)], 1u);
        const unsigned gen = old / nloc;
        if (old + 1u == (gen + 1u) * nloc) {
            __builtin_amdgcn_fence(__ATOMIC_RELEASE, "agent");
            asm volatile("s_waitcnt vmcnt(0)" ::: "memory");
            const unsigned og = xb_add(&bar[XB_TOP], 1u);
            const unsigned tg = og / nx;
            if (og + 1u == (tg + 1u) * nx) xb_add(&bar[XB_TOPGEN], 1u);
            else XB_SPIN(xb_ld(&bar[XB_TOPGEN]) == tg, bar);
            __builtin_amdgcn_fence(__ATOMIC_ACQUIRE, "agent");
            xb_add(&bar[XB_XGEN(b.x)], 1u);
            asm volatile("s_waitcnt vmcnt(0)" ::: "memory");
        } else {
            XB_SPIN(xb_ld(&bar[XB_XGEN(b.x)]) == gen, bar);
            __builtin_amdgcn_fence(__ATOMIC_ACQUIRE, "agent");
            asm volatile("s_waitcnt vmcnt(0)" ::: "memory");
        }
    }
    __syncthreads();
}

namespace pg8 {
constexpr int BM = 256, BK = 64, HALF = 128, HTB = HALF * BK * 2, STAGE_BYTES = 8 * HTB, NXCD = 8, WGM = 8;
__device__ __forceinline__ int lds_byte(int r, int c) { const int st = (r >> 4) * 2 + (c >> 5), rr = r & 15, cc = c & 31, ob = rr * 64 + cc * 2; return st * 1024 + (ob ^ (((ob >> 9) & 1) << 5)); }
__device__ __forceinline__ void stage_rc(int b, int& R, int& C) { const int st = b / 1024, sb = b % 1024, swz = sb ^ (((sb >> 9) & 1) << 5); R = (st >> 1) * 16 + swz / 64; C = (st & 1) * 32 + (swz % 64) / 2; }
__device__ __forceinline__ int perm32(int rho) { const int n = rho >> 4, i = rho & 15; return 8 * (i >> 2) + 4 * n + (i & 3); }

struct Unit { const char* A; const char* B; unsigned lda2, ldb2; int nt, pm, pn, kind, aux; };

__device__ __forceinline__ void tile_of(int wgid, int nM, int nN, int& pm, int& pn) {
    const int nwg = nM * nN;
    { const int q = nwg / NXCD, r = nwg % NXCD, xcd = wgid % NXCD, off = wgid / NXCD; wgid = (xcd < r ? xcd * (q + 1) : r * (q + 1) + (xcd - r) * q) + off; }
    const int nig = WGM * nN, gid = wgid / nig, fm = gid * WGM, gsz = (nM - fm) < WGM ? (nM - fm) : WGM;
    pm = fm + ((wgid % nig) % gsz); pn = (wgid % nig) / gsz;
}

struct Job { const bf16_t* A; const bf16_t* B; int lda, K, nM, nN, kind; };
struct JobSched1 {
    Job j0; int G, c;
    __device__ __forceinline__ void finish(int G_, int c_) { G = G_; c = c_; }
    __device__ __forceinline__ bool next(int i, Unit& u) const {
        const long L = (long)i * G + c; if (L >= j0.nM * j0.nN) return false;
        int pm, pn; tile_of((int)L, j0.nM, j0.nN, pm, pn);
        u.A = (const char*)(j0.A + (size_t)pm * BM * j0.lda); u.B = (const char*)(j0.B + (size_t)pn * BM * j0.K);
        u.lda2 = (unsigned)j0.lda * 2u; u.ldb2 = (unsigned)j0.K * 2u; u.nt = j0.K / BK; u.pm = pm; u.pn = pn; u.kind = j0.kind; return true;
    }
};

#define PG8_SA(b, h) (((b) * 2 + (h)) * HTB)
#define PG8_SB(b, h) ((4 + (b) * 2 + (h)) * HTB)
#define PG8_STAGE(bufoff, gbase, Rv, ld2) do { const unsigned _vo = (unsigned)(Rv) * (ld2) + c2; \
        __builtin_amdgcn_global_load_lds((const unsigned*)((gbase) + _vo), (LAS unsigned*)(lds + (bufoff) + ldsw), 16, 0, 0); \
        __builtin_amdgcn_global_load_lds((const unsigned*)((gbase) + 64u * (ld2) + _vo), (LAS unsigned*)(lds + (bufoff) + ldsw + 8192), 16, 0, 0); } while (0)
#define PG8_LDA(dst, b, h) do { _Pragma("unroll") for (int m = 0; m < 4; ++m) _Pragma("unroll") for (int k = 0; k < 2; ++k) dst[m][k] = *(const LAS bf16x8*)(lds + PG8_SA(b, h) + aoff + m * 2048 + k * 1024); } while (0)
#define PG8_LDB(dst, b, h) do { _Pragma("unroll") for (int n = 0; n < 2; ++n) _Pragma("unroll") for (int k = 0; k < 2; ++k) dst[n][k] = *(const LAS bf16x8*)(lds + PG8_SB(b, h) + boff + n * 2048 + k * 1024); } while (0)
#define PG8_MMA(ai, bj, At, Bt) do { __builtin_amdgcn_s_setprio(1); _Pragma("unroll") for (int m = 0; m < 4; ++m) _Pragma("unroll") for (int n = 0; n < 2; ++n) _Pragma("unroll") for (int k = 0; k < 2; ++k) \
        acc[ai][bj][m][n] = __builtin_amdgcn_mfma_f32_16x16x32_bf16(Bt[n][k], At[m][k], acc[ai][bj][m][n], 0, 0, 0); __builtin_amdgcn_s_setprio(0); } while (0)
#define PG8_WAIT_V(n) asm volatile("s_waitcnt vmcnt(" #n ")" ::: "memory")
#define PG8_WAIT_L(n) asm volatile("s_waitcnt lgkmcnt(" #n ")" ::: "memory")
#define PG8_BAR __builtin_amdgcn_s_barrier()
#define PG8_SCHED __builtin_amdgcn_sched_barrier(0)

template <class Epi, class Sched>
__device__ __forceinline__ void gemm_stream(LAS unsigned char* lds, const Sched& S, const Epi& E, int wv) {
    int wvl = wv; asm volatile("" : "+s"(wvl)); int tid = wvl * 64 + lane_id(); asm volatile("" : "+v"(tid));
    const int wid = __builtin_amdgcn_readfirstlane(tid >> 6), lane = tid & 63, wr = wid >> 2, wc = wid & 3, fr = lane & 15, fq = lane >> 4;
    int R0, C0; stage_rc(tid * 16, R0, C0);
    const int Rb0 = Epi::PERM ? ((R0 & ~31) + perm32(R0 & 31)) : R0;
    const unsigned c2 = (unsigned)C0 * 2u;
    const unsigned ldsw = (unsigned)wid * 1024u;
    const int aoff = lds_byte(wr * 64 + fr, fq * 8), boff = lds_byte(wc * 32 + fr, fq * 8);
    Unit cur, nxt; int ui = 0;
    if (!S.next(0, cur)) return;
    f32x4 acc[2][2][4][2];
#pragma unroll
    for (int a = 0; a < 2; ++a)
#pragma unroll
        for (int b = 0; b < 2; ++b)
#pragma unroll
            for (int m = 0; m < 4; ++m)
#pragma unroll
                for (int n = 0; n < 2; ++n) acc[a][b][m][n] = (f32x4){0.f, 0.f, 0.f, 0.f};
    bf16x8 At[4][2], B0[2][2], B1[2][2];
    const char* cA = cur.A; const char* cB = cur.B; unsigned la = cur.lda2, lb = cur.ldb2;
    const size_t kstep = (size_t)(BK * 2);
    PG8_STAGE(PG8_SB(0, 0), cB, Rb0, lb); PG8_STAGE(PG8_SB(0, 1), cB + (size_t)HALF * lb, Rb0, lb); PG8_STAGE(PG8_SA(0, 0), cA, R0, la); PG8_STAGE(PG8_SA(0, 1), cA + (size_t)HALF * la, R0, la);
    if (wr == 1) PG8_BAR;
    PG8_WAIT_V(2); PG8_BAR;
    PG8_STAGE(PG8_SB(1, 0), cB + kstep, Rb0, lb); PG8_STAGE(PG8_SA(1, 0), cA + kstep, R0, la); PG8_STAGE(PG8_SB(1, 1), cB + (size_t)HALF * lb + kstep, Rb0, lb);
    PG8_WAIT_V(6); PG8_BAR;
    for (;;) {
        const bool has_next = S.next(ui + 1, nxt);
        const char* nA = has_next ? nxt.A : cA; const char* nB = has_next ? nxt.B : cB;
        const unsigned nla = has_next ? nxt.lda2 : la, nlb = has_next ? nxt.ldb2 : lb;
        const int nt = cur.nt;
        for (int t = 0; t < nt; t += 2) {
            const bool last = (t == nt - 2);
            const char* a1 = cA + (size_t)(t + 1) * kstep;
            const char* a2 = last ? nA : cA + (size_t)(t + 2) * kstep; const char* b2 = last ? nB : cB + (size_t)(t + 2) * kstep;
            const unsigned la2 = last ? nla : la, lb2 = last ? nlb : lb;
            const char* a3 = a2 + kstep; const char* b3 = b2 + kstep;
            PG8_LDB(B0, 0, 0); PG8_LDB(B1, 0, 1); PG8_SCHED; PG8_LDA(At, 0, 0); PG8_STAGE(PG8_SA(1, 1), a1 + (size_t)HALF * la, R0, la);
            PG8_WAIT_V(8); PG8_WAIT_L(0); PG8_BAR; PG8_MMA(0, 0, At, B0); PG8_MMA(0, 1, At, B1); PG8_BAR; PG8_SCHED;
            PG8_LDA(At, 0, 1); PG8_STAGE(PG8_SB(0, 0), b2, Rb0, lb2); PG8_STAGE(PG8_SB(0, 1), b2 + (size_t)HALF * lb2, Rb0, lb2); PG8_STAGE(PG8_SA(0, 0), a2, R0, la2);
            PG8_WAIT_V(8); PG8_WAIT_L(0); PG8_BAR; PG8_MMA(1, 0, At, B0); PG8_MMA(1, 1, At, B1); PG8_BAR; PG8_SCHED;
            PG8_LDB(B0, 1, 0); PG8_LDB(B1, 1, 1); PG8_SCHED; PG8_LDA(At, 1, 0); PG8_STAGE(PG8_SA(0, 1), a2 + (size_t)HALF * la2, R0, la2);
            PG8_WAIT_V(8); PG8_WAIT_L(0); PG8_BAR; PG8_MMA(0, 0, At, B0); PG8_MMA(0, 1, At, B1); PG8_BAR; PG8_SCHED;
            PG8_LDA(At, 1, 1); PG8_STAGE(PG8_SB(1, 0), b3, Rb0, lb2); PG8_STAGE(PG8_SB(1, 1), b3 + (size_t)HALF * lb2, Rb0, lb2); PG8_STAGE(PG8_SA(1, 0), a3, R0, la2);
            PG8_WAIT_V(8); PG8_WAIT_L(0); PG8_BAR; PG8_MMA(1, 0, At, B0); PG8_MMA(1, 1, At, B1); PG8_BAR; PG8_SCHED;
        }
        if (wr == 0) PG8_BAR;
        const bool keep = E(acc, cur, wr, wc, fr, fq);
        if (!has_next) break;
        if (!keep) {
#pragma unroll
            for (int a = 0; a < 2; ++a)
#pragma unroll
                for (int b = 0; b < 2; ++b)
#pragma unroll
                    for (int m = 0; m < 4; ++m)
#pragma unroll
                        for (int n = 0; n < 2; ++n) acc[a][b][m][n] = (f32x4){0.f, 0.f, 0.f, 0.f};
        }
        cur = nxt; cA = nA; cB = nB; la = nla; lb = nlb; ++ui;
        if (wr == 1) PG8_BAR;
    }
    PG8_WAIT_V(0);
    PG8_BAR;
}
}

struct Args { const float* in[30]; float* out; unsigned char* ws; };
enum { I_XP = 0, I_MEMP, I_XS, I_CLAT, I_CKPE, I_SPOOL, I_CMK, I_CMV, I_GMIX, I_WIN, I_BGATE, I_WPOOL, I_PSCALE, I_GQLAT, I_WQB, I_GQHEAD, I_GKVLAT, I_WKB, I_WVB,
       I_GKHEAD, I_WMLAO, I_GMEM, I_WMEMKV, I_GMEMQ, I_GMEMK, I_WMEMO, I_WOUT, I_GFF, I_WUP, I_WDOWN };

__device__ __forceinline__ void transpose_item(const float* __restrict__ W, int ldw, int K, bf16_t* __restrict__ WT, LAS unsigned char* scr, int kb, int n0src, int nrow_dst, int lane, const float* __restrict__ kscale) {
    const int k0 = 64 * kb, kq = lane >> 4, cq = lane & 15;
    f32x4 v[16];
#pragma unroll
    for (int i = 0; i < 16; ++i) v[i] = __builtin_nontemporal_load((const f32x4*)(W + (size_t)(k0 + 4 * i + kq) * ldw + n0src + cq * 4));
#pragma unroll
    for (int i = 0; i < 16; ++i) { const int kk = 4 * i + kq; f32x4 x = v[i]; if (kscale) x = x * kscale[k0 + kk];
        const int fk = (kk & 2) | ((kk & 8) >> 1);
        *(LAS u32x2*)(scr + kk * 128 + (((cq >> 1) ^ fk) << 4) + (cq & 1) * 8) = (u32x2){cvtpk(x.x, x.y), cvtpk(x.z, x.w)}; }
    LDS_WAIT(); asm volatile("" ::: "memory");
    const int g = lane >> 4, i16 = lane & 15;
#pragma unroll
    for (int s = 0; s < 8; ++s) { const int nb = s >> 1, c = (s & 1) * 4 + g;
        const int ka = 8 * c + (i16 >> 2), kb2 = ka + 4, chunk = 2 * nb + ((i16 & 3) >> 1);
        const int fa = (ka & 2) | ((ka & 8) >> 1), fb = (kb2 & 2) | ((kb2 & 8) >> 1);
        const s16x4 lo = vtr((const LAS char*)scr + ka * 128 + ((chunk ^ fa) << 4) + (i16 & 1) * 8);
        const s16x4 hi = vtr((const LAS char*)scr + kb2 * 128 + ((chunk ^ fb) << 4) + (i16 & 1) * 8);
        *(bf16x8*)(WT + (size_t)(nrow_dst + 16 * nb + i16) * K + k0 + 8 * c) = PKV(lo, hi); }
    LDS_WAIT(); asm volatile("" ::: "memory");
}
__device__ __forceinline__ void rms_row_2048(const float* __restrict__ xrow, const float* __restrict__ g, bf16_t* __restrict__ orow, int lane) {
    const f32x4* xr = (const f32x4*)xrow + lane; const f32x4* gr = (const f32x4*)g + lane;
    f32x4 v[8]; float s = 0.f;
#pragma unroll
    for (int j = 0; j < 8; ++j) { v[j] = __builtin_nontemporal_load(xr + 64 * j); s += (v[j].x * v[j].x + v[j].y * v[j].y) + (v[j].z * v[j].z + v[j].w * v[j].w); }
    const float r = rsqrtf(wave_sum(s) * (1.f / 2048.f) + EPS);
    u32x2* o8 = (u32x2*)orow + lane;
#pragma unroll
    for (int j = 0; j < 8; ++j) { const f32x4 gg = gr[64 * j]; u32x2 w; w.x = cvtpk(v[j].x * r * gg.x, v[j].y * r * gg.y); w.y = cvtpk(v[j].z * r * gg.z, v[j].w * r * gg.w); o8[64 * j] = w; }
}
__device__ __forceinline__ float rope_lane(float w, int lane, float pos) {
    const float partner = __shfl_xor(w, 32);
    float sn, cs; fast_sincos(pos * rope_inv(lane & 31), sn, cs);
    return lane < 32 ? w * cs - partner * sn : w * cs + partner * sn;
}

template <int PART>
__device__ __forceinline__ void phase_prep(const Args& P, LAS unsigned char* lds, int gw, int NGW, int wave, int lane) {
    unsigned char* ws = P.ws;
    LAS unsigned char* scr = lds + wave * 16384;
    {
        constexpr int I_IN = 32 * 145, I_MKV = 32 * 32, I_QB = 8 * 48, I_KB = 8 * 32, I_VB = 8 * 32, I_PL = 4 * 4 * 8, I_MLAO = 32 * 32, I_MEMO = 16 * 32, I_OUT = 32 * 32, I_UP = 32 * 128, I_DN = 128 * 32,
                      I_MV = 16 * 4 * 16;
        constexpr int NITEMS = I_IN + I_MKV + I_QB + I_KB + I_VB + I_PL + I_MLAO + I_MEMO + I_OUT + I_UP + I_DN + I_MV;
        for (int it = (PART == 1 ? 0 : I_IN + I_MKV) + gw; it < (PART == 1 ? I_IN + I_MKV : NITEMS); it += NGW) {
            int r = it;
            if (r < I_IN) { const int kb = r / 145, nb = r % 145, n0 = nb * 64; const int nd = n0 < 2048 ? n0 : (n0 < 2112 ? 9216 + (n0 - 2048) : n0 - 64);
                transpose_item(P.in[I_WIN], 9280, 2048, (bf16_t*)(ws + WS_WIN), scr, kb, n0, nd, lane, nullptr); continue; } r -= I_IN;
            if (r < I_MKV) { transpose_item(P.in[I_WMEMKV], 2048, 2048, (bf16_t*)(ws + WS_WMEMKV), scr, r / 32, (r % 32) * 64, (r % 32) * 64, lane, nullptr); continue; } r -= I_MKV;
            if (r < I_QB) { transpose_item(P.in[I_WQB], 3072, 512, (bf16_t*)(ws + WS_WQB), scr, r / 48, (r % 48) * 64, (r % 48) * 64, lane, nullptr); continue; } r -= I_QB;
            if (r < I_KB) { transpose_item(P.in[I_WKB], 2048, 512, (bf16_t*)(ws + WS_WKB), scr, r / 32, (r % 32) * 64, (r % 32) * 64, lane, nullptr); continue; } r -= I_KB;
            if (r < I_VB) { transpose_item(P.in[I_WVB], 2048, 512, (bf16_t*)(ws + WS_WVB), scr, r / 32, (r % 32) * 64, (r % 32) * 64, lane, nullptr); continue; } r -= I_VB;
            if (r < I_PL) { const int g = r / 32, q = r % 32; transpose_item(P.in[I_WPOOL] + (size_t)g * 256 * 512, 512, 256, (bf16_t*)(ws + WS_WPOOL), scr, q / 8, (q % 8) * 64, g * 512 + (q % 8) * 64, lane, nullptr); continue; } r -= I_PL;
            if (r < I_MLAO) { transpose_item(P.in[I_WMLAO], 2048, 2048, (bf16_t*)(ws + WS_WMLAO), scr, r / 32, (r % 32) * 64, (r % 32) * 64, lane, nullptr); continue; } r -= I_MLAO;
            if (r < I_MEMO) { transpose_item(P.in[I_WMEMO], 2048, 1024, (bf16_t*)(ws + WS_WMEMO), scr, r / 32, (r % 32) * 64, (r % 32) * 64, lane, nullptr); continue; } r -= I_MEMO;
            if (r < I_OUT) { transpose_item(P.in[I_WOUT], 2048, 2048, (bf16_t*)(ws + WS_WOUT), scr, r / 32, (r % 32) * 64, (r % 32) * 64, lane, nullptr); continue; } r -= I_OUT;
            if (r < I_UP) { transpose_item(P.in[I_WUP], 8192, 2048, (bf16_t*)(ws + WS_WUP), scr, r / 128, (r % 128) * 64, (r % 128) * 64, lane, P.in[I_GFF]); continue; } r -= I_UP;
            if (r < I_DN) { transpose_item(P.in[I_WDOWN], 2048, 8192, (bf16_t*)(ws + WS_WDOWN), scr, r / 32, (r % 32) * 64, (r % 32) * 64, lane, nullptr); continue; } r -= I_DN;
            { const int b = r / 64, q = r % 64;
              transpose_item(P.in[I_CMV] + (size_t)b * 262144, 1024, 256, (bf16_t*)(ws + WS_MVT) + (size_t)(2 + b) * 262144, scr, q / 16, (q % 16) * 64, (q % 16) * 64, lane, nullptr); }
        }
    }
    if (PART == 1) for (int m = gw; m < TT + 512; m += NGW) {
        if (m < TP) rms_row_2048(P.in[I_XP] + (size_t)m * DM, P.in[I_GMIX], (bf16_t*)(ws + WS_H) + (size_t)m * DM, lane);
        else if (m < TT) rms_row_2048(P.in[I_XS] + (size_t)(m - TP) * DM, P.in[I_GMIX], (bf16_t*)(ws + WS_H) + (size_t)m * DM, lane);
        else rms_row_2048(P.in[I_MEMP] + (size_t)(m - TT) * DM, P.in[I_GMEM], (bf16_t*)(ws + WS_HM) + (size_t)(m - TT) * DM, lane);
    }
    if (PART == 2) {
        bf16_t* KRs = (bf16_t*)(ws + WS_KRS); float* KPESS = (float*)(ws + WS_KPESS); bf16_t* LATs = (bf16_t*)(ws + WS_LATS);
        const float gk = P.in[I_GKHEAD][128 + lane];
        const float inv = rope_inv(lane & 31);
        for (int pos = gw; pos < 4096; pos += NGW) {
            float sn, cs; fast_sincos((float)pos * inv, sn, cs);
            float v[NBS];
#pragma unroll
            for (int b = 0; b < NBS; ++b) v[b] = __builtin_nontemporal_load(P.in[I_CKPE] + ((size_t)b * 4096 + pos) * 64 + lane);
#pragma unroll
            for (int b = 0; b < NBS; ++b) { const float ss = wave_sum(v[b] * v[b]); const float w = v[b] * gk, pr = __shfl_xor(w, 32);
                const float o = lane < 32 ? w * cs - pr * sn : w * cs + pr * sn;
                const size_t kidx = (size_t)b * KPAD + pos; KRs[kidx * 64 + lane] = f2bf(o); if (lane == 0) KPESS[kidx] = ss; } }
        for (int rr = gw; rr < NBS * 32; rr += NGW) { const size_t kidx = (size_t)(rr >> 5) * KPAD + 4128 + (rr & 31);
            KRs[kidx * 64 + lane] = 0; if (lane == 0) KPESS[kidx] = 0.f;
            *(u32x4*)(LATs + kidx * 512 + lane * 8) = (u32x4){0u, 0u, 0u, 0u}; }
    }
    if (PART == 2) {
        const long tid_g = (long)gw * 64 + lane, NT_G = (long)NGW * 64;
        bf16_t* LATs = (bf16_t*)(ws + WS_LATS);
        for (long i0 = tid_g; i0 < (long)NBS * 4096 * 64; i0 += 4 * NT_G) {
            f32x4 a[4], c[4];
#pragma unroll
            for (int q = 0; q < 4; ++q) { long i = i0 + q * NT_G; if (i >= (long)NBS * 4096 * 64) i = i0; a[q] = __builtin_nontemporal_load((const f32x4*)(P.in[I_CLAT] + i * 8)); c[q] = __builtin_nontemporal_load((const f32x4*)(P.in[I_CLAT] + i * 8 + 4)); }
#pragma unroll
            for (int q = 0; q < 4; ++q) { long i = i0 + q * NT_G; if (i >= (long)NBS * 4096 * 64) i = i0; const long b = i >> 18, rem = i & 262143;
                *(u32x4*)(LATs + (size_t)b * KPAD * 512 + rem * 8) = (u32x4){cvtpk(a[q].x, a[q].y), cvtpk(a[q].z, a[q].w), cvtpk(c[q].x, c[q].y), cvtpk(c[q].z, c[q].w)}; } }
        bf16_t* MKs = (bf16_t*)(ws + WS_MK) + (size_t)2 * 262144;
        for (long i0 = tid_g; i0 < (long)NBS * 262144 / 8; i0 += 4 * NT_G) {
            f32x4 a[4], c[4];
#pragma unroll
            for (int q = 0; q < 4; ++q) { long i = i0 + q * NT_G; if (i >= (long)NBS * 262144 / 8) i = i0; a[q] = __builtin_nontemporal_load((const f32x4*)(P.in[I_CMK] + i * 8)); c[q] = __builtin_nontemporal_load((const f32x4*)(P.in[I_CMK] + i * 8 + 4)); }
#pragma unroll
            for (int q = 0; q < 4; ++q) { long i = i0 + q * NT_G; if (i >= (long)NBS * 262144 / 8) i = i0;
                *(u32x4*)(MKs + i * 8) = (u32x4){cvtpk(a[q].x, a[q].y), cvtpk(a[q].z, a[q].w), cvtpk(c[q].x, c[q].y), cvtpk(c[q].z, c[q].w)}; } }
        bf16_t* WKN = (bf16_t*)(ws + WS_WKBN);
        for (long i = tid_g; i < 512L * 2048 / 8; i += NT_G) {
            const f32x4 a = *(const f32x4*)(P.in[I_WKB] + i * 8), c = *(const f32x4*)(P.in[I_WKB] + i * 8 + 4);
            *(u32x4*)(WKN + i * 8) = (u32x4){cvtpk(a.x, a.y), cvtpk(a.z, a.w), cvtpk(c.x, c.y), cvtpk(c.z, c.w)}; }
    }
}

struct EpiIn {
    static constexpr bool PERM = true;
    bf16_t* ZS; bf16_t* G; float* M; const float* bgate;
    __device__ __forceinline__ bool operator()(f32x4 (&acc)[2][2][4][2], const pg8::Unit& u, int wr, int wc, int fr_, int fq) const {
        int fr = fr_; asm volatile("" : "+v"(fr));
        const int row0 = u.pm * 256 + wr * 64 + fr, ct = wc * 32 + 8 * fq;
        if (u.kind == 1) {
#pragma unroll
            for (int ai = 0; ai < 2; ++ai)
#pragma unroll
                for (int m = 0; m < 4; ++m) { float* rp = M + (size_t)(row0 + ai * 128 + m * 16) * 2048 + u.pn * 256 + ct;
#pragma unroll
                    for (int bj = 0; bj < 2; ++bj) { *(f32x4*)(rp + bj * 128) = acc[ai][bj][m][0]; *(f32x4*)(rp + bj * 128 + 4) = acc[ai][bj][m][1]; } }
            return false;
        }
        const int pn = u.pn;
        if (pn >= 12 && pn < 36) {
            const int gc = (pn - 12) * 256 + ct;
            f32x4 bv[2][2];
#pragma unroll
            for (int bj = 0; bj < 2; ++bj) { bv[bj][0] = *(const f32x4*)(bgate + gc + bj * 128); bv[bj][1] = *(const f32x4*)(bgate + gc + bj * 128 + 4); }
#pragma unroll
            for (int ai = 0; ai < 2; ++ai)
#pragma unroll
                for (int m = 0; m < 4; ++m) { bf16_t* rp = G + (size_t)(row0 + ai * 128 + m * 16) * G_LD + gc;
#pragma unroll
                    for (int bj = 0; bj < 2; ++bj) { f32x4 v0 = acc[ai][bj][m][0] + bv[bj][0], v1 = acc[ai][bj][m][1] + bv[bj][1];
#pragma unroll
                        for (int e = 0; e < 4; ++e) { v0[e] = __builtin_amdgcn_rcpf(1.f + __builtin_amdgcn_exp2f(-1.4426950408889634f * v0[e])); v1[e] = __builtin_amdgcn_rcpf(1.f + __builtin_amdgcn_exp2f(-1.4426950408889634f * v1[e])); }
                        __builtin_nontemporal_store((u32x4){cvtpk(v0[0], v0[1]), cvtpk(v0[2], v0[3]), cvtpk(v1[0], v1[1]), cvtpk(v1[2], v1[3])}, (u32x4*)(rp + bj * 128)); } }
            return false;
        }
        const int zc = (pn < 12 ? pn * 256 : 3072) + ct;
#pragma unroll
        for (int ai = 0; ai < 2; ++ai)
#pragma unroll
            for (int m = 0; m < 4; ++m) { bf16_t* rp = ZS + (size_t)(row0 + ai * 128 + m * 16) * ZS_LD + zc;
#pragma unroll
                for (int bj = 0; bj < 2; ++bj) { if (pn == 36 && (bj == 1 || wc >= 2)) continue;
                    const f32x4 v0 = acc[ai][bj][m][0], v1 = acc[ai][bj][m][1];
                    *(u32x4*)(rp + bj * 128) = (u32x4){cvtpk(v0[0], v0[1]), cvtpk(v0[2], v0[3]), cvtpk(v1[0], v1[1]), cvtpk(v1[2], v1[3])}; } }
        return false;
    }
};

__device__ __forceinline__ void unpack8(const u32x4 w, float (&f)[8]) { f[0] = bflo(w.x); f[1] = bfhi(w.x); f[2] = bflo(w.y); f[3] = bfhi(w.y); f[4] = bflo(w.z); f[5] = bfhi(w.z); f[6] = bflo(w.w); f[7] = bfhi(w.w); }
__device__ __forceinline__ u32x4 pack8(const float (&f)[8]) { return (u32x4){cvtpk(f[0], f[1]), cvtpk(f[2], f[3]), cvtpk(f[4], f[5]), cvtpk(f[6], f[7])}; }

__device__ __forceinline__ void phase_rows(const Args& P, LAS unsigned char* lds, int gw, int NGW, int wave, int lane) {
    unsigned char* ws = P.ws; float* out = P.out;
    const bf16_t* ZS = (const bf16_t*)(ws + WS_ZS);
    const f32x4 gkv0 = *(const f32x4*)(P.in[I_GKVLAT] + lane * 8), gkv1 = *(const f32x4*)(P.in[I_GKVLAT] + lane * 8 + 4);
    const f32x4 gql0 = *(const f32x4*)(P.in[I_GQLAT] + lane * 8), gql1 = *(const f32x4*)(P.in[I_GQLAT] + lane * 8 + 4);
    const f32x4 gmq = *(const f32x4*)(P.in[I_GMEMQ] + lane * 4);
    const float gkr = P.in[I_GKHEAD][128 + lane];
    for (int t = gw; t < TT; t += NGW) {
        const bool prm = t < TP; const int b = prm ? (t >> 12) : ((t - TP) >> 5), li = prm ? (t & 4095) : ((t - TP) & 31), pos = prm ? li : 4096 + li;
        const bf16_t* z = ZS + (size_t)t * ZS_LD;
        const int ca = lane * 8, cb = 512 + lane * 8, wa = lane < 32 ? 2 : 4, wb = lane < 32 ? 8 : 16;
        const u32x4 kvw = *(const u32x4*)(z + 1536 + lane * 8), qlw = *(const u32x4*)(z + 1024 + lane * 8), uaw = *(const u32x4*)(z + ca), ubw = *(const u32x4*)(z + cb);
        const bf16_t kpw = z[3072 + lane];
        u32x2 mqw[4];
#pragma unroll
        for (int h = 0; h < 4; ++h) mqw[h] = *(const u32x2*)(z + 2048 + h * 256 + lane * 4);
        u32x4 ra[3], rb[15];
        if (prm) {
#pragma unroll
            for (int k = 1; k < 4; ++k) ra[k - 1] = *(const u32x4*)(z - (size_t)(k <= li ? k : 0) * ZS_LD + ca);
#pragma unroll
            for (int k = 1; k < 16; ++k) rb[k - 1] = *(const u32x4*)(z - (size_t)(k <= li ? k : 0) * ZS_LD + cb);
        }
        asm volatile("" ::: "memory");
        { float v[8]; unpack8(kvw, v); float s = 0.f;
#pragma unroll
          for (int j = 0; j < 8; ++j) s += v[j] * v[j];
          const float r = rsqrtf(wave_sum(s) * (1.f / 512.f) + EPS);
          v[0] *= r * gkv0.x; v[1] *= r * gkv0.y; v[2] *= r * gkv0.z; v[3] *= r * gkv0.w; v[4] *= r * gkv1.x; v[5] *= r * gkv1.y; v[6] *= r * gkv1.z; v[7] *= r * gkv1.w;
          float* lo = prm ? out + O_LATP + (size_t)t * 512 : out + O_LATS + (size_t)(t - TP) * 512;
          *(f32x4*)(lo + lane * 8) = (f32x4){v[0], v[1], v[2], v[3]}; *(f32x4*)(lo + lane * 8 + 4) = (f32x4){v[4], v[5], v[6], v[7]};
          bf16_t* dst = prm ? (bf16_t*)((unsigned char*)out + DO_CKVP) + (size_t)t * 512 : (bf16_t*)(ws + WS_LATS) + ((size_t)b * KPAD + 4096 + li) * 512;
          *(u32x4*)(dst + lane * 8) = pack8(v); }
        { const float v = bf2f(kpw);
          (prm ? out + O_KPEP + (size_t)t * 64 : out + O_KPES + (size_t)(t - TP) * 64)[lane] = v;
          const float ss = wave_sum(v * v); const float o = rope_lane(v * gkr, lane, (float)pos);
          if (prm) { ((bf16_t*)(ws + WS_KRP))[(size_t)t * 64 + lane] = f2bf(o); if (lane == 0) ((float*)(ws + WS_KPESSP))[t] = ss; }
          else { const size_t kidx = (size_t)b * KPAD + 4096 + li; ((bf16_t*)(ws + WS_KRS))[kidx * 64 + lane] = f2bf(o); if (lane == 0) ((float*)(ws + WS_KPESS))[kidx] = ss; } }
        { float v[8]; unpack8(qlw, v); float s = 0.f;
#pragma unroll
          for (int j = 0; j < 8; ++j) s += v[j] * v[j];
          const float r = rsqrtf(wave_sum(s) * (1.f / 512.f) + EPS);
          v[0] *= r * gql0.x; v[1] *= r * gql0.y; v[2] *= r * gql0.z; v[3] *= r * gql0.w; v[4] *= r * gql1.x; v[5] *= r * gql1.y; v[6] *= r * gql1.z; v[7] *= r * gql1.w;
          *(u32x4*)((bf16_t*)(ws + WS_QN) + (size_t)t * 512 + lane * 8) = pack8(v); }
#pragma unroll
        for (int h = 0; h < 4; ++h) { const u32x2 w = mqw[h];
            const float a0 = bflo(w.x), a1 = bfhi(w.x), a2 = bflo(w.y), a3 = bfhi(w.y);
            const float r = rsqrtf(wave_sum((a0 * a0 + a1 * a1) + (a2 * a2 + a3 * a3)) * (1.f / 256.f) + EPS) * MEM_C;
            *(u32x2*)((bf16_t*)(ws + WS_QM) + (size_t)t * 1024 + h * 256 + lane * 4) = (u32x2){cvtpk(a0 * r * gmq.x, a1 * r * gmq.y), cvtpk(a2 * r * gmq.z, a3 * r * gmq.w)}; }
        { float sa[8], sb[8], ua[8], ub[8];
          unpack8(uaw, ua); unpack8(ubw, ub);
#pragma unroll
          for (int j = 0; j < 8; ++j) { sa[j] = ua[j]; sb[j] = ub[j]; }
          if (prm) {
#pragma unroll
              for (int k = 1; k < 4; ++k) { float tmp[8]; unpack8(ra[k - 1], tmp); const float w = (k <= li && k < wa) ? 1.f : 0.f;
#pragma unroll
                  for (int j = 0; j < 8; ++j) sa[j] += w * tmp[j]; }
#pragma unroll
              for (int k = 1; k < 16; ++k) { float tmp[8]; unpack8(rb[k - 1], tmp); const float w = (k <= li && k < wb) ? 1.f : 0.f;
#pragma unroll
                  for (int j = 0; j < 8; ++j) sb[j] += w * tmp[j]; }
          } else
          for (int k = 1; k < 16; ++k) {
              if (k <= li) { const bf16_t* zk = z - (size_t)k * ZS_LD; float tmp[8];
                  if (k < wa) { unpack8(*(const u32x4*)(zk + ca), tmp);
#pragma unroll
                      for (int j = 0; j < 8; ++j) sa[j] += tmp[j]; }
                  if (k < wb) { unpack8(*(const u32x4*)(zk + cb), tmp);
#pragma unroll
                      for (int j = 0; j < 8; ++j) sb[j] += tmp[j]; } }
              else { const float* sp = P.in[I_SPOOL] + ((size_t)b * 15 + (15 + li - k)) * 1024;
                  if (k < wa) { const f32x4 p0 = *(const f32x4*)(sp + ca), p1 = *(const f32x4*)(sp + ca + 4); sa[0] += p0.x; sa[1] += p0.y; sa[2] += p0.z; sa[3] += p0.w; sa[4] += p1.x; sa[5] += p1.y; sa[6] += p1.z; sa[7] += p1.w; }
                  if (k < wb) { const f32x4 p0 = *(const f32x4*)(sp + cb), p1 = *(const f32x4*)(sp + cb + 4); sb[0] += p0.x; sb[1] += p0.y; sb[2] += p0.z; sb[3] += p0.w; sb[4] += p1.x; sb[5] += p1.y; sb[6] += p1.z; sb[7] += p1.w; } }
          }
          const float ia = 1.f / (float)(pos + 1 < wa ? pos + 1 : wa), ib = 1.f / (float)(pos + 1 < wb ? pos + 1 : wb);
#pragma unroll
          for (int j = 0; j < 8; ++j) { sa[j] = sa[j] * ia - ua[j]; sb[j] = sb[j] * ib - ub[j]; }
          bf16_t* dp = (bf16_t*)(ws + WS_DP) + (size_t)t * 1024;
          *(u32x4*)(dp + ca) = pack8(sa); *(u32x4*)(dp + cb) = pack8(sb);
          const int last0 = prm ? 4081 : 17;
          if (li >= last0) { float* po = (prm ? out + O_POOLP : out + O_POOLS) + ((size_t)b * 15 + (li - last0)) * 1024;
              *(f32x4*)(po + ca) = (f32x4){ua[0], ua[1], ua[2], ua[3]}; *(f32x4*)(po + ca + 4) = (f32x4){ua[4], ua[5], ua[6], ua[7]};
              *(f32x4*)(po + cb) = (f32x4){ub[0], ub[1], ub[2], ub[3]}; *(f32x4*)(po + cb + 4) = (f32x4){ub[4], ub[5], ub[6], ub[7]}; } }
    }
    for (int m = gw; m < 512; m += NGW) {
        const float* mr = (const float*)(ws + WS_M) + (size_t)m * 2048; const f32x4 g = *(const f32x4*)(P.in[I_GMEMK] + lane * 4);
#pragma unroll
        for (int h = 0; h < 4; ++h) { f32x4 v = *(const f32x4*)(mr + h * 256 + lane * 4);
            const float r = rsqrtf(wave_sum((v.x * v.x + v.y * v.y) + (v.z * v.z + v.w * v.w)) * (1.f / 256.f) + EPS);
            v.x *= r * g.x; v.y *= r * g.y; v.z *= r * g.z; v.w *= r * g.w;
            *(f32x4*)(out + O_MEMK + (size_t)m * 1024 + h * 256 + lane * 4) = v;
            *(u32x2*)((bf16_t*)(ws + WS_MK) + (size_t)m * 1024 + h * 256 + lane * 4) = (u32x2){cvtpk(v.x, v.y), cvtpk(v.z, v.w)};
            *(f32x4*)(out + O_MEMV + (size_t)m * 1024 + h * 256 + lane * 4) = *(const f32x4*)(mr + 1024 + h * 256 + lane * 4); }
    }
    { LAS unsigned char* scr = lds + wave * 16384;
      for (int it = gw; it < 2 * 64; it += NGW) { const int b = it / 64, q = it % 64;
          transpose_item((const float*)(ws + WS_M) + (size_t)b * 256 * 2048 + 1024, 2048, 256, (bf16_t*)(ws + WS_MVT) + (size_t)b * 262144, scr, q / 16, (q % 16) * 64, (q % 16) * 64, lane, nullptr); } }
}

struct EpiQKV {
    static constexpr bool PERM = true;
    bf16_t* Q; bf16_t* K; bf16_t* V; float* RKG; bf16_t* PM; float* PS; const float* KPESS; const float* KPESSP; const bf16_t* KRP; const float* gk; LAS unsigned char* lds;
    __device__ __forceinline__ void half_sumsq(const f32x4 (&acc)[2][2][4][2], float (&tot)[2][4][2], int wr, int wc, int fr, int fq) const {
        LAS float* part = (LAS float*)(lds + 131072);
#pragma unroll
        for (int ai = 0; ai < 2; ++ai)
#pragma unroll
            for (int m = 0; m < 4; ++m)
#pragma unroll
                for (int bj = 0; bj < 2; ++bj) { const f32x4 a = acc[ai][bj][m][0], b = acc[ai][bj][m][1];
                    float s = ((a.x * a.x + a.y * a.y) + (a.z * a.z + a.w * a.w)) + ((b.x * b.x + b.y * b.y) + (b.z * b.z + b.w * b.w));
                    s += __shfl_xor(s, 16); s += __shfl_xor(s, 32);
                    if (fq == 0) part[((ai * 128 + wr * 64 + m * 16 + fr) * 2 + bj) * 4 + wc] = s; }
        asm volatile("s_waitcnt lgkmcnt(0)" ::: "memory"); __builtin_amdgcn_s_barrier(); asm volatile("" ::: "memory");
#pragma unroll
        for (int ai = 0; ai < 2; ++ai)
#pragma unroll
            for (int m = 0; m < 4; ++m)
#pragma unroll
                for (int bj = 0; bj < 2; ++bj) { const f32x4 p4 = *(const LAS f32x4*)(part + ((ai * 128 + wr * 64 + m * 16 + fr) * 2 + bj) * 4); tot[ai][m][bj] = (p4.x + p4.y) + (p4.z + p4.w); }
    }
    __device__ __forceinline__ bool operator()(f32x4 (&acc)[2][2][4][2], const pg8::Unit& u, int wr, int wc, int fr_, int fq) const {
        int fr = fr_; asm volatile("" : "+v"(fr));
        const int row0 = u.pm * 256 + wr * 64 + fr, ct = wc * 32 + 8 * fq;
        if (u.kind == 3) {
            float tot[2][4][2]; half_sumsq(acc, tot, wr, wc, fr, fq);
            if (wc == 0 && fq == 0) {
#pragma unroll
                for (int ai = 0; ai < 2; ++ai)
#pragma unroll
                    for (int m = 0; m < 4; ++m) { const size_t row = (size_t)(row0 + ai * 128 + m * 16); const float kp = KPESS[row];
#pragma unroll
                        for (int bj = 0; bj < 2; ++bj) RKG[row * 16 + u.pn * 2 + bj] = rsqrtf((tot[ai][m][bj] + kp) * (1.f / 192.f) + EPS) * MLA_C; } }
            return false;
        }
        if (u.kind == 1) {
            float tot[2][4][2]; half_sumsq(acc, tot, wr, wc, fr, fq);
            const f32x4 g0 = *(const f32x4*)(gk + ct), g1 = *(const f32x4*)(gk + ct + 4);
#pragma unroll
            for (int ai = 0; ai < 2; ++ai) {
                float kp[4]; u32x2 kr[4];
#pragma unroll
                for (int m = 0; m < 4; ++m) { const size_t row = (size_t)(row0 + ai * 128 + m * 16); kp[m] = KPESSP[row]; kr[m] = *(const u32x2*)(KRP + row * 64 + wc * 16 + fq * 4); }
                asm volatile("" ::: "memory");
#pragma unroll
                for (int m = 0; m < 4; ++m) { bf16_t* rp = K + (size_t)(row0 + ai * 128 + m * 16) * QLD;
#pragma unroll
                    for (int bj = 0; bj < 2; ++bj) { const float rk = rsqrtf((tot[ai][m][bj] + kp[m]) * (1.f / 192.f) + EPS);
                        const f32x4 v0 = acc[ai][bj][m][0] * rk * g0, v1 = acc[ai][bj][m][1] * rk * g1; bf16_t* hp = rp + (u.pn * 2 + bj) * 192;
                        *(u32x4*)(hp + ct) = (u32x4){cvtpk(v0[0], v0[1]), cvtpk(v0[2], v0[3]), cvtpk(v1[0], v1[1]), cvtpk(v1[2], v1[3])};
                        *(u32x2*)(hp + 128 + wc * 16 + fq * 4) = (u32x2){cvtpk(bflo(kr[m].x) * rk, bfhi(kr[m].x) * rk), cvtpk(bflo(kr[m].y) * rk, bfhi(kr[m].y) * rk)}; } }
            }
            return false;
        }
        if (u.kind >= 4) {
            const int cc = u.pn * 256 + ct;
#pragma unroll
            for (int ai = 0; ai < 2; ++ai)
#pragma unroll
                for (int m = 0; m < 4; ++m) { const int rl = ai * 128 + wr * 64 + m * 16 + fr; const size_t row = (size_t)(u.pm + rl); float s = 0.f;
#pragma unroll
                    for (int bj = 0; bj < 2; ++bj) { f32x4 v0 = acc[ai][bj][m][0], v1 = acc[ai][bj][m][1];
#pragma unroll
                        for (int e = 0; e < 4; ++e) { v0[e] = __builtin_amdgcn_exp2f(v0[e]); v1[e] = __builtin_amdgcn_exp2f(v1[e]); }
                        s += ((v0[0] + v0[1]) + (v0[2] + v0[3])) + ((v1[0] + v1[1]) + (v1[2] + v1[3]));
                        if (u.kind == 4 || rl < 32) *(u32x4*)(PM + row * 1024 + cc + bj * 128) = (u32x4){cvtpk(v0[0], v0[1]), cvtpk(v0[2], v0[3]), cvtpk(v1[0], v1[1]), cvtpk(v1[2], v1[3])}; }
                    s += __shfl_xor(s, 16); s += __shfl_xor(s, 32);
                    if (fq == 0 && (u.kind == 4 || rl < 32)) PS[row * 16 + u.pn * 4 + wc] = s; }
            return false;
        }
        bf16_t* base; int ld;
        if (u.kind == 0) { base = Q; ld = QLD; } else { base = V; ld = 2048; }
        const int c0 = u.pn * 256 + ct;
#pragma unroll
        for (int ai = 0; ai < 2; ++ai)
#pragma unroll
            for (int m = 0; m < 4; ++m) { bf16_t* rp = base + (size_t)(row0 + ai * 128 + m * 16) * ld;
#pragma unroll
                for (int bj = 0; bj < 2; ++bj) { const f32x4 v0 = acc[ai][bj][m][0], v1 = acc[ai][bj][m][1];
                    *(u32x4*)(rp + c0 + bj * 128) = (u32x4){cvtpk(v0[0], v0[1]), cvtpk(v0[2], v0[3]), cvtpk(v1[0], v1[1]), cvtpk(v1[2], v1[3])}; } }
        return false;
    }
};

#define SWZF(row) ((((((row) & 2) << 1) | (((row) >> 2) & 3))) << 4)
__device__ __forceinline__ void partialSM(f32x16& p0, f32x16& p1, float& m_reg, float& mn, float& alpha, const float C) {
    float pmax = p0[0];
#pragma unroll
    for (int r = 1; r < 16; ++r) pmax = fmaxf(pmax, p0[r]);
#pragma unroll
    for (int r = 0; r < 16; ++r) pmax = fmaxf(pmax, p1[r]);
    { auto rr = __builtin_amdgcn_permlane32_swap(__float_as_uint(pmax), __float_as_uint(pmax), false, false);
      pmax = fmaxf(__uint_as_float(rr[0]), __uint_as_float(rr[1])); }
    if (__builtin_expect(__all((pmax - m_reg) * C <= 11.5f), 1)) { mn = m_reg; alpha = 1.f; }
    else { mn = fmaxf(m_reg, pmax); alpha = __builtin_amdgcn_exp2f((m_reg - mn) * C); m_reg = mn; }
    const float mnC = -mn * C;
#pragma unroll
    for (int r = 0; r < 16; ++r) p0[r] = fmaf(p0[r], C, mnC);
#pragma unroll
    for (int r = 0; r < 16; ++r) p1[r] = fmaf(p1[r], C, mnC);
#pragma unroll
    for (int r = 0; r < 16; ++r) p0[r] = __builtin_amdgcn_exp2f(p0[r]);
}
__device__ __forceinline__ void finishSM(f32x16& p0, f32x16& p1, float alpha, float& l_reg, bf16x8& pa0, bf16x8& pa1, bf16x8& pa2, bf16x8& pa3) {
#pragma unroll
    for (int r = 0; r < 16; ++r) p1[r] = __builtin_amdgcn_exp2f(p1[r]);
    float ps = 0;
#pragma unroll
    for (int r = 0; r < 16; ++r) ps += p0[r];
#pragma unroll
    for (int r = 0; r < 16; ++r) ps += p1[r];
    { auto rr = __builtin_amdgcn_permlane32_swap(__float_as_uint(ps), __float_as_uint(ps), false, false);
      ps = __uint_as_float(rr[0]) + __uint_as_float(rr[1]); }
    l_reg = l_reg * alpha + ps;
#define PK4(P, BASE, OUT) do { unsigned a0 = cvtpk(P[BASE + 0], P[BASE + 1]), a1 = cvtpk(P[BASE + 2], P[BASE + 3]);   \
    unsigned b0 = cvtpk(P[BASE + 4], P[BASE + 5]), b1 = cvtpk(P[BASE + 6], P[BASE + 7]);                              \
    auto r0 = __builtin_amdgcn_permlane32_swap(a0, b0, false, false); auto r1 = __builtin_amdgcn_permlane32_swap(a1, b1, false, false); \
    u32x4 w = {r0[0], r1[0], r0[1], r1[1]}; OUT = __builtin_bit_cast(bf16x8, w); } while (0)
    PK4(p0, 0, pa0); PK4(p0, 8, pa1); PK4(p1, 0, pa2); PK4(p1, 8, pa3);
#undef PK4
}

namespace pat {
constexpr int LDQ = 3072, LDK = 3072, LDV = 2048, LDO = 2048;
constexpr int SHM_V = 16384, SHM_K = 24576, OFF_WS = 3 * SHM_K + 3 * SHM_V, OFF_QR = OFF_WS + 2048;
#define KSW(row, colB) ((row) * 384 + ((colB) ^ SWZF(row)))
#define DSR128(dst, addr, OFF) asm volatile("ds_read_b128 %0, %1 offset:%2" : "=v"(dst) : "v"(addr), "i"(OFF) : "memory")
#define WAITK4(N, F) asm volatile("s_waitcnt lgkmcnt(" #N ")" : "+v"(F[0]), "+v"(F[1]), "+v"(F[2]), "+v"(F[3]) :: "memory")
#define WAITK6(N, F, Q) asm volatile("s_waitcnt lgkmcnt(" #N ")" : "+v"(F[0]), "+v"(F[1]), "+v"(F[2]), "+v"(F[3]), "+v"(Q[0]), "+v"(Q[1]) :: "memory")
__device__ __forceinline__ void qkt(f32x16& p0, f32x16& p1, int ks, const bf16x8* qr, int qrow, int hi, int qsw, const int (&kbo)[2]) {
    p0 = f32x16{}; p1 = f32x16{};
    bf16x8 fa[4], fb[4], qa[2], qb[2];
    const int k0 = ks + kbo[0] + kbo[1], k1 = ks + kbo[0] + (kbo[1] ^ 32), k2 = ks + kbo[0] + (kbo[1] ^ 64), k3 = ks + kbo[0] + (kbo[1] ^ 96);
    const int q0 = qrow + (((0 + hi) ^ qsw) << 4), q1 = qrow + (((2 + hi) ^ qsw) << 4), q2 = qrow + (((4 + hi) ^ qsw) << 4), q3 = qrow + (((6 + hi) ^ qsw) << 4);
#define RDK(F, KA, KB, OFF) do { DSR128(F[0], KA, OFF); DSR128(F[1], KA, OFF + 12288); DSR128(F[2], KB, OFF); DSR128(F[3], KB, OFF + 12288); } while (0)
#define MMK(F, QA, QB) do { p0 = __builtin_amdgcn_mfma_f32_32x32x16_bf16(F[0], QA, p0, 0, 0, 0); p1 = __builtin_amdgcn_mfma_f32_32x32x16_bf16(F[1], QA, p1, 0, 0, 0); \
        p0 = __builtin_amdgcn_mfma_f32_32x32x16_bf16(F[2], QB, p0, 0, 0, 0); p1 = __builtin_amdgcn_mfma_f32_32x32x16_bf16(F[3], QB, p1, 0, 0, 0); } while (0)
    RDK(fa, k0, k1, 0);
    RDK(fb, k2, k3, 0);    WAITK4(4, fa); MMK(fa, qr[0], qr[1]);
    RDK(fa, k0, k1, 128);  WAITK4(4, fb); MMK(fb, qr[2], qr[3]);
    RDK(fb, k2, k3, 128);  WAITK4(4, fa); MMK(fa, qr[4], qr[5]);
    RDK(fa, k0, k1, 256); DSR128(qa[0], q0, 0); DSR128(qa[1], q1, 0);  WAITK4(6, fb); MMK(fb, qr[6], qr[7]);
    RDK(fb, k2, k3, 256); DSR128(qb[0], q2, 0); DSR128(qb[1], q3, 0);  WAITK6(6, fa, qa); MMK(fa, qa[0], qa[1]);
    WAITK6(0, fb, qb); MMK(fb, qb[0], qb[1]);
#undef RDK
#undef MMK
}
__device__ __forceinline__ int v_st(int k, int c) { const int kk = (k & ~0xC) | ((k & 4) << 1) | ((k & 8) >> 1); return ((kk >> 3) * 4 + (c >> 5)) * 512 + ((kk & 7) * 32 + (c & 31)) * 2; }
__device__ __forceinline__ int v_rd_base(int lane) { return ((lane & 3) << 3) | (((lane >> 2) & 3) << 6) | (((lane >> 4) & 1) << 5) | (((lane >> 5) & 1) << 8); }
constexpr int v_rd_off(int d0, int ks, int half) { return d0 * 512 + ks * 4096 + half * 2048; }
#define TRR(dst, base, OFF) asm volatile("ds_read_b64_tr_b16 %0, %1 offset:%2" : "=v"(dst) : "v"(base), "i"(OFF) : "memory")
#define WAITV8(N, L, H) asm volatile("s_waitcnt lgkmcnt(" #N ")" : "+v"(L[0]), "+v"(L[1]), "+v"(L[2]), "+v"(L[3]), "+v"(H[0]), "+v"(H[1]), "+v"(H[2]), "+v"(H[3]) :: "memory")
__device__ __forceinline__ void pv_d0(f32x16* o, int vb, bf16x8 pa0, bf16x8 pa1, bf16x8 pa2, bf16x8 pa3) {
    s16x4 la[4], ha[4], lb[4], hb[4];
#define RDV(L, H, D0) do { TRR(L[0], vb, v_rd_off(D0, 0, 0)); TRR(H[0], vb, v_rd_off(D0, 0, 1)); TRR(L[1], vb, v_rd_off(D0, 1, 0)); TRR(H[1], vb, v_rd_off(D0, 1, 1)); \
        TRR(L[2], vb, v_rd_off(D0, 2, 0)); TRR(H[2], vb, v_rd_off(D0, 2, 1)); TRR(L[3], vb, v_rd_off(D0, 3, 0)); TRR(H[3], vb, v_rd_off(D0, 3, 1)); } while (0)
#define MMV(L, H, D0) do { o[D0] = __builtin_amdgcn_mfma_f32_32x32x16_bf16(pa0, PKV(L[0], H[0]), o[D0], 0, 0, 0); o[D0] = __builtin_amdgcn_mfma_f32_32x32x16_bf16(pa1, PKV(L[1], H[1]), o[D0], 0, 0, 0); \
        o[D0] = __builtin_amdgcn_mfma_f32_32x32x16_bf16(pa2, PKV(L[2], H[2]), o[D0], 0, 0, 0); o[D0] = __builtin_amdgcn_mfma_f32_32x32x16_bf16(pa3, PKV(L[3], H[3]), o[D0], 0, 0, 0); } while (0)
    RDV(la, ha, 0);
    RDV(lb, hb, 1); WAITV8(8, la, ha); MMV(la, ha, 0);
    RDV(la, ha, 2); WAITV8(8, lb, hb); MMV(lb, hb, 1);
    RDV(lb, hb, 3); WAITV8(8, la, ha); MMV(la, ha, 2);
    WAITV8(0, lb, hb); MMV(lb, hb, 3);
#undef RDV
#undef MMV
}
__device__ __forceinline__ void unit(const bf16_t* __restrict__ Qb, const bf16_t* __restrict__ Kh, const bf16_t* __restrict__ Vh, bf16_t* __restrict__ Ob, int qb, LAS char* lds, const float* __restrict__ gq, int wv) {
    constexpr float C = MLA_C;
    int wvl = wv; asm volatile("" : "+s"(wvl)); int tid = wvl * 64 + lane_id(); asm volatile("" : "+v"(tid));
    const int wid = __builtin_amdgcn_readfirstlane(tid >> 6), lane = tid & 63, r32 = lane & 31, hi = lane >> 5;
    LAS char* K_lds = lds; LAS char* V_lds = lds + 3 * SHM_K;
    LAS float* wsf = (LAS float*)(lds + OFF_WS) + wid * 64; LAS float* li_l = wsf; LAS float* al_l = wsf + 32;
    LAS char* qlds = lds + OFF_QR + (wid * 32 + r32) * 128; const int qsw = r32 & 7; const int qrow = (int)(uintptr_t)qlds, klds = (int)(uintptr_t)K_lds;
    const int kbo[2] = {r32 * 384, (16 * hi) ^ SWZF(r32)};
    float m_reg = -1e30f, l_reg = 0; f32x16 o[4] = {}; bf16x8 qr[8];
    const bf16_t* Qw = Qb + (size_t)(wid * 32 + r32) * LDQ + hi * 8;
    {
        float ss = 0.f;
#pragma unroll
        for (int d0 = 0; d0 < 12; ++d0) { float t8[8]; unpack8(*(const u32x4*)(Qw + d0 * 16), t8);
#pragma unroll
            for (int j = 0; j < 8; ++j) ss += t8[j] * t8[j]; }
        ss += __shfl_xor(ss, 32);
        const float r = rsqrtf(ss * (1.f / 192.f) + EPS);
#define QSCALE(F, d0) do { unpack8(*(const u32x4*)(Qw + (d0) * 16), F); const f32x4 g0 = *(const f32x4*)(gq + (d0) * 16 + hi * 8), g1 = *(const f32x4*)(gq + (d0) * 16 + hi * 8 + 4); \
            F[0] *= r * g0.x; F[1] *= r * g0.y; F[2] *= r * g0.z; F[3] *= r * g0.w; F[4] *= r * g1.x; F[5] *= r * g1.y; F[6] *= r * g1.z; F[7] *= r * g1.w; } while (0)
#pragma unroll
        for (int d0 = 0; d0 < 8; ++d0) { float t8[8]; QSCALE(t8, d0); qr[d0] = __builtin_bit_cast(bf16x8, pack8(t8)); }
        const float pos = (float)(qb * 256 + wid * 32 + r32);
#pragma unroll
        for (int dd = 0; dd < 2; ++dd) { float a8[8], b8[8]; QSCALE(a8, 8 + dd); QSCALE(b8, 10 + dd);
#pragma unroll
            for (int j = 0; j < 8; ++j) { float sn, cs; fast_sincos(pos * rope_inv(16 * dd + 8 * hi + j), sn, cs);
                const float x1 = a8[j], x2 = b8[j]; a8[j] = x1 * cs - x2 * sn; b8[j] = x2 * cs + x1 * sn; }
            *(LAS u32x4*)(qlds + (((dd * 2 + hi) ^ qsw) << 4)) = pack8(a8); *(LAS u32x4*)(qlds + ((((2 + dd) * 2 + hi) ^ qsw) << 4)) = pack8(b8); }
#undef QSCALE
    }
    asm volatile("s_waitcnt vmcnt(0)" ::: "memory");
    unsigned ksrc[3], vsrc[2];
#pragma unroll
    for (int k = 0; k < 3; ++k) { const int d = (wid + 8 * k) * 1024 + lane * 16, row = d / 384, cs = (d - row * 384) >> 4, c = (cs & ~7) | ((cs & 7) ^ (SWZF(row) >> 4));
        ksrc[k] = (unsigned)(row * LDK + c * 8) * 2u; }
#pragma unroll
    for (int k = 0; k < 2; ++k) { const int d = (wid + 8 * k) * 1024 + lane * 16, sub = d >> 9, win = d & 511, kk = (sub >> 2) * 8 + (win >> 6), col = (sub & 3) * 32 + ((win & 63) >> 1);
        const int key = (kk & ~0xC) | ((kk & 4) << 1) | ((kk & 8) >> 1);
        vsrc[k] = (unsigned)(key * LDV + col) * 2u; }
#define DMA_K(t, slot) do { _Pragma("unroll") for (int k = 0; k < 3; ++k) \
        __builtin_amdgcn_global_load_lds((const unsigned*)((const char*)Kh + (size_t)(t) * (64 * LDK * 2) + ksrc[k]), (LAS unsigned*)(K_lds + (slot) + (wid + 8 * k) * 1024), 16, 0, 0); } while (0)
#define DMA_V(t, slot) do { _Pragma("unroll") for (int k = 0; k < 2; ++k) \
        __builtin_amdgcn_global_load_lds((const unsigned*)((const char*)Vh + (size_t)(t) * (64 * LDV * 2) + vsrc[k]), (LAS unsigned*)(V_lds + (slot) + (wid + 8 * k) * 1024), 16, 0, 0); } while (0)
#define WAITBAR(N) do { asm volatile("s_waitcnt vmcnt(" #N ") lgkmcnt(0)" ::: "memory"); __builtin_amdgcn_s_barrier(); asm volatile("" ::: "memory"); } while (0)
    const int vbase = (int)(uintptr_t)V_lds + v_rd_base(lane);
#define RESC(a) do { if (__any((a) < 1.f)) { if (hi == 0) al_l[r32] = (a); LDS_WAIT(); \
    _Pragma("unroll") for (int d = 0; d < 4; ++d) _Pragma("unroll") for (int r = 0; r < 16; ++r) o[d][r] *= al_l[crow(r, hi)]; } } while (0)
#define MASKT(P0, P1, tix) do { if ((tix) > mylast) { _Pragma("unroll") for (int r = 0; r < 16; ++r) { P0[r] = -1e30f; P1[r] = -1e30f; } } } while (0)
    f32x16 pA0, pA1, pB0, pB1; float mnA, mnB, alA, alB; bf16x8 pa0, pa1, pa2, pa3;
    const int NT = 4 * qb + 4, mylast = 4 * qb + (wid >> 1);
    int kc = 0, kn = SHM_K, kf = 2 * SHM_K, vp = 2 * SHM_V, vc = 0, vf = SHM_V;
#define ROT() do { const int t_ = kc; kc = kn; kn = kf; kf = t_; const int u_ = vp; vp = vc; vc = vf; vf = u_; } while (0)
    DMA_K(0, 0); DMA_V(0, 0); DMA_K(1, SHM_K);
    WAITBAR(5);
    qkt(pA0, pA1, klds + kc, qr, qrow, hi, qsw, kbo); partialSM(pA0, pA1, m_reg, mnA, alA, C);
    DMA_K(2, 2 * SHM_K); DMA_V(1, SHM_V);
    WAITBAR(5);
    ROT();
#define STEP(PC0, PC1, mnC, alC, PP0, PP1, alP, t) do { \
        SBAR(); qkt(PC0, PC1, klds + kc, qr, qrow, hi, qsw, kbo); MASKT(PC0, PC1, t); \
        finishSM(PP0, PP1, alP, l_reg, pa0, pa1, pa2, pa3); SBAR(); \
        if ((t) + 2 < NT) DMA_K((t) + 2, kf); if ((t) + 1 < NT) DMA_V((t) + 1, vf); \
        pv_d0(o, vbase + vp, pa0, pa1, pa2, pa3); partialSM(PC0, PC1, m_reg, mnC, alC, C); \
        RESC(alC); \
        if ((t) + 2 < NT) WAITBAR(5); else if ((t) + 1 < NT) WAITBAR(2); else WAITBAR(0); \
        ROT(); } while (0)
    for (int t = 1; t + 1 < NT; t += 2) {
        STEP(pB0, pB1, mnB, alB, pA0, pA1, alA, t);
        STEP(pA0, pA1, mnA, alA, pB0, pB1, alB, t + 1);
    }
    STEP(pB0, pB1, mnB, alB, pA0, pA1, alA, NT - 1);
    finishSM(pB0, pB1, alB, l_reg, pa0, pa1, pa2, pa3); SBAR();
    pv_d0(o, vbase + vp, pa0, pa1, pa2, pa3);
    if (hi == 0) li_l[r32] = l_reg; LDS_WAIT();
    float rli[16];
#pragma unroll
    for (int r = 0; r < 16; ++r) rli[r] = __builtin_amdgcn_rcpf(li_l[crow(r, hi)]);
    bf16_t* Ow = Ob + (size_t)(wid * 32) * LDO;
#pragma unroll
    for (int r = 0; r < 16; ++r) { const int orow = crow(r, hi);
#pragma unroll
        for (int d0 = 0; d0 < 4; ++d0) Ow[(size_t)orow * LDO + d0 * 32 + r32] = f2bf(o[d0][r] * rli[r]); }
    asm volatile("s_waitcnt lgkmcnt(0)" ::: "memory"); __builtin_amdgcn_s_barrier(); asm volatile("" ::: "memory");
#undef DMA_K
#undef DMA_V
#undef WAITBAR
#undef RESC
#undef MASKT
#undef ROT
#undef STEP
}
}

template <int NB> __device__ __forceinline__ void resc_shfl(f32x16 (&o)[NB], float alpha, int hi) {
    if (__any(alpha < 1.f)) {
#pragma unroll
        for (int r = 0; r < 16; ++r) { const float a = __shfl(alpha, crow(r, hi));
#pragma unroll
            for (int d = 0; d < NB; ++d) o[d][r] *= a; }
    }
}

namespace sat {
constexpr int ROWB = 1152, TKEYS = 64, CT_BYTES = TKEYS * ROWB, BUF_BYTES = CT_BYTES + 1024, NT = 4160 / TKEYS, OLB = 1040;
typedef float f32x4v __attribute__((ext_vector_type(4)));
__device__ __forceinline__ int swz2(int row) { return (((row & 2) << 1) | ((row & 4) >> 1)) << 4; }
__device__ __forceinline__ int coff(int row, int colB) { return row * ROWB + (colB ^ swz2(row)); }
template <int MODE = 0>
__device__ __forceinline__ void unit(const Args& P, int b, int hp, LAS char* lds, int wv) {
    unsigned char* ws = P.ws;
    int wvl = wv; asm volatile("" : "+s"(wvl)); int tid = wvl * 64 + lane_id(); asm volatile("" : "+v"(tid));
    const int wid = __builtin_amdgcn_readfirstlane(tid >> 6), lane = tid & 63, i16 = lane & 15, g = lane >> 4;
    const int hl = wid >> 2, qb = (wid >> 1) & 1, ch = wid & 1, h = 2 * hp + hl;
    const char* LATb = (const char*)((const bf16_t*)(ws + WS_LATS) + (size_t)b * KPAD * 512);
    const char* KRb = (const char*)((const bf16_t*)(ws + WS_KRS) + (size_t)b * KPAD * 64);
    const char* RKb = (const char*)((const float*)(ws + WS_RKG) + (size_t)b * KPAD * 16 + (2 * hp & ~3));
    bf16x8 qa[18];
    { const bf16_t* Qh = (const bf16_t*)(ws + WS_Q) + (size_t)(TP + b * 32 + 16 * qb + i16) * QLD + h * 192;
      const float* gk = P.in[I_GKHEAD]; const float* gq = P.in[I_GQHEAD];
      bf16x8 qg[4];
      float fn[4][8], fr[2][8]; float ss = 0.f;
#pragma unroll
      for (int kd = 0; kd < 4; ++kd) { unpack8(*(const u32x4*)(Qh + kd * 32 + g * 8), fn[kd]);
#pragma unroll
          for (int j = 0; j < 8; ++j) ss += fn[kd][j] * fn[kd][j]; }
#pragma unroll
      for (int kr = 0; kr < 2; ++kr) { unpack8(*(const u32x4*)(Qh + 128 + kr * 32 + g * 8), fr[kr]);
#pragma unroll
          for (int j = 0; j < 8; ++j) ss += fr[kr][j] * fr[kr][j]; }
      ss += __shfl_xor(ss, 16); ss += __shfl_xor(ss, 32);
      const float rq = rsqrtf(ss * (1.f / 192.f) + EPS);
#pragma unroll
      for (int kd = 0; kd < 4; ++kd) { float f[8];
#pragma unroll
          for (int j = 0; j < 8; ++j) f[j] = fn[kd][j] * rq * gq[kd * 32 + g * 8 + j] * gk[kd * 32 + g * 8 + j];
          qg[kd] = __builtin_bit_cast(bf16x8, pack8(f)); }
      { const float pos = (float)(4096 + 16 * qb + i16);
#pragma unroll
        for (int j = 0; j < 8; ++j) { float sn, cs; fast_sincos(pos * rope_inv(8 * g + j), sn, cs);
            const float x1 = fr[0][j] * rq * gq[128 + 8 * g + j], x2 = fr[1][j] * rq * gq[160 + 8 * g + j]; fr[0][j] = x1 * cs - x2 * sn; fr[1][j] = x2 * cs + x1 * sn; } }
      const bf16_t* Wn = (const bf16_t*)(ws + WS_WKBN) + (size_t)(8 * (i16 >> 2) + (i16 & 3)) * 2048 + h * 128 + g * 8;
#pragma unroll
      for (int ks = 0; ks < 16; ++ks) { f32x4 a0 = {0.f, 0.f, 0.f, 0.f}, a1 = a0;
#pragma unroll
          for (int kd = 0; kd < 4; ++kd) {
              const bf16x8 w0 = *(const bf16x8*)(Wn + (size_t)(32 * ks) * 2048 + kd * 32), w1 = *(const bf16x8*)(Wn + (size_t)(32 * ks + 4) * 2048 + kd * 32);
              a0 = __builtin_amdgcn_mfma_f32_16x16x32_bf16(w0, qg[kd], a0, 0, 0, 0); a1 = __builtin_amdgcn_mfma_f32_16x16x32_bf16(w1, qg[kd], a1, 0, 0, 0); }
          qa[ks] = __builtin_bit_cast(bf16x8, (u32x4){cvtpk(a0[0], a0[1]), cvtpk(a0[2], a0[3]), cvtpk(a1[0], a1[1]), cvtpk(a1[2], a1[3])});
          if ((ks & 3) == 3) asm volatile("" ::: "memory"); }
      qa[16] = __builtin_bit_cast(bf16x8, pack8(fr[0])); qa[17] = __builtin_bit_cast(bf16x8, pack8(fr[1])); }
    asm volatile("s_waitcnt vmcnt(0)" ::: "memory");
    unsigned soff[10]; unsigned kmask = 0u;
#pragma unroll
    for (int k = 0; k < 10; ++k) { const int p = wid + 8 * k;
        if (p < 72) { const int d = p * 1024 + lane * 16, row = d / ROWB, cs = (d - row * ROWB) >> 4, c = (cs & ~7) | ((cs & 7) ^ (swz2(row) >> 4));
            if (c >= 64) { kmask |= 1u << (2 * k); soff[k] = (unsigned)(row * 128 + (c - 64) * 16); } else soff[k] = (unsigned)(row * 1024 + c * 16); }
        else { kmask |= 2u << (2 * k); soff[k] = (unsigned)(lane * 64); } }
#define TDMA(j, bufoff) do { _Pragma("unroll") for (int k = 0; k < 10; ++k) { const int p_ = wid + 8 * k; if (p_ < 73) { const unsigned kd_ = (kmask >> (2 * k)) & 3u; \
        const char* sp_ = kd_ == 0u ? LATb + (size_t)(j) * (64 * 1024) + soff[k] : (kd_ == 1u ? KRb + (size_t)(j) * (64 * 128) + soff[k] : RKb + (size_t)(j) * (64 * 64) + soff[k]); \
        __builtin_amdgcn_global_load_lds((const unsigned*)sp_, (LAS unsigned*)(lds + (bufoff) + p_ * 1024), 16, 0, 0); } } } while (0)
    const int sw = swz2(i16);
    const int ao0 = i16 * ROWB + ((16 * g) ^ sw), ao1 = i16 * ROWB + ((64 + 16 * g) ^ sw);
    int trb[4];
    { const int row = 4 * g + (i16 >> 2), sr = swz2(row);
#pragma unroll
      for (int c4 = 0; c4 < 4; ++c4) trb[c4] = row * ROWB + ((512 * ch + 32 * c4 + 8 * (i16 & 3)) ^ sr) - ((512 * ch) & 0) ; }
    const int rko = CT_BYTES + (4 * g) * 16 + ((2 * hp & 3) + hl) * 4;
    float m_reg = 0.f, l_reg = 0.f; f32x4 o[16]; bf16x8 pown, poth;
#pragma unroll
    for (int d = 0; d < 16; ++d) o[d] = (f32x4){0.f, 0.f, 0.f, 0.f};
    TDMA(0, 0);
    asm volatile("s_waitcnt vmcnt(0)" ::: "memory");
    __builtin_amdgcn_s_barrier(); asm volatile("" ::: "memory");
    int cur = 0;
    for (int j = 0; j < NT; ++j) {
        const LAS char* CTb = lds + cur;
        if (MODE != 1) { if (j + 1 < NT) TDMA(j + 1, cur ? 0 : BUF_BYTES); }
        if (MODE != 2) {
        f32x4 sk[2] = {(f32x4){0.f, 0.f, 0.f, 0.f}, (f32x4){0.f, 0.f, 0.f, 0.f}};
        { const int sa0 = (int)(uintptr_t)CTb + ao0 + ch * 32 * ROWB, sa1 = (int)(uintptr_t)CTb + ao1 + ch * 32 * ROWB;
          bf16x8 fa[4], fb[4];
#define RDS(F, n) do { DSR128(F[0], sa0, (n) * 128); DSR128(F[1], sa0, (n) * 128 + 16 * ROWB); DSR128(F[2], sa1, (n) * 128); DSR128(F[3], sa1, (n) * 128 + 16 * ROWB); } while (0)
#define MMS(F, n) do { sk[0] = __builtin_amdgcn_mfma_f32_16x16x32_bf16(F[0], qa[2 * (n)], sk[0], 0, 0, 0); sk[1] = __builtin_amdgcn_mfma_f32_16x16x32_bf16(F[1], qa[2 * (n)], sk[1], 0, 0, 0); \
              sk[0] = __builtin_amdgcn_mfma_f32_16x16x32_bf16(F[2], qa[2 * (n) + 1], sk[0], 0, 0, 0); sk[1] = __builtin_amdgcn_mfma_f32_16x16x32_bf16(F[3], qa[2 * (n) + 1], sk[1], 0, 0, 0); } while (0)
          RDS(fa, 0);
#pragma unroll
          for (int n = 0; n < 8; n += 2) {
              RDS(fb, n + 1); WAITK4(4, fa); MMS(fa, n);
              RDS(fa, n + 2); WAITK4(4, fb); MMS(fb, n + 1);
          }
          WAITK4(0, fa); MMS(fa, 8);
#undef RDS
#undef MMS
        }
        float e8[8]; float mloc = -1e30f;
#pragma unroll
        for (int kb = 0; kb < 2; ++kb)
#pragma unroll
            for (int r = 0; r < 4; ++r) { float v = sk[kb][r] * *(const LAS float*)(CTb + rko + (32 * ch + 16 * kb + r) * 16);
                if (j == NT - 1 && ch == 1) v = -1e30f;
                mloc = fmaxf(mloc, v); e8[4 * kb + r] = __builtin_amdgcn_exp2f(v - m_reg); }
        mloc = fmaxf(mloc, __shfl_xor(mloc, 16)); mloc = fmaxf(mloc, __shfl_xor(mloc, 32));
        { LAS char* xb = (LAS char*)lds + 2 * BUF_BYTES;
          *(LAS u32x4*)(xb + wid * 1024 + lane * 16) = (u32x4){cvtpk(e8[0], e8[1]), cvtpk(e8[2], e8[3]), cvtpk(e8[4], e8[5]), cvtpk(e8[6], e8[7])};
          if (g == 0) *(LAS float*)(xb + 8192 + wid * 64 + i16 * 4) = mloc;
          asm volatile("s_waitcnt lgkmcnt(0)" ::: "memory"); __builtin_amdgcn_s_barrier(); asm volatile("" ::: "memory");
          const u32x4 pp = *(const LAS u32x4*)(xb + (wid ^ 1) * 1024 + lane * 16); const float mp = *(const LAS float*)(xb + 8192 + (wid ^ 1) * 64 + i16 * 4);
          const float mc = fmaxf(mloc, mp); float f = 1.f;
          if (!__builtin_expect(__all(mc - m_reg <= 11.5f), 1)) { const float mn = fmaxf(m_reg, mc); f = __builtin_amdgcn_exp2f(m_reg - mn); m_reg = mn; }
          float q8[8]; unpack8(pp, q8);
          float ps = 0.f;
#pragma unroll
          for (int i = 0; i < 8; ++i) { e8[i] *= f; q8[i] *= f; ps += e8[i] + q8[i]; }
          ps += __shfl_xor(ps, 16); ps += __shfl_xor(ps, 32);
          l_reg = l_reg * f + ps;
          if (__any(f < 1.f)) {
              const float a0 = __shfl(f, 4 * g), a1 = __shfl(f, 4 * g + 1), a2 = __shfl(f, 4 * g + 2), a3 = __shfl(f, 4 * g + 3);
#pragma unroll
              for (int d = 0; d < 16; ++d) { o[d][0] *= a0; o[d][1] *= a1; o[d][2] *= a2; o[d][3] *= a3; } }
          e8[0] = e8[0];
          pown = __builtin_bit_cast(bf16x8, pack8(e8)); poth = __builtin_bit_cast(bf16x8, pack8(q8)); }
        const bf16x8 pa0 = ch == 0 ? pown : poth, pa1 = ch == 0 ? poth : pown;
        const int ctb = (int)(uintptr_t)CTb;
        { s16x4 la[4], ha[4], lb[4], hb[4];
#define RDP(L, H, G) do { const int tb_ = ctb + trb[(G) & 3]; constexpr int o_ = ((G) >> 2) * 256; \
            TRR(L[0], tb_, o_); TRR(H[0], tb_, o_ + 16 * ROWB); TRR(L[1], tb_, o_ + 32 * ROWB); TRR(H[1], tb_, o_ + 48 * ROWB); \
            TRR(L[2], tb_, o_ + 128); TRR(H[2], tb_, o_ + 128 + 16 * ROWB); TRR(L[3], tb_, o_ + 128 + 32 * ROWB); TRR(H[3], tb_, o_ + 128 + 48 * ROWB); } while (0)
#define MMP(L, H, G) do { constexpr int d_ = ((G) & 3) + 8 * ((G) >> 2); \
            o[d_] = __builtin_amdgcn_mfma_f32_16x16x32_bf16(pa0, PKV(L[0], H[0]), o[d_], 0, 0, 0); o[d_] = __builtin_amdgcn_mfma_f32_16x16x32_bf16(pa1, PKV(L[1], H[1]), o[d_], 0, 0, 0); \
            o[d_ + 4] = __builtin_amdgcn_mfma_f32_16x16x32_bf16(pa0, PKV(L[2], H[2]), o[d_ + 4], 0, 0, 0); o[d_ + 4] = __builtin_amdgcn_mfma_f32_16x16x32_bf16(pa1, PKV(L[3], H[3]), o[d_ + 4], 0, 0, 0); } while (0)
          RDP(la, ha, 0);
          RDP(lb, hb, 1); WAITV8(8, la, ha); MMP(la, ha, 0);
          RDP(la, ha, 2); WAITV8(8, lb, hb); MMP(lb, hb, 1);
          RDP(lb, hb, 3); WAITV8(8, la, ha); MMP(la, ha, 2);
          RDP(la, ha, 4); WAITV8(8, lb, hb); MMP(lb, hb, 3);
          RDP(lb, hb, 5); WAITV8(8, la, ha); MMP(la, ha, 4);
          RDP(la, ha, 6); WAITV8(8, lb, hb); MMP(lb, hb, 5);
          RDP(lb, hb, 7); WAITV8(8, la, ha); MMP(la, ha, 6);
          WAITV8(0, lb, hb); MMP(lb, hb, 7);
#undef RDP
#undef MMP
        }
        }
        asm volatile("s_waitcnt vmcnt(0) lgkmcnt(0)" ::: "memory");
        __builtin_amdgcn_s_barrier(); asm volatile("" ::: "memory");
        cur = cur ? 0 : BUF_BYTES;
    }
    asm volatile("s_waitcnt vmcnt(0)" ::: "memory");
    { const float rl = __builtin_amdgcn_rcpf(l_reg);
      const float r0 = __shfl(rl, 4 * g), r1 = __shfl(rl, 4 * g + 1), r2 = __shfl(rl, 4 * g + 2), r3 = __shfl(rl, 4 * g + 3);
      LAS bf16_t* OL = (LAS bf16_t*)(lds + hl * 32 * OLB) + (16 * qb + 4 * g) * (OLB / 2) + 256 * ch + i16;
#pragma unroll
      for (int d = 0; d < 16; ++d) { OL[16 * d] = f2bf(o[d][0] * r0); OL[(OLB / 2) + 16 * d] = f2bf(o[d][1] * r1); OL[2 * (OLB / 2) + 16 * d] = f2bf(o[d][2] * r2); OL[3 * (OLB / 2) + 16 * d] = f2bf(o[d][3] * r3); }
      __syncthreads();
      const int r32 = lane & 31, hi = lane >> 5, wq = wid & 3;
      f32x16 acc = f32x16{};
      const bf16_t* Wv = (const bf16_t*)(ws + WS_WVB) + (size_t)(h * 128 + 32 * wq + r32) * 512 + hi * 8;
      const LAS char* ar = lds + hl * 32 * OLB + r32 * OLB + hi * 16;
#pragma unroll 8
      for (int ks = 0; ks < 32; ++ks) { const bf16x8 a = *(const LAS bf16x8*)(ar + ks * 32); const bf16x8 bw = *(const bf16x8*)(Wv + ks * 16);
          acc = __builtin_amdgcn_mfma_f32_32x32x16_bf16(a, bw, acc, 0, 0, 0); }
      bf16_t* Ow = (bf16_t*)(ws + WS_OMLA) + (size_t)(TP + b * 32) * 2048 + h * 128 + 32 * wq + r32;
#pragma unroll
      for (int r = 0; r < 16; ++r) Ow[(size_t)crow(r, hi) * 2048] = f2bf(acc[r]);
      __syncthreads(); }
#undef TDMA
}
}


struct MergeSched {
    const bf16_t *D, *WP, *OML, *WML, *OME, *WME; int G, c;
    __device__ __forceinline__ void seg_ptrs(pg8::Unit& u, int seg, int pm, int pn, int kt0) const {
        if (seg == 0) { u.A = (const char*)(D + (size_t)pm * 256 * 1024 + (pn >> 1) * 256); u.lda2 = 2048u; u.B = (const char*)(WP + (size_t)pn * 256 * 256); u.ldb2 = 512u; }
        else if (seg == 1) { u.A = (const char*)(OML + (size_t)pm * 256 * 2048 + kt0 * 64); u.lda2 = 4096u; u.B = (const char*)(WML + (size_t)pn * 256 * 2048 + kt0 * 64); u.ldb2 = 4096u; }
        else { u.A = (const char*)(OME + (size_t)pm * 256 * 1024 + kt0 * 64); u.lda2 = 2048u; u.B = (const char*)(WME + (size_t)pn * 256 * 1024 + kt0 * 64); u.ldb2 = 2048u; }
    }
    __device__ __forceinline__ bool next(int i, pg8::Unit& u) const {
        const int nmain = c < 256 ? (256 - c + G - 1) / G : 0;
        if (i < 3 * nmain) { const int ti = i / 3, seg = i - 3 * ti; int pm, pn; pg8::tile_of(ti * G + c, 32, 8, pm, pn); u.pm = pm; u.pn = pn; u.kind = seg; u.aux = 0;
            seg_ptrs(u, seg, pm, pn, 0); u.nt = seg == 0 ? 4 : (seg == 1 ? 32 : 16); return true; }
        const long p = (long)(i - 3 * nmain) * G + c; if (p >= 16 * 13) return false;
        const int t = (int)p / 13, piece = (int)p - 13 * t, pm = 32 + (t >> 3), pn = t & 7, seg = piece == 0 ? 0 : (piece < 9 ? 1 : 2);
        u.pm = pm; u.pn = pn; u.kind = 3 + seg; u.aux = (int)p; u.nt = 4;
        seg_ptrs(u, seg, pm, pn, seg == 1 ? (piece - 1) * 4 : (seg == 2 ? (piece - 9) * 4 : 0)); return true;
    }
};
struct TailSched {
    const bf16_t* A; const bf16_t* B; int K, G, c;
    __device__ __forceinline__ bool next(int i, pg8::Unit& u) const {
        const int nmain = c < 256 ? (256 - c + G - 1) / G : 0;
        u.lda2 = (unsigned)K * 2u; u.ldb2 = u.lda2;
        if (i < nmain) { int pm, pn; pg8::tile_of(i * G + c, 32, 8, pm, pn); u.pm = pm; u.pn = pn; u.kind = 0; u.aux = 0; u.nt = K / 64;
            u.A = (const char*)(A + (size_t)pm * 256 * K); u.B = (const char*)(B + (size_t)pn * 256 * K); return true; }
        const long p = (long)(i - nmain) * G + c; if (p >= 256) return false;
        const int t = (int)p >> 4, piece = (int)p & 15, pm = 32 + (t >> 3), pn = t & 7, ntp = K / 64 / 16;
        u.pm = pm; u.pn = pn; u.kind = 1; u.aux = (int)p; u.nt = ntp;
        u.A = (const char*)(A + (size_t)pm * 256 * K + piece * ntp * 64); u.B = (const char*)(B + (size_t)pn * 256 * K + piece * ntp * 64); return true;
    }
};
struct EpiMerge {
    static constexpr bool PERM = true;
    const bf16_t* G; const float* ps; bf16_t* MG; float* slab;
    __device__ __forceinline__ bool operator()(f32x4 (&acc)[2][2][4][2], const pg8::Unit& u, int wr, int wc, int fr_, int fq) const {
        int fr = fr_; asm volatile("" : "+v"(fr));
        const int row0 = u.pm * 256 + wr * 64 + fr, c0 = u.pn * 256 + wc * 32 + 8 * fq;
        const int kind = u.kind, sg = kind >= 3 ? kind - 3 : kind;
        const bool ratio = kind < 2;
        float* sl = slab + (size_t)u.aux * 65536 + (wr * 64 + fr) * 256 + wc * 32 + 8 * fq;
        f32x4 pv[2][2];
#pragma unroll
        for (int bj = 0; bj < 2; ++bj) { pv[bj][0] = (f32x4){1.f, 1.f, 1.f, 1.f}; pv[bj][1] = pv[bj][0]; }
        if (sg == 0) {
#pragma unroll
            for (int bj = 0; bj < 2; ++bj) { pv[bj][0] = *(const f32x4*)(ps + c0 + bj * 128); pv[bj][1] = *(const f32x4*)(ps + c0 + bj * 128 + 4); }
        }
#pragma unroll
        for (int ai = 0; ai < 2; ++ai) {
            u32x4 ga[4][2], gb[4][2];
#pragma unroll
            for (int m = 0; m < 4; ++m) { const bf16_t* gr = G + (size_t)(row0 + ai * 128 + m * 16) * G_LD + sg * 2048 + c0;
#pragma unroll
                for (int bj = 0; bj < 2; ++bj) { ga[m][bj] = *(const u32x4*)(gr + bj * 128); gb[m][bj] = ratio ? *(const u32x4*)(gr + 2048 + bj * 128) : (u32x4){0u, 0u, 0u, 0u}; } }
            asm volatile("" ::: "memory");
#pragma unroll
            for (int m = 0; m < 4; ++m) { const size_t row = (size_t)(row0 + ai * 128 + m * 16);
#pragma unroll
                for (int bj = 0; bj < 2; ++bj) {
                    float f[8]; unpack8(ga[m][bj], f);
                    if (ratio) { float b[8]; unpack8(gb[m][bj], b);
#pragma unroll
                        for (int e = 0; e < 8; ++e) f[e] *= __builtin_amdgcn_rcpf(b[e]); }
#pragma unroll
                    for (int e = 0; e < 8; ++e) f[e] *= pv[bj][e >> 2][e & 3];
                    f32x4& v0 = acc[ai][bj][m][0]; f32x4& v1 = acc[ai][bj][m][1];
                    v0[0] *= f[0]; v0[1] *= f[1]; v0[2] *= f[2]; v0[3] *= f[3]; v1[0] *= f[4]; v1[1] *= f[5]; v1[2] *= f[6]; v1[3] *= f[7];
                    if (kind == 2) *(u32x4*)(MG + row * 2048 + c0 + bj * 128) = (u32x4){cvtpk(v0[0], v0[1]), cvtpk(v0[2], v0[3]), cvtpk(v1[0], v1[1]), cvtpk(v1[2], v1[3])};
                    else if (kind >= 3) { float* sp = sl + (ai * 128 + m * 16) * 256 + bj * 128; *(f32x4*)sp = v0; *(f32x4*)(sp + 4) = v1; }
                } }
            asm volatile("" ::: "memory");
        }
        return kind < 2;
    }
};
__device__ __forceinline__ void store_slab(const f32x4 (&acc)[2][2][4][2], float* sl, int wr, int wc, int fr, int fq) {
    float* s0 = sl + (wr * 64 + fr) * 256 + wc * 32 + 4 * fq;
#pragma unroll
    for (int ai = 0; ai < 2; ++ai)
#pragma unroll
        for (int m = 0; m < 4; ++m)
#pragma unroll
            for (int bj = 0; bj < 2; ++bj)
#pragma unroll
                for (int n = 0; n < 2; ++n) *(f32x4*)(s0 + (ai * 128 + m * 16) * 256 + bj * 128 + n * 16) = acc[ai][bj][m][n];
}
struct EpiOut {
    static constexpr bool PERM = false;
    const float* xp; const float* xs; float* X1; bf16_t* X1b; float* SSX; float* slab;
    __device__ __forceinline__ bool operator()(f32x4 (&acc)[2][2][4][2], const pg8::Unit& u, int wr, int wc, int fr_, int fq) const {
        int fr = fr_; asm volatile("" : "+v"(fr));
        const int row0 = u.pm * 256 + wr * 64 + fr, c0 = u.pn * 256 + wc * 32 + 4 * fq;
        if (u.kind == 1) { store_slab(acc, slab + (size_t)u.aux * 65536, wr, wc, fr, fq); return false; }
#pragma unroll
        for (int ai = 0; ai < 2; ++ai) {
            f32x4 xv[4][2][2];
#pragma unroll
            for (int m = 0; m < 4; ++m) { const int row = row0 + ai * 128 + m * 16;
                const float* xr = (row < TP ? xp + (size_t)row * DM : xs + (size_t)(row - TP) * DM) + c0;
#pragma unroll
                for (int bj = 0; bj < 2; ++bj)
#pragma unroll
                    for (int n = 0; n < 2; ++n) xv[m][bj][n] = __builtin_nontemporal_load((const f32x4*)(xr + bj * 128 + n * 16)); }
            asm volatile("" ::: "memory");
#pragma unroll
            for (int m = 0; m < 4; ++m) { const int row = row0 + ai * 128 + m * 16; float s = 0.f;
#pragma unroll
                for (int bj = 0; bj < 2; ++bj)
#pragma unroll
                    for (int n = 0; n < 2; ++n) { const f32x4 v = acc[ai][bj][m][n] + xv[m][bj][n];
                        s += (v.x * v.x + v.y * v.y) + (v.z * v.z + v.w * v.w);
                        *(u32x2*)(X1b + (size_t)row * DM + c0 + bj * 128 + n * 16) = (u32x2){cvtpk(v.x, v.y), cvtpk(v.z, v.w)}; }
                s += __shfl_xor(s, 16); s += __shfl_xor(s, 32);
                if (fq == 0) SSX[(size_t)row * 32 + u.pn * 4 + wc] = s; }
            asm volatile("" ::: "memory");
        }
        return false;
    }
};
struct EpiUp {
    static constexpr bool PERM = true;
    const float* SSX; bf16_t* A;
    __device__ __forceinline__ bool operator()(f32x4 (&acc)[2][2][4][2], const pg8::Unit& u, int wr, int wc, int fr_, int fq) const {
        int fr = fr_; asm volatile("" : "+v"(fr));
        const int row0 = u.pm * 256 + wr * 64 + fr, c0 = u.pn * 256 + wc * 32 + 8 * fq;
        f32x4 sv[2][4][2];
#pragma unroll
        for (int ai = 0; ai < 2; ++ai)
#pragma unroll
            for (int m = 0; m < 4; ++m) { const size_t row = (size_t)(row0 + ai * 128 + m * 16); sv[ai][m][0] = *(const f32x4*)(SSX + row * 32 + fq * 8); sv[ai][m][1] = *(const f32x4*)(SSX + row * 32 + fq * 8 + 4); }
        asm volatile("" ::: "memory");
#pragma unroll
        for (int ai = 0; ai < 2; ++ai)
#pragma unroll
            for (int m = 0; m < 4; ++m) { const size_t row = (size_t)(row0 + ai * 128 + m * 16);
                const f32x4 s0 = sv[ai][m][0], s1 = sv[ai][m][1];
                float s = ((s0.x + s0.y) + (s0.z + s0.w)) + ((s1.x + s1.y) + (s1.z + s1.w));
                s += __shfl_xor(s, 16); s += __shfl_xor(s, 32);
                const float r = rsqrtf(s * (1.f / 2048.f) + EPS);
#pragma unroll
                for (int bj = 0; bj < 2; ++bj) { f32x4 v0 = acc[ai][bj][m][0] * r, v1 = acc[ai][bj][m][1] * r;
#pragma unroll
                    for (int e = 0; e < 4; ++e) { const float a = fmaxf(v0[e], 0.f), b = fmaxf(v1[e], 0.f); v0[e] = a * a; v1[e] = b * b; }
                    *(u32x4*)(A + row * 8192 + c0 + bj * 128) = (u32x4){cvtpk(v0[0], v0[1]), cvtpk(v0[2], v0[3]), cvtpk(v1[0], v1[1]), cvtpk(v1[2], v1[3])}; } }
        return false;
    }
};
struct EpiDown {
    static constexpr bool PERM = false;
    float* Y; const bf16_t* X1b; float* slab;
    __device__ __forceinline__ bool operator()(f32x4 (&acc)[2][2][4][2], const pg8::Unit& u, int wr, int wc, int fr_, int fq) const {
        int fr = fr_; asm volatile("" : "+v"(fr));
        const int row0 = u.pm * 256 + wr * 64 + fr, c0 = u.pn * 256 + wc * 32 + 4 * fq;
        if (u.kind == 1) { store_slab(acc, slab + (size_t)u.aux * 65536, wr, wc, fr, fq); return false; }
        u32x2 xv[2][4][2][2];
#pragma unroll
        for (int ai = 0; ai < 2; ++ai)
#pragma unroll
            for (int m = 0; m < 4; ++m) { const bf16_t* xr = X1b + (size_t)(row0 + ai * 128 + m * 16) * DM + c0;
#pragma unroll
                for (int bj = 0; bj < 2; ++bj)
#pragma unroll
                    for (int n = 0; n < 2; ++n) xv[ai][m][bj][n] = *(const u32x2*)(xr + bj * 128 + n * 16); }
        asm volatile("" ::: "memory");
#pragma unroll
        for (int ai = 0; ai < 2; ++ai)
#pragma unroll
            for (int m = 0; m < 4; ++m) { float* yr = Y + (size_t)(row0 + ai * 128 + m * 16) * DM + c0;
#pragma unroll
                for (int bj = 0; bj < 2; ++bj)
#pragma unroll
                    for (int n = 0; n < 2; ++n) { const u32x2 w = xv[ai][m][bj][n];
                        __builtin_nontemporal_store((f32x4){bflo(w.x), bfhi(w.x), bflo(w.y), bfhi(w.y)} + acc[ai][bj][m][n], (f32x4*)(yr + bj * 128 + n * 16)); } }
        return false;
    }
};
template <int NP> __device__ __forceinline__ f32x4 slab_sum(const float* slab, int t, int r, int lane) {
    const float* sp = slab + ((size_t)t * NP) * 65536 + r * 256 + lane * 4;
    f32x4 s = *(const f32x4*)sp;
#pragma unroll
    for (int p = 1; p < NP; ++p) s += *(const f32x4*)(sp + (size_t)p * 65536);
    return s;
}
__device__ __forceinline__ void reduce_merge(const float* slab, bf16_t* MG, int gw, int NGW, int lane) {
    for (int it = gw; it < TS * 4; it += NGW) { const int rs = it >> 2, q = it & 3, r = rs & 255, t0 = (rs >> 8) * 8;
#pragma unroll
        for (int pn = 2 * q; pn < 2 * q + 2; ++pn) { const f32x4 s = slab_sum<13>(slab, t0 + pn, r, lane);
            *(u32x2*)(MG + (size_t)(TP + rs) * DM + pn * 256 + lane * 4) = (u32x2){cvtpk(s.x, s.y), cvtpk(s.z, s.w)}; } }
}
__device__ __forceinline__ void reduce_out(const float* slab, const float* xs, float* X1, bf16_t* X1b, float* SSX, int gw, int NGW, int lane) {
    for (int it = gw; it < TS * 4; it += NGW) { const int rs = it >> 2, q = it & 3, r = rs & 255, t0 = (rs >> 8) * 8; float ss = 0.f;
#pragma unroll
        for (int pn = 2 * q; pn < 2 * q + 2; ++pn) { const size_t o = (size_t)rs * DM + pn * 256 + lane * 4;
            const f32x4 v = slab_sum<16>(slab, t0 + pn, r, lane) + *(const f32x4*)(xs + o);
            ss += (v.x * v.x + v.y * v.y) + (v.z * v.z + v.w * v.w);
            *(u32x2*)(X1b + (size_t)TP * DM + o) = (u32x2){cvtpk(v.x, v.y), cvtpk(v.z, v.w)}; }
        ss = wave_sum(ss);
        if (lane < 8) SSX[(size_t)(TP + rs) * 32 + q * 8 + lane] = lane == 0 ? ss : 0.f; }
}
__device__ __forceinline__ void reduce_down(const float* slab, const bf16_t* X1b, float* Y, int gw, int NGW, int lane) {
    for (int it = gw; it < TS * 4; it += NGW) { const int rs = it >> 2, q = it & 3, r = rs & 255, t0 = (rs >> 8) * 8;
#pragma unroll
        for (int pn = 2 * q; pn < 2 * q + 2; ++pn) { const size_t o = (size_t)(TP + rs) * DM + pn * 256 + lane * 4; const u32x2 w = *(const u32x2*)(X1b + o);
            *(f32x4*)(Y + o) = (f32x4){bflo(w.x), bfhi(w.x), bflo(w.y), bfhi(w.y)} + slab_sum<16>(slab, t0 + pn, r, lane); } }
}

struct SchedB {
    const unsigned char* ws; int G, c;
    __device__ __forceinline__ bool next(int i, pg8::Unit& u) const {
        const long L = (long)i * G + c; constexpr int N0 = 34 * 37, N1 = 2 * 8; if (L >= N0 + N1) return false;
        int pm, pn; u.lda2 = 4096u; u.ldb2 = 4096u; u.nt = 32;
        if (L < N0) { pg8::tile_of((int)L, 34, 37, pm, pn); u.A = (const char*)(ws + WS_H + (size_t)pm * 256 * 4096); u.B = (const char*)(ws + WS_WIN + (size_t)pn * 256 * 4096); u.kind = 0; }
        else { pg8::tile_of((int)L - N0, 2, 8, pm, pn); u.A = (const char*)(ws + WS_HM + (size_t)pm * 256 * 4096); u.B = (const char*)(ws + WS_WMEMKV + (size_t)pn * 256 * 4096); u.kind = 1; }
        u.pm = pm; u.pn = pn; return true;
    }
};
__device__ __forceinline__ void mem_unit(int u, int& row0, int& bsel, int& h) {
    h = u & 3;
    if (u < 128) { const int b = u >> 6, pt = (u >> 2) & 15; row0 = b * 4096 + pt * 256; bsel = b; }
    else { const int b = (u - 128) >> 2; row0 = TP + b * 32; bsel = 2 + b; }
}
struct SchedD {
    const unsigned char* ws; const unsigned char* ob; int G, c;
    __device__ __forceinline__ bool next(int i, pg8::Unit& u) const {
        const long L = (long)i * G + c; constexpr int N0 = (NBS * KPAD / 256) * 8, N1 = N0 + 34 * 12, N2 = N1 + 32 * 8, N3 = N2 + 32 * 8, N4 = N3 + 192; if (L >= N4) return false;
        int pm, pn; u.lda2 = 1024u; u.ldb2 = 1024u; u.nt = 8; u.aux = 0;
        if (L < N0) { pg8::tile_of((int)L, NBS * KPAD / 256, 8, pm, pn); u.A = (const char*)(ws + WS_LATS + (size_t)pm * 256 * 1024); u.B = (const char*)(ws + WS_WKB + (size_t)pn * 256 * 1024); u.kind = 3; }
        else if (L < N1) { pg8::tile_of((int)L - N0, 34, 12, pm, pn); u.A = (const char*)(ws + WS_QN + (size_t)pm * 256 * 1024); u.B = (const char*)(ws + WS_WQB + (size_t)pn * 256 * 1024); u.kind = 0; }
        else if (L < N2) { pg8::tile_of((int)L - N1, 32, 8, pm, pn); u.A = (const char*)(ob + DO_CKVP + (size_t)pm * 256 * 1024); u.B = (const char*)(ws + WS_WKB + (size_t)pn * 256 * 1024); u.kind = 1; }
        else if (L < N3) { pg8::tile_of((int)L - N2, 32, 8, pm, pn); u.A = (const char*)(ob + DO_CKVP + (size_t)pm * 256 * 1024); u.B = (const char*)(ws + WS_WVB + (size_t)pn * 256 * 1024); u.kind = 2; }
        else { const int mu = (int)L - N3; int row0, bsel, h; mem_unit(mu, row0, bsel, h);
            u.A = (const char*)(ws + WS_QM + ((size_t)row0 * 1024 + h * 256) * 2); u.B = (const char*)(ws + WS_MK + ((size_t)bsel * 262144 + h * 256) * 2); u.lda2 = 2048u; u.ldb2 = 2048u; u.nt = 4;
            u.kind = mu < 128 ? 4 : 5; pm = row0; pn = h; }
        u.pm = pm; u.pn = pn; return true;
    }
};
struct SchedMO {
    const unsigned char* ws; int G, c;
    __device__ __forceinline__ bool next(int i, pg8::Unit& u) const {
        const long L = (long)i * G + c; if (L >= 192) return false;
        int row0, bsel, h; mem_unit((int)L, row0, bsel, h);
        u.A = (const char*)(ws + WS_PM + ((size_t)row0 * 1024 + h * 256) * 2); u.B = (const char*)(ws + WS_MVT + ((size_t)bsel * 262144 + (size_t)h * 65536) * 2); u.lda2 = 2048u; u.ldb2 = 512u; u.nt = 4;
        u.kind = L < 128 ? 4 : 5; u.pm = row0; u.pn = h; u.aux = 0; return true;
    }
};
struct EpiMO {
    static constexpr bool PERM = true;
    const float* PS; bf16_t* O;
    __device__ __forceinline__ bool operator()(f32x4 (&acc)[2][2][4][2], const pg8::Unit& u, int wr, int wc, int fr_, int fq) const {
        int fr = fr_; asm volatile("" : "+v"(fr));
        const int c0 = u.pn * 256 + wc * 32 + 8 * fq;
        f32x4 sv[2][4];
#pragma unroll
        for (int ai = 0; ai < 2; ++ai)
#pragma unroll
            for (int m = 0; m < 4; ++m) { const int rl = ai * 128 + wr * 64 + m * 16 + fr; sv[ai][m] = *(const f32x4*)(PS + (size_t)(u.pm + ((u.kind == 5 && rl >= 32) ? 0 : rl)) * 16 + u.pn * 4); }
        asm volatile("" ::: "memory");
#pragma unroll
        for (int ai = 0; ai < 2; ++ai)
#pragma unroll
            for (int m = 0; m < 4; ++m) { const int rl = ai * 128 + wr * 64 + m * 16 + fr; if (u.kind == 5 && rl >= 32) continue;
                const size_t row = (size_t)(u.pm + rl); const f32x4 s4 = sv[ai][m];
                const float inv = __builtin_amdgcn_rcpf((s4.x + s4.y) + (s4.z + s4.w));
#pragma unroll
                for (int bj = 0; bj < 2; ++bj) { const f32x4 v0 = acc[ai][bj][m][0] * inv, v1 = acc[ai][bj][m][1] * inv;
                    *(u32x4*)(O + row * 1024 + c0 + bj * 128) = (u32x4){cvtpk(v0[0], v0[1]), cvtpk(v0[2], v0[3]), cvtpk(v1[0], v1[1]), cvtpk(v1[2], v1[3])}; } }
        return false;
    }
};

constexpr int CW_BAR = 4096, CW_QUEUE = 64;
#ifndef PROBE_K
#define PROBE_K -1
#endif
#ifndef PROBE_BX
#define PROBE_BX 0
#endif
#define STAMP(k) do { if (PROBE_K >= 0 && bx == 0 && tid == 0) { const unsigned long long t_ = __builtin_amdgcn_s_memrealtime(); MISC[32 + 2 * (k)] = (unsigned)t_; MISC[33 + 2 * (k)] = (unsigned)(t_ >> 32); } } while (0)
#ifndef ONLY
#define ONLY -1
#endif
#define PH(x) (ONLY < 0 || ONLY == (x))
__global__ void __launch_bounds__(NWAVES * 64, 2) mega_fwd(Args P) {
    extern __shared__ __attribute__((aligned(16))) unsigned char lds_raw[];
    LAS unsigned char* lds = (LAS unsigned char*)lds_raw;
    const int tid = threadIdx.x, lane = tid & 63, wave = __builtin_amdgcn_readfirstlane(tid >> 6);
    const int G = gridDim.x, bx = blockIdx.x;
    const int vcu = (G % 8 == 0) ? (bx % 8) * (G / 8) + bx / 8 : bx;
    const int gw = vcu * NWAVES + wave, NGW = G * NWAVES;
    volatile LAS unsigned* MISC = (volatile LAS unsigned*)(lds + MISC_OFF);
    if (tid < 64) MISC[tid] = 0u;
    __syncthreads();
    unsigned* ctl = (unsigned*)(P.ws + WS_CTL);
    XcdBarrier bar = xcd_barrier_post(ctl + CW_BAR, MISC + 8); bar.wv = wave;
    unsigned char* ws = P.ws;
    STAMP(0);

#define LAUNDER() int lane_l = lane_id(), gw_l = gw; asm volatile("" : "+v"(lane_l)); asm volatile("" : "+s"(gw_l))
    if (PH(0)) { LAUNDER(); phase_prep<1>(P, lds, gw_l, NGW, wave, lane_l); }
    xcd_barrier(bar); STAMP(1);
    {
        const bool conv_first = ((bx >> 3) & 1) != 0;
        if (PH(0) && conv_first) { LAUNDER(); phase_prep<2>(P, lds, gw_l, NGW, wave, lane_l); __syncthreads(); }
        if (PH(1)) {
            SchedB S{ws, G, bx};
            EpiIn E{(bf16_t*)(ws + WS_ZS), (bf16_t*)(ws + WS_G), (float*)(ws + WS_M), P.in[I_BGATE]};
            pg8::gemm_stream<EpiIn, SchedB>(lds, S, E, wave);
        }
        if (PH(0) && !conv_first) { __syncthreads(); LAUNDER(); phase_prep<2>(P, lds, gw_l, NGW, wave, lane_l); }
    }
    xcd_barrier(bar); STAMP(2);
    if (PH(2)) { LAUNDER(); phase_rows(P, lds, gw_l, NGW, wave, lane_l); }
    xcd_barrier(bar); STAMP(3);
    if (PH(3)) {
        SchedD S{ws, (const unsigned char*)P.out, G, bx};
        EpiQKV E{(bf16_t*)(ws + WS_Q), (bf16_t*)((unsigned char*)P.out + DO_K), (bf16_t*)(ws + WS_V), (float*)(ws + WS_RKG), (bf16_t*)(ws + WS_PM), (float*)(ws + WS_PS),
                 (const float*)(ws + WS_KPESS), (const float*)(ws + WS_KPESSP), (const bf16_t*)(ws + WS_KRP), P.in[I_GKHEAD], lds};
        pg8::gemm_stream<EpiQKV, SchedD>(lds, S, E, wave);
    }
    xcd_barrier(bar); STAMP(4);
    {
        const bf16_t* Qg = (const bf16_t*)(ws + WS_Q); const bf16_t* Kg = (const bf16_t*)((unsigned char*)P.out + DO_K); const bf16_t* Vg = (const bf16_t*)(ws + WS_V);
        bf16_t* Og = (bf16_t*)(ws + WS_OMLA);
        constexpr int NI_P = 512;
#define DEQUEUE(qw) ({ LAS unsigned* mq_ = (LAS unsigned*)(lds + MISC_OFF + 64); asm volatile("" : "+s"(mq_));   \
        if (wave == 0 && lane_id() == 0) *(volatile LAS unsigned*)mq_ = __hip_atomic_fetch_add(ctl + (qw), 1u, __ATOMIC_RELAXED, __HIP_MEMORY_SCOPE_AGENT); __syncthreads(); const int it_ = (int)*(volatile LAS unsigned*)mq_; __syncthreads(); it_; })
#define PROBE_BEGIN() const bool pr_ = PROBE_K >= 20 && bx == PROBE_BX && tid == 0; unsigned long long ts_ = 0; if (pr_) ts_ = __builtin_amdgcn_s_memrealtime()
#define PROBE_END(pk) do { if (pr_ && (pk) == PROBE_K && MISC[20] == 0u) { MISC[20] = 1u; MISC[21] = (unsigned)(__builtin_amdgcn_s_memrealtime() - ts_); } } while (0)
        if (PH(7)) { SchedMO S{ws, G, bx}; EpiMO E{(const float*)(ws + WS_PS), (bf16_t*)(ws + WS_OMEM)};
            pg8::gemm_stream<EpiMO, SchedMO>(lds, S, E, wave); __syncthreads(); }
        const int xq = (int)(bar.x & 7u);
        unsigned long long tf0_ = 0; if (PROBE_K >= 40 && tid == 0) tf0_ = __builtin_amdgcn_s_memrealtime();
#define LOOP_T0() unsigned long long tl_ = 0; if (PROBE_K >= 23 && PROBE_K < 40 && bx == 0 && tid == 0) tl_ = __builtin_amdgcn_s_memrealtime()
#define LOOP_T1(pk) do { if (PROBE_K == (pk) && bx == 0 && tid == 0) MISC[21] = (unsigned)(__builtin_amdgcn_s_memrealtime() - tl_); \
        if (PROBE_K >= 40 && tid == 0) ctl[8192 + ((pk) - 23) * 256 + bx] = (unsigned)(__builtin_amdgcn_s_memrealtime() - tf0_); } while (0)
        { LOOP_T0();
        if (PH(6)) for (;;) { const int it = DEQUEUE(CW_QUEUE + 64 * (1 + xq)); if (it >= 16) break; PROBE_BEGIN();
            sat::unit(P, 2 * xq + (it & 1), it >> 1, (LAS char*)lds, wave); PROBE_END(20); }
        LOOP_T1(23); }
        if (PH(6)) for (int qq = 1; qq < 8; ++qq) { const int q = (xq + qq) & 7;
            for (;;) { const int it = DEQUEUE(CW_QUEUE + 64 * (1 + q)); if (it >= 16) break; sat::unit(P, 2 * q + (it & 1), it >> 1, (LAS char*)lds, wave); } }
        { LOOP_T0();
        if (PH(5)) for (;;) { const int it = DEQUEUE(CW_QUEUE + 64 * 9); if (it >= NI_P) break; PROBE_BEGIN();
            const int qb = 15 - (it >> 5), bh = it & 31, b = bh >> 4, h = bh & 15;
            pat::unit(Qg + ((size_t)(b * 4096 + qb * 256) * QLD + h * 192), Kg + ((size_t)b * 4096 * QLD + h * 192), Vg + ((size_t)b * 4096 * 2048 + h * 128),
                      Og + ((size_t)(b * 4096 + qb * 256) * 2048 + h * 128), qb, (LAS char*)lds, P.in[I_GQHEAD], wave); PROBE_END(21);
            if (pr_ && PROBE_K == 26) MISC[21] += (unsigned)(__builtin_amdgcn_s_memrealtime() - ts_);
            if (pr_ && PROBE_K == 27) MISC[21] += 25u * (unsigned)(4 * qb + 4); }
        LOOP_T1(24); }
    }
    xcd_barrier(bar); STAMP(5);
    if (PROBE_K >= 40 && bx == 0 && tid == 0) {
        const int lp = (PROBE_K - 40) >> 1; unsigned long long sum = 0; unsigned mx = 0;
        for (int i = 0; i < G; ++i) { const unsigned v = __hip_atomic_load(ctl + 8192 + lp * 256 + i, __ATOMIC_RELAXED, __HIP_MEMORY_SCOPE_AGENT); sum += v; mx = v > mx ? v : mx; }
        MISC[21] = (PROBE_K & 1) ? mx : (unsigned)(sum / G); }
    if (PH(8)) {
        MergeSched S{(const bf16_t*)(ws + WS_DP), (const bf16_t*)(ws + WS_WPOOL), (const bf16_t*)(ws + WS_OMLA), (const bf16_t*)(ws + WS_WMLAO),
                     (const bf16_t*)(ws + WS_OMEM), (const bf16_t*)(ws + WS_WMEMO), G, bx};
        EpiMerge E{(const bf16_t*)(ws + WS_G), P.in[I_PSCALE], (bf16_t*)(ws + WS_MG), (float*)(ws + WS_Q)};
        pg8::gemm_stream<EpiMerge, MergeSched>(lds, S, E, wave);
        xcd_barrier(bar); STAMP(6);
        { LAUNDER(); reduce_merge((const float*)(ws + WS_Q), (bf16_t*)(ws + WS_MG), gw_l, NGW, lane_l); }
    }
    xcd_barrier(bar); STAMP(7);
    if (PH(9)) {
        TailSched S{(const bf16_t*)(ws + WS_MG), (const bf16_t*)(ws + WS_WOUT), 2048, G, bx};
        EpiOut E{P.in[I_XP], P.in[I_XS], P.out + O_YP, (bf16_t*)(ws + WS_X1B), (float*)(ws + WS_SSX), (float*)(ws + WS_G)};
        pg8::gemm_stream<EpiOut, TailSched>(lds, S, E, wave);
        xcd_barrier(bar); STAMP(8);
        { LAUNDER(); reduce_out((const float*)(ws + WS_G), P.in[I_XS], P.out + O_YP, (bf16_t*)(ws + WS_X1B), (float*)(ws + WS_SSX), gw_l, NGW, lane_l); }
    }
    xcd_barrier(bar); STAMP(9);
    if (PH(10)) {
        pg8::JobSched1 S; S.j0 = pg8::Job{(const bf16_t*)(ws + WS_X1B), (const bf16_t*)(ws + WS_WUP), 2048, 2048, 34, 32, 0}; S.finish(G, bx);
        EpiUp E{(const float*)(ws + WS_SSX), (bf16_t*)(ws + WS_A)};
        pg8::gemm_stream<EpiUp, pg8::JobSched1>(lds, S, E, wave);
    }
    xcd_barrier(bar); STAMP(10);
    if (PH(11)) {
        TailSched S{(const bf16_t*)(ws + WS_A), (const bf16_t*)(ws + WS_WDOWN), 8192, G, bx};
        EpiDown E{P.out + O_YP, (const bf16_t*)(ws + WS_X1B), (float*)(ws + WS_H)};
        pg8::gemm_stream<EpiDown, TailSched>(lds, S, E, wave);
        xcd_barrier(bar); STAMP(11);
        { LAUNDER(); reduce_down((const float*)(ws + WS_H), (const bf16_t*)(ws + WS_X1B), P.out + O_YP, gw_l, NGW, lane_l); }
    }
    if (PROBE_K == 30 && bx == 0) {
        __syncthreads(); unsigned long long ti_ = 0; if (tid == 0) ti_ = __builtin_amdgcn_s_memrealtime();
        pat::unit((const bf16_t*)(ws + WS_Q) + ((size_t)(15 * 256) * QLD), (const bf16_t*)((unsigned char*)P.out + DO_K), (const bf16_t*)(ws + WS_V), (bf16_t*)(ws + WS_OMLA) + ((size_t)(15 * 256) * 2048), 15, (LAS char*)lds, P.in[I_GQHEAD], wave);
        if (tid == 0) MISC[21] = (unsigned)(__builtin_amdgcn_s_memrealtime() - ti_);
    }
    if (PROBE_K == 32 || PROBE_K == 33) {
        __syncthreads(); unsigned long long ti_ = 0; if (tid == 0) ti_ = __builtin_amdgcn_s_memrealtime();
        const int bh_ = PROBE_K == 32 ? (bx & 31) : ((bx >> 3) & 31), b_ = bh_ >> 4, h_ = bh_ & 15;
        pat::unit((const bf16_t*)(ws + WS_Q) + ((size_t)(b_ * 4096 + 15 * 256) * QLD + h_ * 192), (const bf16_t*)((unsigned char*)P.out + DO_K) + ((size_t)b_ * 4096 * QLD + h_ * 192),
                  (const bf16_t*)(ws + WS_V) + ((size_t)b_ * 4096 * 2048 + h_ * 128), (bf16_t*)(ws + WS_OMLA) + ((size_t)(b_ * 4096 + 15 * 256) * 2048 + h_ * 128), 15, (LAS char*)lds, P.in[I_GQHEAD], wave);
        if (tid == 0 && bx == 0) MISC[21] = (unsigned)(__builtin_amdgcn_s_memrealtime() - ti_);
    }
    if ((PROBE_K == 34 || PROBE_K == 35) && bx == 0) {
        __syncthreads(); unsigned long long ti_ = 0; if (tid == 0) ti_ = __builtin_amdgcn_s_memrealtime();
        sat::unit<PROBE_K == 34 ? 1 : 2>(P, 0, 0, (LAS char*)lds, wave);
        if (tid == 0) MISC[21] = (unsigned)(__builtin_amdgcn_s_memrealtime() - ti_);
    }
    if (PROBE_K == 31 && bx == 0) {
        __syncthreads(); unsigned long long ti_ = 0; if (tid == 0) ti_ = __builtin_amdgcn_s_memrealtime();
        sat::unit(P, 0, 0, (LAS char*)lds, wave);
        if (tid == 0) MISC[21] = (unsigned)(__builtin_amdgcn_s_memrealtime() - ti_);
    }
    if (PROBE_K >= 0 && bx == 0) {
        __syncthreads();
        if (tid == 0) { STAMP(12);
            constexpr int PKI = PROBE_K >= 0 && PROBE_K < 13 ? PROBE_K : 0;
            const unsigned long long a_ = ((unsigned long long)MISC[33 + 2 * PKI] << 32) | MISC[32 + 2 * PKI], b_ = ((unsigned long long)MISC[35 + 2 * PKI] << 32) | MISC[34 + 2 * PKI];
            const unsigned long long t0_ = __builtin_amdgcn_s_memrealtime(), dl_ = PROBE_K >= 20 ? 4ull * MISC[21] : 4ull * (b_ - a_);
            while (__builtin_amdgcn_s_memrealtime() - t0_ < dl_) __builtin_amdgcn_s_sleep(16); }
    }
}

extern "C" void kernel_launch(void* const* d_in, const int* in_sizes, int n_in, void* d_out, int out_size, void* d_ws, size_t ws_size, hipStream_t stream) {
    static int grid = 0;
    if (grid == 0) {
        if (n_in != 30 || ws_size < WS_END || out_size != 24164352) { fprintf(stderr, "kernel_launch: unexpected problem: n_in %d out %d ws %zu (need %zu)\n", n_in, out_size, ws_size, (size_t)WS_END); grid = -1; return; }
        int dev = 0, cus = 0, per_cu = 0;
        if (hipGetDevice(&dev) != hipSuccess || hipDeviceGetAttribute(&cus, hipDeviceAttributeMultiprocessorCount, dev) != hipSuccess) { grid = -1; return; }
        if (hipFuncSetAttribute((const void*)mega_fwd, hipFuncAttributeMaxDynamicSharedMemorySize, LDS_BYTES) != hipSuccess) { fprintf(stderr, "kernel_launch: hipFuncSetAttribute(%d) failed\n", LDS_BYTES); grid = -1; return; }
        if (hipOccupancyMaxActiveBlocksPerMultiprocessor(&per_cu, (const void*)mega_fwd, NWAVES * 64, LDS_BYTES) != hipSuccess || per_cu < 1) { fprintf(stderr, "kernel_launch: occupancy query says %d blocks per CU\n", per_cu); grid = -1; (void)hipGetLastError(); return; }
        grid = cus;
    }
    if (grid < 0) return;
    (void)hipMemsetAsync((char*)d_ws + WS_CTL, 0, CTL_ZERO_BYTES, stream);
    Args a{};
    for (int i = 0; i < 30; ++i) a.in[i] = (const float*)d_in[i];
    a.out = (float*)d_out; a.ws = (unsigned char*)d_ws;
    hipLaunchKernelGGL(mega_fwd, dim3(grid), dim3(NWAVES * 64), LDS_BYTES, stream, a);
}
```

```cpp
#include <hip/hip_runtime.h>
#include <cstdio>
#include <cstdint>

#define LAS __attribute__((address_space(3)))
#define GAS __attribute__((address_space(1)))
typedef unsigned short bf16_t;
typedef short bf16x8 __attribute__((ext_vector_type(8)));
typedef short s16x4 __attribute__((ext_vector_type(4)));
typedef float f32x2 __attribute__((ext_vector_type(2)));
typedef float f32x4 __attribute__((ext_vector_type(4)));
typedef float f32x16 __attribute__((ext_vector_type(16)));
typedef unsigned u32x2 __attribute__((ext_vector_type(2)));
typedef unsigned u32x4 __attribute__((ext_vector_type(4)));
typedef __bf16 bf16x2_t __attribute__((ext_vector_type(2)));

constexpr int DM = 2048, TP = 8192, TS = 512, TT = TP + TS, SEQ = 4096, LS = 32, NBS = 16;
constexpr int KPAD = 4160;
constexpr int ZS_LD = 3136, G_LD = 6144, QLD = 3072, NHEAD = 16;
constexpr float EPS = 1e-6f;
constexpr float MLA_C = 0.07216878364870322f * 1.4426950408889634f;
constexpr float MEM_C = 0.0625f * 1.4426950408889634f;
constexpr size_t O_YP = 0, O_YS = 16777216, O_LATP = 17825792, O_KPEP = 22020096, O_POOLP = 22544384, O_MEMK = 22575104, O_MEMV = 23099392,
                 O_LATS = 23623680, O_KPES = 23885824, O_POOLS = 23918592;
constexpr size_t MiB = 1u << 20;
constexpr size_t WS_CTL = 0, CTL_ZERO_BYTES = 1 * MiB;
constexpr size_t WS_WIN = 1 * MiB, WS_WMEMKV = 38 * MiB, WS_WQB = 46 * MiB, WS_WKB = 49 * MiB, WS_WVB = 51 * MiB, WS_WKBN = 53 * MiB, WS_WPOOL = 55 * MiB,
                 WS_WMLAO = 56 * MiB, WS_WMEMO = 64 * MiB, WS_WOUT = 68 * MiB, WS_WUP = 76 * MiB, WS_WDOWN = 108 * MiB;
constexpr size_t WS_G = 140 * MiB, WS_ZS = 242 * MiB, WS_Q = 242 * MiB, WS_A = 140 * MiB;
constexpr size_t WS_LATS = 295 * MiB, WS_KRS = 360 * MiB, WS_KPESS = 368 * MiB + 512 * 1024, WS_MG = 295 * MiB, WS_X1B = 329 * MiB;
constexpr size_t WS_H = 369 * MiB, WS_DP = 369 * MiB, WS_QN = 386 * MiB, WS_OMEM = 386 * MiB, WS_OMLA = 1 * MiB;
constexpr size_t WS_RKG = 403 * MiB;
constexpr size_t WS_HM = 403 * MiB, WS_M = 405 * MiB, WS_QM = 409 * MiB, WS_V = 426 * MiB, WS_KSS = 458 * MiB, WS_MK = 475 * MiB, WS_MVT = 484 * MiB,
                 WS_KRP = 493 * MiB, WS_KPESSP = 494 * MiB, WS_SSX = 494 * MiB + 256 * 1024,
                 WS_PM = 496 * MiB  , WS_PS = 514 * MiB  ;
constexpr size_t WS_L8A = 458 * MiB, WS_L8D = 515 * MiB, WS_SA = 518 * MiB + 512 * 1024  , WS_WKB8 = 519 * MiB  ,
                 WS_SB = 520 * MiB  , WS_END = 520 * MiB + 64 * 1024;
constexpr size_t WS_H8 = 426 * MiB, WS_W8G = 443 * MiB, WS_W8X = 455 * MiB, WS_SAH = 514 * MiB + 768 * 1024, WS_SBG = WS_SAH + 64 * 1024, WS_SBX = WS_SAH + 128 * 1024;
constexpr size_t WS_X8 = 426 * MiB, WS_WUP8 = 442 * MiB, WS_SAX = 458 * MiB, WS_SBU = 458 * MiB + 64 * 1024;
constexpr size_t WS_QN8 = 1 * MiB, WS_CKV8 = 6 * MiB, WS_WQB8 = 10 * MiB, WS_WVB8 = 12 * MiB, WS_SAQ = 13 * MiB, WS_SAC = WS_SAQ + 64 * 1024, WS_SBQ = WS_SAQ + 128 * 1024, WS_SBV = WS_SAQ + 192 * 1024;
constexpr size_t DO_K = 0, DO_CKVP = 56 * MiB, DO_L8B = 48 * MiB, DO_L8C = 64 * MiB  ;

constexpr int LDS_BYTES = 160 * 1024, MISC_OFF = LDS_BYTES - 256;
constexpr int NWAVES = 8;

#define LDS_WAIT() asm volatile("s_waitcnt lgkmcnt(0)" ::: "memory")
#define VM_WAIT() asm volatile("s_waitcnt vmcnt(0)" ::: "memory")
#define SBAR() __builtin_amdgcn_sched_barrier(0)
__device__ __forceinline__ unsigned cvtpk(float lo, float hi) { f32x2 v = {lo, hi}; bf16x2_t b = __builtin_convertvector(v, bf16x2_t); return __builtin_bit_cast(unsigned, b); }
__device__ __forceinline__ float bflo(unsigned u) { return __uint_as_float(u << 16); }
__device__ __forceinline__ float bfhi(unsigned u) { return __uint_as_float(u & 0xffff0000u); }
__device__ __forceinline__ float bf2f(bf16_t b) { return __uint_as_float((unsigned)b << 16); }
__device__ __forceinline__ bf16_t f2bf(float f) { return (bf16_t)(cvtpk(f, 0.f) & 0xffffu); }
__device__ __forceinline__ float wave_sum(float v) {
#pragma unroll
    for (int o = 1; o < 64; o <<= 1) v += __shfl_xor(v, o);
    return v;
}
__device__ __forceinline__ int lane_id() { int r; asm volatile("v_mbcnt_lo_u32_b32 %0, -1, 0\n\tv_mbcnt_hi_u32_b32 %0, -1, %0" : "=v"(r)); return r; }
__device__ __forceinline__ float rows4_sum(float s) {
    { auto r = __builtin_amdgcn_permlane16_swap(__float_as_uint(s), __float_as_uint(s), false, false); s = __uint_as_float(r[0]) + __uint_as_float(r[1]); }
    { auto r = __builtin_amdgcn_permlane32_swap(__float_as_uint(s), __float_as_uint(s), false, false); s = __uint_as_float(r[0]) + __uint_as_float(r[1]); }
    return s;
}
__device__ __forceinline__ int crow(int r, int hi) { return (r & 3) + 8 * (r >> 2) + 4 * hi; }
__device__ __forceinline__ void fast_sincos(float ang, float& sn, float& cs) {
    float t = ang * 0.15915494309189535f; t = t - floorf(t);
    sn = __builtin_amdgcn_sinf(t); cs = __builtin_amdgcn_cosf(t);
}
__device__ __forceinline__ float rope_inv(int j) { return __builtin_amdgcn_exp2f(-(float)j * (13.287712379549449f / 32.0f)); }

typedef short v4i16_t __attribute__((ext_vector_type(4)));
__device__ __forceinline__ s16x4 vtr(const LAS char* p) { return __builtin_bit_cast(s16x4, __builtin_amdgcn_ds_read_tr16_b64_v4i16((LAS v4i16_t*)p)); }
#define PKV(L, H) (bf16x8){L[0], L[1], L[2], L[3], H[0], H[1], H[2], H[3]}
__device__ __forceinline__ unsigned char* l8_tile(unsigned char* ws, unsigned char* outb, int t) {
    if (t < 136) return ws + (458u << 20) + (size_t)t * 131072;
    if (t < 200) return outb + (48u << 20) + (size_t)(t - 136) * 131072;
    if (t < 232) return outb + (64u << 20) + (size_t)(t - 200) * 131072;
    return ws + (515u << 20) + (size_t)(t - 232) * 131072;
}
__device__ __forceinline__ float wave_max_nn(float mx) {
#define DPP_MAX_(ctrl) mx = fmaxf(mx, __uint_as_float((unsigned)__builtin_amdgcn_update_dpp(0, (int)__float_as_uint(mx), ctrl, 0xF, 0xF, true)))
    DPP_MAX_(0xB1); DPP_MAX_(0x4E); DPP_MAX_(0x141); DPP_MAX_(0x140);
#undef DPP_MAX_
    { const unsigned u = __float_as_uint(mx); auto r = __builtin_amdgcn_permlane16_swap(u, u, false, false); mx = fmaxf(__uint_as_float(r[0]), __uint_as_float(r[1])); }
    { const unsigned u = __float_as_uint(mx); auto r = __builtin_amdgcn_permlane32_swap(u, u, false, false); mx = fmaxf(__uint_as_float(r[0]), __uint_as_float(r[1])); }
    return mx;
}
__device__ __forceinline__ float wave_sum_v(float v) {
#define DPP_ADD_(ctrl) v += __uint_as_float((unsigned)__builtin_amdgcn_update_dpp(0, (int)__float_as_uint(v), ctrl, 0xF, 0xF, true))
    DPP_ADD_(0xB1); DPP_ADD_(0x4E); DPP_ADD_(0x141); DPP_ADD_(0x140);
#undef DPP_ADD_
    { const unsigned u = __float_as_uint(v); auto r = __builtin_amdgcn_permlane16_swap(u, u, false, false); v = __uint_as_float(r[0]) + __uint_as_float(r[1]); }
    { const unsigned u = __float_as_uint(v); auto r = __builtin_amdgcn_permlane32_swap(u, u, false, false); v = __uint_as_float(r[0]) + __uint_as_float(r[1]); }
    return v;
}
__device__ __forceinline__ unsigned q8x4(float a, float b, float c, float d, float inv) {
    auto q = [&](float x) { int v = (int)rintf(x * inv); v = v > 127 ? 127 : (v < -127 ? -127 : v); return (unsigned)v & 0xffu; };
    return q(a) | (q(b) << 8) | (q(c) << 16) | (q(d) << 24);
}
__device__ __forceinline__ u32x2 quant_row8(const float (&v)[8], float& sc) {
    float mx = 0.f;
#pragma unroll
    for (int j = 0; j < 8; ++j) mx = fmaxf(mx, fabsf(v[j]));
    mx = wave_max_nn(mx);
    sc = mx * (1.f / 127.f); const float inv = mx > 0.f ? 127.f / mx : 0.f;
    unsigned w[2] = {0u, 0u};
#pragma unroll
    for (int j = 0; j < 8; ++j) { int q = (int)rintf(v[j] * inv); q = q > 127 ? 127 : (q < -127 ? -127 : q); w[j >> 2] |= ((unsigned)q & 0xffu) << (8 * (j & 3)); }
    return (u32x2){w[0], w[1]};
}

#define XB_TMO      128
#define XB_XCNT(j)  (256  + 64 * (j))
#define XB_XSUB(j)  (1280 + 64 * (j))
#define XB_XGEN(j)  (2304 + 64 * (j))
#define XB_TOP      3328
#define XB_TOPGEN   3392
#define XCD_BAR_WORDS 3456
#define XB_SPIN_CAP (1u << 20)
__device__ __forceinline__ unsigned xb_ld(unsigned* p)              { return __hip_atomic_load(p, __ATOMIC_RELAXED, __HIP_MEMORY_SCOPE_AGENT); }
__device__ __forceinline__ unsigned xb_add(unsigned* p, unsigned v) { return __hip_atomic_fetch_add(p, v, __ATOMIC_RELAXED, __HIP_MEMORY_SCOPE_AGENT); }
__device__ __forceinline__ unsigned xb_xcc_id() { return (unsigned)__builtin_amdgcn_s_getreg((3 << 11) | 20) & 0xFu; }
#define XB_SPIN(cond, bar) do { unsigned _sp = 0; while (cond) { __builtin_amdgcn_s_sleep(1); \
    if ((++_sp & 255u) == 0u) { if (xb_ld(&(bar)[XB_TMO])) break; if (_sp > XB_SPIN_CAP) { atomicAdd(&(bar)[XB_TMO], 1u); break; } } } } while (0)
struct XcdBarrier { unsigned* bar; unsigned x; volatile LAS unsigned* st; int wv; };
__device__ __forceinline__ XcdBarrier xcd_barrier_post(unsigned* bar, volatile LAS unsigned* st) {
    XcdBarrier b; b.bar = bar; b.x = xb_xcc_id(); b.st = st; b.wv = 0;
    if (threadIdx.x == 0) (void)xb_add(&bar[XB_XCNT(b.x)], 1u);
    return b;
}
__device__ __forceinline__ void xcd_barrier_complete(unsigned* bar, unsigned x, unsigned& nloc, unsigned& nx) {
    const unsigned G = gridDim.x * gridDim.y * gridDim.z;
    unsigned sum, cnt, mine, sp = 0u;
    for (;;) {
        sum = 0u; cnt = 0u; mine = 0u;
#pragma unroll
        for (unsigned j = 0; j < 16; ++j) { const unsigned c = xb_ld(&bar[XB_XCNT(j)]); sum += c; cnt += (c > 0u) ? 1u : 0u; mine = (j == x) ? c : mine; }
        if (sum == G) break;
        __builtin_amdgcn_s_sleep(1);
        if ((++sp & 255u) == 0u) { if (xb_ld(&bar[XB_TMO])) break; if (sp > XB_SPIN_CAP) { atomicAdd(&bar[XB_TMO], 1u); break; } }
    }
    nloc = mine > 0u ? mine : 1u; nx = cnt > 0u ? cnt : 1u;
}
__device__ __forceinline__ void xcd_barrier(const XcdBarrier& b) {
    asm volatile("s_waitcnt vmcnt(0)" ::: "memory");
    __syncthreads();
    if (threadIdx.x == 0) {
        unsigned* bar = b.bar;
        __builtin_amdgcn_s_waitcnt(0);
        unsigned nloc = b.st[0], nx = b.st[1];
        if (nloc == 0u) { xcd_barrier_complete(bar, b.x, nloc, nx); b.st[0] = nloc; b.st[1] = nx; }
        const unsigned old = xb_add(&bar[XB_XSUB(b.x)], 1u);
        const unsigned gen = old / nloc;
        if (old + 1u == (gen + 1u) * nloc) {
            __builtin_amdgcn_fence(__ATOMIC_RELEASE, "agent");
            asm volatile("s_waitcnt vmcnt(0)" ::: "memory");
            const unsigned og = xb_add(&bar[XB_TOP], 1u);
            const unsigned tg = og / nx;
            if (og + 1u == (tg + 1u) * nx) xb_add(&bar[XB_TOPGEN], 1u);
            else XB_SPIN(xb_ld(&bar[XB_TOPGEN]) == tg, bar);
            __builtin_amdgcn_fence(__ATOMIC_ACQUIRE, "agent");
            xb_add(&bar[XB_XGEN(b.x)], 1u);
            asm volatile("s_waitcnt vmcnt(0)" ::: "memory");
        } else {
            XB_SPIN(xb_ld(&bar[XB_XGEN(b.x)]) == gen, bar);
            __builtin_amdgcn_fence(__ATOMIC_ACQUIRE, "agent");
            asm volatile("s_waitcnt vmcnt(0)" ::: "memory");
        }
    }
    __syncthreads();
}

namespace pg8 {
constexpr int BM = 256, BK = 64, HALF = 128, HTB = HALF * BK * 2, STAGE_BYTES = 8 * HTB, NXCD = 8, WGM = 8;
__device__ __forceinline__ int lds_byte(int r, int c) { const int st = (r >> 4) * 2 + (c >> 5), rr = r & 15, cc = c & 31, ob = rr * 64 + cc * 2; return st * 1024 + (ob ^ (((ob >> 9) & 1) << 5)); }
__device__ __forceinline__ void stage_rc(int b, int& R, int& C) { const int st = b / 1024, sb = b % 1024, swz = sb ^ (((sb >> 9) & 1) << 5); R = (st >> 1) * 16 + swz / 64; C = (st & 1) * 32 + (swz % 64) / 2; }
__device__ __forceinline__ int perm32(int rho) { const int n = rho >> 4, i = rho & 15; return 8 * (i >> 2) + 4 * n + (i & 3); }

struct Unit { const char* A; const char* B; unsigned lda2, ldb2; int nt, pm, pn, kind, aux; };

__device__ __forceinline__ void tile_of(int wgid, int nM, int nN, int& pm, int& pn) {
    const int nwg = nM * nN;
    { const int q = nwg / NXCD, r = nwg % NXCD, xcd = wgid % NXCD, off = wgid / NXCD; wgid = (xcd < r ? xcd * (q + 1) : r * (q + 1) + (xcd - r) * q) + off; }
    const int nig = WGM * nN, gid = wgid / nig, fm = gid * WGM, gsz = (nM - fm) < WGM ? (nM - fm) : WGM;
    pm = fm + ((wgid % nig) % gsz); pn = (wgid % nig) / gsz;
}

struct Job { const bf16_t* A; const bf16_t* B; int lda, K, nM, nN, kind; };
struct JobSched1 {
    Job j0; int G, c;
    __device__ __forceinline__ void finish(int G_, int c_) { G = G_; c = c_; }
    __device__ __forceinline__ bool next(int i, Unit& u) const {
        const long L = (long)i * G + c; if (L >= j0.nM * j0.nN) return false;
        int pm, pn; tile_of((int)L, j0.nM, j0.nN, pm, pn);
        u.A = (const char*)(j0.A + (size_t)pm * BM * j0.lda); u.B = (const char*)(j0.B + (size_t)pn * BM * j0.K);
        u.lda2 = (unsigned)j0.lda * 2u; u.ldb2 = (unsigned)j0.K * 2u; u.nt = j0.K / BK; u.pm = pm; u.pn = pn; u.kind = j0.kind; return true;
    }
};

#define PG8_SA(b, h) (((b) * 2 + (h)) * HTB)
#define PG8_SB(b, h) ((4 + (b) * 2 + (h)) * HTB)
#define PG8_STAGE(bufoff, gbase, Rv, ld2) do { const unsigned _vo = (unsigned)(Rv) * (ld2) + c2; \
        __builtin_amdgcn_global_load_lds((const unsigned*)((gbase) + _vo), (LAS unsigned*)(lds + (bufoff) + ldsw), 16, 0, 0); \
        __builtin_amdgcn_global_load_lds((const unsigned*)((gbase) + 64u * (ld2) + _vo), (LAS unsigned*)(lds + (bufoff) + ldsw + 8192), 16, 0, 0); } while (0)
#define PG8_LDA(dst, b, h) do { _Pragma("unroll") for (int m = 0; m < 4; ++m) _Pragma("unroll") for (int k = 0; k < 2; ++k) dst[m][k] = *(const LAS bf16x8*)(lds + PG8_SA(b, h) + aoff + m * 2048 + k * 1024); } while (0)
#define PG8_LDB(dst, b, h) do { _Pragma("unroll") for (int n = 0; n < 2; ++n) _Pragma("unroll") for (int k = 0; k < 2; ++k) dst[n][k] = *(const LAS bf16x8*)(lds + PG8_SB(b, h) + boff + n * 2048 + k * 1024); } while (0)
typedef int i32x4 __attribute__((ext_vector_type(4)));
#define PG8_MMA(ai, bj, At, Bt) do { __builtin_amdgcn_s_setprio(1); _Pragma("unroll") for (int m = 0; m < 4; ++m) _Pragma("unroll") for (int n = 0; n < 2; ++n) _Pragma("unroll") for (int k = 0; k < 2; ++k) { \
        if (I8) acc[ai][bj][m][n] = __builtin_bit_cast(f32x4, __builtin_amdgcn_mfma_i32_16x16x64_i8(__builtin_bit_cast(i32x4, Bt[n][k]), __builtin_bit_cast(i32x4, At[m][k]), __builtin_bit_cast(i32x4, acc[ai][bj][m][n]), 0, 0, 0)); \
        else acc[ai][bj][m][n] = __builtin_amdgcn_mfma_f32_16x16x32_bf16(Bt[n][k], At[m][k], acc[ai][bj][m][n], 0, 0, 0); } __builtin_amdgcn_s_setprio(0); } while (0)
#define PG8_WAIT_V(n) asm volatile("s_waitcnt vmcnt(" #n ")" ::: "memory")
#define PG8_WAIT_L(n) asm volatile("s_waitcnt lgkmcnt(" #n ")" ::: "memory")
#define PG8_BAR __builtin_amdgcn_s_barrier()
#define PG8_SCHED __builtin_amdgcn_sched_barrier(0)

template <class Epi, class Sched, bool I8 = false>
__device__ __forceinline__ void gemm_stream(LAS unsigned char* lds, const Sched& S, const Epi& E, int wv) {
    int wvl = wv; asm volatile("" : "+s"(wvl)); int tid = wvl * 64 + lane_id(); asm volatile("" : "+v"(tid));
    const int wid = __builtin_amdgcn_readfirstlane(tid >> 6), lane = tid & 63, wr = wid >> 2, wc = wid & 3, fr = lane & 15, fq = lane >> 4;
    int R0, C0; stage_rc(tid * 16, R0, C0);
    const int Rb0 = Epi::PERM ? ((R0 & ~31) + perm32(R0 & 31)) : R0;
    const unsigned c2 = (unsigned)C0 * 2u;
    const unsigned ldsw = (unsigned)wid * 1024u;
    const int aoff = lds_byte(wr * 64 + fr, fq * 8), boff = lds_byte(wc * 32 + fr, fq * 8);
    Unit cur, nxt; int ui = 0;
    if (!S.next(0, cur)) return;
    f32x4 acc[2][2][4][2];
#pragma unroll
    for (int a = 0; a < 2; ++a)
#pragma unroll
        for (int b = 0; b < 2; ++b)
#pragma unroll
            for (int m = 0; m < 4; ++m)
#pragma unroll
                for (int n = 0; n < 2; ++n) acc[a][b][m][n] = (f32x4){0.f, 0.f, 0.f, 0.f};
    bf16x8 At[4][2], B0[2][2], B1[2][2];
    const char* cA = cur.A; const char* cB = cur.B; unsigned la = cur.lda2, lb = cur.ldb2;
    const size_t kstep = (size_t)(BK * 2);
    PG8_STAGE(PG8_SB(0, 0), cB, Rb0, lb); PG8_STAGE(PG8_SB(0, 1), cB + (size_t)HALF * lb, Rb0, lb); PG8_STAGE(PG8_SA(0, 0), cA, R0, la); PG8_STAGE(PG8_SA(0, 1), cA + (size_t)HALF * la, R0, la);
    if (wr == 1) PG8_BAR;
    PG8_WAIT_V(2); PG8_BAR;
    PG8_STAGE(PG8_SB(1, 0), cB + kstep, Rb0, lb); PG8_STAGE(PG8_SA(1, 0), cA + kstep, R0, la); PG8_STAGE(PG8_SB(1, 1), cB + (size_t)HALF * lb + kstep, Rb0, lb);
    PG8_WAIT_V(6); PG8_BAR;
    for (;;) {
        const bool has_next = S.next(ui + 1, nxt);
        const char* nA = has_next ? nxt.A : cA; const char* nB = has_next ? nxt.B : cB;
        const unsigned nla = has_next ? nxt.lda2 : la, nlb = has_next ? nxt.ldb2 : lb;
        const int nt = cur.nt;
        for (int t = 0; t < nt; t += 2) {
            const bool last = (t == nt - 2);
            const char* a1 = cA + (size_t)(t + 1) * kstep;
            const char* a2 = last ? nA : cA + (size_t)(t + 2) * kstep; const char* b2 = last ? nB : cB + (size_t)(t + 2) * kstep;
            const unsigned la2 = last ? nla : la, lb2 = last ? nlb : lb;
            const char* a3 = a2 + kstep; const char* b3 = b2 + kstep;
            PG8_LDB(B0, 0, 0); PG8_LDB(B1, 0, 1); PG8_SCHED; PG8_LDA(At, 0, 0); PG8_STAGE(PG8_SA(1, 1), a1 + (size_t)HALF * la, R0, la);
            PG8_WAIT_V(8); PG8_WAIT_L(0); PG8_BAR; PG8_MMA(0, 0, At, B0); PG8_MMA(0, 1, At, B1); PG8_BAR; PG8_SCHED;
            PG8_LDA(At, 0, 1); PG8_STAGE(PG8_SB(0, 0), b2, Rb0, lb2); PG8_STAGE(PG8_SB(0, 1), b2 + (size_t)HALF * lb2, Rb0, lb2); PG8_STAGE(PG8_SA(0, 0), a2, R0, la2);
            PG8_WAIT_V(8); PG8_WAIT_L(0); PG8_BAR; PG8_MMA(1, 0, At, B0); PG8_MMA(1, 1, At, B1); PG8_BAR; PG8_SCHED;
            PG8_LDB(B0, 1, 0); PG8_LDB(B1, 1, 1); PG8_SCHED; PG8_LDA(At, 1, 0); PG8_STAGE(PG8_SA(0, 1), a2 + (size_t)HALF * la2, R0, la2);
            PG8_WAIT_V(8); PG8_WAIT_L(0); PG8_BAR; PG8_MMA(0, 0, At, B0); PG8_MMA(0, 1, At, B1); PG8_BAR; PG8_SCHED;
            PG8_LDA(At, 1, 1); PG8_STAGE(PG8_SB(1, 0), b3, Rb0, lb2); PG8_STAGE(PG8_SB(1, 1), b3 + (size_t)HALF * lb2, Rb0, lb2); PG8_STAGE(PG8_SA(1, 0), a3, R0, la2);
            PG8_WAIT_V(8); PG8_WAIT_L(0); PG8_BAR; PG8_MMA(1, 0, At, B0); PG8_MMA(1, 1, At, B1); PG8_BAR; PG8_SCHED;
        }
        if (wr == 0) PG8_BAR;
        const bool keep = E(acc, cur, wr, wc, fr, fq);
        if (!has_next) break;
        if (!keep) {
#pragma unroll
            for (int a = 0; a < 2; ++a)
#pragma unroll
                for (int b = 0; b < 2; ++b)
#pragma unroll
                    for (int m = 0; m < 4; ++m)
#pragma unroll
                        for (int n = 0; n < 2; ++n) acc[a][b][m][n] = (f32x4){0.f, 0.f, 0.f, 0.f};
        }
        cur = nxt; cA = nA; cB = nB; la = nla; lb = nlb; ++ui;
        if (wr == 1) PG8_BAR;
    }
    PG8_WAIT_V(0);
    PG8_BAR;
}
}

struct Args { const float* in[30]; float* out; unsigned char* ws; };
enum { I_XP = 0, I_MEMP, I_XS, I_CLAT, I_CKPE, I_SPOOL, I_CMK, I_CMV, I_GMIX, I_WIN, I_BGATE, I_WPOOL, I_PSCALE, I_GQLAT, I_WQB, I_GQHEAD, I_GKVLAT, I_WKB, I_WVB,
       I_GKHEAD, I_WMLAO, I_GMEM, I_WMEMKV, I_GMEMQ, I_GMEMK, I_WMEMO, I_WOUT, I_GFF, I_WUP, I_WDOWN };

__device__ __forceinline__ void transpose_item(const float* __restrict__ W, int ldw, int K, bf16_t* __restrict__ WT, LAS unsigned char* scr, int kb, int n0src, int nrow_dst, int lane, const float* __restrict__ kscale) {
    const int k0 = 64 * kb, kq = lane >> 4, cq = lane & 15;
    f32x4 v[16];
#pragma unroll
    for (int i = 0; i < 16; ++i) v[i] = __builtin_nontemporal_load((const f32x4*)(W + (size_t)(k0 + 4 * i + kq) * ldw + n0src + cq * 4));
#pragma unroll
    for (int i = 0; i < 16; ++i) { const int kk = 4 * i + kq; f32x4 x = v[i]; if (kscale) x = x * kscale[k0 + kk];
        const int fk = (kk & 2) | ((kk & 8) >> 1);
        *(LAS u32x2*)(scr + kk * 128 + (((cq >> 1) ^ fk) << 4) + (cq & 1) * 8) = (u32x2){cvtpk(x.x, x.y), cvtpk(x.z, x.w)}; }
    LDS_WAIT(); asm volatile("" ::: "memory");
    const int g = lane >> 4, i16 = lane & 15;
#pragma unroll
    for (int s = 0; s < 8; ++s) { const int nb = s >> 1, c = (s & 1) * 4 + g;
        const int ka = 8 * c + (i16 >> 2), kb2 = ka + 4, chunk = 2 * nb + ((i16 & 3) >> 1);
        const int fa = (ka & 2) | ((ka & 8) >> 1), fb = (kb2 & 2) | ((kb2 & 8) >> 1);
        const s16x4 lo = vtr((const LAS char*)scr + ka * 128 + ((chunk ^ fa) << 4) + (i16 & 1) * 8);
        const s16x4 hi = vtr((const LAS char*)scr + kb2 * 128 + ((chunk ^ fb) << 4) + (i16 & 1) * 8);
        *(bf16x8*)(WT + (size_t)(nrow_dst + 16 * nb + i16) * K + k0 + 8 * c) = PKV(lo, hi); }
    LDS_WAIT(); asm volatile("" ::: "memory");
}
__device__ __forceinline__ void rms_row_2048(const float* __restrict__ xrow, const float* __restrict__ g, bf16_t* __restrict__ orow, int lane, unsigned char* __restrict__ o8row = nullptr, float* __restrict__ sarow = nullptr) {
    const f32x4* xr = (const f32x4*)xrow + lane; const f32x4* gr = (const f32x4*)g + lane;
    f32x4 v[8]; float s = 0.f;
#pragma unroll
    for (int j = 0; j < 8; ++j) { v[j] = __builtin_nontemporal_load(xr + 64 * j); s += (v[j].x * v[j].x + v[j].y * v[j].y) + (v[j].z * v[j].z + v[j].w * v[j].w); }
    const float r = rsqrtf(wave_sum(s) * (1.f / 2048.f) + EPS);
    u32x2* o8 = (u32x2*)orow + lane; float mx = 0.f;
#pragma unroll
    for (int j = 0; j < 8; ++j) { const f32x4 gg = gr[64 * j]; v[j] = v[j] * r * gg; u32x2 w; w.x = cvtpk(v[j].x, v[j].y); w.y = cvtpk(v[j].z, v[j].w); o8[64 * j] = w;
        mx = fmaxf(fmaxf(mx, fmaxf(fabsf(v[j].x), fabsf(v[j].y))), fmaxf(fabsf(v[j].z), fabsf(v[j].w))); }
    if (o8row) {
        mx = wave_max_nn(mx); const float inv = mx > 0.f ? 127.f / mx : 0.f;
        unsigned* q = (unsigned*)o8row + lane;
#pragma unroll
        for (int j = 0; j < 8; ++j) q[64 * j] = q8x4(v[j].x, v[j].y, v[j].z, v[j].w, inv);
        if (lane == 0) *sarow = mx * (1.f / 127.f); }
}
__device__ __forceinline__ float rope_lane(float w, int lane, float pos) {
    const float partner = __shfl_xor(w, 32);
    float sn, cs; fast_sincos(pos * rope_inv(lane & 31), sn, cs);
    return lane < 32 ? w * cs - partner * sn : w * cs + partner * sn;
}

template <int PART>
__device__ __forceinline__ void phase_prep(const Args& P, LAS unsigned char* lds, int gw, int NGW, int wave, int lane) {
    unsigned char* ws = P.ws;
    LAS unsigned char* scr = lds + wave * 16384;
    {
        constexpr int I_IN = 32 * 145, I_MKV = 32 * 32, I_QB = 8 * 48, I_KB = 8 * 32, I_VB = 8 * 32, I_PL = 4 * 4 * 8, I_MLAO = 32 * 32, I_MEMO = 16 * 32, I_OUT = 32 * 32, I_UP = 32 * 128, I_DN = 128 * 32,
                      I_MV = 16 * 4 * 16;
        constexpr int NITEMS = I_IN + I_MKV + I_QB + I_KB + I_VB + I_PL + I_MLAO + I_MEMO + I_OUT + I_UP + I_DN + I_MV;
        for (int it = (PART == 1 ? 0 : I_IN + I_MKV) + gw; it < (PART == 1 ? I_IN + I_MKV : NITEMS); it += NGW) {
            int r = it;
            if (r < I_IN) { const int kb = r / 145, nb = r % 145, n0 = nb * 64; const int nd = n0 < 2048 ? n0 : (n0 < 2112 ? 9216 + (n0 - 2048) : n0 - 64);
                transpose_item(P.in[I_WIN], 9280, 2048, (bf16_t*)(ws + WS_WIN), scr, kb, n0, nd, lane, nullptr); continue; } r -= I_IN;
            if (r < I_MKV) { transpose_item(P.in[I_WMEMKV], 2048, 2048, (bf16_t*)(ws + WS_WMEMKV), scr, r / 32, (r % 32) * 64, (r % 32) * 64, lane, nullptr); continue; } r -= I_MKV;
            if (r < I_QB) { transpose_item(P.in[I_WQB], 3072, 512, (bf16_t*)(ws + WS_WQB), scr, r / 48, (r % 48) * 64, (r % 48) * 64, lane, nullptr); continue; } r -= I_QB;
            if (r < I_KB) { transpose_item(P.in[I_WKB], 2048, 512, (bf16_t*)(ws + WS_WKB), scr, r / 32, (r % 32) * 64, (r % 32) * 64, lane, nullptr); continue; } r -= I_KB;
            if (r < I_VB) { transpose_item(P.in[I_WVB], 2048, 512, (bf16_t*)(ws + WS_WVB), scr, r / 32, (r % 32) * 64, (r % 32) * 64, lane, nullptr); continue; } r -= I_VB;
            if (r < I_PL) { const int g = r / 32, q = r % 32; transpose_item(P.in[I_WPOOL] + (size_t)g * 256 * 512, 512, 256, (bf16_t*)(ws + WS_WPOOL), scr, q / 8, (q % 8) * 64, g * 512 + (q % 8) * 64, lane, nullptr); continue; } r -= I_PL;
            if (r < I_MLAO) { transpose_item(P.in[I_WMLAO], 2048, 2048, (bf16_t*)(ws + WS_WMLAO), scr, r / 32, (r % 32) * 64, (r % 32) * 64, lane, nullptr); continue; } r -= I_MLAO;
            if (r < I_MEMO) { transpose_item(P.in[I_WMEMO], 2048, 1024, (bf16_t*)(ws + WS_WMEMO), scr, r / 32, (r % 32) * 64, (r % 32) * 64, lane, nullptr); continue; } r -= I_MEMO;
            if (r < I_OUT) { transpose_item(P.in[I_WOUT], 2048, 2048, (bf16_t*)(ws + WS_WOUT), scr, r / 32, (r % 32) * 64, (r % 32) * 64, lane, nullptr); continue; } r -= I_OUT;
            if (r < I_UP) { transpose_item(P.in[I_WUP], 8192, 2048, (bf16_t*)(ws + WS_WUP), scr, r / 128, (r % 128) * 64, (r % 128) * 64, lane, P.in[I_GFF]); continue; } r -= I_UP;
            if (r < I_DN) { transpose_item(P.in[I_WDOWN], 2048, 8192, (bf16_t*)(ws + WS_WDOWN), scr, r / 32, (r % 32) * 64, (r % 32) * 64, lane, nullptr); continue; } r -= I_DN;
            { const int b = r / 64, q = r % 64;
              transpose_item(P.in[I_CMV] + (size_t)b * 262144, 1024, 256, (bf16_t*)(ws + WS_MVT) + (size_t)(2 + b) * 262144, scr, q / 16, (q % 16) * 64, (q % 16) * 64, lane, nullptr); }
        }
    }
    if (PART == 1) for (int m = gw; m < TT + 512; m += NGW) {
        if (m < TP) rms_row_2048(P.in[I_XP] + (size_t)m * DM, P.in[I_GMIX], (bf16_t*)(ws + WS_H) + (size_t)m * DM, lane, ws + WS_H8 + (size_t)m * DM, (float*)(ws + WS_SAH) + m);
        else if (m < TT) rms_row_2048(P.in[I_XS] + (size_t)(m - TP) * DM, P.in[I_GMIX], (bf16_t*)(ws + WS_H) + (size_t)m * DM, lane, ws + WS_H8 + (size_t)m * DM, (float*)(ws + WS_SAH) + m);
        else rms_row_2048(P.in[I_MEMP] + (size_t)(m - TT) * DM, P.in[I_GMEM], (bf16_t*)(ws + WS_HM) + (size_t)(m - TT) * DM, lane);
    }
    if (PART == 2) {
        bf16_t* KRs = (bf16_t*)(ws + WS_KRS); float* KPESS = (float*)(ws + WS_KPESS); bf16_t* LATs = (bf16_t*)(ws + WS_LATS);
        const float gk = P.in[I_GKHEAD][128 + lane];
        const float inv = rope_inv(lane & 31);
        for (int pos = gw; pos < 4096; pos += NGW) {
            float sn, cs; fast_sincos((float)pos * inv, sn, cs);
            float v[NBS];
#pragma unroll
            for (int b = 0; b < NBS; ++b) v[b] = __builtin_nontemporal_load(P.in[I_CKPE] + ((size_t)b * 4096 + pos) * 64 + lane);
#pragma unroll
            for (int b = 0; b < NBS; ++b) { const float ss = wave_sum(v[b] * v[b]); const float w = v[b] * gk, pr = __shfl_xor(w, 32);
                const float o = lane < 32 ? w * cs - pr * sn : w * cs + pr * sn;
                const size_t kidx = (size_t)b * KPAD + pos; KRs[kidx * 64 + lane] = f2bf(o); if (lane == 0) KPESS[kidx] = ss; } }
        for (int rr = gw; rr < NBS * 32; rr += NGW) { const size_t kidx = (size_t)(rr >> 5) * KPAD + 4128 + (rr & 31);
            KRs[kidx * 64 + lane] = 0; if (lane == 0) KPESS[kidx] = 0.f;
            *(u32x4*)(LATs + kidx * 512 + lane * 8) = (u32x4){0u, 0u, 0u, 0u};
            *(u32x2*)(l8_tile(ws, (unsigned char*)P.out, (int)(kidx >> 8)) + (kidx & 255) * 512 + lane * 8) = (u32x2){0u, 0u}; if (lane == 0) ((float*)(ws + WS_SA))[kidx] = 0.f; }
    }
    if (PART == 2) {
        const long tid_g = (long)gw * 64 + lane, NT_G = (long)NGW * 64;
        bf16_t* LATs = (bf16_t*)(ws + WS_LATS);
        for (long i0 = tid_g; i0 < (long)NBS * 4096 * 64; i0 += 4 * NT_G) {
            f32x4 a[4], c[4];
#pragma unroll
            for (int q = 0; q < 4; ++q) { long i = i0 + q * NT_G; if (i >= (long)NBS * 4096 * 64) i = i0; a[q] = __builtin_nontemporal_load((const f32x4*)(P.in[I_CLAT] + i * 8)); c[q] = __builtin_nontemporal_load((const f32x4*)(P.in[I_CLAT] + i * 8 + 4)); }
#pragma unroll
            for (int q = 0; q < 4; ++q) { long i = i0 + q * NT_G; if (i >= (long)NBS * 4096 * 64) i = i0; const long b = i >> 18, rem = i & 262143;
                *(u32x4*)(LATs + (size_t)b * KPAD * 512 + rem * 8) = (u32x4){cvtpk(a[q].x, a[q].y), cvtpk(a[q].z, a[q].w), cvtpk(c[q].x, c[q].y), cvtpk(c[q].z, c[q].w)};
                const float v8[8] = {a[q].x, a[q].y, a[q].z, a[q].w, c[q].x, c[q].y, c[q].z, c[q].w}; float sc; const u32x2 q8 = quant_row8(v8, sc);
                const int R = (int)b * KPAD + (int)(rem >> 6);
                *(u32x2*)(l8_tile(ws, (unsigned char*)P.out, R >> 8) + (R & 255) * 512 + lane * 8) = q8; if (lane == 0) ((float*)(ws + WS_SA))[R] = sc; } }
        bf16_t* MKs = (bf16_t*)(ws + WS_MK) + (size_t)2 * 262144;
        for (long i0 = tid_g; i0 < (long)NBS * 262144 / 8; i0 += 4 * NT_G) {
            f32x4 a[4], c[4];
#pragma unroll
            for (int q = 0; q < 4; ++q) { long i = i0 + q * NT_G; if (i >= (long)NBS * 262144 / 8) i = i0; a[q] = __builtin_nontemporal_load((const f32x4*)(P.in[I_CMK] + i * 8)); c[q] = __builtin_nontemporal_load((const f32x4*)(P.in[I_CMK] + i * 8 + 4)); }
#pragma unroll
            for (int q = 0; q < 4; ++q) { long i = i0 + q * NT_G; if (i >= (long)NBS * 262144 / 8) i = i0;
                *(u32x4*)(MKs + i * 8) = (u32x4){cvtpk(a[q].x, a[q].y), cvtpk(a[q].z, a[q].w), cvtpk(c[q].x, c[q].y), cvtpk(c[q].z, c[q].w)}; } }
        bf16_t* WKN = (bf16_t*)(ws + WS_WKBN);
        for (long i = tid_g; i < 512L * 2048 / 8; i += NT_G) {
            const f32x4 a = *(const f32x4*)(P.in[I_WKB] + i * 8), c = *(const f32x4*)(P.in[I_WKB] + i * 8 + 4);
            *(u32x4*)(WKN + i * 8) = (u32x4){cvtpk(a.x, a.y), cvtpk(a.z, a.w), cvtpk(c.x, c.y), cvtpk(c.z, c.w)}; }
    }
}

struct EpiIn {
    static constexpr bool PERM = true;
    bf16_t* ZS; bf16_t* G; float* M; const float* bgate; const float* SAH; const float* SBG; bool i8; const float* SBX;
    __device__ __forceinline__ bool operator()(f32x4 (&acc)[2][2][4][2], const pg8::Unit& u, int wr, int wc, int fr_, int fq) const {
        int fr = fr_; asm volatile("" : "+v"(fr));
        const int row0 = u.pm * 256 + wr * 64 + fr, ct = wc * 32 + 8 * fq;
        if (u.kind == 1) {
#pragma unroll
            for (int ai = 0; ai < 2; ++ai)
#pragma unroll
                for (int m = 0; m < 4; ++m) { float* rp = M + (size_t)(row0 + ai * 128 + m * 16) * 2048 + u.pn * 256 + ct;
#pragma unroll
                    for (int bj = 0; bj < 2; ++bj) { *(f32x4*)(rp + bj * 128) = acc[ai][bj][m][0]; *(f32x4*)(rp + bj * 128 + 4) = acc[ai][bj][m][1]; } }
            return false;
        }
        const int pn = u.pn;
        if (pn >= 12 && pn < 36) {
            const int gc = (pn - 12) * 256 + ct;
            f32x4 bv[2][2];
#pragma unroll
            for (int bj = 0; bj < 2; ++bj) { bv[bj][0] = *(const f32x4*)(bgate + gc + bj * 128); bv[bj][1] = *(const f32x4*)(bgate + gc + bj * 128 + 4); }
            f32x4 sbv[2][2]; float sah[2][4];
            if (i8) {
#pragma unroll
                for (int bj = 0; bj < 2; ++bj) { sbv[bj][0] = *(const f32x4*)(SBG + gc + bj * 128); sbv[bj][1] = *(const f32x4*)(SBG + gc + bj * 128 + 4); }
#pragma unroll
                for (int ai = 0; ai < 2; ++ai)
#pragma unroll
                    for (int m = 0; m < 4; ++m) sah[ai][m] = SAH[row0 + ai * 128 + m * 16]; }
#pragma unroll
            for (int ai = 0; ai < 2; ++ai)
#pragma unroll
                for (int m = 0; m < 4; ++m) { bf16_t* rp = G + (size_t)(row0 + ai * 128 + m * 16) * G_LD + gc;
#pragma unroll
                    for (int bj = 0; bj < 2; ++bj) { f32x4 v0 = acc[ai][bj][m][0], v1 = acc[ai][bj][m][1];
                        if (i8) { const pg8::i32x4 i0 = __builtin_bit_cast(pg8::i32x4, v0), i1 = __builtin_bit_cast(pg8::i32x4, v1);
                            v0 = (f32x4){(float)i0[0], (float)i0[1], (float)i0[2], (float)i0[3]} * sbv[bj][0] * sah[ai][m]; v1 = (f32x4){(float)i1[0], (float)i1[1], (float)i1[2], (float)i1[3]} * sbv[bj][1] * sah[ai][m]; }
                        v0 += bv[bj][0]; v1 += bv[bj][1];
#pragma unroll
                        for (int e = 0; e < 4; ++e) { v0[e] = __builtin_amdgcn_rcpf(1.f + __builtin_amdgcn_exp2f(-1.4426950408889634f * v0[e])); v1[e] = __builtin_amdgcn_rcpf(1.f + __builtin_amdgcn_exp2f(-1.4426950408889634f * v1[e])); }
                        __builtin_nontemporal_store((u32x4){cvtpk(v0[0], v0[1]), cvtpk(v0[2], v0[3]), cvtpk(v1[0], v1[1]), cvtpk(v1[2], v1[3])}, (u32x4*)(rp + bj * 128)); } }
            return false;
        }
        if (i8) {
            const int xc = (pn < 6 ? (pn - 4) * 256 : 512 + (pn - 8) * 256) + ct;
#pragma unroll
            for (int bj = 0; bj < 2; ++bj) { const f32x4 s0 = *(const f32x4*)(SBX + xc + bj * 128), s1 = *(const f32x4*)(SBX + xc + bj * 128 + 4);
#pragma unroll
                for (int ai = 0; ai < 2; ++ai)
#pragma unroll
                    for (int m = 0; m < 4; ++m) { const float sa = SAH[row0 + ai * 128 + m * 16];
                        const pg8::i32x4 i0 = __builtin_bit_cast(pg8::i32x4, acc[ai][bj][m][0]), i1 = __builtin_bit_cast(pg8::i32x4, acc[ai][bj][m][1]);
                        acc[ai][bj][m][0] = (f32x4){(float)i0[0], (float)i0[1], (float)i0[2], (float)i0[3]} * s0 * sa; acc[ai][bj][m][1] = (f32x4){(float)i1[0], (float)i1[1], (float)i1[2], (float)i1[3]} * s1 * sa; } } }
        const int zc = (pn < 12 ? pn * 256 : 3072) + ct;
#pragma unroll
        for (int ai = 0; ai < 2; ++ai)
#pragma unroll
            for (int m = 0; m < 4; ++m) { bf16_t* rp = ZS + (size_t)(row0 + ai * 128 + m * 16) * ZS_LD + zc;
#pragma unroll
                for (int bj = 0; bj < 2; ++bj) { if (pn == 36 && (bj == 1 || wc >= 2)) continue;
                    const f32x4 v0 = acc[ai][bj][m][0], v1 = acc[ai][bj][m][1];
                    *(u32x4*)(rp + bj * 128) = (u32x4){cvtpk(v0[0], v0[1]), cvtpk(v0[2], v0[3]), cvtpk(v1[0], v1[1]), cvtpk(v1[2], v1[3])}; } }
        return false;
    }
};

__device__ __forceinline__ void unpack8(const u32x4 w, float (&f)[8]) { f[0] = bflo(w.x); f[1] = bfhi(w.x); f[2] = bflo(w.y); f[3] = bfhi(w.y); f[4] = bflo(w.z); f[5] = bfhi(w.z); f[6] = bflo(w.w); f[7] = bfhi(w.w); }
template <int NR>
__device__ __forceinline__ void quant_rows2048(const bf16_t* __restrict__ src, size_t sstride, unsigned char* __restrict__ dst, size_t dstride, float* __restrict__ sc, size_t cstride, int lane, const float* __restrict__ ssx = nullptr, size_t ssx_stride = 0) {
    u32x4 wv[NR][4];
#pragma unroll
    for (int r = 0; r < NR; ++r)
#pragma unroll
        for (int j = 0; j < 4; ++j) wv[r][j] = *(const u32x4*)(src + r * sstride + (lane + 64 * j) * 8);
    asm volatile("" ::: "memory");
#pragma unroll
    for (int r = 0; r < NR; ++r) { float mx = 0.f, f[4][8];
#pragma unroll
        for (int j = 0; j < 4; ++j) { unpack8(wv[r][j], f[j]);
#pragma unroll
            for (int e2 = 0; e2 < 8; ++e2) mx = fmaxf(mx, fabsf(f[j][e2])); }
        mx = wave_max_nn(mx); const float inv = mx > 0.f ? 127.f / mx : 0.f;
#pragma unroll
        for (int j = 0; j < 4; ++j) *(u32x2*)(dst + r * dstride + (lane + 64 * j) * 8) = (u32x2){q8x4(f[j][0], f[j][1], f[j][2], f[j][3], inv), q8x4(f[j][4], f[j][5], f[j][6], f[j][7], inv)};
        float scale = mx * (1.f / 127.f);
        if (ssx) scale *= rsqrtf(wave_sum_v(ssx[r * ssx_stride + (lane & 31)]) * (0.5f / 2048.f) + EPS);
        if (lane == 0) sc[r * cstride] = scale; }
}
__device__ __forceinline__ void quant_row2048(const bf16_t* __restrict__ src, unsigned char* __restrict__ dst, float* __restrict__ sc, int lane) { quant_rows2048<1>(src, 0, dst, 0, sc, 0, lane); }
__device__ __forceinline__ u32x4 pack8(const float (&f)[8]) { return (u32x4){cvtpk(f[0], f[1]), cvtpk(f[2], f[3]), cvtpk(f[4], f[5]), cvtpk(f[6], f[7])}; }

__device__ __forceinline__ void phase_rows(const Args& P, LAS unsigned char* lds, int gw, int NGW, int wave, int lane) {
    unsigned char* ws = P.ws; float* out = P.out;
    const bf16_t* ZS = (const bf16_t*)(ws + WS_ZS);
    const f32x4 gkv0 = *(const f32x4*)(P.in[I_GKVLAT] + lane * 8), gkv1 = *(const f32x4*)(P.in[I_GKVLAT] + lane * 8 + 4);
    const f32x4 gql0 = *(const f32x4*)(P.in[I_GQLAT] + lane * 8), gql1 = *(const f32x4*)(P.in[I_GQLAT] + lane * 8 + 4);
    const f32x4 gmq = *(const f32x4*)(P.in[I_GMEMQ] + lane * 4);
    const float gkr = P.in[I_GKHEAD][128 + lane];
    struct RowRegs { u32x4 kvw, qlw, uaw, ubw, la, lb; u32x2 mqw[4]; bf16_t kpw; };
    const int ca = lane * 8, cb = 512 + lane * 8, wa = lane < 32 ? 2 : 4, wb = lane < 32 ? 8 : 16;
    auto load_row = [&](int t, RowRegs& R) {
        const bool prm = t < TP; const int li = prm ? (t & 4095) : ((t - TP) & 31);
        const bf16_t* z = ZS + (size_t)t * ZS_LD;
        R.kvw = *(const u32x4*)(z + 1536 + lane * 8); R.qlw = *(const u32x4*)(z + 1024 + lane * 8); R.uaw = *(const u32x4*)(z + ca); R.ubw = *(const u32x4*)(z + cb);
        R.kpw = z[3072 + lane];
#pragma unroll
        for (int h = 0; h < 4; ++h) R.mqw[h] = *(const u32x2*)(z + 2048 + h * 256 + lane * 4);
        R.la = *(const u32x4*)(z - (size_t)((prm && wa <= li) ? wa : 0) * ZS_LD + ca); R.lb = *(const u32x4*)(z - (size_t)((prm && wb <= li) ? wb : 0) * ZS_LD + cb);
    };
    RowRegs R;
    const int RPW = (TP + NGW - 1) / NGW, t0p = gw * RPW, npr = t0p < TP ? (TP - t0p < RPW ? TP - t0p : RPW) : 0, gws = (gw + NGW / 4) % NGW;
    auto row_of = [&](int i) -> int { if (i < npr) return t0p + i; const int s = gws + (i - npr) * NGW; return s < TS ? TP + s : -1; };
    int t = row_of(0);
    f32x4 Ssa0 = (f32x4){0.f, 0.f, 0.f, 0.f}, Ssa1 = Ssa0, Ssb0 = Ssa0, Ssb1 = Ssa0;
    if (npr > 0) {
        const int li0 = t0p & 4095; const bf16_t* z0 = ZS + (size_t)t0p * ZS_LD;
        u32x4 pa[4], pb[16];
#pragma unroll
        for (int k = 1; k <= 4; ++k) pa[k - 1] = *(const u32x4*)(z0 - (size_t)(k <= li0 ? k : 0) * ZS_LD + ca);
#pragma unroll
        for (int k = 1; k <= 16; ++k) pb[k - 1] = *(const u32x4*)(z0 - (size_t)(k <= li0 ? k : 0) * ZS_LD + cb);
        load_row(t, R);
        float sa[8], sb[8];
#pragma unroll
        for (int j = 0; j < 8; ++j) { sa[j] = 0.f; sb[j] = 0.f; }
#pragma unroll
        for (int k = 1; k <= 4; ++k) { float tmp[8]; unpack8(pa[k - 1], tmp); const float w = (k <= li0 && k <= wa) ? 1.f : 0.f;
#pragma unroll
            for (int j = 0; j < 8; ++j) sa[j] += w * tmp[j]; }
#pragma unroll
        for (int k = 1; k <= 16; ++k) { float tmp[8]; unpack8(pb[k - 1], tmp); const float w = (k <= li0 && k <= wb) ? 1.f : 0.f;
#pragma unroll
            for (int j = 0; j < 8; ++j) sb[j] += w * tmp[j]; }
        Ssa0 = (f32x4){sa[0], sa[1], sa[2], sa[3]}; Ssa1 = (f32x4){sa[4], sa[5], sa[6], sa[7]}; Ssb0 = (f32x4){sb[0], sb[1], sb[2], sb[3]}; Ssb1 = (f32x4){sb[4], sb[5], sb[6], sb[7]};
    } else if (t >= 0) load_row(t, R);
    for (int ri = 0; t >= 0; ++ri) {
        const int tnext = row_of(ri + 1);
        const bool prm = t < TP; const int b = prm ? (t >> 12) : ((t - TP) >> 5), li = prm ? (t & 4095) : ((t - TP) & 31), pos = prm ? li : 4096 + li;
        const bf16_t* z = ZS + (size_t)t * ZS_LD;
        float sa[8], sb[8], ua[8], ub[8];
        {
          unpack8(R.uaw, ua); unpack8(R.ubw, ub);
#pragma unroll
          for (int j = 0; j < 8; ++j) { sa[j] = ua[j]; sb[j] = ub[j]; }
          if (prm) { float la[8], lb[8]; unpack8(R.la, la); unpack8(R.lb, lb);
              const float wla = wa <= li ? 1.f : 0.f, wlb = wb <= li ? 1.f : 0.f, kp = li == 0 ? 0.f : 1.f;
#pragma unroll
              for (int j = 0; j < 4; ++j) { sa[j] = kp * Ssa0[j] + ua[j] - wla * la[j]; sa[4 + j] = kp * Ssa1[j] + ua[4 + j] - wla * la[4 + j]; sb[j] = kp * Ssb0[j] + ub[j] - wlb * lb[j]; sb[4 + j] = kp * Ssb1[j] + ub[4 + j] - wlb * lb[4 + j]; }
              Ssa0 = (f32x4){sa[0], sa[1], sa[2], sa[3]}; Ssa1 = (f32x4){sa[4], sa[5], sa[6], sa[7]}; Ssb0 = (f32x4){sb[0], sb[1], sb[2], sb[3]}; Ssb1 = (f32x4){sb[4], sb[5], sb[6], sb[7]};
          } else
          for (int k = 1; k < 16; ++k) {
              if (k <= li) { const bf16_t* zk = z - (size_t)k * ZS_LD; float tmp[8];
                  if (k < wa) { unpack8(*(const u32x4*)(zk + ca), tmp);
#pragma unroll
                      for (int j = 0; j < 8; ++j) sa[j] += tmp[j]; }
                  if (k < wb) { unpack8(*(const u32x4*)(zk + cb), tmp);
#pragma unroll
                      for (int j = 0; j < 8; ++j) sb[j] += tmp[j]; } }
              else { const float* sp = P.in[I_SPOOL] + ((size_t)b * 15 + (15 + li - k)) * 1024;
                  if (k < wa) { const f32x4 p0 = *(const f32x4*)(sp + ca), p1 = *(const f32x4*)(sp + ca + 4); sa[0] += p0.x; sa[1] += p0.y; sa[2] += p0.z; sa[3] += p0.w; sa[4] += p1.x; sa[5] += p1.y; sa[6] += p1.z; sa[7] += p1.w; }
                  if (k < wb) { const f32x4 p0 = *(const f32x4*)(sp + cb), p1 = *(const f32x4*)(sp + cb + 4); sb[0] += p0.x; sb[1] += p0.y; sb[2] += p0.z; sb[3] += p0.w; sb[4] += p1.x; sb[5] += p1.y; sb[6] += p1.z; sb[7] += p1.w; } }
          }
        }
        asm volatile("" ::: "memory");
        const u32x4 kvw = R.kvw, qlw = R.qlw; const bf16_t kpw = R.kpw;
        u32x2 mqw[4];
#pragma unroll
        for (int h = 0; h < 4; ++h) mqw[h] = R.mqw[h];
        if (tnext >= 0) load_row(tnext, R);
        asm volatile("" ::: "memory");
        { float v[8]; unpack8(kvw, v); float s = 0.f;
#pragma unroll
          for (int j = 0; j < 8; ++j) s += v[j] * v[j];
          const float r = rsqrtf(wave_sum_v(s) * (1.f / 512.f) + EPS);
          v[0] *= r * gkv0.x; v[1] *= r * gkv0.y; v[2] *= r * gkv0.z; v[3] *= r * gkv0.w; v[4] *= r * gkv1.x; v[5] *= r * gkv1.y; v[6] *= r * gkv1.z; v[7] *= r * gkv1.w;
          float* lo = prm ? out + O_LATP + (size_t)t * 512 : out + O_LATS + (size_t)(t - TP) * 512;
          *(f32x4*)(lo + lane * 8) = (f32x4){v[0], v[1], v[2], v[3]}; *(f32x4*)(lo + lane * 8 + 4) = (f32x4){v[4], v[5], v[6], v[7]};
          bf16_t* dst = prm ? (bf16_t*)((unsigned char*)out + DO_CKVP) + (size_t)t * 512 : (bf16_t*)(ws + WS_LATS) + ((size_t)b * KPAD + 4096 + li) * 512;
          *(u32x4*)(dst + lane * 8) = pack8(v);
          if (prm) { float sc; const u32x2 q8 = quant_row8(v, sc); *(u32x2*)(ws + WS_CKV8 + (size_t)t * 512 + lane * 8) = q8; if (lane == 0) ((float*)(ws + WS_SAC))[t] = sc; }
          if (!prm) { float sc; const u32x2 q8 = quant_row8(v, sc); const int R = b * KPAD + 4096 + li;
              *(u32x2*)(l8_tile(ws, (unsigned char*)out, R >> 8) + (R & 255) * 512 + lane * 8) = q8; if (lane == 0) ((float*)(ws + WS_SA))[R] = sc; } }
        { const float v = bf2f(kpw);
          (prm ? out + O_KPEP + (size_t)t * 64 : out + O_KPES + (size_t)(t - TP) * 64)[lane] = v;
          const float ss = wave_sum_v(v * v); const float o = rope_lane(v * gkr, lane, (float)pos);
          if (prm) { ((bf16_t*)(ws + WS_KRP))[(size_t)t * 64 + lane] = f2bf(o); if (lane == 0) ((float*)(ws + WS_KPESSP))[t] = ss; }
          else { const size_t kidx = (size_t)b * KPAD + 4096 + li; ((bf16_t*)(ws + WS_KRS))[kidx * 64 + lane] = f2bf(o); if (lane == 0) ((float*)(ws + WS_KPESS))[kidx] = ss; } }
        { float v[8]; unpack8(qlw, v); float s = 0.f;
#pragma unroll
          for (int j = 0; j < 8; ++j) s += v[j] * v[j];
          const float r = rsqrtf(wave_sum_v(s) * (1.f / 512.f) + EPS);
          v[0] *= r * gql0.x; v[1] *= r * gql0.y; v[2] *= r * gql0.z; v[3] *= r * gql0.w; v[4] *= r * gql1.x; v[5] *= r * gql1.y; v[6] *= r * gql1.z; v[7] *= r * gql1.w;
          *(u32x4*)((bf16_t*)(ws + WS_QN) + (size_t)t * 512 + lane * 8) = pack8(v);
          { float sc; const u32x2 q8 = quant_row8(v, sc); *(u32x2*)(ws + WS_QN8 + (size_t)t * 512 + lane * 8) = q8; if (lane == 0) ((float*)(ws + WS_SAQ))[t] = sc; } }
#pragma unroll
        for (int h = 0; h < 4; ++h) { const u32x2 w = mqw[h];
            const float a0 = bflo(w.x), a1 = bfhi(w.x), a2 = bflo(w.y), a3 = bfhi(w.y);
            const float r = rsqrtf(wave_sum_v((a0 * a0 + a1 * a1) + (a2 * a2 + a3 * a3)) * (1.f / 256.f) + EPS) * MEM_C;
            *(u32x2*)((bf16_t*)(ws + WS_QM) + (size_t)t * 1024 + h * 256 + lane * 4) = (u32x2){cvtpk(a0 * r * gmq.x, a1 * r * gmq.y), cvtpk(a2 * r * gmq.z, a3 * r * gmq.w)}; }
        {
          const float ia = 1.f / (float)(pos + 1 < wa ? pos + 1 : wa), ib = 1.f / (float)(pos + 1 < wb ? pos + 1 : wb);
#pragma unroll
          for (int j = 0; j < 8; ++j) { sa[j] = sa[j] * ia - ua[j]; sb[j] = sb[j] * ib - ub[j]; }
          bf16_t* dp = (bf16_t*)(ws + WS_DP) + (size_t)t * 1024;
          *(u32x4*)(dp + ca) = pack8(sa); *(u32x4*)(dp + cb) = pack8(sb);
          const int last0 = prm ? 4081 : 17;
          if (li >= last0) { float* po = (prm ? out + O_POOLP : out + O_POOLS) + ((size_t)b * 15 + (li - last0)) * 1024;
              *(f32x4*)(po + ca) = (f32x4){ua[0], ua[1], ua[2], ua[3]}; *(f32x4*)(po + ca + 4) = (f32x4){ua[4], ua[5], ua[6], ua[7]};
              *(f32x4*)(po + cb) = (f32x4){ub[0], ub[1], ub[2], ub[3]}; *(f32x4*)(po + cb + 4) = (f32x4){ub[4], ub[5], ub[6], ub[7]}; } }
        asm volatile("" ::: "memory");
        t = tnext;
    }
    { auto wsrc = [&](int n) -> const bf16_t* { return n < 2048 ? (const bf16_t*)(ws + WS_WKB) + (size_t)n * 512 : (n < 5120 ? (const bf16_t*)(ws + WS_WQB) + (size_t)(n - 2048) * 512 : (const bf16_t*)(ws + WS_WVB) + (size_t)(n - 5120) * 512); };
      auto wdst = [&](int n) -> unsigned char* { return n < 2048 ? ws + WS_WKB8 + (size_t)n * 512 : (n < 5120 ? ws + WS_WQB8 + (size_t)(n - 2048) * 512 : ws + WS_WVB8 + (size_t)(n - 5120) * 512); };
      auto wsc = [&](int n) -> float* { return n < 2048 ? (float*)(ws + WS_SB) + n : (n < 5120 ? (float*)(ws + WS_SBQ) + (n - 2048) : (float*)(ws + WS_SBV) + (n - 5120)); };
      for (int n0 = gw; n0 < 7168; n0 += 4 * NGW) { u32x4 wv[4];
#pragma unroll
          for (int k = 0; k < 4; ++k) { const int n = n0 + k * NGW; wv[k] = *(const u32x4*)(wsrc(n < 7168 ? n : n0) + lane * 8); }
          asm volatile("" ::: "memory");
#pragma unroll
          for (int k = 0; k < 4; ++k) { const int n = n0 + k * NGW; if (n < 7168) { float w8[8]; unpack8(wv[k], w8); float sc; const u32x2 q8 = quant_row8(w8, sc);
              *(u32x2*)(wdst(n) + lane * 8) = q8; if (lane == 0) *wsc(n) = sc; } } } }
    for (int m = (gw + NGW / 2) % NGW; m < 512; m += NGW) {
        const float* mr = (const float*)(ws + WS_M) + (size_t)m * 2048; const f32x4 g = *(const f32x4*)(P.in[I_GMEMK] + lane * 4);
#pragma unroll
        for (int h = 0; h < 4; ++h) { f32x4 v = *(const f32x4*)(mr + h * 256 + lane * 4);
            const float r = rsqrtf(wave_sum_v((v.x * v.x + v.y * v.y) + (v.z * v.z + v.w * v.w)) * (1.f / 256.f) + EPS);
            v.x *= r * g.x; v.y *= r * g.y; v.z *= r * g.z; v.w *= r * g.w;
            *(f32x4*)(out + O_MEMK + (size_t)m * 1024 + h * 256 + lane * 4) = v;
            *(u32x2*)((bf16_t*)(ws + WS_MK) + (size_t)m * 1024 + h * 256 + lane * 4) = (u32x2){cvtpk(v.x, v.y), cvtpk(v.z, v.w)};
            *(f32x4*)(out + O_MEMV + (size_t)m * 1024 + h * 256 + lane * 4) = *(const f32x4*)(mr + 1024 + h * 256 + lane * 4); }
    }
    { LAS unsigned char* scr = lds + wave * 16384;
      for (int it = (gw + 3 * NGW / 4) % NGW; it < 2 * 64; it += NGW) { const int b = it / 64, q = it % 64;
          transpose_item((const float*)(ws + WS_M) + (size_t)b * 256 * 2048 + 1024, 2048, 256, (bf16_t*)(ws + WS_MVT) + (size_t)b * 262144, scr, q / 16, (q % 16) * 64, (q % 16) * 64, lane, nullptr); } }
}

template <int MODE>
struct EpiQKV {
    static constexpr bool PERM = true;
    bf16_t* Q; bf16_t* K; bf16_t* V; float* RKG; bf16_t* PM; float* PS; const float* KPESS; const float* KPESSP; const bf16_t* KRP; const float* gk; LAS unsigned char* lds; const float* SA; const float* SB; const float* SQ; bool i8;
    template <bool I8 = false>
    __device__ __forceinline__ void half_sumsq(const f32x4 (&acc)[2][2][4][2], float (&tot)[2][4][2], int wr, int wc, int fr, int fq, const f32x4 (*sb)[2] = nullptr) const {
        LAS float* part = (LAS float*)(lds + 131072);
#pragma unroll
        for (int ai = 0; ai < 2; ++ai)
#pragma unroll
            for (int m = 0; m < 4; ++m)
#pragma unroll
                for (int bj = 0; bj < 2; ++bj) { f32x4 a = acc[ai][bj][m][0], b = acc[ai][bj][m][1];
                    if (I8) { const pg8::i32x4 ia = __builtin_bit_cast(pg8::i32x4, a), ib = __builtin_bit_cast(pg8::i32x4, b);
                        a = (f32x4){(float)ia[0], (float)ia[1], (float)ia[2], (float)ia[3]} * sb[bj][0]; b = (f32x4){(float)ib[0], (float)ib[1], (float)ib[2], (float)ib[3]} * sb[bj][1]; }
                    float s = ((a.x * a.x + a.y * a.y) + (a.z * a.z + a.w * a.w)) + ((b.x * b.x + b.y * b.y) + (b.z * b.z + b.w * b.w));
                    s = rows4_sum(s);
                    if (fq == 0) part[((ai * 128 + wr * 64 + m * 16 + fr) * 2 + bj) * 4 + wc] = s; }
        asm volatile("s_waitcnt lgkmcnt(0)" ::: "memory"); __builtin_amdgcn_s_barrier(); asm volatile("" ::: "memory");
#pragma unroll
        for (int ai = 0; ai < 2; ++ai)
#pragma unroll
            for (int m = 0; m < 4; ++m)
#pragma unroll
                for (int bj = 0; bj < 2; ++bj) { const f32x4 p4 = *(const LAS f32x4*)(part + ((ai * 128 + wr * 64 + m * 16 + fr) * 2 + bj) * 4); tot[ai][m][bj] = (p4.x + p4.y) + (p4.z + p4.w); }
    }
    __device__ __forceinline__ bool operator()(f32x4 (&acc)[2][2][4][2], const pg8::Unit& u, int wr, int wc, int fr_, int fq_) const {
        int fr = fr_, fq = fq_; asm volatile("" : "+v"(fr), "+v"(fq));
        const int row0 = u.pm * 256 + wr * 64 + fr, ct = wc * 32 + 8 * fq;
        if (MODE == 2) {
            const float* ra = u.kind == 0 ? SQ : SQ + 16384; const float* cb = (u.kind == 0 ? SQ + 32768 : (u.kind == 1 ? SB : SQ + 49152)) + u.pn * 256 + ct;
#pragma unroll
            for (int bj = 0; bj < 2; ++bj) { const f32x4 s0 = *(const f32x4*)(cb + bj * 128), s1 = *(const f32x4*)(cb + bj * 128 + 4);
#pragma unroll
                for (int ai = 0; ai < 2; ++ai)
#pragma unroll
                    for (int m = 0; m < 4; ++m) { const float sa = ra[row0 + ai * 128 + m * 16];
                        const pg8::i32x4 i0 = __builtin_bit_cast(pg8::i32x4, acc[ai][bj][m][0]), i1 = __builtin_bit_cast(pg8::i32x4, acc[ai][bj][m][1]);
                        acc[ai][bj][m][0] = (f32x4){(float)i0[0], (float)i0[1], (float)i0[2], (float)i0[3]} * s0 * sa; acc[ai][bj][m][1] = (f32x4){(float)i1[0], (float)i1[1], (float)i1[2], (float)i1[3]} * s1 * sa; }
                asm volatile("" ::: "memory"); }
            asm volatile("" : "+v"(fr)); }
        if (MODE == 1) {
            float kp[2][4], sa[2][4];
#pragma unroll
            for (int ai = 0; ai < 2; ++ai)
#pragma unroll
                for (int m = 0; m < 4; ++m) { kp[ai][m] = KPESS[(size_t)(row0 + ai * 128 + m * 16)]; sa[ai][m] = SA[(size_t)(row0 + ai * 128 + m * 16)]; }
            f32x4 sb[2][2];
#pragma unroll
            for (int bj = 0; bj < 2; ++bj) { sb[bj][0] = *(const f32x4*)(SB + u.pn * 256 + bj * 128 + ct); sb[bj][1] = *(const f32x4*)(SB + u.pn * 256 + bj * 128 + ct + 4); }
            float tot[2][4][2]; half_sumsq<true>(acc, tot, wr, wc, fr, fq, sb);
            if (wc == 0 && fq == 0) {
#pragma unroll
                for (int ai = 0; ai < 2; ++ai)
#pragma unroll
                    for (int m = 0; m < 4; ++m) { const size_t row = (size_t)(row0 + ai * 128 + m * 16); const float s2 = sa[ai][m] * sa[ai][m];
                        *(f32x2*)(RKG + row * 16 + u.pn * 2) = (f32x2){rsqrtf((tot[ai][m][0] * s2 + kp[ai][m]) * (1.f / 192.f) + EPS) * MLA_C, rsqrtf((tot[ai][m][1] * s2 + kp[ai][m]) * (1.f / 192.f) + EPS) * MLA_C}; } }
            return false;
        }
        if (MODE == 2 && u.kind == 1) {
            const f32x4 g0 = *(const f32x4*)(gk + ct), g1 = *(const f32x4*)(gk + ct + 4);
            float kpa[2][4]; u32x2 kra[2][4];
#pragma unroll
            for (int ai = 0; ai < 2; ++ai)
#pragma unroll
                for (int m = 0; m < 4; ++m) { const size_t row = (size_t)(row0 + ai * 128 + m * 16); kpa[ai][m] = KPESSP[row]; kra[ai][m] = *(const u32x2*)(KRP + row * 64 + wc * 16 + fq * 4); }
            float tot[2][4][2]; half_sumsq(acc, tot, wr, wc, fr, fq);
#pragma unroll
            for (int ai = 0; ai < 2; ++ai) {
                const float (&kp)[4] = kpa[ai]; const u32x2 (&kr)[4] = kra[ai];
#pragma unroll
                for (int m = 0; m < 4; ++m) { bf16_t* rp = K + (size_t)(row0 + ai * 128 + m * 16) * QLD;
#pragma unroll
                    for (int bj = 0; bj < 2; ++bj) { const float rk = rsqrtf((tot[ai][m][bj] + kp[m]) * (1.f / 192.f) + EPS);
                        const f32x4 v0 = acc[ai][bj][m][0] * rk * g0, v1 = acc[ai][bj][m][1] * rk * g1; bf16_t* hp = rp + (u.pn * 2 + bj) * 192;
                        *(u32x4*)(hp + ct) = (u32x4){cvtpk(v0[0], v0[1]), cvtpk(v0[2], v0[3]), cvtpk(v1[0], v1[1]), cvtpk(v1[2], v1[3])};
                        *(u32x2*)(hp + 128 + wc * 16 + fq * 4) = (u32x2){cvtpk(bflo(kr[m].x) * rk, bfhi(kr[m].x) * rk), cvtpk(bflo(kr[m].y) * rk, bfhi(kr[m].y) * rk)}; } }
            }
            return false;
        }
        if (MODE == 0) {
            const int cc = u.pn * 256 + ct;
#pragma unroll
            for (int ai = 0; ai < 2; ++ai)
#pragma unroll
                for (int m = 0; m < 4; ++m) { const int rl = ai * 128 + wr * 64 + m * 16 + fr; const size_t row = (size_t)(u.pm + rl); float s = 0.f;
#pragma unroll
                    for (int bj = 0; bj < 2; ++bj) { f32x4 v0 = acc[ai][bj][m][0], v1 = acc[ai][bj][m][1];
#pragma unroll
                        for (int e = 0; e < 4; ++e) { v0[e] = __builtin_amdgcn_exp2f(v0[e]); v1[e] = __builtin_amdgcn_exp2f(v1[e]); }
                        s += ((v0[0] + v0[1]) + (v0[2] + v0[3])) + ((v1[0] + v1[1]) + (v1[2] + v1[3]));
                        if (u.kind == 4 || rl < 32) *(u32x4*)(PM + row * 1024 + cc + bj * 128) = (u32x4){cvtpk(v0[0], v0[1]), cvtpk(v0[2], v0[3]), cvtpk(v1[0], v1[1]), cvtpk(v1[2], v1[3])}; }
                    s = rows4_sum(s);
                    if (fq == 0 && (u.kind == 4 || rl < 32)) PS[row * 16 + u.pn * 4 + wc] = s; }
            return false;
        }
        if (MODE != 2) return false;
        bf16_t* base; int ld;
        if (u.kind == 0) { base = Q; ld = QLD; } else { base = V; ld = 2048; }
        const int c0 = u.pn * 256 + ct;
#pragma unroll
        for (int ai = 0; ai < 2; ++ai)
#pragma unroll
            for (int m = 0; m < 4; ++m) { bf16_t* rp = base + (size_t)(row0 + ai * 128 + m * 16) * ld;
#pragma unroll
                for (int bj = 0; bj < 2; ++bj) { const f32x4 v0 = acc[ai][bj][m][0], v1 = acc[ai][bj][m][1];
                    *(u32x4*)(rp + c0 + bj * 128) = (u32x4){cvtpk(v0[0], v0[1]), cvtpk(v0[2], v0[3]), cvtpk(v1[0], v1[1]), cvtpk(v1[2], v1[3])}; } }
        return false;
    }
};

#define SWZF(row) ((((((row) & 2) << 1) | (((row) >> 2) & 3))) << 4)
__device__ __forceinline__ void partialSM(f32x16& p0, f32x16& p1, float& m_reg, float& mn, float& alpha, const float C) {
    float pmax = p0[0];
#pragma unroll
    for (int r = 1; r < 16; ++r) pmax = fmaxf(pmax, p0[r]);
#pragma unroll
    for (int r = 0; r < 16; ++r) pmax = fmaxf(pmax, p1[r]);
    { auto rr = __builtin_amdgcn_permlane32_swap(__float_as_uint(pmax), __float_as_uint(pmax), false, false);
      pmax = fmaxf(__uint_as_float(rr[0]), __uint_as_float(rr[1])); }
    if (__builtin_expect(__all((pmax - m_reg) * C <= 11.5f), 1)) { mn = m_reg; alpha = 1.f; }
    else { mn = fmaxf(m_reg, pmax); alpha = __builtin_amdgcn_exp2f((m_reg - mn) * C); m_reg = mn; }
    const float mnC = -mn * C;
#pragma unroll
    for (int r = 0; r < 16; ++r) p0[r] = fmaf(p0[r], C, mnC);
#pragma unroll
    for (int r = 0; r < 16; ++r) p1[r] = fmaf(p1[r], C, mnC);
#pragma unroll
    for (int r = 0; r < 16; ++r) p0[r] = __builtin_amdgcn_exp2f(p0[r]);
}
__device__ __forceinline__ void finishSM(f32x16& p0, f32x16& p1, float alpha, float& l_reg, bf16x8& pa0, bf16x8& pa1, bf16x8& pa2, bf16x8& pa3) {
#pragma unroll
    for (int r = 0; r < 16; ++r) p1[r] = __builtin_amdgcn_exp2f(p1[r]);
    float ps = 0;
#pragma unroll
    for (int r = 0; r < 16; ++r) ps += p0[r];
#pragma unroll
    for (int r = 0; r < 16; ++r) ps += p1[r];
    { auto rr = __builtin_amdgcn_permlane32_swap(__float_as_uint(ps), __float_as_uint(ps), false, false);
      ps = __uint_as_float(rr[0]) + __uint_as_float(rr[1]); }
    l_reg = l_reg * alpha + ps;
#define PK4(P, BASE, OUT) do { unsigned a0 = cvtpk(P[BASE + 0], P[BASE + 1]), a1 = cvtpk(P[BASE + 2], P[BASE + 3]);   \
    unsigned b0 = cvtpk(P[BASE + 4], P[BASE + 5]), b1 = cvtpk(P[BASE + 6], P[BASE + 7]);                              \
    auto r0 = __builtin_amdgcn_permlane32_swap(a0, b0, false, false); auto r1 = __builtin_amdgcn_permlane32_swap(a1, b1, false, false); \
    u32x4 w = {r0[0], r1[0], r0[1], r1[1]}; OUT = __builtin_bit_cast(bf16x8, w); } while (0)
    PK4(p0, 0, pa0); PK4(p0, 8, pa1); PK4(p1, 0, pa2); PK4(p1, 8, pa3);
#undef PK4
}

namespace pat {
constexpr int LDQ = 3072, LDK = 3072, LDV = 2048, LDO = 2048;
constexpr int SHM_V = 16384, SHM_K = 24576, OFF_WS = 3 * SHM_K + 3 * SHM_V, OFF_QR = OFF_WS + 2048;
#define KSW(row, colB) ((row) * 384 + ((colB) ^ SWZF(row)))
#define DSR128(dst, addr, OFF) asm volatile("ds_read_b128 %0, %1 offset:%2" : "=v"(dst) : "v"(addr), "i"(OFF) : "memory")
#define WAITK4(N, F) asm volatile("s_waitcnt lgkmcnt(" #N ")" : "+v"(F[0]), "+v"(F[1]), "+v"(F[2]), "+v"(F[3]) :: "memory")
#define WAITK6(N, F, Q) asm volatile("s_waitcnt lgkmcnt(" #N ")" : "+v"(F[0]), "+v"(F[1]), "+v"(F[2]), "+v"(F[3]), "+v"(Q[0]), "+v"(Q[1]) :: "memory")
__device__ __forceinline__ void qkt(f32x16& p0, f32x16& p1, int ks, const bf16x8* qr, int qrow, int hi, int qsw, const int (&kbo)[2]) {
    p0 = f32x16{}; p1 = f32x16{};
    bf16x8 fa[4], fb[4], qa[2], qb[2];
    const int k0 = ks + kbo[0] + kbo[1], k1 = ks + kbo[0] + (kbo[1] ^ 32), k2 = ks + kbo[0] + (kbo[1] ^ 64), k3 = ks + kbo[0] + (kbo[1] ^ 96);
    const int q0 = qrow + (((0 + hi) ^ qsw) << 4), q1 = qrow + (((2 + hi) ^ qsw) << 4), q2 = qrow + (((4 + hi) ^ qsw) << 4), q3 = qrow + (((6 + hi) ^ qsw) << 4);
#define RDK(F, KA, KB, OFF) do { DSR128(F[0], KA, OFF); DSR128(F[1], KA, OFF + 12288); DSR128(F[2], KB, OFF); DSR128(F[3], KB, OFF + 12288); } while (0)
#define MMK(F, QA, QB) do { p0 = __builtin_amdgcn_mfma_f32_32x32x16_bf16(F[0], QA, p0, 0, 0, 0); p1 = __builtin_amdgcn_mfma_f32_32x32x16_bf16(F[1], QA, p1, 0, 0, 0); \
        p0 = __builtin_amdgcn_mfma_f32_32x32x16_bf16(F[2], QB, p0, 0, 0, 0); p1 = __builtin_amdgcn_mfma_f32_32x32x16_bf16(F[3], QB, p1, 0, 0, 0); } while (0)
    RDK(fa, k0, k1, 0);
    RDK(fb, k2, k3, 0);    WAITK4(4, fa); MMK(fa, qr[0], qr[1]);
    RDK(fa, k0, k1, 128);  WAITK4(4, fb); MMK(fb, qr[2], qr[3]);
    RDK(fb, k2, k3, 128);  WAITK4(4, fa); MMK(fa, qr[4], qr[5]);
    RDK(fa, k0, k1, 256); DSR128(qa[0], q0, 0); DSR128(qa[1], q1, 0);  WAITK4(6, fb); MMK(fb, qr[6], qr[7]);
    RDK(fb, k2, k3, 256); DSR128(qb[0], q2, 0); DSR128(qb[1], q3, 0);  WAITK6(6, fa, qa); MMK(fa, qa[0], qa[1]);
    WAITK6(0, fb, qb); MMK(fb, qb[0], qb[1]);
#undef RDK
#undef MMK
}
__device__ __forceinline__ int v_st(int k, int c) { const int kk = (k & ~0xC) | ((k & 4) << 1) | ((k & 8) >> 1); return ((kk >> 3) * 4 + (c >> 5)) * 512 + ((kk & 7) * 32 + (c & 31)) * 2; }
__device__ __forceinline__ int v_rd_base(int lane) { return ((lane & 3) << 3) | (((lane >> 2) & 3) << 6) | (((lane >> 4) & 1) << 5) | (((lane >> 5) & 1) << 8); }
constexpr int v_rd_off(int d0, int ks, int half) { return d0 * 512 + ks * 4096 + half * 2048; }
#define TRR(dst, base, OFF) asm volatile("ds_read_b64_tr_b16 %0, %1 offset:%2" : "=v"(dst) : "v"(base), "i"(OFF) : "memory")
#define WAITV8(N, L, H) asm volatile("s_waitcnt lgkmcnt(" #N ")" : "+v"(L[0]), "+v"(L[1]), "+v"(L[2]), "+v"(L[3]), "+v"(H[0]), "+v"(H[1]), "+v"(H[2]), "+v"(H[3]) :: "memory")
__device__ __forceinline__ void pv_d0(f32x16* o, int vb, bf16x8 pa0, bf16x8 pa1, bf16x8 pa2, bf16x8 pa3) {
    s16x4 la[4], ha[4], lb[4], hb[4];
#define RDV(L, H, D0) do { TRR(L[0], vb, v_rd_off(D0, 0, 0)); TRR(H[0], vb, v_rd_off(D0, 0, 1)); TRR(L[1], vb, v_rd_off(D0, 1, 0)); TRR(H[1], vb, v_rd_off(D0, 1, 1)); \
        TRR(L[2], vb, v_rd_off(D0, 2, 0)); TRR(H[2], vb, v_rd_off(D0, 2, 1)); TRR(L[3], vb, v_rd_off(D0, 3, 0)); TRR(H[3], vb, v_rd_off(D0, 3, 1)); } while (0)
#define MMV(L, H, D0) do { o[D0] = __builtin_amdgcn_mfma_f32_32x32x16_bf16(pa0, PKV(L[0], H[0]), o[D0], 0, 0, 0); o[D0] = __builtin_amdgcn_mfma_f32_32x32x16_bf16(pa1, PKV(L[1], H[1]), o[D0], 0, 0, 0); \
        o[D0] = __builtin_amdgcn_mfma_f32_32x32x16_bf16(pa2, PKV(L[2], H[2]), o[D0], 0, 0, 0); o[D0] = __builtin_amdgcn_mfma_f32_32x32x16_bf16(pa3, PKV(L[3], H[3]), o[D0], 0, 0, 0); } while (0)
    RDV(la, ha, 0);
    RDV(lb, hb, 1); WAITV8(8, la, ha); MMV(la, ha, 0);
    RDV(la, ha, 2); WAITV8(8, lb, hb); MMV(lb, hb, 1);
    RDV(lb, hb, 3); WAITV8(8, la, ha); MMV(la, ha, 2);
    WAITV8(0, lb, hb); MMV(lb, hb, 3);
#undef RDV
#undef MMV
}
__device__ __forceinline__ void unit(const bf16_t* __restrict__ Qb, const bf16_t* __restrict__ Kh, const bf16_t* __restrict__ Vh, bf16_t* __restrict__ Ob, int qb, LAS char* lds, const float* __restrict__ gq, int wv) {
    constexpr float C = MLA_C;
    int wvl = wv; asm volatile("" : "+s"(wvl)); int tid = wvl * 64 + lane_id(); asm volatile("" : "+v"(tid));
    const int wid = __builtin_amdgcn_readfirstlane(tid >> 6), lane = tid & 63, r32 = lane & 31, hi = lane >> 5;
    LAS char* K_lds = lds; LAS char* V_lds = lds + 3 * SHM_K;
    LAS float* wsf = (LAS float*)(lds + OFF_WS) + wid * 64; LAS float* li_l = wsf; LAS float* al_l = wsf + 32;
    LAS char* qlds = lds + OFF_QR + (wid * 32 + r32) * 128; const int qsw = r32 & 7; const int qrow = (int)(uintptr_t)qlds, klds = (int)(uintptr_t)K_lds;
    const int kbo[2] = {r32 * 384, (16 * hi) ^ SWZF(r32)};
    float m_reg = -1e30f, l_reg = 0; f32x16 o[4] = {}; bf16x8 qr[8];
    const bf16_t* Qw = Qb + (size_t)(wid * 32 + r32) * LDQ + hi * 8;
    {
        float ss = 0.f;
#pragma unroll
        for (int d0 = 0; d0 < 12; ++d0) { float t8[8]; unpack8(*(const u32x4*)(Qw + d0 * 16), t8);
#pragma unroll
            for (int j = 0; j < 8; ++j) ss += t8[j] * t8[j]; }
        ss += __shfl_xor(ss, 32);
        const float r = rsqrtf(ss * (1.f / 192.f) + EPS);
#define QSCALE(F, d0) do { unpack8(*(const u32x4*)(Qw + (d0) * 16), F); const f32x4 g0 = *(const f32x4*)(gq + (d0) * 16 + hi * 8), g1 = *(const f32x4*)(gq + (d0) * 16 + hi * 8 + 4); \
            F[0] *= r * g0.x; F[1] *= r * g0.y; F[2] *= r * g0.z; F[3] *= r * g0.w; F[4] *= r * g1.x; F[5] *= r * g1.y; F[6] *= r * g1.z; F[7] *= r * g1.w; } while (0)
#pragma unroll
        for (int d0 = 0; d0 < 8; ++d0) { float t8[8]; QSCALE(t8, d0); qr[d0] = __builtin_bit_cast(bf16x8, pack8(t8)); }
        const float pos = (float)(qb * 256 + wid * 32 + r32);
#pragma unroll
        for (int dd = 0; dd < 2; ++dd) { float a8[8], b8[8]; QSCALE(a8, 8 + dd); QSCALE(b8, 10 + dd);
#pragma unroll
            for (int j = 0; j < 8; ++j) { float sn, cs; fast_sincos(pos * rope_inv(16 * dd + 8 * hi + j), sn, cs);
                const float x1 = a8[j], x2 = b8[j]; a8[j] = x1 * cs - x2 * sn; b8[j] = x2 * cs + x1 * sn; }
            *(LAS u32x4*)(qlds + (((dd * 2 + hi) ^ qsw) << 4)) = pack8(a8); *(LAS u32x4*)(qlds + ((((2 + dd) * 2 + hi) ^ qsw) << 4)) = pack8(b8); }
#undef QSCALE
    }
    asm volatile("s_waitcnt vmcnt(0)" ::: "memory");
    unsigned ksrc[3], vsrc[2];
#pragma unroll
    for (int k = 0; k < 3; ++k) { const int d = (wid + 8 * k) * 1024 + lane * 16, row = d / 384, cs = (d - row * 384) >> 4, c = (cs & ~7) | ((cs & 7) ^ (SWZF(row) >> 4));
        ksrc[k] = (unsigned)(row * LDK + c * 8) * 2u; }
#pragma unroll
    for (int k = 0; k < 2; ++k) { const int d = (wid + 8 * k) * 1024 + lane * 16, sub = d >> 9, win = d & 511, kk = (sub >> 2) * 8 + (win >> 6), col = (sub & 3) * 32 + ((win & 63) >> 1);
        const int key = (kk & ~0xC) | ((kk & 4) << 1) | ((kk & 8) >> 1);
        vsrc[k] = (unsigned)(key * LDV + col) * 2u; }
#define DMA_K(t, slot) do { _Pragma("unroll") for (int k = 0; k < 3; ++k) \
        __builtin_amdgcn_global_load_lds((const unsigned*)((const char*)Kh + (size_t)(t) * (64 * LDK * 2) + ksrc[k]), (LAS unsigned*)(K_lds + (slot) + (wid + 8 * k) * 1024), 16, 0, 0); } while (0)
#define DMA_V(t, slot) do { _Pragma("unroll") for (int k = 0; k < 2; ++k) \
        __builtin_amdgcn_global_load_lds((const unsigned*)((const char*)Vh + (size_t)(t) * (64 * LDV * 2) + vsrc[k]), (LAS unsigned*)(V_lds + (slot) + (wid + 8 * k) * 1024), 16, 0, 0); } while (0)
#define WAITBAR(N) do { asm volatile("s_waitcnt vmcnt(" #N ") lgkmcnt(0)" ::: "memory"); __builtin_amdgcn_s_barrier(); asm volatile("" ::: "memory"); } while (0)
    const int vbase = (int)(uintptr_t)V_lds + v_rd_base(lane);
#define RESC(a) do { if (__any((a) < 1.f)) { if (hi == 0) al_l[r32] = (a); LDS_WAIT(); \
    _Pragma("unroll") for (int d = 0; d < 4; ++d) _Pragma("unroll") for (int r = 0; r < 16; ++r) o[d][r] *= al_l[crow(r, hi)]; } } while (0)
#define MASKT(P0, P1, tix) do { if ((tix) > mylast) { _Pragma("unroll") for (int r = 0; r < 16; ++r) { P0[r] = -1e30f; P1[r] = -1e30f; } } } while (0)
    f32x16 pA0, pA1, pB0, pB1; float mnA, mnB, alA, alB; bf16x8 pa0, pa1, pa2, pa3;
    const int NT = 4 * qb + 4, mylast = 4 * qb + (wid >> 1);
    int kc = 0, kn = SHM_K, kf = 2 * SHM_K, vp = 2 * SHM_V, vc = 0, vf = SHM_V;
#define ROT() do { const int t_ = kc; kc = kn; kn = kf; kf = t_; const int u_ = vp; vp = vc; vc = vf; vf = u_; } while (0)
    DMA_K(0, 0); DMA_V(0, 0); DMA_K(1, SHM_K);
    WAITBAR(5);
    qkt(pA0, pA1, klds + kc, qr, qrow, hi, qsw, kbo); partialSM(pA0, pA1, m_reg, mnA, alA, C);
    DMA_K(2, 2 * SHM_K); DMA_V(1, SHM_V);
    WAITBAR(5);
    ROT();
#define STEP(PC0, PC1, mnC, alC, PP0, PP1, alP, t) do { \
        SBAR(); qkt(PC0, PC1, klds + kc, qr, qrow, hi, qsw, kbo); MASKT(PC0, PC1, t); \
        finishSM(PP0, PP1, alP, l_reg, pa0, pa1, pa2, pa3); SBAR(); \
        if ((t) + 2 < NT) DMA_K((t) + 2, kf); if ((t) + 1 < NT) DMA_V((t) + 1, vf); \
        pv_d0(o, vbase + vp, pa0, pa1, pa2, pa3); partialSM(PC0, PC1, m_reg, mnC, alC, C); \
        RESC(alC); \
        if ((t) + 2 < NT) WAITBAR(5); else if ((t) + 1 < NT) WAITBAR(2); else WAITBAR(0); \
        ROT(); } while (0)
    for (int t = 1; t + 1 < NT; t += 2) {
        STEP(pB0, pB1, mnB, alB, pA0, pA1, alA, t);
        STEP(pA0, pA1, mnA, alA, pB0, pB1, alB, t + 1);
    }
    STEP(pB0, pB1, mnB, alB, pA0, pA1, alA, NT - 1);
    finishSM(pB0, pB1, alB, l_reg, pa0, pa1, pa2, pa3); SBAR();
    pv_d0(o, vbase + vp, pa0, pa1, pa2, pa3);
    if (hi == 0) li_l[r32] = l_reg; LDS_WAIT();
    float rli[16];
#pragma unroll
    for (int r = 0; r < 16; ++r) rli[r] = __builtin_amdgcn_rcpf(li_l[crow(r, hi)]);
    bf16_t* Ow = Ob + (size_t)(wid * 32) * LDO;
#pragma unroll
    for (int r = 0; r < 16; ++r) { const int orow = crow(r, hi);
#pragma unroll
        for (int d0 = 0; d0 < 4; ++d0) Ow[(size_t)orow * LDO + d0 * 32 + r32] = f2bf(o[d0][r] * rli[r]); }
    asm volatile("s_waitcnt lgkmcnt(0)" ::: "memory"); __builtin_amdgcn_s_barrier(); asm volatile("" ::: "memory");
#undef DMA_K
#undef DMA_V
#undef WAITBAR
#undef RESC
#undef MASKT
#undef ROT
#undef STEP
}
}

template <int NB> __device__ __forceinline__ void resc_shfl(f32x16 (&o)[NB], float alpha, int hi) {
    if (__any(alpha < 1.f)) {
#pragma unroll
        for (int r = 0; r < 16; ++r) { const float a = __shfl(alpha, crow(r, hi));
#pragma unroll
            for (int d = 0; d < NB; ++d) o[d][r] *= a; }
    }
}

namespace sat {
constexpr int ROWB = 1152, TKEYS = 64, CT_BYTES = TKEYS * ROWB, BUF_BYTES = CT_BYTES + 1024, NT = 4160 / TKEYS, OLB = 1040;
typedef float f32x4v __attribute__((ext_vector_type(4)));
__device__ __forceinline__ int swz2(int row) { return (((row & 2) << 1) | ((row & 4) >> 1)) << 4; }
__device__ __forceinline__ int coff(int row, int colB) { return row * ROWB + (colB ^ swz2(row)); }
template <int MODE = 0>
__device__ __forceinline__ void unit(const Args& P, int b, int hp, LAS char* lds, int wv) {
    unsigned char* ws = P.ws;
    int wvl = wv; asm volatile("" : "+s"(wvl)); int tid = wvl * 64 + lane_id(); asm volatile("" : "+v"(tid));
    const int wid = __builtin_amdgcn_readfirstlane(tid >> 6), lane = tid & 63, i16 = lane & 15, g = lane >> 4;
    const int hl = wid >> 2, qb = (wid >> 1) & 1, ch = wid & 1, h = 2 * hp + hl;
    const char* LATb = (const char*)((const bf16_t*)(ws + WS_LATS) + (size_t)b * KPAD * 512);
    const char* KRb = (const char*)((const bf16_t*)(ws + WS_KRS) + (size_t)b * KPAD * 64);
    const char* RKb = (const char*)((const float*)(ws + WS_RKG) + (size_t)b * KPAD * 16 + (2 * hp & ~3));
    bf16x8 qa[18];
    { const bf16_t* Qh = (const bf16_t*)(ws + WS_Q) + (size_t)(TP + b * 32 + 16 * qb + i16) * QLD + h * 192;
      const float* gk = P.in[I_GKHEAD]; const float* gq = P.in[I_GQHEAD];
      bf16x8 qg[4];
      float fn[4][8], fr[2][8]; float ss = 0.f;
#pragma unroll
      for (int kd = 0; kd < 4; ++kd) { unpack8(*(const u32x4*)(Qh + kd * 32 + g * 8), fn[kd]);
#pragma unroll
          for (int j = 0; j < 8; ++j) ss += fn[kd][j] * fn[kd][j]; }
#pragma unroll
      for (int kr = 0; kr < 2; ++kr) { unpack8(*(const u32x4*)(Qh + 128 + kr * 32 + g * 8), fr[kr]);
#pragma unroll
          for (int j = 0; j < 8; ++j) ss += fr[kr][j] * fr[kr][j]; }
      ss += __shfl_xor(ss, 16); ss += __shfl_xor(ss, 32);
      const float rq = rsqrtf(ss * (1.f / 192.f) + EPS);
#pragma unroll
      for (int kd = 0; kd < 4; ++kd) { float f[8];
#pragma unroll
          for (int j = 0; j < 8; ++j) f[j] = fn[kd][j] * rq * gq[kd * 32 + g * 8 + j] * gk[kd * 32 + g * 8 + j];
          qg[kd] = __builtin_bit_cast(bf16x8, pack8(f)); }
      { const float pos = (float)(4096 + 16 * qb + i16);
#pragma unroll
        for (int j = 0; j < 8; ++j) { float sn, cs; fast_sincos(pos * rope_inv(8 * g + j), sn, cs);
            const float x1 = fr[0][j] * rq * gq[128 + 8 * g + j], x2 = fr[1][j] * rq * gq[160 + 8 * g + j]; fr[0][j] = x1 * cs - x2 * sn; fr[1][j] = x2 * cs + x1 * sn; } }
      const bf16_t* Wn = (const bf16_t*)(ws + WS_WKBN) + (size_t)(8 * (i16 >> 2) + (i16 & 3)) * 2048 + h * 128 + g * 8;
#pragma unroll
      for (int ks = 0; ks < 16; ++ks) { f32x4 a0 = {0.f, 0.f, 0.f, 0.f}, a1 = a0;
#pragma unroll
          for (int kd = 0; kd < 4; ++kd) {
              const bf16x8 w0 = *(const bf16x8*)(Wn + (size_t)(32 * ks) * 2048 + kd * 32), w1 = *(const bf16x8*)(Wn + (size_t)(32 * ks + 4) * 2048 + kd * 32);
              a0 = __builtin_amdgcn_mfma_f32_16x16x32_bf16(w0, qg[kd], a0, 0, 0, 0); a1 = __builtin_amdgcn_mfma_f32_16x16x32_bf16(w1, qg[kd], a1, 0, 0, 0); }
          qa[ks] = __builtin_bit_cast(bf16x8, (u32x4){cvtpk(a0[0], a0[1]), cvtpk(a0[2], a0[3]), cvtpk(a1[0], a1[1]), cvtpk(a1[2], a1[3])});
          if ((ks & 3) == 3) asm volatile("" ::: "memory"); }
      qa[16] = __builtin_bit_cast(bf16x8, pack8(fr[0])); qa[17] = __builtin_bit_cast(bf16x8, pack8(fr[1])); }
    asm volatile("s_waitcnt vmcnt(0)" ::: "memory");
    unsigned soff[10]; unsigned kmask = 0u;
#pragma unroll
    for (int k = 0; k < 10; ++k) { const int p = wid + 8 * k;
        if (p < 72) { const int d = p * 1024 + lane * 16, row = d / ROWB, cs = (d - row * ROWB) >> 4, c = (cs & ~7) | ((cs & 7) ^ (swz2(row) >> 4));
            if (c >= 64) { kmask |= 1u << (2 * k); soff[k] = (unsigned)(row * 128 + (c - 64) * 16); } else soff[k] = (unsigned)(row * 1024 + c * 16); }
        else { kmask |= 2u << (2 * k); soff[k] = (unsigned)(lane * 64); } }
#define TDMA(j, bufoff) do { _Pragma("unroll") for (int k = 0; k < 10; ++k) { const int p_ = wid + 8 * k; if (p_ < 73) { const unsigned kd_ = (kmask >> (2 * k)) & 3u; \
        const char* sp_ = kd_ == 0u ? LATb + (size_t)(j) * (64 * 1024) + soff[k] : (kd_ == 1u ? KRb + (size_t)(j) * (64 * 128) + soff[k] : RKb + (size_t)(j) * (64 * 64) + soff[k]); \
        __builtin_amdgcn_global_load_lds((const unsigned*)sp_, (LAS unsigned*)(lds + (bufoff) + p_ * 1024), 16, 0, 0); } } } while (0)
    const int sw = swz2(i16);
    const int ao0 = i16 * ROWB + ((16 * g) ^ sw), ao1 = i16 * ROWB + ((64 + 16 * g) ^ sw);
    int trb[4];
    { const int row = 4 * g + (i16 >> 2), sr = swz2(row);
#pragma unroll
      for (int c4 = 0; c4 < 4; ++c4) trb[c4] = row * ROWB + ((512 * ch + 32 * c4 + 8 * (i16 & 3)) ^ sr) - ((512 * ch) & 0) ; }
    const int rko = CT_BYTES + (4 * g) * 16 + ((2 * hp & 3) + hl) * 4;
    float m_reg = 0.f, l_reg = 0.f; f32x4 o[16]; bf16x8 pown, poth;
#pragma unroll
    for (int d = 0; d < 16; ++d) o[d] = (f32x4){0.f, 0.f, 0.f, 0.f};
    TDMA(0, 0);
    asm volatile("s_waitcnt vmcnt(0)" ::: "memory");
    __builtin_amdgcn_s_barrier(); asm volatile("" ::: "memory");
    int cur = 0;
    for (int j = 0; j < NT; ++j) {
        const LAS char* CTb = lds + cur;
        if (MODE != 1) { if (j + 1 < NT) TDMA(j + 1, cur ? 0 : BUF_BYTES); }
        if (MODE != 2) {
        f32x4 sk[2] = {(f32x4){0.f, 0.f, 0.f, 0.f}, (f32x4){0.f, 0.f, 0.f, 0.f}};
        { const int sa0 = (int)(uintptr_t)CTb + ao0 + ch * 32 * ROWB, sa1 = (int)(uintptr_t)CTb + ao1 + ch * 32 * ROWB;
          bf16x8 fa[4], fb[4], fc[4];
#define RDS(F, n) do { DSR128(F[0], sa0, (n) * 128); DSR128(F[1], sa0, (n) * 128 + 16 * ROWB); DSR128(F[2], sa1, (n) * 128); DSR128(F[3], sa1, (n) * 128 + 16 * ROWB); } while (0)
#define MMS(F, n) do { sk[0] = __builtin_amdgcn_mfma_f32_16x16x32_bf16(F[0], qa[2 * (n)], sk[0], 0, 0, 0); sk[1] = __builtin_amdgcn_mfma_f32_16x16x32_bf16(F[1], qa[2 * (n)], sk[1], 0, 0, 0); \
              sk[0] = __builtin_amdgcn_mfma_f32_16x16x32_bf16(F[2], qa[2 * (n) + 1], sk[0], 0, 0, 0); sk[1] = __builtin_amdgcn_mfma_f32_16x16x32_bf16(F[3], qa[2 * (n) + 1], sk[1], 0, 0, 0); } while (0)
          RDS(fa, 0); RDS(fb, 1);
          RDS(fc, 2); WAITK4(8, fa); MMS(fa, 0);
          RDS(fa, 3); WAITK4(8, fb); MMS(fb, 1);
          RDS(fb, 4); WAITK4(8, fc); MMS(fc, 2);
          RDS(fc, 5); WAITK4(8, fa); MMS(fa, 3);
          RDS(fa, 6); WAITK4(8, fb); MMS(fb, 4);
          RDS(fb, 7); WAITK4(8, fc); MMS(fc, 5);
          RDS(fc, 8); WAITK4(8, fa); MMS(fa, 6);
          WAITK4(4, fb); MMS(fb, 7);
          WAITK4(0, fc); MMS(fc, 8);
#undef RDS
#undef MMS
        }
        float e8[8]; float mloc = -1e30f;
#pragma unroll
        for (int kb = 0; kb < 2; ++kb)
#pragma unroll
            for (int r = 0; r < 4; ++r) { float v = sk[kb][r] * *(const LAS float*)(CTb + rko + (32 * ch + 16 * kb + r) * 16);
                if (j == NT - 1 && ch == 1) v = -1e30f;
                mloc = fmaxf(mloc, v); e8[4 * kb + r] = __builtin_amdgcn_exp2f(v - m_reg); }
        mloc = fmaxf(mloc, __shfl_xor(mloc, 16)); mloc = fmaxf(mloc, __shfl_xor(mloc, 32));
        { LAS char* xb = (LAS char*)lds + 2 * BUF_BYTES;
          *(LAS u32x4*)(xb + wid * 1024 + lane * 16) = (u32x4){cvtpk(e8[0], e8[1]), cvtpk(e8[2], e8[3]), cvtpk(e8[4], e8[5]), cvtpk(e8[6], e8[7])};
          if (g == 0) *(LAS float*)(xb + 8192 + wid * 64 + i16 * 4) = mloc;
          asm volatile("s_waitcnt lgkmcnt(0)" ::: "memory"); __builtin_amdgcn_s_barrier(); asm volatile("" ::: "memory");
          const u32x4 pp = *(const LAS u32x4*)(xb + (wid ^ 1) * 1024 + lane * 16); const float mp = *(const LAS float*)(xb + 8192 + (wid ^ 1) * 64 + i16 * 4);
          const float mc = fmaxf(mloc, mp); float f = 1.f;
          if (!__builtin_expect(__all(mc - m_reg <= 11.5f), 1)) { const float mn = fmaxf(m_reg, mc); f = __builtin_amdgcn_exp2f(m_reg - mn); m_reg = mn; }
          float q8[8]; unpack8(pp, q8);
          float ps = 0.f;
#pragma unroll
          for (int i = 0; i < 8; ++i) { e8[i] *= f; q8[i] *= f; ps += e8[i] + q8[i]; }
          ps += __shfl_xor(ps, 16); ps += __shfl_xor(ps, 32);
          l_reg = l_reg * f + ps;
          if (__any(f < 1.f)) {
              const float a0 = __shfl(f, 4 * g), a1 = __shfl(f, 4 * g + 1), a2 = __shfl(f, 4 * g + 2), a3 = __shfl(f, 4 * g + 3);
#pragma unroll
              for (int d = 0; d < 16; ++d) { o[d][0] *= a0; o[d][1] *= a1; o[d][2] *= a2; o[d][3] *= a3; } }
          e8[0] = e8[0];
          pown = __builtin_bit_cast(bf16x8, pack8(e8)); poth = __builtin_bit_cast(bf16x8, pack8(q8)); }
        const bf16x8 pa0 = ch == 0 ? pown : poth, pa1 = ch == 0 ? poth : pown;
        const int ctb = (int)(uintptr_t)CTb;
        { s16x4 la[4], ha[4], lb[4], hb[4];
#define RDP(L, H, G) do { const int tb_ = ctb + trb[(G) & 3]; constexpr int o_ = ((G) >> 2) * 256; \
            TRR(L[0], tb_, o_); TRR(H[0], tb_, o_ + 16 * ROWB); TRR(L[1], tb_, o_ + 32 * ROWB); TRR(H[1], tb_, o_ + 48 * ROWB); \
            TRR(L[2], tb_, o_ + 128); TRR(H[2], tb_, o_ + 128 + 16 * ROWB); TRR(L[3], tb_, o_ + 128 + 32 * ROWB); TRR(H[3], tb_, o_ + 128 + 48 * ROWB); } while (0)
#define MMP(L, H, G) do { constexpr int d_ = ((G) & 3) + 8 * ((G) >> 2); \
            o[d_] = __builtin_amdgcn_mfma_f32_16x16x32_bf16(pa0, PKV(L[0], H[0]), o[d_], 0, 0, 0); o[d_] = __builtin_amdgcn_mfma_f32_16x16x32_bf16(pa1, PKV(L[1], H[1]), o[d_], 0, 0, 0); \
            o[d_ + 4] = __builtin_amdgcn_mfma_f32_16x16x32_bf16(pa0, PKV(L[2], H[2]), o[d_ + 4], 0, 0, 0); o[d_ + 4] = __builtin_amdgcn_mfma_f32_16x16x32_bf16(pa1, PKV(L[3], H[3]), o[d_ + 4], 0, 0, 0); } while (0)
          RDP(la, ha, 0);
          RDP(lb, hb, 1); WAITV8(8, la, ha); MMP(la, ha, 0);
          RDP(la, ha, 2); WAITV8(8, lb, hb); MMP(lb, hb, 1);
          RDP(lb, hb, 3); WAITV8(8, la, ha); MMP(la, ha, 2);
          RDP(la, ha, 4); WAITV8(8, lb, hb); MMP(lb, hb, 3);
          RDP(lb, hb, 5); WAITV8(8, la, ha); MMP(la, ha, 4);
          RDP(la, ha, 6); WAITV8(8, lb, hb); MMP(lb, hb, 5);
          RDP(lb, hb, 7); WAITV8(8, la, ha); MMP(la, ha, 6);
          WAITV8(0, lb, hb); MMP(lb, hb, 7);
#undef RDP
#undef MMP
        }
        }
        asm volatile("s_waitcnt vmcnt(0) lgkmcnt(0)" ::: "memory");
        __builtin_amdgcn_s_barrier(); asm volatile("" ::: "memory");
        cur = cur ? 0 : BUF_BYTES;
    }
    asm volatile("s_waitcnt vmcnt(0)" ::: "memory");
    { const float rl = __builtin_amdgcn_rcpf(l_reg);
      const float r0 = __shfl(rl, 4 * g), r1 = __shfl(rl, 4 * g + 1), r2 = __shfl(rl, 4 * g + 2), r3 = __shfl(rl, 4 * g + 3);
      LAS bf16_t* OL = (LAS bf16_t*)(lds + hl * 32 * OLB) + (16 * qb + 4 * g) * (OLB / 2) + 256 * ch + i16;
#pragma unroll
      for (int d = 0; d < 16; ++d) { OL[16 * d] = f2bf(o[d][0] * r0); OL[(OLB / 2) + 16 * d] = f2bf(o[d][1] * r1); OL[2 * (OLB / 2) + 16 * d] = f2bf(o[d][2] * r2); OL[3 * (OLB / 2) + 16 * d] = f2bf(o[d][3] * r3); }
      __syncthreads();
      const int r32 = lane & 31, hi = lane >> 5, wq = wid & 3;
      f32x16 acc = f32x16{};
      const bf16_t* Wv = (const bf16_t*)(ws + WS_WVB) + (size_t)(h * 128 + 32 * wq + r32) * 512 + hi * 8;
      const LAS char* ar = lds + hl * 32 * OLB + r32 * OLB + hi * 16;
#pragma unroll 8
      for (int ks = 0; ks < 32; ++ks) { const bf16x8 a = *(const LAS bf16x8*)(ar + ks * 32); const bf16x8 bw = *(const bf16x8*)(Wv + ks * 16);
          acc = __builtin_amdgcn_mfma_f32_32x32x16_bf16(a, bw, acc, 0, 0, 0); }
      bf16_t* Ow = (bf16_t*)(ws + WS_OMLA) + (size_t)(TP + b * 32) * 2048 + h * 128 + 32 * wq + r32;
#pragma unroll
      for (int r = 0; r < 16; ++r) Ow[(size_t)crow(r, hi) * 2048] = f2bf(acc[r]);
      __syncthreads(); }
#undef TDMA
}
}


struct MergeSched {
    const bf16_t *D, *WP, *OML, *WML, *OME, *WME; int G, c;
    __device__ __forceinline__ void seg_ptrs(pg8::Unit& u, int seg, int pm, int pn, int kt0) const {
        if (seg == 0) { u.A = (const char*)(D + (size_t)pm * 256 * 1024 + (pn >> 1) * 256); u.lda2 = 2048u; u.B = (const char*)(WP + (size_t)pn * 256 * 256); u.ldb2 = 512u; }
        else if (seg == 1) { u.A = (const char*)(OML + (size_t)pm * 256 * 2048 + kt0 * 64); u.lda2 = 4096u; u.B = (const char*)(WML + (size_t)pn * 256 * 2048 + kt0 * 64); u.ldb2 = 4096u; }
        else { u.A = (const char*)(OME + (size_t)pm * 256 * 1024 + kt0 * 64); u.lda2 = 2048u; u.B = (const char*)(WME + (size_t)pn * 256 * 1024 + kt0 * 64); u.ldb2 = 2048u; }
    }
    __device__ __forceinline__ bool next(int i, pg8::Unit& u) const {
        const int nmain = c < 256 ? (256 - c + G - 1) / G : 0;
        if (i < 3 * nmain) { const int ti = i / 3, seg = i - 3 * ti; int pm, pn; pg8::tile_of(ti * G + c, 32, 8, pm, pn); u.pm = pm; u.pn = pn; u.kind = seg; u.aux = 0;
            seg_ptrs(u, seg, pm, pn, 0); u.nt = seg == 0 ? 4 : (seg == 1 ? 32 : 16); return true; }
        const long p = (long)(i - 3 * nmain) * G + c; if (p >= 16 * 13) return false;
        const int t = (int)p / 13, piece = (int)p - 13 * t, pm = 32 + (t >> 3), pn = t & 7, seg = piece == 0 ? 0 : (piece < 9 ? 1 : 2);
        u.pm = pm; u.pn = pn; u.kind = 3 + seg; u.aux = (int)p; u.nt = 4;
        seg_ptrs(u, seg, pm, pn, seg == 1 ? (piece - 1) * 4 : (seg == 2 ? (piece - 9) * 4 : 0)); return true;
    }
};
struct TailSched {
    const bf16_t* A; const bf16_t* B; int K, G, c;
    __device__ __forceinline__ bool next(int i, pg8::Unit& u) const {
        const int nmain = c < 256 ? (256 - c + G - 1) / G : 0;
        u.lda2 = (unsigned)K * 2u; u.ldb2 = u.lda2;
        if (i < nmain) { int pm, pn; pg8::tile_of(i * G + c, 32, 8, pm, pn); u.pm = pm; u.pn = pn; u.kind = 0; u.aux = 0; u.nt = K / 64;
            u.A = (const char*)(A + (size_t)pm * 256 * K); u.B = (const char*)(B + (size_t)pn * 256 * K); return true; }
        const long p = (long)(i - nmain) * G + c; if (p >= 256) return false;
        const int t = (int)p >> 4, piece = (int)p & 15, pm = 32 + (t >> 3), pn = t & 7, ntp = K / 64 / 16;
        u.pm = pm; u.pn = pn; u.kind = 1; u.aux = (int)p; u.nt = ntp;
        u.A = (const char*)(A + (size_t)pm * 256 * K + piece * ntp * 64); u.B = (const char*)(B + (size_t)pn * 256 * K + piece * ntp * 64); return true;
    }
};
struct EpiMerge {
    static constexpr bool PERM = true;
    const bf16_t* G; const float* ps; bf16_t* MG; unsigned char* slab;
    __device__ __forceinline__ bool operator()(f32x4 (&acc)[2][2][4][2], const pg8::Unit& u, int wr, int wc, int fr_, int fq) const {
        int fr = fr_; asm volatile("" : "+v"(fr));
        const int row0 = u.pm * 256 + wr * 64 + fr, c0 = u.pn * 256 + wc * 32 + 8 * fq;
        const int kind = u.kind, sg = kind >= 3 ? kind - 3 : kind;
        const bool ratio = kind < 2;
        unsigned char* sl = slab + (size_t)u.aux * 131072 + (wr * 64 + fr) * 512 + (wc * 32 + 8 * fq) * 2;
        f32x4 pv[2][2];
#pragma unroll
        for (int bj = 0; bj < 2; ++bj) { pv[bj][0] = (f32x4){1.f, 1.f, 1.f, 1.f}; pv[bj][1] = pv[bj][0]; }
        if (sg == 0) {
#pragma unroll
            for (int bj = 0; bj < 2; ++bj) { pv[bj][0] = *(const f32x4*)(ps + c0 + bj * 128); pv[bj][1] = *(const f32x4*)(ps + c0 + bj * 128 + 4); }
        }
#pragma unroll
        for (int ai = 0; ai < 2; ++ai) {
            u32x4 ga[4][2], gb[4][2];
#pragma unroll
            for (int m = 0; m < 4; ++m) { const bf16_t* gr = G + (size_t)(row0 + ai * 128 + m * 16) * G_LD + sg * 2048 + c0;
#pragma unroll
                for (int bj = 0; bj < 2; ++bj) { ga[m][bj] = *(const u32x4*)(gr + bj * 128); gb[m][bj] = ratio ? *(const u32x4*)(gr + 2048 + bj * 128) : (u32x4){0u, 0u, 0u, 0u}; } }
            asm volatile("" ::: "memory");
#pragma unroll
            for (int m = 0; m < 4; ++m) { const size_t row = (size_t)(row0 + ai * 128 + m * 16);
#pragma unroll
                for (int bj = 0; bj < 2; ++bj) {
                    float f[8]; unpack8(ga[m][bj], f);
                    if (ratio) { float b[8]; unpack8(gb[m][bj], b);
#pragma unroll
                        for (int e = 0; e < 8; ++e) f[e] *= __builtin_amdgcn_rcpf(b[e]); }
#pragma unroll
                    for (int e = 0; e < 8; ++e) f[e] *= pv[bj][e >> 2][e & 3];
                    f32x4& v0 = acc[ai][bj][m][0]; f32x4& v1 = acc[ai][bj][m][1];
                    v0[0] *= f[0]; v0[1] *= f[1]; v0[2] *= f[2]; v0[3] *= f[3]; v1[0] *= f[4]; v1[1] *= f[5]; v1[2] *= f[6]; v1[3] *= f[7];
                    const u32x4 pk = (u32x4){cvtpk(v0[0], v0[1]), cvtpk(v0[2], v0[3]), cvtpk(v1[0], v1[1]), cvtpk(v1[2], v1[3])};
                    if (kind == 2) *(u32x4*)(MG + row * 2048 + c0 + bj * 128) = pk;
                    else if (kind >= 3) *(u32x4*)(sl + (ai * 128 + m * 16) * 512 + bj * 256) = pk;
                } }
            asm volatile("" ::: "memory");
        }
        return kind < 2;
    }
};
__device__ __forceinline__ int slab_col(int u) { return (u >> 5) * 128 + ((u >> 3) & 3) * 32 + (u & 1) * 16 + ((u >> 1) & 3) * 4; }
__device__ __forceinline__ void store_slab(const f32x4 (&acc)[2][2][4][2], unsigned char* sl, int wr, int wc, int fr, int fq) {
    unsigned char* s0 = sl + (wr * 64 + fr) * 512 + (wc * 4 + fq) * 16;
#pragma unroll
    for (int ai = 0; ai < 2; ++ai)
#pragma unroll
        for (int m = 0; m < 4; ++m)
#pragma unroll
            for (int bj = 0; bj < 2; ++bj) { const f32x4 a = acc[ai][bj][m][0], b = acc[ai][bj][m][1];
                *(u32x4*)(s0 + (ai * 128 + m * 16) * 512 + bj * 256) = (u32x4){cvtpk(a[0], a[1]), cvtpk(a[2], a[3]), cvtpk(b[0], b[1]), cvtpk(b[2], b[3])}; }
}
struct EpiOut {
    static constexpr bool PERM = false;
    const float* xp; const float* xs; float* X1; bf16_t* X1b; float* SSX; unsigned char* slab;
    __device__ __forceinline__ bool operator()(f32x4 (&acc)[2][2][4][2], const pg8::Unit& u, int wr, int wc, int fr_, int fq) const {
        int fr = fr_; asm volatile("" : "+v"(fr));
        const int row0 = u.pm * 256 + wr * 64 + fr, c0 = u.pn * 256 + wc * 32 + 4 * fq;
        if (u.kind == 1) { store_slab(acc, slab + (size_t)u.aux * 131072, wr, wc, fr, fq); return false; }
#pragma unroll
        for (int ai = 0; ai < 2; ++ai) {
            f32x4 xv[4][2][2];
#pragma unroll
            for (int m = 0; m < 4; ++m) { const int row = row0 + ai * 128 + m * 16;
                const float* xr = (row < TP ? xp + (size_t)row * DM : xs + (size_t)(row - TP) * DM) + c0;
#pragma unroll
                for (int bj = 0; bj < 2; ++bj)
#pragma unroll
                    for (int n = 0; n < 2; ++n) xv[m][bj][n] = __builtin_nontemporal_load((const f32x4*)(xr + bj * 128 + n * 16)); }
            asm volatile("" ::: "memory");
#pragma unroll
            for (int m = 0; m < 4; ++m) { const int row = row0 + ai * 128 + m * 16; float s = 0.f;
#pragma unroll
                for (int bj = 0; bj < 2; ++bj)
#pragma unroll
                    for (int n = 0; n < 2; ++n) { const f32x4 v = acc[ai][bj][m][n] + xv[m][bj][n];
                        s += (v.x * v.x + v.y * v.y) + (v.z * v.z + v.w * v.w);
                        *(u32x2*)(X1b + (size_t)row * DM + c0 + bj * 128 + n * 16) = (u32x2){cvtpk(v.x, v.y), cvtpk(v.z, v.w)}; }
                s = rows4_sum(s);
                if (fq == 0) SSX[(size_t)row * 32 + u.pn * 4 + wc] = s; }
            asm volatile("" ::: "memory");
        }
        return false;
    }
};
struct SchedJ {
    const unsigned char* A; const unsigned char* B; int G, c;
    __device__ __forceinline__ bool next(int i, pg8::Unit& u) const {
        const long L = (long)i * G + c; if (L >= 1024) return false; int pm, pn; pg8::tile_of((int)L, 32, 32, pm, pn);
        u.lda2 = 2048u; u.ldb2 = 2048u; u.kind = 0; u.aux = 0; u.nt = 16; u.A = (const char*)(A + (size_t)pm * 256 * 2048); u.B = (const char*)(B + (size_t)pn * 256 * 2048); u.pm = pm; u.pn = pn; return true;
    }
};
struct SchedJp {
    const bf16_t* A; const bf16_t* B; int G, c;
    __device__ __forceinline__ bool next(int i, pg8::Unit& u) const {
        const long p = (long)i * G + c; if (p >= 256) return false;
        const int ts = (int)p >> 2, piece = (int)p & 3, pm = 32 + (ts >> 5), pn = ts & 31; u.kind = 1; u.aux = (int)p; u.nt = 8; u.lda2 = 4096u; u.ldb2 = 4096u;
        u.A = (const char*)(A + (size_t)pm * 256 * 2048 + piece * 512); u.B = (const char*)(B + (size_t)pn * 256 * 2048 + piece * 512); u.pm = pm; u.pn = pn; return true;
    }
};
struct EpiUp {
    static constexpr bool PERM = true;
    const float* SSX; bf16_t* A; unsigned char* slab; const float* SAX; const float* SBU;
    __device__ __forceinline__ bool operator()(f32x4 (&acc)[2][2][4][2], const pg8::Unit& u, int wr, int wc, int fr_, int fq) const {
        int fr = fr_; asm volatile("" : "+v"(fr));
        const int row0 = u.pm * 256 + wr * 64 + fr, c0 = u.pn * 256 + wc * 32 + 8 * fq;
        if (u.kind == 1) {
            unsigned char* sl = slab + (size_t)u.aux * 131072 + (wr * 64 + fr) * 512 + (wc * 32 + 8 * fq) * 2;
#pragma unroll
            for (int ai = 0; ai < 2; ++ai)
#pragma unroll
                for (int m = 0; m < 4; ++m)
#pragma unroll
                    for (int bj = 0; bj < 2; ++bj) { const f32x4 v0 = acc[ai][bj][m][0], v1 = acc[ai][bj][m][1];
                        *(u32x4*)(sl + (ai * 128 + m * 16) * 512 + bj * 256) = (u32x4){cvtpk(v0[0], v0[1]), cvtpk(v0[2], v0[3]), cvtpk(v1[0], v1[1]), cvtpk(v1[2], v1[3])}; }
            return false; }
        f32x4 sbu[2][2]; float sax[2][4];
#pragma unroll
        for (int ai = 0; ai < 2; ++ai)
#pragma unroll
            for (int m = 0; m < 4; ++m) sax[ai][m] = SAX[(size_t)(row0 + ai * 128 + m * 16)];
#pragma unroll
        for (int bj = 0; bj < 2; ++bj) { sbu[bj][0] = *(const f32x4*)(SBU + c0 + bj * 128); sbu[bj][1] = *(const f32x4*)(SBU + c0 + bj * 128 + 4); }
        asm volatile("" ::: "memory");
#pragma unroll
        for (int ai = 0; ai < 2; ++ai)
#pragma unroll
            for (int m = 0; m < 4; ++m) { const size_t row = (size_t)(row0 + ai * 128 + m * 16);
                const float r = sax[ai][m];
#pragma unroll
                for (int bj = 0; bj < 2; ++bj) { const pg8::i32x4 i0 = __builtin_bit_cast(pg8::i32x4, acc[ai][bj][m][0]), i1 = __builtin_bit_cast(pg8::i32x4, acc[ai][bj][m][1]);
                    f32x4 v0 = (f32x4){(float)i0[0], (float)i0[1], (float)i0[2], (float)i0[3]} * sbu[bj][0] * r, v1 = (f32x4){(float)i1[0], (float)i1[1], (float)i1[2], (float)i1[3]} * sbu[bj][1] * r;
#pragma unroll
                    for (int e = 0; e < 4; ++e) { const float a = fmaxf(v0[e], 0.f), b = fmaxf(v1[e], 0.f); v0[e] = a * a; v1[e] = b * b; }
                    *(u32x4*)(A + row * 8192 + c0 + bj * 128) = (u32x4){cvtpk(v0[0], v0[1]), cvtpk(v0[2], v0[3]), cvtpk(v1[0], v1[1]), cvtpk(v1[2], v1[3])}; } }
        return false;
    }
};
struct EpiDown {
    static constexpr bool PERM = false;
    float* Y; const bf16_t* X1b; unsigned char* slab;
    __device__ __forceinline__ bool operator()(f32x4 (&acc)[2][2][4][2], const pg8::Unit& u, int wr, int wc, int fr_, int fq) const {
        int fr = fr_; asm volatile("" : "+v"(fr));
        const int row0 = u.pm * 256 + wr * 64 + fr, c0 = u.pn * 256 + wc * 32 + 4 * fq;
        if (u.kind == 1) { store_slab(acc, slab + (size_t)u.aux * 131072, wr, wc, fr, fq); return false; }
        u32x2 xv[2][4][2][2];
#pragma unroll
        for (int ai = 0; ai < 2; ++ai)
#pragma unroll
            for (int m = 0; m < 4; ++m) { const bf16_t* xr = X1b + (size_t)(row0 + ai * 128 + m * 16) * DM + c0;
#pragma unroll
                for (int bj = 0; bj < 2; ++bj)
#pragma unroll
                    for (int n = 0; n < 2; ++n) xv[ai][m][bj][n] = *(const u32x2*)(xr + bj * 128 + n * 16); }
        asm volatile("" ::: "memory");
#pragma unroll
        for (int ai = 0; ai < 2; ++ai)
#pragma unroll
            for (int m = 0; m < 4; ++m) { float* yr = Y + (size_t)(row0 + ai * 128 + m * 16) * DM + c0;
#pragma unroll
                for (int bj = 0; bj < 2; ++bj)
#pragma unroll
                    for (int n = 0; n < 2; ++n) { const u32x2 w = xv[ai][m][bj][n];
                        __builtin_nontemporal_store((f32x4){bflo(w.x), bfhi(w.x), bflo(w.y), bfhi(w.y)} + acc[ai][bj][m][n], (f32x4*)(yr + bj * 128 + n * 16)); } }
        return false;
    }
};
template <int NP> __device__ __forceinline__ f32x4 slab_sum(const unsigned char* slab, int t, int r, int lane) {
    const unsigned char* sp = slab + ((size_t)t * NP) * 131072 + r * 512 + lane * 8;
    u32x2 w[NP];
#pragma unroll
    for (int p = 0; p < NP; ++p) w[p] = *(const u32x2*)(sp + (size_t)p * 131072);
    f32x4 s = (f32x4){bflo(w[0].x), bfhi(w[0].x), bflo(w[0].y), bfhi(w[0].y)};
#pragma unroll
    for (int p = 1; p < NP; ++p) s += (f32x4){bflo(w[p].x), bfhi(w[p].x), bflo(w[p].y), bfhi(w[p].y)};
    return s;
}
__device__ __forceinline__ void reduce_merge(const unsigned char* slab, bf16_t* MG, int gw, int NGW, int lane) {
    for (int it = gw; it < TS * 4; it += NGW) { const int rs = it >> 2, q = it & 3, r = rs & 255, t0 = (rs >> 8) * 8;
#pragma unroll
        for (int pn = 2 * q; pn < 2 * q + 2; ++pn) { const f32x4 s = slab_sum<13>(slab, t0 + pn, r, lane);
            *(u32x2*)(MG + (size_t)(TP + rs) * DM + pn * 256 + lane * 4) = (u32x2){cvtpk(s.x, s.y), cvtpk(s.z, s.w)}; } }
}
__device__ __forceinline__ void reduce_out(const unsigned char* slab, const float* xs, float* X1, bf16_t* X1b, float* SSX, int gw, int NGW, int lane) {
    const int cl = slab_col(lane);
    for (int it = gw; it < TS * 4; it += NGW) { const int rs = it >> 2, q = it & 3, r = rs & 255, t0 = (rs >> 8) * 8; float ss = 0.f;
#pragma unroll
        for (int pn = 2 * q; pn < 2 * q + 2; ++pn) { const size_t o = (size_t)rs * DM + pn * 256 + cl;
            const f32x4 v = slab_sum<16>(slab, t0 + pn, r, lane) + *(const f32x4*)(xs + o);
            ss += (v.x * v.x + v.y * v.y) + (v.z * v.z + v.w * v.w);
            *(u32x2*)(X1b + (size_t)TP * DM + o) = (u32x2){cvtpk(v.x, v.y), cvtpk(v.z, v.w)}; }
        ss = wave_sum(ss);
        if (lane < 8) SSX[(size_t)(TP + rs) * 32 + q * 8 + lane] = lane == 0 ? ss : 0.f; }
}
__device__ __forceinline__ void reduce_down(const unsigned char* slab, const bf16_t* X1b, float* Y, int gw, int NGW, int lane) {
    const int cl = slab_col(lane);
    for (int it = gw; it < TS * 4; it += NGW) { const int rs = it >> 2, q = it & 3, r = rs & 255, t0 = (rs >> 8) * 8;
#pragma unroll
        for (int pn = 2 * q; pn < 2 * q + 2; ++pn) { const size_t o = (size_t)(TP + rs) * DM + pn * 256 + cl; const u32x2 w = *(const u32x2*)(X1b + o);
            *(f32x4*)(Y + o) = (f32x4){bflo(w.x), bfhi(w.x), bflo(w.y), bfhi(w.y)} + slab_sum<16>(slab, t0 + pn, r, lane); } }
}

__device__ __forceinline__ void reduce_up(const unsigned char* slab, const float* SSX, bf16_t* A, int gw, int NGW, int lane) {
    for (int it = gw; it < TS * 8; it += NGW) { const int rs = it >> 3, q = it & 7, r = rs & 255, t0 = (rs >> 8) * 32 + q * 4;
        const float sx = SSX[(size_t)(TP + rs) * 32 + (lane & 31)];
        f32x4 s[4];
#pragma unroll
        for (int j = 0; j < 4; ++j) s[j] = slab_sum<4>(slab, t0 + j, r, lane);
        const float rstd = rsqrtf(wave_sum(sx) * (0.5f / 2048.f) + EPS);
#pragma unroll
        for (int j = 0; j < 4; ++j) { f32x4 v = s[j] * rstd;
#pragma unroll
            for (int e = 0; e < 4; ++e) { const float a = fmaxf(v[e], 0.f); v[e] = a * a; }
            *(u32x2*)(A + (size_t)(TP + rs) * 8192 + (q * 4 + j) * 256 + lane * 4) = (u32x2){cvtpk(v[0], v[1]), cvtpk(v[2], v[3])}; } }
}

struct SchedB {
    const unsigned char* ws; int G, c;
    __device__ __forceinline__ bool next(int i, pg8::Unit& u) const {
        const long L = (long)i * G + c; constexpr int N0 = 34 * 7, N1 = 2 * 8; if (L >= N0 + N1) return false;
        int pm, pn; u.lda2 = 4096u; u.ldb2 = 4096u; u.nt = 32;
        if (L < N0) { pg8::tile_of((int)L, 34, 7, pm, pn); pn = pn < 4 ? pn : (pn < 6 ? pn + 2 : 36); u.A = (const char*)(ws + WS_H + (size_t)pm * 256 * 4096); u.B = (const char*)(ws + WS_WIN + (size_t)pn * 256 * 4096); u.kind = 0; }
        else { pg8::tile_of((int)L - N0, 2, 8, pm, pn); u.A = (const char*)(ws + WS_HM + (size_t)pm * 256 * 4096); u.B = (const char*)(ws + WS_WMEMKV + (size_t)pn * 256 * 4096); u.kind = 1; }
        u.pm = pm; u.pn = pn; return true;
    }
};
struct SchedB2 {
    const unsigned char* ws; int G, c;
    __device__ __forceinline__ bool next(int i, pg8::Unit& u) const {
        constexpr int NB1 = 34 * 7 + 16, NG = 34 * 24, NX = 34 * 6;
        const long L = (long)i * G + (c + G - NB1 % G) % G; if (L >= NG + NX) return false;
        int pm, pn; u.lda2 = 2048u; u.ldb2 = 2048u; u.nt = 16; u.kind = 0; u.aux = 0;
        if (L < NG) { pg8::tile_of((int)L, 34, 24, pm, pn); u.B = (const char*)(ws + WS_W8G + (size_t)pn * 256 * 2048); pn += 12; }
        else { pg8::tile_of((int)L - NG, 34, 6, pm, pn); u.B = (const char*)(ws + WS_W8X + (size_t)pn * 256 * 2048); pn = pn < 2 ? 4 + pn : 6 + pn; }
        u.A = (const char*)(ws + WS_H8 + (size_t)pm * 256 * 2048); u.pm = pm; u.pn = pn; return true;
    }
};
__device__ __forceinline__ void mem_unit(int u, int& row0, int& bsel, int& h) {
    h = u & 3;
    if (u < 128) { const int b = u >> 6, pt = (u >> 2) & 15; row0 = b * 4096 + pt * 256; bsel = b; }
    else { const int b = (u - 128) >> 2; row0 = TP + b * 32; bsel = 2 + b; }
}
struct SchedD1 {
    unsigned char* ws; unsigned char* ob; int G, c;
    __device__ __forceinline__ bool next(int i, pg8::Unit& u) const {
        const long L = (long)i * G + c; constexpr int N0 = (NBS * KPAD / 256) * 8; if (L >= N0) return false;
        int pm, pn; pg8::tile_of((int)L, NBS * KPAD / 256, 8, pm, pn);
        u.A = (const char*)l8_tile(ws, ob, pm); u.B = (const char*)(ws + WS_WKB8 + (size_t)pn * 256 * 512); u.lda2 = 512u; u.ldb2 = 512u; u.nt = 4; u.kind = 3; u.aux = 0; u.pm = pm; u.pn = pn; return true;
    }
};
struct SchedD2 {
    const unsigned char* ws; int G, c;
    __device__ __forceinline__ bool next(int i, pg8::Unit& u) const {
        constexpr int R0 = ((NBS * KPAD / 256) * 8) % 256, N1 = 34 * 12, N2 = N1 + 32 * 8, N3 = N2 + 32 * 8;
        const long L = (long)i * G + (c + G - R0 % G) % G; if (L >= N3) return false;
        int pm, pn; u.lda2 = 512u; u.ldb2 = 512u; u.nt = 4; u.aux = 0;
        if (L < N1) { pg8::tile_of((int)L, 34, 12, pm, pn); u.A = (const char*)(ws + WS_QN8 + (size_t)pm * 256 * 512); u.B = (const char*)(ws + WS_WQB8 + (size_t)pn * 256 * 512); u.kind = 0; }
        else if (L < N2) { pg8::tile_of((int)L - N1, 32, 8, pm, pn); u.A = (const char*)(ws + WS_CKV8 + (size_t)pm * 256 * 512); u.B = (const char*)(ws + WS_WKB8 + (size_t)pn * 256 * 512); u.kind = 1; }
        else { pg8::tile_of((int)L - N2, 32, 8, pm, pn); u.A = (const char*)(ws + WS_CKV8 + (size_t)pm * 256 * 512); u.B = (const char*)(ws + WS_WVB8 + (size_t)pn * 256 * 512); u.kind = 2; }
        u.pm = pm; u.pn = pn; return true;
    }
};
struct SchedD {
    const unsigned char* ws; const unsigned char* ob; int G, c;
    __device__ __forceinline__ bool next(int i, pg8::Unit& u) const {
        constexpr int R1 = (((NBS * KPAD / 256) * 8) % 256 + (34 * 12 + 2 * 32 * 8) % 256) % 256;
        const long L = (long)i * G + (c + G - R1 % G) % G; if (L >= 192) return false;
        int row0, bsel, h; mem_unit((int)L, row0, bsel, h);
        u.A = (const char*)(ws + WS_QM + ((size_t)row0 * 1024 + h * 256) * 2); u.B = (const char*)(ws + WS_MK + ((size_t)bsel * 262144 + h * 256) * 2); u.lda2 = 2048u; u.ldb2 = 2048u; u.nt = 4; u.aux = 0;
        u.kind = L < 128 ? 4 : 5; u.pm = row0; u.pn = h; return true;
    }
};
struct SchedMO {
    const unsigned char* ws; int G, c;
    __device__ __forceinline__ bool next(int i, pg8::Unit& u) const {
        const long L = (long)i * G + c; if (L >= 192) return false;
        int row0, bsel, h; mem_unit((int)L, row0, bsel, h);
        u.A = (const char*)(ws + WS_PM + ((size_t)row0 * 1024 + h * 256) * 2); u.B = (const char*)(ws + WS_MVT + ((size_t)bsel * 262144 + (size_t)h * 65536) * 2); u.lda2 = 2048u; u.ldb2 = 512u; u.nt = 4;
        u.kind = L < 128 ? 4 : 5; u.pm = row0; u.pn = h; u.aux = 0; return true;
    }
};
struct EpiMO {
    static constexpr bool PERM = true;
    const float* PS; bf16_t* O;
    __device__ __forceinline__ bool operator()(f32x4 (&acc)[2][2][4][2], const pg8::Unit& u, int wr, int wc, int fr_, int fq) const {
        int fr = fr_; asm volatile("" : "+v"(fr));
        const int c0 = u.pn * 256 + wc * 32 + 8 * fq;
        f32x4 sv[2][4];
#pragma unroll
        for (int ai = 0; ai < 2; ++ai)
#pragma unroll
            for (int m = 0; m < 4; ++m) { const int rl = ai * 128 + wr * 64 + m * 16 + fr; sv[ai][m] = *(const f32x4*)(PS + (size_t)(u.pm + ((u.kind == 5 && rl >= 32) ? 0 : rl)) * 16 + u.pn * 4); }
        asm volatile("" ::: "memory");
#pragma unroll
        for (int ai = 0; ai < 2; ++ai)
#pragma unroll
            for (int m = 0; m < 4; ++m) { const int rl = ai * 128 + wr * 64 + m * 16 + fr; if (u.kind == 5 && rl >= 32) continue;
                const size_t row = (size_t)(u.pm + rl); const f32x4 s4 = sv[ai][m];
                const float inv = __builtin_amdgcn_rcpf((s4.x + s4.y) + (s4.z + s4.w));
#pragma unroll
                for (int bj = 0; bj < 2; ++bj) { const f32x4 v0 = acc[ai][bj][m][0] * inv, v1 = acc[ai][bj][m][1] * inv;
                    *(u32x4*)(O + row * 1024 + c0 + bj * 128) = (u32x4){cvtpk(v0[0], v0[1]), cvtpk(v0[2], v0[3]), cvtpk(v1[0], v1[1]), cvtpk(v1[2], v1[3])}; } }
        return false;
    }
};

constexpr int CW_BAR = 4096, CW_QUEUE = 64;
#ifndef PROBE_K
#define PROBE_K -1
#endif
#ifndef PROBE_BX
#define PROBE_BX 0
#endif
#define STAMP(k) do { if (PROBE_K >= 0 && bx == 0 && tid == 0) { const unsigned long long t_ = __builtin_amdgcn_s_memrealtime(); MISC[32 + 2 * (k)] = (unsigned)t_; MISC[33 + 2 * (k)] = (unsigned)(t_ >> 32); } } while (0)
#ifndef ONLY
#define ONLY -1
#endif
#define PH(x) (ONLY < 0 || ONLY == (x))
__global__ void __launch_bounds__(NWAVES * 64, 2) mega_fwd(Args P) {
    extern __shared__ __attribute__((aligned(16))) unsigned char lds_raw[];
    LAS unsigned char* lds = (LAS unsigned char*)lds_raw;
    const int tid = threadIdx.x, lane = tid & 63, wave = __builtin_amdgcn_readfirstlane(tid >> 6);
    const int G = gridDim.x, bx = blockIdx.x;
    const int vcu = (G % 8 == 0) ? (bx % 8) * (G / 8) + bx / 8 : bx;
    const int gw = vcu * NWAVES + wave, NGW = G * NWAVES;
    volatile LAS unsigned* MISC = (volatile LAS unsigned*)(lds + MISC_OFF);
    if (tid < 64) MISC[tid] = 0u;
    __syncthreads();
    unsigned* ctl = (unsigned*)(P.ws + WS_CTL);
    XcdBarrier bar = xcd_barrier_post(ctl + CW_BAR, MISC + 8); bar.wv = wave;
    unsigned char* ws = P.ws;
    STAMP(0);

#define LAUNDER() int lane_l = lane_id(), gw_l = gw; asm volatile("" : "+v"(lane_l)); asm volatile("" : "+s"(gw_l))
    if (PH(0)) { LAUNDER(); phase_prep<1>(P, lds, gw_l, NGW, wave, lane_l); }
    xcd_barrier(bar); STAMP(1);
    if (PH(0)) { LAUNDER();
        if (NGW == 2048) {
            quant_rows2048<3>((const bf16_t*)(ws + WS_WIN) + (size_t)(3072 + gw_l) * 2048, (size_t)NGW * 2048, ws + WS_W8G + (size_t)gw_l * 2048, (size_t)NGW * 2048, (float*)(ws + WS_SBG) + gw_l, (size_t)NGW, lane_l);
            if (gw_l < 1536) { const int e = gw_l, wrow = e < 512 ? 1024 + e : 1536 + e;
                quant_row2048((const bf16_t*)(ws + WS_WIN) + (size_t)wrow * 2048, ws + WS_W8X + (size_t)e * 2048, (float*)(ws + WS_SBX) + e, lane_l); }
        } else
        for (int n = gw_l; n < 6144 + 1536; n += NGW) {
            if (n < 6144) quant_row2048((const bf16_t*)(ws + WS_WIN) + (size_t)(3072 + n) * 2048, ws + WS_W8G + (size_t)n * 2048, (float*)(ws + WS_SBG) + n, lane_l);
            else { const int e = n - 6144, wrow = e < 512 ? 1024 + e : 1536 + e;
                quant_row2048((const bf16_t*)(ws + WS_WIN) + (size_t)wrow * 2048, ws + WS_W8X + (size_t)e * 2048, (float*)(ws + WS_SBX) + e, lane_l); } } }
    xcd_barrier(bar);
    {
        const bool conv_first = ((bx >> 3) & 1) != 0;
        if (PH(0) && conv_first) { LAUNDER(); phase_prep<2>(P, lds, gw_l, NGW, wave, lane_l); __syncthreads(); }
        if (PH(1)) {
            { SchedB S{ws, G, bx}; EpiIn E{(bf16_t*)(ws + WS_ZS), (bf16_t*)(ws + WS_G), (float*)(ws + WS_M), P.in[I_BGATE], nullptr, nullptr, false, nullptr};
              pg8::gemm_stream<EpiIn, SchedB>(lds, S, E, wave); }
            __syncthreads();
            { SchedB2 S{ws, G, bx}; EpiIn E{(bf16_t*)(ws + WS_ZS), (bf16_t*)(ws + WS_G), (float*)(ws + WS_M), P.in[I_BGATE], (const float*)(ws + WS_SAH), (const float*)(ws + WS_SBG), true, (const float*)(ws + WS_SBX)};
              pg8::gemm_stream<EpiIn, SchedB2, true>(lds, S, E, wave); }
        }
        if (PH(0) && !conv_first) { __syncthreads(); LAUNDER(); phase_prep<2>(P, lds, gw_l, NGW, wave, lane_l); }
    }
    xcd_barrier(bar); STAMP(2);
    if (PH(2)) { LAUNDER(); phase_rows(P, lds, gw_l, NGW, wave, lane_l); }
    xcd_barrier(bar); STAMP(3);
    if (PH(3)) {
#define EPIQKV_INIT(I8FLAG) {(bf16_t*)(ws + WS_Q), (bf16_t*)((unsigned char*)P.out + DO_K), (bf16_t*)(ws + WS_V), (float*)(ws + WS_RKG), (bf16_t*)(ws + WS_PM), (float*)(ws + WS_PS), \
                 (const float*)(ws + WS_KPESS), (const float*)(ws + WS_KPESSP), (const bf16_t*)(ws + WS_KRP), P.in[I_GKHEAD], lds, (const float*)(ws + WS_SA), (const float*)(ws + WS_SB), \
                 (const float*)(ws + WS_SAQ), I8FLAG}
        { const EpiQKV<1> E1 EPIQKV_INIT(true); SchedD1 S1{ws, (unsigned char*)P.out, G, bx}; pg8::gemm_stream<EpiQKV<1>, SchedD1, true>(lds, S1, E1, wave); }
        __syncthreads();
        { const EpiQKV<2> E2 EPIQKV_INIT(true); SchedD2 S2{ws, G, bx}; pg8::gemm_stream<EpiQKV<2>, SchedD2, true>(lds, S2, E2, wave); }
        __syncthreads();
        const EpiQKV<0> Eb EPIQKV_INIT(false);
        SchedD S{ws, (const unsigned char*)P.out, G, bx};
        pg8::gemm_stream<EpiQKV<0>, SchedD>(lds, S, Eb, wave);
    }
    xcd_barrier(bar); STAMP(4);
    {
        const bf16_t* Qg = (const bf16_t*)(ws + WS_Q); const bf16_t* Kg = (const bf16_t*)((unsigned char*)P.out + DO_K); const bf16_t* Vg = (const bf16_t*)(ws + WS_V);
        bf16_t* Og = (bf16_t*)(ws + WS_OMLA);
        constexpr int NI_P = 512;
#define DEQUEUE(qw) ({ LAS unsigned* mq_ = (LAS unsigned*)(lds + MISC_OFF + 64); asm volatile("" : "+s"(mq_));   \
        if (wave == 0 && lane_id() == 0) *(volatile LAS unsigned*)mq_ = __hip_atomic_fetch_add(ctl + (qw), 1u, __ATOMIC_RELAXED, __HIP_MEMORY_SCOPE_AGENT); __syncthreads(); const int it_ = (int)*(volatile LAS unsigned*)mq_; __syncthreads(); it_; })
#define PROBE_BEGIN() const bool pr_ = PROBE_K >= 20 && bx == PROBE_BX && tid == 0; unsigned long long ts_ = 0; if (pr_) ts_ = __builtin_amdgcn_s_memrealtime()
#define PROBE_END(pk) do { if (pr_ && (pk) == PROBE_K && MISC[20] == 0u) { MISC[20] = 1u; MISC[21] = (unsigned)(__builtin_amdgcn_s_memrealtime() - ts_); } } while (0)
        if (PH(7)) { SchedMO S{ws, G, bx}; EpiMO E{(const float*)(ws + WS_PS), (bf16_t*)(ws + WS_OMEM)};
            pg8::gemm_stream<EpiMO, SchedMO>(lds, S, E, wave); __syncthreads(); }
        const int xq = (int)(bar.x & 7u);
        unsigned long long tf0_ = 0; if (PROBE_K >= 40 && tid == 0) tf0_ = __builtin_amdgcn_s_memrealtime();
#define LOOP_T0() unsigned long long tl_ = 0; if (PROBE_K >= 23 && PROBE_K < 40 && bx == 0 && tid == 0) tl_ = __builtin_amdgcn_s_memrealtime()
#define LOOP_T1(pk) do { if (PROBE_K == (pk) && bx == 0 && tid == 0) MISC[21] = (unsigned)(__builtin_amdgcn_s_memrealtime() - tl_); \
        if (PROBE_K >= 40 && tid == 0) ctl[8192 + ((pk) - 23) * 256 + bx] = (unsigned)(__builtin_amdgcn_s_memrealtime() - tf0_); } while (0)
        { LOOP_T0();
        if (PH(6)) for (;;) { const int it = DEQUEUE(CW_QUEUE + 64 * (1 + xq)); if (it >= 16) break; PROBE_BEGIN();
            sat::unit(P, 2 * xq + (it & 1), it >> 1, (LAS char*)lds, wave); PROBE_END(20); }
        LOOP_T1(23); }
        if (PH(6)) for (int qq = 1; qq < 8; ++qq) { const int q = (xq + qq) & 7;
            for (;;) { const int it = DEQUEUE(CW_QUEUE + 64 * (1 + q)); if (it >= 16) break; sat::unit(P, 2 * q + (it & 1), it >> 1, (LAS char*)lds, wave); } }
        { LOOP_T0();
        if (PH(5)) for (;;) { const int it = DEQUEUE(CW_QUEUE + 64 * 9); if (it >= NI_P) break; PROBE_BEGIN();
            const int qb = 15 - (it >> 5), bh = it & 31, b = bh >> 4, h = bh & 15;
            pat::unit(Qg + ((size_t)(b * 4096 + qb * 256) * QLD + h * 192), Kg + ((size_t)b * 4096 * QLD + h * 192), Vg + ((size_t)b * 4096 * 2048 + h * 128),
                      Og + ((size_t)(b * 4096 + qb * 256) * 2048 + h * 128), qb, (LAS char*)lds, P.in[I_GQHEAD], wave); PROBE_END(21);
            if (pr_ && PROBE_K == 26) MISC[21] += (unsigned)(__builtin_amdgcn_s_memrealtime() - ts_);
            if (pr_ && PROBE_K == 27) MISC[21] += 25u * (unsigned)(4 * qb + 4); }
        LOOP_T1(24); }
    }
    xcd_barrier(bar); STAMP(5);
    if (PROBE_K >= 40 && bx == 0 && tid == 0) {
        const int lp = (PROBE_K - 40) >> 1; unsigned long long sum = 0; unsigned mx = 0;
        for (int i = 0; i < G; ++i) { const unsigned v = __hip_atomic_load(ctl + 8192 + lp * 256 + i, __ATOMIC_RELAXED, __HIP_MEMORY_SCOPE_AGENT); sum += v; mx = v > mx ? v : mx; }
        MISC[21] = (PROBE_K & 1) ? mx : (unsigned)(sum / G); }
    if (PH(8)) {
        MergeSched S{(const bf16_t*)(ws + WS_DP), (const bf16_t*)(ws + WS_WPOOL), (const bf16_t*)(ws + WS_OMLA), (const bf16_t*)(ws + WS_WMLAO),
                     (const bf16_t*)(ws + WS_OMEM), (const bf16_t*)(ws + WS_WMEMO), G, bx};
        EpiMerge E{(const bf16_t*)(ws + WS_G), P.in[I_PSCALE], (bf16_t*)(ws + WS_MG), ws + WS_Q};
        pg8::gemm_stream<EpiMerge, MergeSched>(lds, S, E, wave);
        xcd_barrier(bar); STAMP(6);
        { LAUNDER(); reduce_merge(ws + WS_Q, (bf16_t*)(ws + WS_MG), gw_l, NGW, lane_l);
          if (NGW * 4 == 8192) quant_rows2048<4>((const bf16_t*)(ws + WS_WUP) + (size_t)gw_l * 2048, (size_t)NGW * 2048, ws + WS_WUP8 + (size_t)gw_l * 2048, (size_t)NGW * 2048, (float*)(ws + WS_SBU) + gw_l, (size_t)NGW, lane_l);
          else for (int n = gw_l; n < 8192; n += NGW) quant_row2048((const bf16_t*)(ws + WS_WUP) + (size_t)n * 2048, ws + WS_WUP8 + (size_t)n * 2048, (float*)(ws + WS_SBU) + n, lane_l); }
    }
    xcd_barrier(bar); STAMP(7);
    if (PH(9)) {
        TailSched S{(const bf16_t*)(ws + WS_MG), (const bf16_t*)(ws + WS_WOUT), 2048, G, bx};
        EpiOut E{P.in[I_XP], P.in[I_XS], P.out + O_YP, (bf16_t*)(ws + WS_X1B), (float*)(ws + WS_SSX), ws + WS_G};
        pg8::gemm_stream<EpiOut, TailSched>(lds, S, E, wave);
        xcd_barrier(bar); STAMP(8);
        { LAUNDER(); reduce_out(ws + WS_G, P.in[I_XS], P.out + O_YP, (bf16_t*)(ws + WS_X1B), (float*)(ws + WS_SSX), gw_l, NGW, lane_l);
          if (NGW * 4 == TP) quant_rows2048<4>((const bf16_t*)(ws + WS_X1B) + (size_t)gw_l * 2048, (size_t)NGW * 2048, ws + WS_X8 + (size_t)gw_l * 2048, (size_t)NGW * 2048, (float*)(ws + WS_SAX) + gw_l, (size_t)NGW, lane_l, (const float*)(ws + WS_SSX) + (size_t)gw_l * 32, (size_t)NGW * 32);
          else for (int n = gw_l; n < TP; n += NGW) quant_rows2048<1>((const bf16_t*)(ws + WS_X1B) + (size_t)n * 2048, 0, ws + WS_X8 + (size_t)n * 2048, 0, (float*)(ws + WS_SAX) + n, 0, lane_l, (const float*)(ws + WS_SSX) + (size_t)n * 32, 0); }
    }
    xcd_barrier(bar); STAMP(9);
    if (PH(10)) {
        EpiUp E{(const float*)(ws + WS_SSX), (bf16_t*)(ws + WS_A), ws + WS_H, (const float*)(ws + WS_SAX), (const float*)(ws + WS_SBU)};
        { SchedJ S{ws + WS_X8, ws + WS_WUP8, G, bx}; pg8::gemm_stream<EpiUp, SchedJ, true>(lds, S, E, wave); }
        __syncthreads();
        { SchedJp S{(const bf16_t*)(ws + WS_X1B), (const bf16_t*)(ws + WS_WUP), G, bx}; pg8::gemm_stream<EpiUp, SchedJp>(lds, S, E, wave); }
        xcd_barrier(bar);
        { LAUNDER(); reduce_up(ws + WS_H, (const float*)(ws + WS_SSX), (bf16_t*)(ws + WS_A), gw_l, NGW, lane_l); }
    }
    xcd_barrier(bar); STAMP(10);
    if (PH(11)) {
        TailSched S{(const bf16_t*)(ws + WS_A), (const bf16_t*)(ws + WS_WDOWN), 8192, G, bx};
        EpiDown E{P.out + O_YP, (const bf16_t*)(ws + WS_X1B), ws + WS_H};
        pg8::gemm_stream<EpiDown, TailSched>(lds, S, E, wave);
        xcd_barrier(bar); STAMP(11);
        { LAUNDER(); reduce_down(ws + WS_H, (const bf16_t*)(ws + WS_X1B), P.out + O_YP, gw_l, NGW, lane_l); }
    }
    if (PROBE_K == 30 && bx == 0) {
        __syncthreads(); unsigned long long ti_ = 0; if (tid == 0) ti_ = __builtin_amdgcn_s_memrealtime();
        pat::unit((const bf16_t*)(ws + WS_Q) + ((size_t)(15 * 256) * QLD), (const bf16_t*)((unsigned char*)P.out + DO_K), (const bf16_t*)(ws + WS_V), (bf16_t*)(ws + WS_OMLA) + ((size_t)(15 * 256) * 2048), 15, (LAS char*)lds, P.in[I_GQHEAD], wave);
        if (tid == 0) MISC[21] = (unsigned)(__builtin_amdgcn_s_memrealtime() - ti_);
    }
    if (PROBE_K == 32 || PROBE_K == 33) {
        __syncthreads(); unsigned long long ti_ = 0; if (tid == 0) ti_ = __builtin_amdgcn_s_memrealtime();
        const int bh_ = PROBE_K == 32 ? (bx & 31) : ((bx >> 3) & 31), b_ = bh_ >> 4, h_ = bh_ & 15;
        pat::unit((const bf16_t*)(ws + WS_Q) + ((size_t)(b_ * 4096 + 15 * 256) * QLD + h_ * 192), (const bf16_t*)((unsigned char*)P.out + DO_K) + ((size_t)b_ * 4096 * QLD + h_ * 192),
                  (const bf16_t*)(ws + WS_V) + ((size_t)b_ * 4096 * 2048 + h_ * 128), (bf16_t*)(ws + WS_OMLA) + ((size_t)(b_ * 4096 + 15 * 256) * 2048 + h_ * 128), 15, (LAS char*)lds, P.in[I_GQHEAD], wave);
        if (tid == 0 && bx == 0) MISC[21] = (unsigned)(__builtin_amdgcn_s_memrealtime() - ti_);
    }
    if ((PROBE_K == 34 || PROBE_K == 35) && bx == 0) {
        __syncthreads(); unsigned long long ti_ = 0; if (tid == 0) ti_ = __builtin_amdgcn_s_memrealtime();
        sat::unit<PROBE_K == 34 ? 1 : 2>(P, 0, 0, (LAS char*)lds, wave);
        if (tid == 0) MISC[21] = (unsigned)(__builtin_amdgcn_s_memrealtime() - ti_);
    }
    if (PROBE_K == 31 && bx == 0) {
        __syncthreads(); unsigned long long ti_ = 0; if (tid == 0) ti_ = __builtin_amdgcn_s_memrealtime();
        sat::unit(P, 0, 0, (LAS char*)lds, wave);
        if (tid == 0) MISC[21] = (unsigned)(__builtin_amdgcn_s_memrealtime() - ti_);
    }
    if (PROBE_K >= 0 && bx == 0) {
        __syncthreads();
        if (tid == 0) { STAMP(12);
            constexpr int PKI = PROBE_K >= 0 && PROBE_K < 13 ? PROBE_K : 0;
            const unsigned long long a_ = ((unsigned long long)MISC[33 + 2 * PKI] << 32) | MISC[32 + 2 * PKI], b_ = ((unsigned long long)MISC[35 + 2 * PKI] << 32) | MISC[34 + 2 * PKI];
            const unsigned long long t0_ = __builtin_amdgcn_s_memrealtime(), dl_ = PROBE_K >= 20 ? 4ull * MISC[21] : 4ull * (b_ - a_);
            while (__builtin_amdgcn_s_memrealtime() - t0_ < dl_) __builtin_amdgcn_s_sleep(16); }
    }
}

extern "C" void kernel_launch(void* const* d_in, const int* in_sizes, int n_in, void* d_out, int out_size, void* d_ws, size_t ws_size, hipStream_t stream) {
    static int grid = 0;
    if (grid == 0) {
        if (n_in != 30 || ws_size < WS_END || out_size != 24164352) { fprintf(stderr, "kernel_launch: unexpected problem: n_in %d out %d ws %zu (need %zu)\n", n_in, out_size, ws_size, (size_t)WS_END); grid = -1; return; }
        int dev = 0, cus = 0, per_cu = 0;
        if (hipGetDevice(&dev) != hipSuccess || hipDeviceGetAttribute(&cus, hipDeviceAttributeMultiprocessorCount, dev) != hipSuccess) { grid = -1; return; }
        if (hipFuncSetAttribute((const void*)mega_fwd, hipFuncAttributeMaxDynamicSharedMemorySize, LDS_BYTES) != hipSuccess) { fprintf(stderr, "kernel_launch: hipFuncSetAttribute(%d) failed\n", LDS_BYTES); grid = -1; return; }
        if (hipOccupancyMaxActiveBlocksPerMultiprocessor(&per_cu, (const void*)mega_fwd, NWAVES * 64, LDS_BYTES) != hipSuccess || per_cu < 1) { fprintf(stderr, "kernel_launch: occupancy query says %d blocks per CU\n", per_cu); grid = -1; (void)hipGetLastError(); return; }
        grid = cus;
    }
    if (grid < 0) return;
    (void)hipMemsetAsync((char*)d_ws + WS_CTL, 0, CTL_ZERO_BYTES, stream);
    Args a{};
    for (int i = 0; i < 30; ++i) a.in[i] = (const float*)d_in[i];
    a.out = (float*)d_out; a.ws = (unsigned char*)d_ws;
    hipLaunchKernelGGL(mega_fwd, dim3(grid), dim3(NWAVES * 64), LDS_BYTES, stream, a);
}
```
